# Optimizing an MI355X kernel written in HIP

```python
import math
import jax, jax.numpy as jnp
from jax import lax
import numpy as np

D_MODEL = 1024
BATCH = 8
SEQ = 4096
DEPTH = 4

N_BRANCH = 4
D_BRANCH = 256
S5_GROUP = 16
S5_GROUPS = D_BRANCH // S5_GROUP
S5_STATE = 64
HEAD_DIM = 64
FOX_HEADS = D_BRANCH // HEAD_DIM
SB_HEADS = D_BRANCH // HEAD_DIM
Q_BLOCK = 128
CONV_WIDTH = 31
D_FF = 2816
N_EXPERTS = 8
TOP_K = 2
D_FF_EXPERT = 2816
N_DENSE = (DEPTH + 1) // 2
N_MOE = DEPTH // 2
EPS = 1e-6

N_S5_IN = D_BRANCH
N_FOX_QKV = 3 * D_BRANCH
N_FOX_F = FOX_HEADS
N_CONV_IN = 2 * D_BRANCH
N_SB_QKV = 3 * D_BRANCH
N_GATES = N_BRANCH * D_MODEL
D_PROJ = N_S5_IN + N_FOX_QKV + N_FOX_F + N_CONV_IN + N_SB_QKV + N_GATES
SPLIT_POINTS = [N_S5_IN,
                N_S5_IN + N_FOX_QKV,
                N_S5_IN + N_FOX_QKV + N_FOX_F,
                N_S5_IN + N_FOX_QKV + N_FOX_F + N_CONV_IN,
                N_S5_IN + N_FOX_QKV + N_FOX_F + N_CONV_IN + N_SB_QKV]

kernel_name = "hybrid_s5_fox_conformer_stickbreak_moe"


def rms_norm(x, g):
    xf = x.astype(jnp.float32)
    y = xf * lax.rsqrt(jnp.mean(xf * xf, axis=-1, keepdims=True) + EPS)
    return (y * g.astype(jnp.float32)).astype(x.dtype)


def layer_norm(x, g, b):
    xf = x.astype(jnp.float32)
    mu = jnp.mean(xf, axis=-1, keepdims=True)
    var = jnp.mean(jnp.square(xf - mu), axis=-1, keepdims=True)
    y = (xf - mu) * lax.rsqrt(var + EPS)
    return (y * g.astype(jnp.float32) + b.astype(jnp.float32)).astype(x.dtype)


def split_heads(t, n_heads):
    b, l, _ = t.shape
    return t.reshape(b, l, n_heads, HEAD_DIM).transpose(0, 2, 1, 3)


def merge_blocks(o):
    nb, b, h, qb, dh = o.shape
    return o.transpose(1, 0, 3, 2, 4).reshape(b, nb * qb, h * dh)


def forgetting_attention(q, k, v, log_f):
    seq = q.shape[2]
    scale = 1.0 / math.sqrt(HEAD_DIM)
    cum = jnp.cumsum(log_f, axis=-1)
    kpos = jnp.arange(seq)

    def block(i):
        start = i * Q_BLOCK
        qb = lax.dynamic_slice_in_dim(q, start, Q_BLOCK, axis=2)
        cq = lax.dynamic_slice_in_dim(cum, start, Q_BLOCK, axis=2)
        qpos = start + jnp.arange(Q_BLOCK)
        s = jnp.einsum("bhqd,bhkd->bhqk", qb, k).astype(jnp.float32) * scale
        s = s + cq[..., :, None] - cum[..., None, :]
        causal = kpos[None, :] <= qpos[:, None]
        s = jnp.where(causal, s, -jnp.inf)
        p = jax.nn.softmax(s, axis=-1)
        return jnp.einsum("bhqk,bhkd->bhqd", p.astype(v.dtype), v)

    return merge_blocks(lax.map(block, jnp.arange(seq // Q_BLOCK)))


def stick_breaking_attention(q, k, v):
    seq = q.shape[2]
    scale = 1.0 / math.sqrt(HEAD_DIM)
    kpos = jnp.arange(seq)

    def block(i):
        start = i * Q_BLOCK
        qb = lax.dynamic_slice_in_dim(q, start, Q_BLOCK, axis=2)
        qpos = start + jnp.arange(Q_BLOCK)
        z = jnp.einsum("bhqd,bhkd->bhqk", qb, k).astype(jnp.float32) * scale
        past = kpos[None, :] < qpos[:, None]
        log_beta = jax.nn.log_sigmoid(z)
        log_keep = jnp.where(past, jax.nn.log_sigmoid(-z), 0.0)
        after = lax.cumsum(log_keep, axis=3, reverse=True) - log_keep
        a = jnp.where(past, jnp.exp(log_beta + after), 0.0)
        return jnp.einsum("bhqk,bhkd->bhqd", a.astype(v.dtype), v)

    return merge_blocks(lax.map(block, jnp.arange(seq // Q_BLOCK)))


def _s5_combine(e1, e2):
    a1r, a1i, b1r, b1i = e1
    a2r, a2i, b2r, b2i = e2
    return (a2r * a1r - a2i * a1i,
            a2r * a1i + a2i * a1r,
            a2r * b1r - a2i * b1i + b2r,
            a2r * b1i + a2i * b1r + b2i)


def s5_ssm(u, lam_re, lam_im, log_dt, b_re, b_im, c_re, c_im, d_skip):
    bsz, seq, _ = u.shape
    f32 = jnp.float32
    uf = u.astype(f32)
    ug = uf.reshape(bsz, seq, S5_GROUPS, S5_GROUP)
    lam_re, lam_im = lam_re.astype(f32), lam_im.astype(f32)
    dt = jnp.exp(log_dt.astype(f32))[:, None]
    mag = jnp.exp(lam_re * dt)
    ab_re = mag * jnp.cos(lam_im * dt)
    ab_im = mag * jnp.sin(lam_im * dt)
    nr, ni = ab_re - 1.0, ab_im
    den = lam_re * lam_re + lam_im * lam_im
    k_re = (nr * lam_re + ni * lam_im) / den
    k_im = (ni * lam_re - nr * lam_im) / den
    b_re, b_im = b_re.astype(f32), b_im.astype(f32)
    bb_re = k_re[..., None] * b_re - k_im[..., None] * b_im
    bb_im = k_re[..., None] * b_im + k_im[..., None] * b_re
    bu_re = jnp.einsum("blgh,gph->blgp", ug, bb_re)
    bu_im = jnp.einsum("blgh,gph->blgp", ug, bb_im)
    a_re = jnp.broadcast_to(ab_re, bu_re.shape)
    a_im = jnp.broadcast_to(ab_im, bu_im.shape)
    _, _, s_re, s_im = lax.associative_scan(_s5_combine, (a_re, a_im, bu_re, bu_im), axis=1)
    y = (jnp.einsum("blgp,ghp->blgh", s_re, c_re.astype(f32))
         - jnp.einsum("blgp,ghp->blgh", s_im, c_im.astype(f32)))
    y = y.reshape(bsz, seq, D_BRANCH) + d_skip.astype(f32) * uf
    return y.astype(u.dtype)


def conformer_conv(ab, w_dw, b_dw, ln_g, ln_b):
    a, b = jnp.split(ab, 2, axis=-1)
    u = a * jax.nn.sigmoid(b)
    u = lax.conv_general_dilated(u, w_dw[:, None, :], window_strides=(1,),
                                 padding=[(CONV_WIDTH - 1, 0)],
                                 dimension_numbers=("NWC", "WIO", "NWC"),
                                 feature_group_count=D_BRANCH) + b_dw
    u = layer_norm(u, ln_g, ln_b)
    return jax.nn.silu(u)


def swiglu(h, w1, w3, w2):
    return (jax.nn.silu(h @ w1) * (h @ w3)) @ w2


def moe_ffn(h, w_router, b_router, w1, w3, w2):
    bsz, seq, d = h.shape
    ht = h.reshape(bsz * seq, d)
    logits = ht.astype(jnp.float32) @ w_router.astype(jnp.float32) + b_router.astype(jnp.float32)
    top_val, top_idx = lax.top_k(logits, TOP_K)
    top_w = jax.nn.softmax(top_val, axis=-1)
    combine = jnp.sum(jax.nn.one_hot(top_idx, N_EXPERTS, dtype=jnp.float32) * top_w[..., None], axis=1)
    combine = combine.astype(h.dtype)
    y = jnp.zeros_like(ht)
    for e in range(N_EXPERTS):
        y = y + combine[:, e:e + 1] * swiglu(ht, w1[e], w3[e], w2[e])
    return y.reshape(bsz, seq, d)


def setup_inputs(seed: int = 0) -> dict:
    key = jax.random.key(seed)
    ks = jax.random.split(key, 40)
    f32 = jnp.float32

    def nrm(k, shape, scale):
        return jax.random.normal(k, shape, f32) * scale

    def gain(k, shape):
        return 1.0 + nrm(k, shape, 0.02)

    G, P, H = S5_GROUPS, S5_STATE, S5_GROUP
    lam_im_init = jnp.pi * jnp.arange(P, dtype=f32)
    return {
        "x": nrm(ks[0], (BATCH, SEQ, D_MODEL), 1.0),
        "g_mix": gain(ks[1], (DEPTH, D_MODEL)),
        "w_in": nrm(ks[2], (DEPTH, D_MODEL, D_PROJ), D_MODEL ** -0.5),
        "b_forget": jax.random.uniform(ks[3], (DEPTH, FOX_HEADS), f32, 1.0, 4.0),
        "fox_q_gain": gain(ks[4], (DEPTH, HEAD_DIM)),
        "fox_k_gain": gain(ks[5], (DEPTH, HEAD_DIM)),
        "sb_q_gain": gain(ks[6], (DEPTH, HEAD_DIM)),
        "sb_k_gain": gain(ks[7], (DEPTH, HEAD_DIM)),
        "s5_lam_re": -0.5 + nrm(ks[8], (DEPTH, G, P), 0.01),
        "s5_lam_im": lam_im_init + nrm(ks[9], (DEPTH, G, P), 0.01),
        "s5_log_dt": jax.random.uniform(ks[10], (DEPTH, G), f32, math.log(1e-3), math.log(1e-1)),
        "s5_b_re": nrm(ks[11], (DEPTH, G, P, H), (2 * H) ** -0.5),
        "s5_b_im": nrm(ks[12], (DEPTH, G, P, H), (2 * H) ** -0.5),
        "s5_c_re": nrm(ks[13], (DEPTH, G, H, P), P ** -0.5),
        "s5_c_im": nrm(ks[14], (DEPTH, G, H, P), P ** -0.5),
        "s5_d": nrm(ks[15], (DEPTH, D_BRANCH), 1.0),
        "s5_w_glu": nrm(ks[16], (DEPTH, D_BRANCH, D_BRANCH), D_BRANCH ** -0.5),
        "conv_w": nrm(ks[17], (DEPTH, CONV_WIDTH, D_BRANCH), CONV_WIDTH ** -0.5),
        "conv_b": nrm(ks[18], (DEPTH, D_BRANCH), 0.02),
        "conv_ln_g": gain(ks[19], (DEPTH, D_BRANCH)),
        "conv_ln_b": nrm(ks[20], (DEPTH, D_BRANCH), 0.02),
        "w_branch": nrm(ks[21], (DEPTH, N_BRANCH, D_BRANCH, D_MODEL), D_BRANCH ** -0.5),
        "w_out": nrm(ks[22], (DEPTH, D_MODEL, D_MODEL), D_MODEL ** -0.5),
        "g_ffn": gain(ks[23], (DEPTH, D_MODEL)),
        "ffn_w1": nrm(ks[24], (N_DENSE, D_MODEL, D_FF), D_MODEL ** -0.5),
        "ffn_w3": nrm(ks[25], (N_DENSE, D_MODEL, D_FF), D_MODEL ** -0.5),
        "ffn_w2": nrm(ks[26], (N_DENSE, D_FF, D_MODEL), D_FF ** -0.5),
        "router_w": nrm(ks[27], (N_MOE, D_MODEL, N_EXPERTS), D_MODEL ** -0.5),
        "router_b": nrm(ks[28], (N_MOE, N_EXPERTS), 0.01),
        "moe_w1": nrm(ks[29], (N_MOE, N_EXPERTS, D_MODEL, D_FF_EXPERT), D_MODEL ** -0.5),
        "moe_w3": nrm(ks[30], (N_MOE, N_EXPERTS, D_MODEL, D_FF_EXPERT), D_MODEL ** -0.5),
        "moe_w2": nrm(ks[31], (N_MOE, N_EXPERTS, D_FF_EXPERT, D_MODEL), D_FF_EXPERT ** -0.5),
    }


def reference(x, g_mix, w_in, b_forget, fox_q_gain, fox_k_gain, sb_q_gain, sb_k_gain,
              s5_lam_re, s5_lam_im, s5_log_dt, s5_b_re, s5_b_im, s5_c_re, s5_c_im, s5_d, s5_w_glu,
              conv_w, conv_b, conv_ln_g, conv_ln_b, w_branch, w_out, g_ffn,
              ffn_w1, ffn_w3, ffn_w2, router_w, router_b, moe_w1, moe_w3, moe_w2):
    bsz, seq = x.shape[0], x.shape[1]
    for i in range(DEPTH):
        h = rms_norm(x, g_mix[i])
        proj = h @ w_in[i]
        u_s5, qkv_f, f_logit, conv_ab, qkv_sb, gate_logit = jnp.split(proj, SPLIT_POINTS, axis=-1)

        y_s5 = s5_ssm(u_s5, s5_lam_re[i], s5_lam_im[i], s5_log_dt[i], s5_b_re[i], s5_b_im[i],
                      s5_c_re[i], s5_c_im[i], s5_d[i])
        y_s5 = jax.nn.gelu(y_s5)
        y_s5 = y_s5 * jax.nn.sigmoid(y_s5 @ s5_w_glu[i])

        qf, kf, vf = [split_heads(t, FOX_HEADS) for t in jnp.split(qkv_f, 3, axis=-1)]
        qf, kf = rms_norm(qf, fox_q_gain[i]), rms_norm(kf, fox_k_gain[i])
        log_f = jax.nn.log_sigmoid(f_logit.astype(jnp.float32) + b_forget[i].astype(jnp.float32))
        y_fox = forgetting_attention(qf, kf, vf, log_f.transpose(0, 2, 1))

        y_conv = conformer_conv(conv_ab, conv_w[i], conv_b[i], conv_ln_g[i], conv_ln_b[i])

        qs, ks_, vs = [split_heads(t, SB_HEADS) for t in jnp.split(qkv_sb, 3, axis=-1)]
        qs, ks_ = rms_norm(qs, sb_q_gain[i]), rms_norm(ks_, sb_k_gain[i])
        y_sb = stick_breaking_attention(qs, ks_, vs)

        ys = jnp.stack([y_s5.astype(x.dtype), y_fox.astype(x.dtype),
                        y_conv.astype(x.dtype), y_sb.astype(x.dtype)], axis=2)
        gates = jax.nn.sigmoid(gate_logit.reshape(bsz, seq, N_BRANCH, D_MODEL))
        merged = jnp.sum(gates * jnp.einsum("blnc,ncd->blnd", ys, w_branch[i]), axis=2)
        x = x + merged @ w_out[i]

        h = rms_norm(x, g_ffn[i])
        j = i // 2
        if i % 2 == 0:
            ffn = swiglu(h, ffn_w1[j], ffn_w3[j], ffn_w2[j])
        else:
            ffn = moe_ffn(h, router_w[j], router_b[j], moe_w1[j], moe_w3[j], moe_w2[j])
        x = x + ffn
    return x
```

```cpp
#include <hip/hip_runtime.h>
#include <cstdio>
#include <cstdint>

#ifndef F8_DENSE_MASK
#define F8_DENSE_MASK 4
#endif
#define DENSE8(layer) (((F8_DENSE_MASK) >> (layer)) & 1)
#ifndef F8_MOE_UP
#define F8_MOE_UP 1
#endif
#ifndef FUSE_DENSE_NORM
#define FUSE_DENSE_NORM 1
#endif
#ifndef GATE8
#define GATE8 2
#endif
#ifndef BR_WG
#define BR_WG 4
#endif
#ifndef F8_GATES
#define F8_GATES 1
#endif
#ifndef F8_MOE_DN
#define F8_MOE_DN 1
#endif

#define GAS __attribute__((address_space(1)))
#define LAS __attribute__((address_space(3)))
typedef unsigned short bf16;
typedef unsigned v4u __attribute__((ext_vector_type(4)));
typedef unsigned v2u __attribute__((ext_vector_type(2)));
typedef float f32x4 __attribute__((ext_vector_type(4)));
typedef float f32x2 __attribute__((ext_vector_type(2)));
typedef short bf16x8 __attribute__((ext_vector_type(8)));

constexpr int NB = 8, SEQ = 4096, D = 1024, DEPTH = 4, T = NB * SEQ;
constexpr int DP = 6404, NPROJ = 6400, FF = 2816, NE = 8;
constexpr float EPS = 1e-6f, LOG2E = 1.4426950408889634f;
constexpr float QSCALE = 0.125f * LOG2E;
constexpr int MOE_ROWS = 2 * T + NE * 256;
constexpr int S5_LDA = 1152;

constexpr size_t MiB = 1u << 20;
constexpr size_t WS_CTL = 0, CTL_ZERO_BYTES = 1 * MiB;
constexpr size_t WS_DUMMY = 768 * 1024;
constexpr size_t WS_WIN = 1 * MiB;
constexpr size_t WS_WIN8 = WS_WIN + (size_t)2304 * D * 2;
constexpr size_t WS_WBR = WS_WIN + (size_t)NPROJ * D * 2;
constexpr size_t WS_WOUT = WS_WBR + 2 * MiB;
constexpr size_t WS_WGLU = WS_WOUT + 2 * MiB;
constexpr size_t WS_WZ = WS_WGLU + 128 * 1024;
constexpr size_t WS_WY = WS_WZ + 8 * MiB;
constexpr size_t WS_WUP = WS_WY + 36 * MiB;
constexpr size_t WS_WDN = WS_WUP + 88 * MiB;
constexpr size_t WS_KFUN = WS_WDN + 44 * MiB;
constexpr size_t WS_ROUTE = WS_KFUN + 1 * MiB;
constexpr size_t WS_LF = WS_ROUTE + 1 * MiB;
constexpr size_t WS_CUM = WS_LF + 512 * 1024;
constexpr size_t WS_XN = 198 * MiB;
static_assert(WS_CUM + 512 * 1024 <= WS_XN, "ws map");
constexpr size_t WS_R = WS_XN + 64 * MiB;
constexpr size_t WS_GATE = WS_R;
constexpr size_t WS_QKV = WS_GATE + 256 * MiB;
constexpr size_t WS_UC = WS_QKV + 96 * MiB;
constexpr size_t WS_UA = WS_UC + 16 * MiB;
constexpr size_t WS_Z = WS_UA + 18 * MiB;
constexpr size_t WS_YP = WS_Z + 4 * MiB;
constexpr size_t WS_YCAT = WS_YP + 16 * MiB;
constexpr size_t WS_MIX_END = WS_YCAT + 64 * MiB;
constexpr size_t WS_XN8 = WS_YCAT;
constexpr size_t WS_HH = WS_R;
constexpr size_t WS_XNP = WS_R;
constexpr size_t WS_HP = WS_XNP + (size_t)NE * T * D;
constexpr size_t WS_FFN_END = WS_HP + (size_t)MOE_ROWS * FF;
static_assert(F8_MOE_UP && F8_MOE_DN, "the MoE path stores its rows and hidden activations as e4m3 bytes");
constexpr size_t WS_XB = ((WS_MIX_END > WS_FFN_END ? WS_MIX_END : WS_FFN_END) + MiB - 1) / MiB * MiB;
constexpr size_t WS_SSP = WS_XB + 64 * MiB;
constexpr size_t WS_END = WS_SSP + 2 * MiB;
static_assert(WS_END <= 856 * MiB, "ws budget");
constexpr int CW_BAR = 4096;
constexpr int CW_Q = 20480;
constexpr int CW_MOE = 16384;

constexpr int RING_BYTES = 131072, MISC_OFF = RING_BYTES + 320, GAIN_OFF = RING_BYTES + 1024, QSLOT_OFF = RING_BYTES + 64, LDS_BYTES = 147456;
constexpr int NWAVES = 8;

__device__ __forceinline__ unsigned f2bf(float f) { unsigned u = __builtin_bit_cast(unsigned, f); return (u + 0x7fffu + ((u >> 16) & 1u)) >> 16; }
__device__ __forceinline__ unsigned pk2(float lo, float hi) { return f2bf(lo) | (f2bf(hi) << 16); }
__device__ __forceinline__ float bflo(unsigned u) { return __builtin_bit_cast(float, u << 16); }
__device__ __forceinline__ float bfhi(unsigned u) { return __builtin_bit_cast(float, u & 0xffff0000u); }
__device__ __forceinline__ float bf2f(bf16 v) { return __builtin_bit_cast(float, (unsigned)v << 16); }
__device__ __forceinline__ float wave_sum(float v) {
#pragma unroll
    for (int o = 1; o < 64; o <<= 1) v += __shfl_xor(v, o);
    return v;
}
__device__ __forceinline__ float fast_exp2(float x) { return __builtin_amdgcn_exp2f(x); }
__device__ __forceinline__ float fast_rcp(float x) { return __builtin_amdgcn_rcpf(x); }
__device__ __forceinline__ float sigmoidf_(float x) { return fast_rcp(1.0f + fast_exp2(-x * LOG2E)); }
__device__ __forceinline__ f32x2 sigmoid2(f32x2 x) { const f32x2 a = x * (-LOG2E); f32x2 t = {fast_exp2(a[0]), fast_exp2(a[1])}; t = t + 1.0f; return (f32x2){fast_rcp(t[0]), fast_rcp(t[1])}; }
__device__ __forceinline__ float gelu_tanh(float y) { const float u = 0.7978845608028654f * (y + 0.044715f * y * y * y); return y * sigmoidf_(2.0f * u); }
__device__ __forceinline__ unsigned pk4_fp8(float a, float b, float c, float d) { unsigned w = 0u; w = (unsigned)__builtin_amdgcn_cvt_pk_fp8_f32(a, b, (int)w, false); w = (unsigned)__builtin_amdgcn_cvt_pk_fp8_f32(c, d, (int)w, true); return w; }
#define LDS_WAIT() asm volatile("s_waitcnt lgkmcnt(0)" ::: "memory")
#define VM_WAIT() asm volatile("s_waitcnt vmcnt(0)" ::: "memory")

namespace pg8 {
#define PG8_LAS __attribute__((address_space(3)))
typedef unsigned short bf16_t;
typedef unsigned u32x4 __attribute__((ext_vector_type(4)));
typedef int v4i __attribute__((ext_vector_type(4)));
typedef int v8i __attribute__((ext_vector_type(8)));
constexpr int BM = 256, BK = 64, HALF = 128, HTB = HALF * BK * 2, STAGE_BYTES = 8 * HTB, NXCD = 8, WGM = 8;
__host__ __device__ __forceinline__ int lds_byte(int r, int c) { const int st = (r >> 4) * 2 + (c >> 5), rr = r & 15, cc = c & 31, ob = rr * 64 + cc * 2; return st * 1024 + (ob ^ (((ob >> 9) & 1) << 5)); }
__host__ __device__ __forceinline__ void stage_rc(int b, int& R, int& C) { const int st = b / 1024, sb = b % 1024, swz = sb ^ (((sb >> 9) & 1) << 5); R = (st >> 1) * 16 + swz / 64; C = (st & 1) * 32 + (swz % 64) / 2; }
__host__ __device__ __forceinline__ int perm32(int rho) { const int n = rho >> 4, i = rho & 15; return 8 * (i >> 2) + 4 * n + (i & 3); }

struct Unit { int pm, pn, z; size_t offA, offB; };
struct Gemm { const bf16_t* A; const bf16_t* Bt; int K, lda, ldb; unsigned* dummy; };

template <int WG = WGM> __device__ __forceinline__ void xcd_tile_map(int L, int nM, int nN, int& pm, int& pn) {
    const int nwg = nM * nN; int wgid = L; { const int q = nwg / NXCD, r = nwg % NXCD, xcd = wgid % NXCD, off = wgid / NXCD; wgid = (xcd < r ? xcd * (q + 1) : r * (q + 1) + (xcd - r) * q) + off; }
    const int nig = WG * nN, gid = wgid / nig, fm = gid * WG, gsz = (nM - fm) < WG ? (nM - fm) : WG;
    pm = fm + ((wgid % nig) % gsz); pn = (wgid % nig) / gsz;
}
struct StaticOrder {
    int nM, nN, nwg, G, c; size_t tA, tB;
    __device__ void init(int M, int N, int G_, int c_, int lda, int ldb) { nM = M / BM; nN = N / BM; nwg = nM * nN; G = G_; c = c_; tA = (size_t)BM * lda * 2; tB = (size_t)BM * ldb * 2; }
    __device__ bool next(int i, Unit& u) const {
        const long L = (long)i * G + c; if (L >= nwg) return false;
        int wgid = (int)L; { const int q = nwg / NXCD, r = nwg % NXCD, xcd = wgid % NXCD, off = wgid / NXCD; wgid = (xcd < r ? xcd * (q + 1) : r * (q + 1) + (xcd - r) * q) + off; }
        const int nig = WGM * nN, gid = wgid / nig, fm = gid * WGM, gsz = (nM - fm) < WGM ? (nM - fm) : WGM;
        u.pm = fm + ((wgid % nig) % gsz); u.pn = (wgid % nig) / gsz; u.z = 0; u.offA = (size_t)u.pm * tA; u.offB = (size_t)u.pn * tB; return true;
    }
};
struct BatchOrder {
    int nM, nN, nZ, G, c; size_t tA, tB, zA, zB;
    __device__ bool next(int i, Unit& u) const {
        const int L = i * G + c; if (L >= nM * nN * nZ) return false;
        u.z = L / (nM * nN); const int r = L % (nM * nN); u.pm = r / nN; u.pn = r % nN;
        u.offA = (size_t)u.z * zA + (size_t)u.pm * tA; u.offB = (size_t)u.z * zB + (size_t)u.pn * tB; return true;
    }
};
struct GroupOrder {
    int nN, G, c; int ts[NE + 1]; size_t tA, tB, zB, zA;
    __device__ bool next(int i, Unit& u) const {
        const int L = i * G + c; if (L >= ts[NE] * nN) return false;
        xcd_tile_map(L, ts[NE], nN, u.pm, u.pn); int e = 0, tse = 0;
#pragma unroll
        for (int k = 1; k < NE; ++k) if (u.pm >= ts[k]) { e = k; tse = ts[k]; }
        u.z = e; u.offA = zA ? (size_t)e * zA + (size_t)(u.pm - tse) * tA : (size_t)u.pm * tA; u.offB = (size_t)e * zB + (size_t)u.pn * tB; return true;
    }
};

typedef __bf16 bf16x2_t __attribute__((ext_vector_type(2)));
__device__ __forceinline__ unsigned cvt_pk_bf16(float lo, float hi) { const f32x2 v = {lo, hi}; const bf16x2_t b = __builtin_convertvector(v, bf16x2_t); return __builtin_bit_cast(unsigned, b); }

__device__ __forceinline__ u32x4 pack8(const f32x4 a, const f32x4 b) { u32x4 w; w.x = cvt_pk_bf16(a[0], a[1]); w.y = cvt_pk_bf16(a[2], a[3]); w.z = cvt_pk_bf16(b[0], b[1]); w.w = cvt_pk_bf16(b[2], b[3]); return w; }
template <class Epi, class Sched, bool ALIGN_EPI, bool FP8 = false>
__device__ __forceinline__ void gemm_phase(PG8_LAS unsigned char* lds, const Gemm g, const Sched& S, const Epi& E) {
    int tid = threadIdx.x; asm volatile("" : "+v"(tid));
    const int wid = __builtin_amdgcn_readfirstlane(tid >> 6), lane = tid & 63, wr = wid >> 2, wc = wid & 3, fr = lane & 15, fq = lane >> 4;
    int K = g.K; asm volatile("" : "+s"(K));
    const int nt = K / BK;
    unsigned voffA[2], voffB[2];
#pragma unroll
    for (int i = 0; i < 2; ++i) { int R, C; stage_rc(tid * 16 + i * 8192, R, C); const int Rb = Epi::PERM ? ((R & ~31) + perm32(R & 31)) : R;
        voffA[i] = (unsigned)(R * g.lda + C) * 2u; voffB[i] = (unsigned)(Rb * g.ldb + C) * 2u; }
    const size_t kstep = (size_t)(BK * 2);
    const size_t hstepA = (size_t)HALF * g.lda * 2, hstepB = (size_t)HALF * g.ldb * 2;
    const unsigned ldsw = (unsigned)wid * 1024u;
    const int aoff = lds_byte(wr * 64 + fr, fq * 8), boff = lds_byte(wc * 32 + fr, fq * 8);
#define PG8_SA(b, h) (((b) * 2 + (h)) * HTB)
#define PG8_SB(b, h) ((4 + (b) * 2 + (h)) * HTB)
#define PG8_STAGE(bufoff, gbase, voff) do { _Pragma("unroll") for (int _i = 0; _i < 2; ++_i) \
        __builtin_amdgcn_global_load_lds((const unsigned*)((const char*)(gbase) + (voff)[_i]), (PG8_LAS unsigned*)(lds + (bufoff) + ldsw + _i * 8192), 16, 0, 0); } while (0)
#define PG8_LDA(dst, b, h) do { _Pragma("unroll") for (int m = 0; m < 4; ++m) { if constexpr (FP8) dst##8[m] = __builtin_shufflevector(*(const PG8_LAS v4i*)(lds + PG8_SA(b, h) + aoff + m * 2048), *(const PG8_LAS v4i*)(lds + PG8_SA(b, h) + aoff + m * 2048 + 1024), 0, 1, 2, 3, 4, 5, 6, 7); \
        else { _Pragma("unroll") for (int k = 0; k < 2; ++k) dst[m][k] = *(const PG8_LAS bf16x8*)(lds + PG8_SA(b, h) + aoff + m * 2048 + k * 1024); } } } while (0)
#define PG8_LDB(dst, b, h) do { _Pragma("unroll") for (int n = 0; n < 2; ++n) { if constexpr (FP8) dst##8[n] = __builtin_shufflevector(*(const PG8_LAS v4i*)(lds + PG8_SB(b, h) + boff + n * 2048), *(const PG8_LAS v4i*)(lds + PG8_SB(b, h) + boff + n * 2048 + 1024), 0, 1, 2, 3, 4, 5, 6, 7); \
        else { _Pragma("unroll") for (int k = 0; k < 2; ++k) dst[n][k] = *(const PG8_LAS bf16x8*)(lds + PG8_SB(b, h) + boff + n * 2048 + k * 1024); } } } while (0)
#define PG8_MMA(ai, bj, At, Bt) do { __builtin_amdgcn_s_setprio(1); _Pragma("unroll") for (int m = 0; m < 4; ++m) _Pragma("unroll") for (int n = 0; n < 2; ++n) { \
        if constexpr (FP8) asm volatile("v_mfma_f32_16x16x128_f8f6f4 %0, %1, %2, %0" : "+v"(acc[ai][bj][m][n]) : "v"(Bt##8[n]), "v"(At##8[m])); \
        else { _Pragma("unroll") for (int k = 0; k < 2; ++k) acc[ai][bj][m][n] = __builtin_amdgcn_mfma_f32_16x16x32_bf16(Bt[n][k], At[m][k], acc[ai][bj][m][n], 0, 0, 0); } } \
        __builtin_amdgcn_s_setprio(0); } while (0)
#define PG8_WAIT_V(n) asm volatile("s_waitcnt vmcnt(" #n ")" ::: "memory")
#define PG8_WAIT_L(n) asm volatile("s_waitcnt lgkmcnt(" #n ")" ::: "memory")
#define PG8_BAR __builtin_amdgcn_s_barrier()
#define PG8_SCHED __builtin_amdgcn_sched_barrier(0)
    Unit cur, nxt; int ui = 0;
    if (!S.next(0, cur)) return;
    f32x4 acc[2][2][4][2];
#pragma unroll
    for (int a = 0; a < 2; ++a)
#pragma unroll
        for (int b = 0; b < 2; ++b)
#pragma unroll
            for (int m = 0; m < 4; ++m)
#pragma unroll
                for (int n = 0; n < 2; ++n) acc[a][b][m][n] = (f32x4){0.f, 0.f, 0.f, 0.f};
    bf16x8 At[4][2], B0[2][2], B1[2][2]; v8i At8[4], B08[2], B18[2];
    const char* cA = (const char*)g.A + cur.offA; const char* cB = (const char*)g.Bt + cur.offB;
    PG8_STAGE(PG8_SB(0, 0), cB, voffB); PG8_STAGE(PG8_SB(0, 1), cB + hstepB, voffB); PG8_STAGE(PG8_SA(0, 0), cA, voffA); PG8_STAGE(PG8_SA(0, 1), cA + hstepA, voffA);
    if (wr == 1) PG8_BAR;
    PG8_WAIT_V(2); PG8_BAR;
    PG8_STAGE(PG8_SB(1, 0), cB + kstep, voffB); PG8_STAGE(PG8_SA(1, 0), cA + kstep, voffA); PG8_STAGE(PG8_SB(1, 1), cB + hstepB + kstep, voffB);
    PG8_WAIT_V(6); PG8_BAR;
    { unsigned* dp = g.dummy + (threadIdx.x & 63); const unsigned zero = 0u;
#pragma unroll
      for (int i = 0; i < Epi::NVM; ++i) asm volatile("global_store_dword %0, %1, off" :: "v"(dp), "v"(zero) : "memory"); }
    for (;;) {
        const bool has_next = S.next(ui + 1, nxt);
        const char* nA = has_next ? (const char*)g.A + nxt.offA : cA; const char* nB = has_next ? (const char*)g.Bt + nxt.offB : cB;
        for (int t = 0; t < nt; t += 2) {
            const bool last = (t == nt - 2);
            const char* a1 = cA + (size_t)(t + 1) * kstep;
            const char* a2 = last ? nA : cA + (size_t)(t + 2) * kstep; const char* b2 = last ? nB : cB + (size_t)(t + 2) * kstep;
            const char* a3 = a2 + kstep; const char* b3 = b2 + kstep;
#define PG8_WAIT_V8R(tt) asm volatile("s_cmp_eq_u32 %0, 0\n\ts_cbranch_scc1 .Lrlx%=\n\ts_waitcnt vmcnt(8)\n\ts_branch .Ldn%=\n.Lrlx%=:\n\ts_waitcnt vmcnt(%1)\n.Ldn%=:" :: "s"(tt), "n"(8 + Epi::NVM) : "memory", "scc")
            const int first = __builtin_amdgcn_readfirstlane(t);
            PG8_LDB(B0, 0, 0); PG8_LDB(B1, 0, 1); PG8_SCHED; PG8_LDA(At, 0, 0); PG8_STAGE(PG8_SA(1, 1), a1 + hstepA, voffA);
            PG8_WAIT_V8R(first); PG8_WAIT_L(0); PG8_BAR; PG8_MMA(0, 0, At, B0); PG8_MMA(0, 1, At, B1); PG8_BAR; PG8_SCHED;
            PG8_LDA(At, 0, 1); PG8_STAGE(PG8_SB(0, 0), b2, voffB); PG8_STAGE(PG8_SB(0, 1), b2 + hstepB, voffB); PG8_STAGE(PG8_SA(0, 0), a2, voffA);
            PG8_WAIT_V8R(first); PG8_WAIT_L(0); PG8_BAR; PG8_MMA(1, 0, At, B0); PG8_MMA(1, 1, At, B1); PG8_BAR; PG8_SCHED;
#undef PG8_WAIT_V8R
            PG8_LDB(B0, 1, 0); PG8_LDB(B1, 1, 1); PG8_SCHED; PG8_LDA(At, 1, 0); PG8_STAGE(PG8_SA(0, 1), a2 + hstepA, voffA);
            PG8_WAIT_V(8); PG8_WAIT_L(0); PG8_BAR; PG8_MMA(0, 0, At, B0); PG8_MMA(0, 1, At, B1); PG8_BAR; PG8_SCHED;
            PG8_LDA(At, 1, 1); PG8_STAGE(PG8_SB(1, 0), b3, voffB); PG8_STAGE(PG8_SB(1, 1), b3 + hstepB, voffB); PG8_STAGE(PG8_SA(1, 0), a3, voffA);
            PG8_WAIT_V(8); PG8_WAIT_L(0); PG8_BAR; PG8_MMA(1, 0, At, B0); PG8_MMA(1, 1, At, B1); PG8_BAR; PG8_SCHED;
        }
        if constexpr (ALIGN_EPI) { if (wr == 0) PG8_BAR; }
        if constexpr (FP8) asm volatile("s_nop 15\n\ts_nop 15" ::: "memory");
        E(acc, cur, wr, wc, fr, fq);
        if (!has_next) break;
#pragma unroll
        for (int a = 0; a < 2; ++a)
#pragma unroll
            for (int b = 0; b < 2; ++b)
#pragma unroll
                for (int m = 0; m < 4; ++m)
#pragma unroll
                    for (int n = 0; n < 2; ++n) acc[a][b][m][n] = (f32x4){0.f, 0.f, 0.f, 0.f};
        cur = nxt; cA = nA; cB = nB; ++ui;
        if constexpr (ALIGN_EPI) { if (wr == 1) PG8_BAR; }
    }
    PG8_WAIT_V(0);
    if constexpr (!ALIGN_EPI) { if (wr == 0) PG8_BAR; }
    PG8_BAR;
#undef PG8_SA
#undef PG8_SB
#undef PG8_STAGE
#undef PG8_LDA
#undef PG8_LDB
#undef PG8_MMA
#undef PG8_WAIT_V
#undef PG8_WAIT_L
#undef PG8_BAR
#undef PG8_SCHED
}


template <class Epi, class Sched>
__device__ __forceinline__ void gemm_phase_n1(PG8_LAS unsigned char* lds, const Gemm g, const Sched& S, const Epi& E) {
    int tid = threadIdx.x; asm volatile("" : "+v"(tid));
    const int wid = __builtin_amdgcn_readfirstlane(tid >> 6), lane = tid & 63, wr = wid >> 2, wc = wid & 3, fr = lane & 15, fq = lane >> 4;
    int K = g.K; asm volatile("" : "+s"(K));
    const int nt = K / BK;
    unsigned voffA[2], voffB[2];
#pragma unroll
    for (int i = 0; i < 2; ++i) { int R, C; stage_rc(tid * 16 + i * 8192, R, C); const int Rb = Epi::PERM ? ((R & ~31) + perm32(R & 31)) : R;
        voffA[i] = (unsigned)(R * g.lda + C) * 2u; voffB[i] = (unsigned)(Rb * g.ldb + C) * 2u; }
    const size_t kstep = (size_t)(BK * 2);
    const size_t hstepA = (size_t)HALF * g.lda * 2;
    const unsigned ldsw = (unsigned)wid * 1024u;
    const int aoff = lds_byte(wr * 64 + fr, fq * 8), boff = lds_byte(wc * 32 + fr, fq * 8);
#define PG8_SA(b, h) (((b) * 2 + (h)) * HTB)
#define PG8_SB(b, h) ((4 + (b) * 2 + (h)) * HTB)
#define PG8_STAGE(bufoff, gbase, voff) do { _Pragma("unroll") for (int _i = 0; _i < 2; ++_i) \
        __builtin_amdgcn_global_load_lds((const unsigned*)((const char*)(gbase) + (voff)[_i]), (PG8_LAS unsigned*)(lds + (bufoff) + ldsw + _i * 8192), 16, 0, 0); } while (0)
#define PG8_LDA(dst, b, h) do { _Pragma("unroll") for (int m = 0; m < 4; ++m) _Pragma("unroll") for (int k = 0; k < 2; ++k) dst[m][k] = *(const PG8_LAS bf16x8*)(lds + PG8_SA(b, h) + aoff + m * 2048 + k * 1024); } while (0)
#define PG8_LDB(dst, b, h) do { _Pragma("unroll") for (int n = 0; n < 2; ++n) _Pragma("unroll") for (int k = 0; k < 2; ++k) dst[n][k] = *(const PG8_LAS bf16x8*)(lds + PG8_SB(b, h) + boff + n * 2048 + k * 1024); } while (0)
#define PG8_MMA1(ai, At, Bt) do { __builtin_amdgcn_s_setprio(1); _Pragma("unroll") for (int m = 0; m < 4; ++m) _Pragma("unroll") for (int n = 0; n < 2; ++n) _Pragma("unroll") for (int k = 0; k < 2; ++k) \
        acc[ai][m][n] = __builtin_amdgcn_mfma_f32_16x16x32_bf16(Bt[n][k], At[m][k], acc[ai][m][n], 0, 0, 0); __builtin_amdgcn_s_setprio(0); } while (0)
#define PG8_WAIT_V(n) asm volatile("s_waitcnt vmcnt(" #n ")" ::: "memory")
#define PG8_WAIT_L(n) asm volatile("s_waitcnt lgkmcnt(" #n ")" ::: "memory")
#define PG8_BAR __builtin_amdgcn_s_barrier()
#define PG8_SCHED __builtin_amdgcn_sched_barrier(0)
    Unit cur, nxt; int ui = 0;
    if (!S.next(0, cur)) return;
    f32x4 acc[2][4][2], st[2][4][2];
#pragma unroll
    for (int a = 0; a < 2; ++a)
#pragma unroll
        for (int m = 0; m < 4; ++m)
#pragma unroll
            for (int n = 0; n < 2; ++n) { acc[a][m][n] = (f32x4){0.f, 0.f, 0.f, 0.f}; st[a][m][n] = (f32x4){0.f, 0.f, 0.f, 0.f}; }
    bf16x8 At[4][2], B0[2][2];
    const char* cA = (const char*)g.A + cur.offA; const char* cB = (const char*)g.Bt + cur.offB;
    PG8_STAGE(PG8_SB(0, 0), cB, voffB); PG8_STAGE(PG8_SA(0, 0), cA, voffA); PG8_STAGE(PG8_SA(0, 1), cA + hstepA, voffA);
    if (wr == 1) PG8_BAR;
    PG8_WAIT_V(2); PG8_BAR;
    PG8_STAGE(PG8_SB(1, 0), cB + kstep, voffB); PG8_STAGE(PG8_SA(1, 0), cA + kstep, voffA);
    PG8_WAIT_V(4); PG8_BAR;
    for (;;) {
        const bool has_next = S.next(ui + 1, nxt);
        const char* nA = has_next ? (const char*)g.A + nxt.offA : cA; const char* nB = has_next ? (const char*)g.Bt + nxt.offB : cB;
        for (int t = 0; t < nt; t += 2) {
            const bool last = (t == nt - 2);
            const char* a1 = cA + (size_t)(t + 1) * kstep;
            const char* a2 = last ? nA : cA + (size_t)(t + 2) * kstep; const char* b2 = last ? nB : cB + (size_t)(t + 2) * kstep;
            const char* a3 = a2 + kstep; const char* b3 = b2 + kstep;
            PG8_LDB(B0, 0, 0); PG8_SCHED; PG8_LDA(At, 0, 0); PG8_STAGE(PG8_SA(1, 1), a1 + hstepA, voffA);
            PG8_WAIT_V(6); PG8_WAIT_L(0); PG8_BAR; PG8_MMA1(0, At, B0); PG8_BAR; PG8_SCHED;
            PG8_LDA(At, 0, 1); PG8_STAGE(PG8_SB(0, 0), b2, voffB); PG8_STAGE(PG8_SA(0, 0), a2, voffA);
            PG8_WAIT_V(6); PG8_WAIT_L(0); PG8_BAR; PG8_MMA1(1, At, B0); PG8_BAR; PG8_SCHED;
            PG8_LDB(B0, 1, 0); PG8_SCHED; PG8_LDA(At, 1, 0); PG8_STAGE(PG8_SA(0, 1), a2 + hstepA, voffA);
            PG8_WAIT_V(6); PG8_WAIT_L(0); PG8_BAR; PG8_MMA1(0, At, B0); PG8_BAR; PG8_SCHED;
            PG8_LDA(At, 1, 1); PG8_STAGE(PG8_SB(1, 0), b3, voffB); PG8_STAGE(PG8_SA(1, 0), a3, voffA);
            PG8_WAIT_V(6); PG8_WAIT_L(0); PG8_BAR; PG8_MMA1(1, At, B0); PG8_BAR; PG8_SCHED;
        }
        if (wr == 0) PG8_BAR;
        E(acc, st, cur, wr, wc, fr, fq);
        if (!has_next) break;
#pragma unroll
        for (int a = 0; a < 2; ++a)
#pragma unroll
            for (int m = 0; m < 4; ++m)
#pragma unroll
                for (int n = 0; n < 2; ++n) acc[a][m][n] = (f32x4){0.f, 0.f, 0.f, 0.f};
        cur = nxt; cA = nA; cB = nB; ++ui;
        if (wr == 1) PG8_BAR;
    }
    PG8_WAIT_V(0);
    PG8_BAR;
#undef PG8_SA
#undef PG8_SB
#undef PG8_STAGE
#undef PG8_LDA
#undef PG8_LDB
#undef PG8_MMA1
#undef PG8_WAIT_V
#undef PG8_WAIT_L
#undef PG8_BAR
#undef PG8_SCHED
}
typedef f32x4 Acc1[2][4][2];
struct OneUnit { int pm; size_t tA;
    __device__ bool next(int i, Unit& u) const { if (i) return false; u.pm = pm; u.pn = 0; u.z = 0; u.offA = (size_t)pm * tA; u.offB = 0; return true; } };
struct BranchOrder1 {
    int nM, nN, G, c; size_t tA, tB, zA, zB; int paired, vc;
    __device__ bool next(int i, Unit& u) const {
        if (paired) { if (i >= 16) return false; u.z = i & 3; u.pm = vc >> 1; u.pn = 4 * (vc & 1) + (i >> 2);
            u.offA = (size_t)u.z * zA + (size_t)u.pm * tA; u.offB = (size_t)u.z * zB + (size_t)u.pn * tB; return true; }
        const int tile = (i >> 2) * G + c; if (tile >= nM * nN) return false;
        u.z = i & 3; xcd_tile_map<BR_WG>(tile, nM, nN, u.pm, u.pn);
        u.offA = (size_t)u.z * zA + (size_t)u.pm * tA; u.offB = (size_t)u.z * zB + (size_t)u.pn * tB; return true;
    }
};
struct EpiGate1 {
    static constexpr bool PERM = true;
    const bf16_t* gate; bf16_t* mb;
    __device__ __forceinline__ void operator()(const Acc1& acc, Acc1& st, const Unit& u, int wr, int wc, int fr, int fq) const {
        const int z = u.z; const int row0 = u.pm * BM + wr * 64 + fr, col = u.pn * HALF + wc * 32 + 8 * fq;
#pragma unroll
        for (int ai = 0; ai < 2; ++ai)
#pragma unroll
            for (int m = 0; m < 4; ++m) { const int row = row0 + ai * HALF + m * 16;
                f32x4 a = acc[ai][m][0], b = acc[ai][m][1];
                if (GATE8 == 2) { const v2u g8 = *(const v2u*)((const unsigned char*)gate + (size_t)row * 4096 + z * 1024 + col); const float k = 1.0f / 255.0f;
                    a[0] *= (float)(g8.x & 0xffu) * k; a[1] *= (float)((g8.x >> 8) & 0xffu) * k; a[2] *= (float)((g8.x >> 16) & 0xffu) * k; a[3] *= (float)(g8.x >> 24) * k;
                    b[0] *= (float)(g8.y & 0xffu) * k; b[1] *= (float)((g8.y >> 8) & 0xffu) * k; b[2] *= (float)((g8.y >> 16) & 0xffu) * k; b[3] *= (float)(g8.y >> 24) * k; }
                else if (GATE8 == 1) { const v2u g8 = *(const v2u*)((const unsigned char*)gate + (size_t)row * 4096 + z * 1024 + col);
                    const f32x2 g0 = __builtin_amdgcn_cvt_pk_f32_fp8((int)g8.x, false), g1 = __builtin_amdgcn_cvt_pk_f32_fp8((int)g8.x, true), g2 = __builtin_amdgcn_cvt_pk_f32_fp8((int)g8.y, false), g3 = __builtin_amdgcn_cvt_pk_f32_fp8((int)g8.y, true);
                    a[0] *= g0[0]; a[1] *= g0[1]; a[2] *= g1[0]; a[3] *= g1[1]; b[0] *= g2[0]; b[1] *= g2[1]; b[2] *= g3[0]; b[3] *= g3[1]; }
                else { const u32x4 gg = *(const u32x4*)(gate + (size_t)row * 4096 + z * 1024 + col);
                    a[0] *= bflo(gg.x); a[1] *= bfhi(gg.x); a[2] *= bflo(gg.y); a[3] *= bfhi(gg.y); b[0] *= bflo(gg.z); b[1] *= bfhi(gg.z); b[2] *= bflo(gg.w); b[3] *= bfhi(gg.w); }
                if (z == 0) { st[ai][m][0] = a; st[ai][m][1] = b; } else { st[ai][m][0] += a; st[ai][m][1] += b; }
                if (z == 3) *(u32x4*)(mb + (size_t)row * 1024 + col) = pack8(st[ai][m][0], st[ai][m][1]); }
    }
};
typedef f32x4 Acc[2][2][4][2];
#define EPI_ROWS_BEGIN const int row0 = u.pm * BM + wr * 64 + fr; _Pragma("unroll") for (int ai = 0; ai < 2; ++ai) _Pragma("unroll") for (int m = 0; m < 4; ++m) { const int row = row0 + ai * HALF + m * 16;
#define EPI_ROWS_END }

struct EpiInProj {
    static constexpr bool PERM = true; static constexpr int NVM = 8;
    bf16_t *ua, *qkv, *uc, *gate; const PG8_LAS float* gl;
    __device__ __forceinline__ void operator()(const Acc& acc, const Unit& u, int wr, int wc, int fr, int fq) const {
        const int pn = u.pn;
        if (pn == 0) {
            EPI_ROWS_BEGIN
#pragma unroll
            for (int bj = 0; bj < 2; ++bj) { const int c8 = bj * HALF + wc * 32 + 8 * fq, gI = c8 >> 4, h0 = c8 & 15;
                *(u32x4*)(ua + ((size_t)(gI * 512 + (row >> 6)) * S5_LDA + (row & 63) * 16 + h0)) = pack8(acc[ai][bj][m][0], acc[ai][bj][m][1]); }
            EPI_ROWS_END
        } else if (pn == 1 || pn == 2 || pn == 6 || pn == 7) {
            const int which = (pn == 1) ? 0 : (pn == 2) ? 1 : (pn == 6) ? 2 : 3;
            const PG8_LAS float* gp = gl + which * 64;
            bf16_t* dst = qkv + (size_t)((pn < 6) ? (pn - 1) : (pn - 3)) * ((size_t)T * 256);
            f32x4 gv[2][2];
#pragma unroll
            for (int bj = 0; bj < 2; ++bj)
#pragma unroll
                for (int n = 0; n < 2; ++n) gv[bj][n] = *(const PG8_LAS f32x4*)(gp + bj * 32 + 8 * fq + 4 * n);
            EPI_ROWS_BEGIN
            float ss = 0.f;
#pragma unroll
            for (int bj = 0; bj < 2; ++bj)
#pragma unroll
                for (int n = 0; n < 2; ++n) { const f32x4 x = acc[ai][bj][m][n]; ss += (x[0] * x[0] + x[1] * x[1]) + (x[2] * x[2] + x[3] * x[3]); }
            ss += __shfl_xor(ss, 16); ss += __shfl_xor(ss, 32);
            const float rs = __builtin_amdgcn_rsqf(ss * (1.0f / 64.0f) + EPS);
#pragma unroll
            for (int bj = 0; bj < 2; ++bj)
                *(u32x4*)(dst + (size_t)row * 256 + wc * 64 + bj * 32 + 8 * fq) = pack8(acc[ai][bj][m][0] * rs * gv[bj][0], acc[ai][bj][m][1] * rs * gv[bj][1]);
            EPI_ROWS_END
        } else if (pn == 3 || pn == 8) {
            bf16_t* dst = qkv + (size_t)((pn == 3) ? 2 : 5) * ((size_t)T * 256);
            EPI_ROWS_BEGIN
#pragma unroll
            for (int bj = 0; bj < 2; ++bj) *(u32x4*)(dst + (size_t)row * 256 + bj * HALF + wc * 32 + 8 * fq) = pack8(acc[ai][bj][m][0], acc[ai][bj][m][1]);
            EPI_ROWS_END
        } else if (pn == 4 || pn == 5) {
            EPI_ROWS_BEGIN
            f32x4 o[2];
#pragma unroll
            for (int n = 0; n < 2; ++n)
#pragma unroll
                for (int e = 0; e < 4; ++e) o[n][e] = acc[ai][0][m][n][e] * sigmoidf_(acc[ai][1][m][n][e]);
            *(u32x4*)(uc + (size_t)row * 256 + (pn - 4) * 128 + wc * 32 + 8 * fq) = pack8(o[0], o[1]);
            EPI_ROWS_END
        } else {
            const int gt = pn - 9;
            EPI_ROWS_BEGIN
#pragma unroll
            for (int bj = 0; bj < 2; ++bj) { f32x4 o[2];
#pragma unroll
                for (int n = 0; n < 2; ++n)
#pragma unroll
                    for (int e = 0; e < 4; ++e) o[n][e] = sigmoidf_(acc[ai][bj][m][n][e]);
                *(u32x4*)(gate + (size_t)row * 4096 + gt * 256 + bj * HALF + wc * 32 + 8 * fq) = pack8(o[0], o[1]); }
            EPI_ROWS_END
        }
    }
};
struct EpiGateSig {
    static constexpr bool PERM = true; static constexpr int NVM = 16;
    bf16_t* gate;
    __device__ __forceinline__ void operator()(const Acc& acc, const Unit& u, int wr, int wc, int fr, int fq) const {
        EPI_ROWS_BEGIN
#pragma unroll
        for (int bj = 0; bj < 2; ++bj) { f32x4 o[2];
#pragma unroll
            for (int n = 0; n < 2; ++n)
#pragma unroll
                for (int e = 0; e < 4; e += 2) { const f32x2 r = sigmoid2((f32x2){acc[ai][bj][m][n][e], acc[ai][bj][m][n][e + 1]} * (1.0f / 64.0f)) * ((GATE8 == 2) ? 255.0f : 1.0f); o[n][e] = r[0]; o[n][e + 1] = r[1]; }
            if (GATE8 == 2) { v2u w = {0u, 0u};
#pragma unroll
                for (int e = 0; e < 4; ++e) { w.x = __builtin_amdgcn_cvt_pk_u8_f32(o[0][e], e, w.x); w.y = __builtin_amdgcn_cvt_pk_u8_f32(o[1][e], e, w.y); }
                *(v2u*)((unsigned char*)gate + (size_t)row * 4096 + u.pn * BM + bj * HALF + wc * 32 + 8 * fq) = w; }
            else if (GATE8 == 1) { v2u w; w.x = pk4_fp8(o[0][0], o[0][1], o[0][2], o[0][3]); w.y = pk4_fp8(o[1][0], o[1][1], o[1][2], o[1][3]); *(v2u*)((unsigned char*)gate + (size_t)row * 4096 + u.pn * BM + bj * HALF + wc * 32 + 8 * fq) = w; }
            else *(u32x4*)(gate + (size_t)row * 4096 + u.pn * BM + bj * HALF + wc * 32 + 8 * fq) = pack8(o[0], o[1]); }
        EPI_ROWS_END
    }
};
struct EpiZ {
    static constexpr bool PERM = false; static constexpr int NVM = 16;
    float* z;
    __device__ __forceinline__ void operator()(const Acc& acc, const Unit& u, int wr, int wc, int fr, int fq) const {
        EPI_ROWS_BEGIN
#pragma unroll
        for (int n = 0; n < 2; ++n) *(f32x4*)(z + ((size_t)(u.z * 512 + row)) * 128 + wc * 32 + 16 * n + 4 * fq) = acc[ai][0][m][n];
        EPI_ROWS_END
    }
};
struct EpiY {
    static constexpr bool PERM = true; static constexpr int NVM = 16;
    const bf16_t* ua; const float* dskip; bf16_t* yp;
    __device__ __forceinline__ void operator()(const Acc& acc, const Unit& u, int wr, int wc, int fr, int fq) const {
        const int gI = u.z, h0 = 8 * (fq & 1);
        const f32x4 d0 = *(const f32x4*)(dskip + gI * 16 + h0), d1 = *(const f32x4*)(dskip + gI * 16 + h0 + 4);
        EPI_ROWS_BEGIN
#pragma unroll
        for (int bj = 0; bj < 2; ++bj) { const int col = u.pn * BM + bj * HALF + wc * 32 + 8 * fq;
            const u32x4 uu = *(const u32x4*)(ua + ((size_t)(gI * 512 + row)) * S5_LDA + col);
            f32x4 a = acc[ai][bj][m][0], b = acc[ai][bj][m][1];
            a[0] += d0[0] * bflo(uu.x); a[1] += d0[1] * bfhi(uu.x); a[2] += d0[2] * bflo(uu.y); a[3] += d0[3] * bfhi(uu.y);
            b[0] += d1[0] * bflo(uu.z); b[1] += d1[1] * bfhi(uu.z); b[2] += d1[2] * bflo(uu.w); b[3] += d1[3] * bfhi(uu.w);
#pragma unroll
            for (int e = 0; e < 4; ++e) { a[e] = gelu_tanh(a[e]); b[e] = gelu_tanh(b[e]); }
            *(u32x4*)(yp + ((size_t)row * 64 + (col >> 4)) * 256 + gI * 16 + h0) = pack8(a, b); }
        EPI_ROWS_END
    }
};
struct EpiGlu {
    static constexpr bool PERM = true; static constexpr int NVM = 16;
    const bf16_t* yp; bf16_t* ycat;
    __device__ __forceinline__ void operator()(const Acc& acc, const Unit& u, int wr, int wc, int fr, int fq) const {
        EPI_ROWS_BEGIN
#pragma unroll
        for (int bj = 0; bj < 2; ++bj) { const int col = bj * HALF + wc * 32 + 8 * fq;
            const u32x4 yy = *(const u32x4*)(yp + (size_t)row * 256 + col);
            f32x4 a = acc[ai][bj][m][0], b = acc[ai][bj][m][1];
            a[0] = bflo(yy.x) * sigmoidf_(a[0]); a[1] = bfhi(yy.x) * sigmoidf_(a[1]); a[2] = bflo(yy.y) * sigmoidf_(a[2]); a[3] = bfhi(yy.y) * sigmoidf_(a[3]);
            b[0] = bflo(yy.z) * sigmoidf_(b[0]); b[1] = bfhi(yy.z) * sigmoidf_(b[1]); b[2] = bflo(yy.w) * sigmoidf_(b[2]); b[3] = bfhi(yy.w) * sigmoidf_(b[3]);
            *(u32x4*)(ycat + (size_t)row * 1024 + col) = pack8(a, b); }
        EPI_ROWS_END
    }
};
template <bool SC64> struct EpiResid {
    static constexpr bool PERM = true; static constexpr float sc = SC64 ? (1.0f / 64.0f) : 1.0f; static constexpr int NVM = 16;
    const float* base32; const bf16_t* base16; bf16_t* out; float* ss; unsigned char* out8; int flags;
    __device__ __forceinline__ void operator()(const Acc& acc, const Unit& u, int wr, int wc, int fr, int fq) const {
        EPI_ROWS_BEGIN
        float q = 0.f;
#pragma unroll
        for (int bj = 0; bj < 2; ++bj) { const size_t off = (size_t)row * 1024 + u.pn * BM + bj * HALF + wc * 32 + 8 * fq;
            f32x4 a, b;
            if (flags & 1) { a = *(const f32x4*)(base32 + off); b = *(const f32x4*)(base32 + off + 4); }
            else { const u32x4 r = *(const u32x4*)(base16 + off); a = (f32x4){bflo(r.x), bfhi(r.x), bflo(r.y), bfhi(r.y)}; b = (f32x4){bflo(r.z), bfhi(r.z), bflo(r.w), bfhi(r.w)}; }
            const u32x4 w = pack8(a + acc[ai][bj][m][0] * sc, b + acc[ai][bj][m][1] * sc); *(u32x4*)(out + off) = w;
            if (flags & 2) { const float x0 = bflo(w.x), x1 = bfhi(w.x), x2 = bflo(w.y), x3 = bfhi(w.y), x4 = bflo(w.z), x5 = bfhi(w.z), x6 = bflo(w.w), x7 = bfhi(w.w);
                q += ((x0 * x0 + x1 * x1) + (x2 * x2 + x3 * x3)) + ((x4 * x4 + x5 * x5) + (x6 * x6 + x7 * x7));
                if (flags & 4) { v2u w8; w8.x = pk4_fp8(x0, x1, x2, x3); w8.y = pk4_fp8(x4, x5, x6, x7); *(v2u*)(out8 + off) = w8; } } }
        if (flags & 2) { q += __shfl_xor(q, 16); q += __shfl_xor(q, 32); if (fq == 0) ss[(size_t)row * 16 + u.pn * 4 + wc] = q; }
        EPI_ROWS_END
    }
};
template <bool H8> struct EpiSwiGlu {
    static constexpr bool PERM = true; static constexpr int NVM = 8;
    bf16_t* h; float sc; const float* ss; int use_ss;
    __device__ __forceinline__ void operator()(const Acc& acc, const Unit& u, int wr, int wc, int fr, int fq) const {
        EPI_ROWS_BEGIN
        float rsc = sc;
        if (use_ss) { const f32x4 s0 = *(const f32x4*)(ss + (size_t)row * 16), s1 = *(const f32x4*)(ss + (size_t)row * 16 + 4), s2 = *(const f32x4*)(ss + (size_t)row * 16 + 8), s3 = *(const f32x4*)(ss + (size_t)row * 16 + 12);
            const f32x4 t = (s0 + s1) + (s2 + s3); rsc = sc * __builtin_amdgcn_rsqf(((t[0] + t[1]) + (t[2] + t[3])) * (1.0f / D) + EPS); }
        f32x4 o[2];
#pragma unroll
        for (int n = 0; n < 2; ++n)
#pragma unroll
            for (int e = 0; e < 4; e += 2) { const f32x2 a = (f32x2){acc[ai][0][m][n][e], acc[ai][0][m][n][e + 1]} * rsc, b = (f32x2){acc[ai][1][m][n][e], acc[ai][1][m][n][e + 1]} * rsc;
                const f32x2 r = (a * b) * sigmoid2(a); o[n][e] = r[0]; o[n][e + 1] = r[1]; }
        if constexpr (H8) { v2u w; w.x = pk4_fp8(o[0][0], o[0][1], o[0][2], o[0][3]); w.y = pk4_fp8(o[1][0], o[1][1], o[1][2], o[1][3]); *(v2u*)((unsigned char*)h + (size_t)row * FF + u.pn * 128 + wc * 32 + 8 * fq) = w; }
        else *(u32x4*)(h + (size_t)row * FF + u.pn * 128 + wc * 32 + 8 * fq) = pack8(o[0], o[1]);
        EPI_ROWS_END
    }
};
struct EpiStore {
    static constexpr bool PERM = true; static constexpr int NVM = 16;
    bf16_t* o; float sc;
    __device__ __forceinline__ void operator()(const Acc& acc, const Unit& u, int wr, int wc, int fr, int fq) const {
        EPI_ROWS_BEGIN
#pragma unroll
        for (int bj = 0; bj < 2; ++bj) *(u32x4*)(o + (size_t)row * 1024 + u.pn * BM + bj * HALF + wc * 32 + 8 * fq) = pack8(acc[ai][bj][m][0] * sc, acc[ai][bj][m][1] * sc);
        EPI_ROWS_END
    }
};
}

#define XB_TMO      128
#define XB_XCNT(j)  (256  + 64 * (j))
#define XB_XSUB(j)  (1280 + 64 * (j))
#define XB_XGEN(j)  (2304 + 64 * (j))
#define XB_TOP      3328
#define XB_TOPGEN   3392
#define XCD_BAR_WORDS 3456
#define XB_SPIN_CAP (1u << 18)
__device__ __forceinline__ unsigned xb_ld(unsigned* p)              { return __hip_atomic_load(p, __ATOMIC_RELAXED, __HIP_MEMORY_SCOPE_AGENT); }
__device__ __forceinline__ unsigned xb_add(unsigned* p, unsigned v) { return __hip_atomic_fetch_add(p, v, __ATOMIC_RELAXED, __HIP_MEMORY_SCOPE_AGENT); }
__device__ __forceinline__ unsigned xb_xcc_id() { return (unsigned)__builtin_amdgcn_s_getreg((3 << 11) | 20) & 0xFu; }
#define XB_SPIN(cond, bar) do { unsigned _sp = 0; while (cond) { __builtin_amdgcn_s_sleep(1); \
    if ((++_sp & 255u) == 0u) { if (xb_ld(&(bar)[XB_TMO])) break; if (_sp > XB_SPIN_CAP) { atomicAdd(&(bar)[XB_TMO], 1u); break; } } } } while (0)
struct XcdBarrier { unsigned* bar; unsigned x; volatile LAS unsigned* st; };
__device__ __forceinline__ XcdBarrier xcd_barrier_post(unsigned* bar, volatile LAS unsigned* st) {
    XcdBarrier b; b.bar = bar; b.x = xb_xcc_id(); b.st = st;
    if (threadIdx.x == 0) (void)xb_add(&bar[XB_XCNT(b.x)], 1u);
    return b;
}
__device__ __forceinline__ void xcd_barrier_complete(unsigned* bar, unsigned x, unsigned& nloc, unsigned& nx) {
    const unsigned G = gridDim.x * gridDim.y * gridDim.z;
    unsigned sum, cnt, mine, sp = 0u;
    for (;;) {
        sum = 0u; cnt = 0u; mine = 0u;
#pragma unroll
        for (unsigned j = 0; j < 16; ++j) { const unsigned c = xb_ld(&bar[XB_XCNT(j)]); sum += c; cnt += (c > 0u) ? 1u : 0u; mine = (j == x) ? c : mine; }
        if (sum == G) break;
        __builtin_amdgcn_s_sleep(1);
        if ((++sp & 255u) == 0u) { if (xb_ld(&bar[XB_TMO])) break; if (sp > XB_SPIN_CAP) { atomicAdd(&bar[XB_TMO], 1u); break; } }
    }
    nloc = mine > 0u ? mine : 1u; nx = cnt > 0u ? cnt : 1u;
}
__device__ __forceinline__ void xcd_barrier(const XcdBarrier& b) {
    asm volatile("s_waitcnt vmcnt(0)" ::: "memory");
    __syncthreads();
    if (threadIdx.x == 0) {
        unsigned* bar = b.bar;
        __builtin_amdgcn_s_waitcnt(0);
        unsigned nloc = b.st[0], nx = b.st[1];
        if (nloc == 0u) { xcd_barrier_complete(bar, b.x, nloc, nx); b.st[0] = nloc; b.st[1] = nx; }
        const unsigned old = xb_add(&bar[XB_XSUB(b.x)], 1u);
        const unsigned gen = old / nloc;
        if (old + 1u == (gen + 1u) * nloc) {
            __builtin_amdgcn_fence(__ATOMIC_RELEASE, "agent");
            asm volatile("s_waitcnt vmcnt(0)" ::: "memory");
            const unsigned og = xb_add(&bar[XB_TOP], 1u);
            const unsigned tg = og / nx;
            if (og + 1u == (tg + 1u) * nx) xb_add(&bar[XB_TOPGEN], 1u);
            else XB_SPIN(xb_ld(&bar[XB_TOPGEN]) == tg, bar);
            __builtin_amdgcn_fence(__ATOMIC_ACQUIRE, "agent");
            xb_add(&bar[XB_XGEN(b.x)], 1u);
            asm volatile("s_waitcnt vmcnt(0)" ::: "memory");
        } else {
            XB_SPIN(xb_ld(&bar[XB_XGEN(b.x)]) == gen, bar);
            __builtin_amdgcn_fence(__ATOMIC_ACQUIRE, "agent");
            asm volatile("s_waitcnt vmcnt(0)" ::: "memory");
        }
    }
    __syncthreads();
}

struct Args { const float* in[32]; float* out; unsigned char* ws; int gp_lo, gp_hi; };
enum { I_X = 0, I_GMIX, I_WIN, I_BFORGET, I_FQG, I_FKG, I_SQG, I_SKG, I_LRE, I_LIM, I_LDT, I_BRE, I_BIM, I_CRE, I_CIM, I_S5D, I_WGLU, I_CONVW, I_CONVB, I_LNG, I_LNB,
       I_WBR, I_WOUT, I_GFFN, I_W1, I_W3, I_W2, I_RW, I_RB, I_MW1, I_MW3, I_MW2 };
constexpr int NPH = 12, GP_FINAL = DEPTH * NPH, GP_TOTAL = GP_FINAL + 1;

struct Frame { LAS unsigned char* lds; int tid, lane, wave, vcu, G, gw, NGW; const Args* a; unsigned char* ws; };

__device__ __forceinline__ void transpose_item(const float* W, int ldw, bf16* WT, int ldt, int k0, int src_col0, int dst_row0, LAS float* scr, int lane, const float* ks = nullptr) {
    f32x4 ld[8];
#pragma unroll
    for (int i = 0; i < 8; ++i) ld[i] = *(const f32x4*)(W + (size_t)(k0 + 8 * i + (lane >> 3)) * ldw + src_col0 + 4 * (lane & 7));
#pragma unroll
    for (int i = 0; i < 8; ++i) { LAS float* d = scr + (8 * i + (lane >> 3)) * 33 + 4 * (lane & 7); const float s = ks ? ks[k0 + 8 * i + (lane >> 3)] : 1.0f; d[0] = ld[i][0] * s; d[1] = ld[i][1] * s; d[2] = ld[i][2] * s; d[3] = ld[i][3] * s; }
    LDS_WAIT(); asm volatile("" ::: "memory");
    const int c = lane & 7;
#pragma unroll
    for (int j = 0; j < 4; ++j) { const int n = (lane >> 3) + 8 * j; const LAS float* s = scr + (8 * c) * 33 + n;
        v4u o; o.x = pk2(s[0 * 33], s[1 * 33]); o.y = pk2(s[2 * 33], s[3 * 33]); o.z = pk2(s[4 * 33], s[5 * 33]); o.w = pk2(s[6 * 33], s[7 * 33]);
        *(GAS v4u*)(WT + (size_t)(dst_row0 + n) * ldt + k0 + 8 * c) = o; }
    LDS_WAIT(); asm volatile("" ::: "memory");
}
__device__ __forceinline__ void transpose_item_f8(const float* W, int ldw, unsigned char* WT, int ldt, int k0, int src_col0, int dst_row0, LAS float* scr, int lane, float sc, const float* ks = nullptr) {
    f32x4 ld[8];
#pragma unroll
    for (int i = 0; i < 8; ++i) ld[i] = *(const f32x4*)(W + (size_t)(k0 + 8 * i + (lane >> 3)) * ldw + src_col0 + 4 * (lane & 7));
#pragma unroll
    for (int i = 0; i < 8; ++i) { LAS float* d = scr + (8 * i + (lane >> 3)) * 33 + 4 * (lane & 7); const float s = ks ? sc * ks[k0 + 8 * i + (lane >> 3)] : sc; d[0] = ld[i][0] * s; d[1] = ld[i][1] * s; d[2] = ld[i][2] * s; d[3] = ld[i][3] * s; }
    LDS_WAIT(); asm volatile("" ::: "memory");
    const int c = lane & 7;
#pragma unroll
    for (int j = 0; j < 4; ++j) { const int n = (lane >> 3) + 8 * j; const LAS float* s = scr + (8 * c) * 33 + n;
        v2u o; o.x = pk4_fp8(s[0 * 33], s[1 * 33], s[2 * 33], s[3 * 33]); o.y = pk4_fp8(s[4 * 33], s[5 * 33], s[6 * 33], s[7 * 33]);
        *(GAS v2u*)(WT + (size_t)(dst_row0 + n) * ldt + k0 + 8 * c) = o; }
    LDS_WAIT(); asm volatile("" ::: "memory");
}
__device__ __forceinline__ int win_src_col(int blk) {
    const int tile = blk >> 3, j = blk & 7, bj = j >> 2, hh = j & 3;
    if (tile == 0) return 32 * j;
    if (tile == 1 || tile == 2) return 256 + 256 * (tile - 1) + 64 * hh + 32 * bj;
    if (tile == 3) return 768 + 32 * j;
    if (tile == 4 || tile == 5) return (j < 4) ? (1028 + 128 * (tile - 4) + 32 * j) : (1284 + 128 * (tile - 4) + 32 * (j - 4));
    if (tile == 6 || tile == 7) return 1540 + 256 * (tile - 6) + 64 * hh + 32 * bj;
    if (tile == 8) return 2052 + 32 * j;
    return 2308 + 256 * (tile - 9) + 32 * j;
}
constexpr int CONV_NIN = 200 * 16, CONV_NBR = 4 * 32 * 4, CONV_NOUT = 32 * 16, CONV_NGLU = 8 * 4, CONV_NUP1 = 176 * 16, CONV_NDN1 = 32 * 44;
constexpr int CONV_NMIX = CONV_NIN + CONV_NBR + CONV_NOUT + CONV_NGLU, CONV_CHUNK = 64;
__device__ __forceinline__ int conv_ffn_items(int layer) { return (CONV_NUP1 + CONV_NDN1) * ((layer & 1) ? NE : 1); }
__device__ __forceinline__ void convert_item(Frame& F, int layer, int it, LAS float* scr) {
    const Args& A = *F.a; unsigned char* ws = F.ws;
    const bool moe = (layer & 1) != 0; const int j2 = layer >> 1, ne = moe ? NE : 1;
    const int n_up = CONV_NUP1 * ne;
    int r = it;
    if (r < CONV_NIN) { const int blk = r >> 4, kb = r & 15;
        if (F8_GATES && blk >= 72) transpose_item_f8(A.in[I_WIN] + (size_t)layer * D * DP, DP, (unsigned char*)(ws + WS_WIN8), D, 64 * kb, win_src_col(blk), 32 * (blk - 72), scr, F.lane, 64.0f);
        else transpose_item(A.in[I_WIN] + (size_t)layer * D * DP, DP, (bf16*)(ws + WS_WIN), D, 64 * kb, win_src_col(blk), 32 * blk, scr, F.lane);
        return; } r -= CONV_NIN;
    if (r < CONV_NBR) { const int z = r >> 7, q = r & 127, blk = q >> 2, kb = q & 3;
        transpose_item(A.in[I_WBR] + ((size_t)layer * 4 + z) * 256 * D, D, (bf16*)(ws + WS_WBR) + (size_t)z * D * 256, 256, 64 * kb, 32 * blk, 32 * blk, scr, F.lane); return; } r -= CONV_NBR;
    if (r < CONV_NOUT) { const int blk = r >> 4, kb = r & 15; transpose_item(A.in[I_WOUT] + (size_t)layer * D * D, D, (bf16*)(ws + WS_WOUT), D, 64 * kb, 32 * blk, 32 * blk, scr, F.lane); return; } r -= CONV_NOUT;
    if (r < CONV_NGLU) { const int blk = r >> 2, kb = r & 3; transpose_item(A.in[I_WGLU] + (size_t)layer * 256 * 256, 256, (bf16*)(ws + WS_WGLU), 256, 64 * kb, 32 * blk, 32 * blk, scr, F.lane); return; } r -= CONV_NGLU;
    if (r < n_up) { const int e = r / CONV_NUP1, q = r % CONV_NUP1, blk = q >> 4, kb = q & 15, tile = blk >> 3, jj = blk & 7;
        const float* w1 = moe ? A.in[I_MW1] + ((size_t)j2 * NE + e) * D * FF : A.in[I_W1] + (size_t)j2 * D * FF;
        const float* w3 = moe ? A.in[I_MW3] + ((size_t)j2 * NE + e) * D * FF : A.in[I_W3] + (size_t)j2 * D * FF;
        const float* ks = (FUSE_DENSE_NORM && !moe) ? A.in[I_GFFN] + layer * D : nullptr;
        if (moe ? (F8_MOE_UP != 0) : (DENSE8(layer) != 0)) transpose_item_f8(jj < 4 ? w1 : w3, FF, (unsigned char*)(ws + WS_WUP) + (size_t)e * 5632 * D, D, 64 * kb, 128 * tile + 32 * (jj & 3), 32 * blk, scr, F.lane, 64.0f, ks);
        else transpose_item(jj < 4 ? w1 : w3, FF, (bf16*)(ws + WS_WUP) + (size_t)e * 5632 * D, D, 64 * kb, 128 * tile + 32 * (jj & 3), 32 * blk, scr, F.lane, ks);
        return; } r -= n_up;
    { const int e = r / CONV_NDN1, q = r % CONV_NDN1, blk = q / 44, kb = q % 44;
        const float* w2 = moe ? A.in[I_MW2] + ((size_t)j2 * NE + e) * FF * D : A.in[I_W2] + (size_t)j2 * FF * D;
        if (moe ? (F8_MOE_DN != 0) : (DENSE8(layer) != 0)) transpose_item_f8(w2, D, (unsigned char*)(ws + WS_WDN) + (size_t)e * D * FF, FF, 64 * kb, 32 * blk, 32 * blk, scr, F.lane, 64.0f);
        else transpose_item(w2, D, (bf16*)(ws + WS_WDN) + (size_t)e * D * FF, FF, 64 * kb, 32 * blk, 32 * blk, scr, F.lane); }
}
__device__ __forceinline__ void phase_convert(Frame& F, int layer) {
    LAS float* scr = (LAS float*)(F.lds + F.wave * 16384);
    for (int it = F.gw; it < CONV_NMIX; it += F.NGW) convert_item(F, layer, it, scr);
}
__device__ __forceinline__ void convert_ffn_chunk(Frame& F, int layer, int chunk) {
    LAS float* scr = (LAS float*)(F.lds + F.wave * 16384); const int nf = conv_ffn_items(layer);
    for (int j = F.wave; j < CONV_CHUNK; j += NWAVES) { const int it = chunk * CONV_CHUNK + j; if (it < nf) convert_item(F, layer, CONV_NMIX + it, scr); }
}
struct S5P { float lr, li, dt, kr, ki; };
__device__ __forceinline__ S5P s5_params(const Args& A, int layer, int g, int p) {
    S5P q; q.lr = A.in[I_LRE][(layer * 16 + g) * 64 + p]; q.li = A.in[I_LIM][(layer * 16 + g) * 64 + p]; q.dt = expf(A.in[I_LDT][layer * 16 + g]);
    const float mag = expf(q.lr * q.dt), abr = mag * cosf(q.li * q.dt), abi = mag * sinf(q.li * q.dt);
    const float nr = abr - 1.0f, ni = abi, den = q.lr * q.lr + q.li * q.li;
    q.kr = (nr * q.lr + ni * q.li) / den; q.ki = (ni * q.lr - nr * q.li) / den; return q;
}
__device__ __forceinline__ void s5_pow(const S5P& q, float n, float& pr, float& pi) { const float m = expf(n * q.lr * q.dt), a = n * q.li * q.dt; pr = m * cosf(a); pi = m * sinf(a); }
__device__ __forceinline__ void phase_kfun(Frame& F, int layer) {
    const Args& A = *F.a; float* kf = (float*)(F.ws + WS_KFUN);
    for (int it = F.gw; it < 16 * 64; it += F.NGW) {
        const int g = it >> 6, tau = it & 63, lane = F.lane;
        const S5P q = s5_params(A, layer, g, lane); float pr, pi; s5_pow(q, (float)tau, pr, pi);
        const float wr_ = pr * q.kr - pi * q.ki, wi_ = pr * q.ki + pi * q.kr;
        const int h = lane >> 2, hp0 = 4 * (lane & 3);
        const float* cre = A.in[I_CRE] + ((size_t)(layer * 16 + g) * 16 + h) * 64; const float* cim = A.in[I_CIM] + ((size_t)(layer * 16 + g) * 16 + h) * 64;
        const float* bre = A.in[I_BRE] + (size_t)(layer * 16 + g) * 64 * 16 + hp0; const float* bim = A.in[I_BIM] + (size_t)(layer * 16 + g) * 64 * 16 + hp0;
        f32x4 acc = {0.f, 0.f, 0.f, 0.f};
        for (int p = 0; p < 64; ++p) {
            const float wpr = __shfl(wr_, p), wpi = __shfl(wi_, p);
            const float cr = cre[p], ci = cim[p], cwr = cr * wpr - ci * wpi, cwi = cr * wpi + ci * wpr;
            const f32x4 br = *(const f32x4*)(bre + p * 16), bi = *(const f32x4*)(bim + p * 16);
            acc += cwr * br - cwi * bi;
        }
        *(f32x4*)(kf + ((size_t)(g * 64 + tau) * 16 + h) * 16 + hp0) = acc;
    }
}
__device__ __forceinline__ void moe_starts(Frame& F, int j2, int (&st)[NE + 1]) {
    const unsigned* cnt = (const unsigned*)(F.ws + WS_CTL) + CW_MOE + 64 * j2; int s = 0;
#pragma unroll
    for (int e = 0; e < NE; ++e) { st[e] = s; const int c = (int)__hip_atomic_load(cnt + e, __ATOMIC_RELAXED, __HIP_MEMORY_SCOPE_AGENT); s += (c + 255) & ~255; }
    st[NE] = s;
}
__device__ __forceinline__ void moe_combine_row(Frame& F, int row, f32x4 (&v)[4], const int (&st)[NE + 1]) {
    const unsigned* rt = (const unsigned*)(F.ws + WS_ROUTE) + (size_t)row * 8;
    const v4u rr = *(const v4u*)rt; unsigned s0 = rr.z, s1 = rr.w;
#pragma unroll
    for (int e = 0; e < NE; ++e) { if ((int)rr.x == e) s0 += (unsigned)st[e]; if ((int)rr.y == e) s1 += (unsigned)st[e]; }
    const float w0 = __builtin_bit_cast(float, rt[4]), w1 = __builtin_bit_cast(float, rt[5]);
    const bf16* yp = (const bf16*)(F.ws + WS_XNP);
#pragma unroll
    for (int j = 0; j < 4; ++j) { const v2u a = *(const v2u*)(yp + (size_t)s0 * D + 4 * F.lane + 256 * j), b = *(const v2u*)(yp + (size_t)s1 * D + 4 * F.lane + 256 * j);
        v[j][0] += w0 * bflo(a.x) + w1 * bflo(b.x); v[j][1] += w0 * bfhi(a.x) + w1 * bfhi(b.x); v[j][2] += w0 * bflo(a.y) + w1 * bflo(b.y); v[j][3] += w0 * bfhi(a.y) + w1 * bfhi(b.y); }
}
__device__ __forceinline__ void phase_rows_mixer(Frame& F, int layer) {
    const Args& A = *F.a; const int lane = F.lane;
    const float* xin = A.in[I_X]; bf16* xb = (bf16*)(F.ws + WS_XB); const bool first = (layer == 0), comb = (layer > 0) && (((layer - 1) & 1) != 0);
    f32x4 gv[4]; f32x4 wf[4][4];
#pragma unroll
    for (int j = 0; j < 4; ++j) { gv[j] = *(const f32x4*)(A.in[I_GMIX] + layer * D + 4 * lane + 256 * j);
#pragma unroll
        for (int e = 0; e < 4; ++e) wf[j][e] = *(const f32x4*)(A.in[I_WIN] + (size_t)layer * D * DP + (size_t)(4 * lane + 256 * j + e) * DP + 1024); }
    const f32x4 bf = *(const f32x4*)(A.in[I_BFORGET] + layer * 4);
    bf16* xn = (bf16*)(F.ws + WS_XN); float* lf = (float*)(F.ws + WS_LF); unsigned char* xn8 = F.ws + WS_XN8;
    int st[NE + 1];
#pragma unroll
    for (int e = 0; e <= NE; ++e) st[e] = 0;
    if (comb) moe_starts(F, (layer - 1) >> 1, st);
    for (int row = F.gw; row < T; row += F.NGW) {
        f32x4 v[4]; float ss = 0.f;
        if (first) {
#pragma unroll
            for (int j = 0; j < 4; ++j) v[j] = *(const f32x4*)(xin + (size_t)row * D + 4 * lane + 256 * j);
        } else {
#pragma unroll
            for (int j = 0; j < 4; ++j) { const v2u r = *(const v2u*)(xb + (size_t)row * D + 4 * lane + 256 * j); v[j] = (f32x4){bflo(r.x), bfhi(r.x), bflo(r.y), bfhi(r.y)}; }
        }
        if (comb) { moe_combine_row(F, row, v, st);
#pragma unroll
            for (int j = 0; j < 4; ++j) { v2u o; o.x = pk2(v[j][0], v[j][1]); o.y = pk2(v[j][2], v[j][3]); *(v2u*)(xb + (size_t)row * D + 4 * lane + 256 * j) = o;
                v[j] = (f32x4){bflo(o.x), bfhi(o.x), bflo(o.y), bfhi(o.y)}; } }
#pragma unroll
        for (int j = 0; j < 4; ++j) ss += (v[j][0] * v[j][0] + v[j][1] * v[j][1]) + (v[j][2] * v[j][2] + v[j][3] * v[j][3]);
        const float rs = 1.0f / sqrtf(wave_sum(ss) * (1.0f / D) + EPS);
        f32x4 fl = {0.f, 0.f, 0.f, 0.f};
#pragma unroll
        for (int j = 0; j < 4; ++j) { const f32x4 h = v[j] * rs * gv[j];
            v2u o; o.x = pk2(h[0], h[1]); o.y = pk2(h[2], h[3]); *(v2u*)(xn + (size_t)row * D + 4 * lane + 256 * j) = o;
            if (F8_GATES) *(unsigned*)(xn8 + (size_t)row * D + 4 * lane + 256 * j) = pk4_fp8(h[0], h[1], h[2], h[3]);
#pragma unroll
            for (int e = 0; e < 4; ++e) fl += h[e] * wf[j][e]; }
#pragma unroll
        for (int e = 0; e < 4; ++e) fl[e] = wave_sum(fl[e]);
        if (lane == 0) { f32x4 o;
#pragma unroll
            for (int e = 0; e < 4; ++e) { const float xx = fl[e] + bf[e]; o[e] = (fminf(xx, 0.f) - log1pf(expf(-fabsf(xx)))) * LOG2E; }
            *(f32x4*)(lf + (size_t)row * 4) = o; }
    }
}
__device__ __forceinline__ void phase_s5_tables(Frame& F, int layer) {
    const Args& A = *F.a; const int lane = F.lane;
    bf16* wz = (bf16*)(F.ws + WS_WZ); bf16* wy = (bf16*)(F.ws + WS_WY); const float* kf = (const float*)(F.ws + WS_KFUN);
    for (int it = F.gw; it < 16 * 256; it += F.NGW) {
        const int g = it >> 8, rowz = it & 255; bf16* dst = wz + ((size_t)(g * 256 + rowz)) * 1024 + lane * 16;
        v4u o0 = {0u, 0u, 0u, 0u}, o1 = {0u, 0u, 0u, 0u};
        if (rowz < 128) { const int p = rowz >> 1, ri = rowz & 1; const S5P q = s5_params(A, layer, g, p); float pr, pi; s5_pow(q, (float)(63 - lane), pr, pi);
            const float wr_ = pr * q.kr - pi * q.ki, wi_ = pr * q.ki + pi * q.kr;
            const float* bre = A.in[I_BRE] + ((size_t)(layer * 16 + g) * 64 + p) * 16; const float* bim = A.in[I_BIM] + ((size_t)(layer * 16 + g) * 64 + p) * 16;
            float val[16];
#pragma unroll
            for (int h = 0; h < 16; ++h) { const float br = bre[h], bi = bim[h]; val[h] = ri == 0 ? (wr_ * br - wi_ * bi) : (wr_ * bi + wi_ * br); }
            o0 = (v4u){pk2(val[0], val[1]), pk2(val[2], val[3]), pk2(val[4], val[5]), pk2(val[6], val[7])};
            o1 = (v4u){pk2(val[8], val[9]), pk2(val[10], val[11]), pk2(val[12], val[13]), pk2(val[14], val[15])}; }
        *(v4u*)dst = o0; *(v4u*)(dst + 8) = o1;
    }
    for (int it = F.gw; it < 16 * 1024; it += F.NGW) {
        const int g = it >> 10, n = it & 1023, t = n >> 4, h = n & 15; bf16* dst = wy + ((size_t)(g * 1024 + n)) * S5_LDA;
        v4u o0 = {0u, 0u, 0u, 0u}, o1 = {0u, 0u, 0u, 0u};
        if (lane <= t) { const float* src = kf + ((size_t)(g * 64 + (t - lane)) * 16 + h) * 16;
            const f32x4 a = *(const f32x4*)src, b = *(const f32x4*)(src + 4), c = *(const f32x4*)(src + 8), d = *(const f32x4*)(src + 12);
            o0 = (v4u){pk2(a[0], a[1]), pk2(a[2], a[3]), pk2(b[0], b[1]), pk2(b[2], b[3])}; o1 = (v4u){pk2(c[0], c[1]), pk2(c[2], c[3]), pk2(d[0], d[1]), pk2(d[2], d[3])}; }
        *(v4u*)(dst + lane * 16) = o0; *(v4u*)(dst + lane * 16 + 8) = o1;
        const S5P q = s5_params(A, layer, g, lane); float pr, pi; s5_pow(q, (float)(t + 1), pr, pi);
        const float cr = A.in[I_CRE][((size_t)(layer * 16 + g) * 16 + h) * 64 + lane], ci = A.in[I_CIM][((size_t)(layer * 16 + g) * 16 + h) * 64 + lane];
        *(unsigned*)(dst + 1024 + 2 * lane) = pk2(cr * pr - ci * pi, -(cr * pi + ci * pr));
    }
}
__device__ __forceinline__ void phase_cumsum(Frame& F) {
    const int first = (gridDim.x >= 160) ? 128 : 0;
    if ((int)blockIdx.x < first || (int)blockIdx.x >= first + 32) return;
    const int bh = (int)blockIdx.x - first, b = bh >> 2, h = bh & 3, tid = F.tid;
    const float* lf = (const float*)(F.ws + WS_LF); float* cum = (float*)(F.ws + WS_CUM);
    LAS float* wtot = (LAS float*)(F.lds);
    float v[8]; float run = 0.f;
#pragma unroll
    for (int i = 0; i < 8; ++i) { run += lf[((size_t)b * SEQ + tid * 8 + i) * 4 + h]; v[i] = run; }
    float incl = run;
#pragma unroll
    for (int o = 1; o < 64; o <<= 1) { const float n = __shfl_up(incl, o); if (F.lane >= o) incl += n; }
    if (F.lane == 63) wtot[F.wave] = incl;
    __syncthreads();
    float base = incl - run;
    for (int w = 0; w < F.wave; ++w) base += wtot[w];
#pragma unroll
    for (int i = 0; i < 8; ++i) cum[(size_t)bh * SEQ + tid * 8 + i] = base + v[i];
    __syncthreads();
}
__device__ __forceinline__ void phase_conv(Frame& F, int layer) {
    const Args& A = *F.a; const int lane = F.lane;
    LAS f32x4* wl = (LAS f32x4*)F.lds;
    for (int i = F.tid; i < 31 * 64; i += NWAVES * 64) wl[i] = *(const f32x4*)(A.in[I_CONVW] + (size_t)layer * 31 * 256 + (size_t)i * 4);
    __syncthreads();
    const f32x4 cb = *(const f32x4*)(A.in[I_CONVB] + layer * 256 + 4 * lane), lg = *(const f32x4*)(A.in[I_LNG] + layer * 256 + 4 * lane), lb = *(const f32x4*)(A.in[I_LNB] + layer * 256 + 4 * lane);
    const bf16* uc = (const bf16*)(F.ws + WS_UC); bf16* ycat = (bf16*)(F.ws + WS_YCAT);
    for (int run = F.gw; run < T / 8; run += F.NGW) {
        const int t0 = run * 8, tl0 = t0 & (SEQ - 1);
        f32x4 acc[8];
#pragma unroll
        for (int i = 0; i < 8; ++i) acc[i] = cb;
#pragma unroll
        for (int r = 0; r < 38; ++r) {
            v2u raw = {0u, 0u};
            if (tl0 - 30 + r >= 0) raw = *(const v2u*)(uc + (size_t)(t0 - 30 + r) * 256 + 4 * lane);
            const f32x4 x = {bflo(raw.x), bfhi(raw.x), bflo(raw.y), bfhi(raw.y)};
#pragma unroll
            for (int i = 0; i < 8; ++i) { const int j = r - i; if (j >= 0 && j < 31) acc[i] += wl[j * 64 + lane] * x; }
        }
#pragma unroll
        for (int i = 0; i < 8; ++i) {
            const f32x4 a = acc[i];
            const float mean = wave_sum((a[0] + a[1]) + (a[2] + a[3])) * (1.0f / 256.0f);
            const f32x4 dlt = a - mean;
            const float var = wave_sum((dlt[0] * dlt[0] + dlt[1] * dlt[1]) + (dlt[2] * dlt[2] + dlt[3] * dlt[3])) * (1.0f / 256.0f);
            const float rs = 1.0f / sqrtf(var + EPS);
            f32x4 y = dlt * rs * lg + lb;
#pragma unroll
            for (int e = 0; e < 4; ++e) y[e] = y[e] * sigmoidf_(y[e]);
            v2u o; o.x = pk2(y[0], y[1]); o.y = pk2(y[2], y[3]);
            *(v2u*)(ycat + (size_t)(t0 + i) * 1024 + 512 + 4 * lane) = o;
        }
    }
    __syncthreads();
}

typedef float f32x16 __attribute__((ext_vector_type(16)));
typedef short s16x4 __attribute__((ext_vector_type(4)));
constexpr int AT_PITCH = 72, AT_VOFF = 64 * AT_PITCH * 2, AT_COFF = 2 * AT_VOFF, AT_BUF = AT_COFF + 256, AT_FLAG = 2 * AT_BUF;
constexpr float SB_DEAD = -152.0f;
__device__ __forceinline__ s16x4 tr_read(const LAS unsigned char* p) { return __builtin_bit_cast(s16x4, __builtin_amdgcn_ds_read_tr16_b64_v4i16((LAS s16x4*)p)); }

template <int MODE>
__device__ __forceinline__ void attn_unit(Frame& F, int bh, int qb, const bf16* Q, const bf16* K, const bf16* V, const float* CUM, bf16* Y, float z2max) {
    const int tid = F.tid, lane = F.lane, w = F.wave, l31 = lane & 31, hh = lane >> 5;
    const int b = bh >> 2, h = bh & 3, Q0 = qb * 256, qw0 = Q0 + 32 * w, qrow = qw0 + l31;
    const size_t rowbase = (size_t)b * SEQ;
    LAS unsigned char* lds = F.lds;
    bf16x8 qf[4];
#pragma unroll
    for (int s = 0; s < 4; ++s) qf[s] = *(const bf16x8*)(Q + (rowbase + qrow) * 256 + h * 64 + 16 * s + 8 * hh);
    const float cq = (MODE == 0) ? CUM[(size_t)bh * SEQ + qrow] : 0.f;
    f32x16 ot[2];
#pragma unroll
    for (int r = 0; r < 16; ++r) { ot[0][r] = 0.f; ot[1][r] = 0.f; }
    float m_run = -INFINITY, l_run = 0.f, carry = 0.f; bool fdead = false;
    const int tmax = (Q0 + 255) >> 6, srow = tid >> 3, sch = tid & 7;
    const bf16* kg = K + (rowbase + srow) * 256 + h * 64 + sch * 8; const bf16* vg = V + (rowbase + srow) * 256 + h * 64 + sch * 8;
    const int sofs = (srow * AT_PITCH + sch * 8) * 2;
    v4u kreg = *(const v4u*)(kg + (size_t)(64 * tmax) * 256), vreg = *(const v4u*)(vg + (size_t)(64 * tmax) * 256);
    float creg = (MODE == 0 && tid < 64) ? -CUM[(size_t)bh * SEQ + 64 * tmax + tid] : 0.f;
    LAS unsigned* flags = (LAS unsigned*)(lds + AT_FLAG);
    if (tid < 3) flags[tid] = 0u;
    *(LAS v4u*)(lds + sofs) = kreg; *(LAS v4u*)(lds + AT_VOFF + sofs) = vreg; if (MODE == 0 && tid < 64) *(LAS float*)(lds + AT_COFF + tid * 4) = creg;
    __syncthreads();
    int cur = 0, it = 0;
    const int ti = lane & 15, tq = ti >> 2, tp = ti & 3, tg = (lane >> 4) & 1;
    const int vlane = (tq * AT_PITCH + 16 * tg + 4 * tp) * 2;
    for (int t = tmax; t >= 0; --t, ++it) {
        const bool more = t > 0;
        if (more) { kreg = *(const v4u*)(kg + (size_t)(64 * (t - 1)) * 256); vreg = *(const v4u*)(vg + (size_t)(64 * (t - 1)) * 256); if (MODE == 0 && tid < 64) creg = -CUM[(size_t)bh * SEQ + 64 * (t - 1) + tid]; }
        const LAS unsigned char* Kb = lds + cur * AT_BUF; const LAS unsigned char* Vb = Kb + AT_VOFF; const LAS unsigned char* Cb = Kb + AT_COFF;
        const int kv0 = 64 * t;
        bool alive = false;
        if (kv0 <= qw0 + 31 && !__all(MODE == 0 ? fdead : (carry < SB_DEAD))) {
            f32x16 p[2];
            if (MODE == 0) {
#pragma unroll
                for (int hf = 0; hf < 2; ++hf)
#pragma unroll
                    for (int c = 0; c < 4; ++c) { const f32x4 ck = *(const LAS f32x4*)(Cb + (32 * hf + 8 * c + 4 * hh) * 4);
#pragma unroll
                        for (int i = 0; i < 4; ++i) p[hf][4 * c + i] = ck[i]; }
            } else {
#pragma unroll
                for (int r = 0; r < 16; ++r) { p[0][r] = 0.f; p[1][r] = 0.f; }
            }
#pragma unroll
            for (int s = 0; s < 4; ++s) {
                const bf16x8 k0 = *(const LAS bf16x8*)(Kb + (l31 * AT_PITCH + 16 * s + 8 * hh) * 2), k1 = *(const LAS bf16x8*)(Kb + ((32 + l31) * AT_PITCH + 16 * s + 8 * hh) * 2);
                p[0] = __builtin_amdgcn_mfma_f32_32x32x16_bf16(k0, qf[s], p[0], 0, 0, 0);
                p[1] = __builtin_amdgcn_mfma_f32_32x32x16_bf16(k1, qf[s], p[1], 0, 0, 0);
            }
            const bool diag = (kv0 + 63 > qw0);
            if (MODE == 0) {
                if (diag) {
#pragma unroll
                    for (int hf = 0; hf < 2; ++hf)
#pragma unroll
                        for (int r = 0; r < 16; ++r) { const int kvg = kv0 + 32 * hf + (r & 3) + 8 * (r >> 2) + 4 * hh; if (kvg > qrow) p[hf][r] = -INFINITY; }
                }
                float mt = p[0][0];
#pragma unroll
                for (int r = 0; r < 16; ++r) { mt = fmaxf(mt, p[0][r]); mt = fmaxf(mt, p[1][r]); }
                mt = fmaxf(mt, __shfl_xor(mt, 32));
                const float mn = fmaxf(m_run, mt), alpha = fast_exp2(m_run - mn); m_run = mn;
                float rs = 0.f;
#pragma unroll
                for (int r = 0; r < 16; ++r) { p[0][r] = fast_exp2(p[0][r] - mn); p[1][r] = fast_exp2(p[1][r] - mn); rs += p[0][r] + p[1][r]; }
                l_run = l_run * alpha + rs;
                if (__any(alpha != 1.0f)) {
#pragma unroll
                    for (int r = 0; r < 16; ++r) { ot[0][r] *= alpha; ot[1][r] *= alpha; } }
                if (more) { const float cnext = CUM[(size_t)bh * SEQ + kv0 - 1]; fdead = (z2max - cnext - m_run) < SB_DEAD; alive = !__all(fdead); }
            } else {
                f32x16 lk[2];
#pragma unroll
                for (int hf = 0; hf < 2; ++hf)
#pragma unroll
                    for (int r = 0; r < 16; ++r) { const float z = p[hf][r], e = fast_exp2(-fabsf(z)), lg = __builtin_amdgcn_logf(1.0f + e);
                        float lb = fminf(z, 0.f) - lg, k_ = -(fmaxf(z, 0.f) + lg);
                        if (diag) { const int kvg = kv0 + 32 * hf + (r & 3) + 8 * (r >> 2) + 4 * hh; if (kvg >= qrow) { k_ = 0.f; lb = -INFINITY; } }
                        p[hf][r] = lb; lk[hf][r] = k_; }
                float T[8], To[8], PS[8];
#pragma unroll
                for (int mI = 0; mI < 8; ++mI) { const int hf = mI >> 2, c = mI & 3; T[mI] = (lk[hf][4 * c] + lk[hf][4 * c + 1]) + (lk[hf][4 * c + 2] + lk[hf][4 * c + 3]); To[mI] = __shfl_xor(T[mI], 32); }
                float run = 0.f;
#pragma unroll
                for (int mI = 7; mI >= 0; --mI) { PS[mI] = run; run += T[mI] + To[mI]; }
#pragma unroll
                for (int mI = 0; mI < 8; ++mI) { const int hf = mI >> 2, c = mI & 3; const float base = carry + PS[mI] + (hh == 0 ? To[mI] : 0.f);
                    const float s3 = lk[hf][4 * c + 3], s2 = s3 + lk[hf][4 * c + 2], s1 = s2 + lk[hf][4 * c + 1];
                    p[hf][4 * c + 3] = fast_exp2(p[hf][4 * c + 3] + base); p[hf][4 * c + 2] = fast_exp2(p[hf][4 * c + 2] + base + s3);
                    p[hf][4 * c + 1] = fast_exp2(p[hf][4 * c + 1] + base + s2); p[hf][4 * c] = fast_exp2(p[hf][4 * c] + base + s1); }
                carry += run;
                alive = __any(carry >= SB_DEAD);
            }
            bf16x8 pb[2][2];
#pragma unroll
            for (int hf = 0; hf < 2; ++hf)
#pragma unroll
                for (int c2 = 0; c2 < 2; ++c2) { v4u wv; wv.x = pg8::cvt_pk_bf16(p[hf][8 * c2], p[hf][8 * c2 + 1]); wv.y = pg8::cvt_pk_bf16(p[hf][8 * c2 + 2], p[hf][8 * c2 + 3]);
                    wv.z = pg8::cvt_pk_bf16(p[hf][8 * c2 + 4], p[hf][8 * c2 + 5]); wv.w = pg8::cvt_pk_bf16(p[hf][8 * c2 + 6], p[hf][8 * c2 + 7]); pb[hf][c2] = __builtin_bit_cast(bf16x8, wv); }
#pragma unroll
            for (int db = 0; db < 2; ++db)
#pragma unroll
                for (int hf = 0; hf < 2; ++hf)
#pragma unroll
                    for (int c2 = 0; c2 < 2; ++c2) { const LAS unsigned char* vp = Vb + ((32 * hf + 16 * c2 + 4 * hh) * AT_PITCH + 32 * db) * 2 + vlane;
                        const s16x4 lo = tr_read(vp), hi = tr_read(vp + 8 * AT_PITCH * 2);
                        const bf16x8 va = {lo[0], lo[1], lo[2], lo[3], hi[0], hi[1], hi[2], hi[3]};
                        ot[db] = __builtin_amdgcn_mfma_f32_32x32x16_bf16(va, pb[hf][c2], ot[db], 0, 0, 0); }
        } else { alive = (kv0 > qw0 + 31); }
        if (more) { const int o = (cur ^ 1) * AT_BUF + sofs; *(LAS v4u*)(lds + o) = kreg; *(LAS v4u*)(lds + o + AT_VOFF) = vreg; if (MODE == 0 && tid < 64) *(LAS float*)(lds + (cur ^ 1) * AT_BUF + AT_COFF + tid * 4) = creg; }
        { const int sl = it % 3, sn = (it + 1) % 3;
            if (alive && lane == 0) flags[sl] = 1u;
            if (tid == 0) flags[sn] = 0u;
            __syncthreads();
            if (flags[sl] == 0u) break; }
        cur ^= 1;
    }
    float inv = 1.0f;
    if (MODE == 0) { const float lt = l_run + __shfl_xor(l_run, 32); inv = 1.0f / lt; }
    bf16* yrow = Y + (rowbase + qrow) * 1024 + h * 64;
#pragma unroll
    for (int db = 0; db < 2; ++db)
#pragma unroll
        for (int c = 0; c < 4; ++c) { v2u o; o.x = pg8::cvt_pk_bf16(ot[db][4 * c] * inv, ot[db][4 * c + 1] * inv); o.y = pg8::cvt_pk_bf16(ot[db][4 * c + 2] * inv, ot[db][4 * c + 3] * inv);
            *(v2u*)(yrow + 32 * db + 8 * c + 4 * hh) = o; }
    __syncthreads();
}
__device__ __forceinline__ int q_pop(Frame& F, unsigned* ctr) {
    LAS int* slot = (LAS int*)(F.lds + QSLOT_OFF);
    __syncthreads();
    if (F.tid == 0) *slot = (int)__hip_atomic_fetch_add(ctr, 1u, __ATOMIC_RELAXED, __HIP_MEMORY_SCOPE_AGENT);
    __syncthreads();
    return *slot;
}
__device__ __forceinline__ void phase_attn_sb(Frame& F, int layer, int rep) {
    const bf16* qkv = (const bf16*)(F.ws + WS_QKV); const size_t sz = (size_t)T * 256; bf16* ycat = (bf16*)(F.ws + WS_YCAT);
    unsigned* ctr = (unsigned*)(F.ws + WS_CTL) + CW_Q + 128 * layer + 16 * rep;
    for (;;) { const int un = q_pop(F, ctr); if (un >= 512) break;
        attn_unit<1>(F, un & 31, 15 - (un >> 5), qkv + 3 * sz, qkv + 4 * sz, qkv + 5 * sz, nullptr, ycat + 768, 0.f); }
}
__device__ __forceinline__ void phase_attn_fox(Frame& F, int layer, int rep) {
    const bf16* qkv = (const bf16*)(F.ws + WS_QKV); const size_t sz = (size_t)T * 256; const float* cum = (const float*)(F.ws + WS_CUM); bf16* ycat = (bf16*)(F.ws + WS_YCAT);
    unsigned* ctr = (unsigned*)(F.ws + WS_CTL) + CW_Q + 128 * layer + 64 + 16 * rep;
    const float gq = fabsf(F.a->in[I_FQG][layer * 64 + F.lane]), gk = fabsf(F.a->in[I_FKG][layer * 64 + F.lane]);
    float mq = gq, mk = gk;
#pragma unroll
    for (int o = 1; o < 64; o <<= 1) { mq = fmaxf(mq, __shfl_xor(mq, o)); mk = fmaxf(mk, __shfl_xor(mk, o)); }
    const float z2max = 8.0f * mq * mk * LOG2E * 1.02f + 0.25f;
    const int nchunk = (conv_ffn_items(layer) + CONV_CHUNK - 1) / CONV_CHUNK;
    const int total = 512 + nchunk;
    for (;;) { const int t = q_pop(F, ctr); if (t >= total) break;
        const int na0 = (int)(((long)t * 512) / total), na1 = (int)(((long)(t + 1) * 512) / total);
        if (na1 > na0) attn_unit<0>(F, na0 & 31, 15 - (na0 >> 5), qkv, qkv + sz, qkv + 2 * sz, cum, ycat + 256, z2max);
        else convert_ffn_chunk(F, layer, t - na0); }
}
__device__ __forceinline__ void phase_s5_scan_unit(Frame& F, int layer, int g, int pm) {
    __builtin_amdgcn_fence(__ATOMIC_ACQUIRE, "agent");
    if (F.tid < 256) {
        const int b = 4 * pm + (F.tid >> 6), p = F.tid & 63;
        const S5P q = s5_params(*F.a, layer, g, p); float ar, ai; s5_pow(q, 64.0f, ar, ai);
        const float* z = (const float*)(F.ws + WS_Z); bf16* ua = (bf16*)(F.ws + WS_UA);
        float sr = 0.f, si = 0.f;
        for (int n0 = 0; n0 < 64; n0 += 16) {
            f32x2 zz[16];
#pragma unroll
            for (int j = 0; j < 16; ++j) zz[j] = *(const f32x2*)(z + ((size_t)g * 512 + b * 64 + n0 + j) * 128 + 2 * p);
#pragma unroll
            for (int j = 0; j < 16; ++j) { const size_t ch = (size_t)g * 512 + b * 64 + n0 + j;
                *(unsigned*)(ua + ch * S5_LDA + 1024 + 2 * p) = pk2(sr, si);
                const float nr = ar * sr - ai * si + zz[j][0], ni = ar * si + ai * sr + zz[j][1]; sr = nr; si = ni; }
        }
    }
    __syncthreads();
}
__device__ __forceinline__ void phase_rows_ffn(Frame& F, int layer) {
    const Args& A = *F.a; const int lane = F.lane; const int j2 = layer >> 1;
    f32x4 gv[4];
#pragma unroll
    for (int j = 0; j < 4; ++j) gv[j] = *(const f32x4*)(A.in[I_GFFN] + layer * D + 4 * lane + 256 * j);
    const bf16* xb = (const bf16*)(F.ws + WS_XB); unsigned char* seg = F.ws + WS_XNP; unsigned* route = (unsigned*)(F.ws + WS_ROUTE); unsigned* cnt = (unsigned*)(F.ws + WS_CTL) + CW_MOE + 64 * j2;
    unsigned my_e0 = 0, my_e1 = 0, my_r0 = 0, my_r1 = 0; float my_w0 = 0.f, my_w1 = 0.f, my_rs = 0.f; unsigned long long lc = 0ull; int nrow = 0;
    for (int row = F.gw; row < T; row += F.NGW, ++nrow) {
        f32x4 v[4]; float ss = 0.f;
#pragma unroll
        for (int j = 0; j < 4; ++j) { const v2u r = *(const v2u*)(xb + (size_t)row * D + 4 * lane + 256 * j); v[j] = (f32x4){bflo(r.x), bfhi(r.x), bflo(r.y), bfhi(r.y)};
            ss += (v[j][0] * v[j][0] + v[j][1] * v[j][1]) + (v[j][2] * v[j][2] + v[j][3] * v[j][3]); }
        const float rs = 1.0f / sqrtf(wave_sum(ss) * (1.0f / D) + EPS);
        float lg[8];
#pragma unroll
        for (int e = 0; e < 8; ++e) lg[e] = 0.f;
#pragma unroll
        for (int j = 0; j < 4; ++j) { const f32x4 h = v[j] * rs * gv[j];
#pragma unroll
            for (int e4 = 0; e4 < 4; ++e4) { const float* wr = A.in[I_RW] + ((size_t)j2 * D + 4 * lane + 256 * j + e4) * NE; const f32x4 a = *(const f32x4*)wr, b = *(const f32x4*)(wr + 4);
                lg[0] += h[e4] * a[0]; lg[1] += h[e4] * a[1]; lg[2] += h[e4] * a[2]; lg[3] += h[e4] * a[3]; lg[4] += h[e4] * b[0]; lg[5] += h[e4] * b[1]; lg[6] += h[e4] * b[2]; lg[7] += h[e4] * b[3]; } }
#pragma unroll
        for (int e = 0; e < 8; ++e) lg[e] = wave_sum(lg[e]) + A.in[I_RB][j2 * NE + e];
        int e0 = 0; float v0 = lg[0];
#pragma unroll
        for (int e = 1; e < 8; ++e) if (lg[e] > v0) { v0 = lg[e]; e0 = e; }
        int e1 = -1; float v1 = -INFINITY;
#pragma unroll
        for (int e = 0; e < 8; ++e) if (e != e0 && lg[e] > v1) { v1 = lg[e]; e1 = e; }
        const float w1 = 1.0f / (1.0f + expf(v0 - v1)), w0 = 1.0f - w1;
        const unsigned r0 = (unsigned)(lc >> (8 * e0)) & 0xffu; lc += 1ull << (8 * e0);
        const unsigned r1 = (unsigned)(lc >> (8 * e1)) & 0xffu; lc += 1ull << (8 * e1);
        if (lane == nrow) { my_e0 = e0; my_e1 = e1; my_r0 = r0; my_r1 = r1; my_w0 = w0; my_w1 = w1; my_rs = rs; }
    }
    unsigned basev = 0;
    if (lane < 8) { const unsigned c = (unsigned)(lc >> (8 * lane)) & 0xffu; basev = c ? __hip_atomic_fetch_add(cnt + lane, c, __ATOMIC_RELAXED, __HIP_MEMORY_SCOPE_AGENT) : 0u; }
    const unsigned my_p0 = __shfl(basev, (int)my_e0) + my_r0, my_p1 = __shfl(basev, (int)my_e1) + my_r1;
    if (lane < nrow) { const int row = F.gw + lane * F.NGW; unsigned* rt = route + (size_t)row * 8;
        *(v4u*)rt = (v4u){my_e0, my_e1, my_p0, my_p1}; *(v4u*)(rt + 4) = (v4u){__builtin_bit_cast(unsigned, my_w0), __builtin_bit_cast(unsigned, my_w1), 0u, 0u}; }
    for (int i = 0; i < nrow; ++i) {
        const int row = F.gw + i * F.NGW; const float rs = __shfl(my_rs, i);
        const size_t d0 = ((size_t)__shfl((int)my_e0, i) * T + (size_t)__shfl((int)my_p0, i)) * D, d1 = ((size_t)__shfl((int)my_e1, i) * T + (size_t)__shfl((int)my_p1, i)) * D;
#pragma unroll
        for (int j = 0; j < 4; ++j) { const v2u r = *(const v2u*)(xb + (size_t)row * D + 4 * lane + 256 * j);
            const f32x4 h = (f32x4){bflo(r.x), bfhi(r.x), bflo(r.y), bfhi(r.y)} * rs * gv[j]; const unsigned w = pk4_fp8(h[0], h[1], h[2], h[3]);
            *(unsigned*)(seg + d0 + 4 * lane + 256 * j) = w; *(unsigned*)(seg + d1 + 4 * lane + 256 * j) = w; }
    }
}
__device__ __forceinline__ void phase_final_combine(Frame& F) {
    const Args& A = *F.a; int st[NE + 1]; moe_starts(F, (DEPTH - 1) >> 1, st);
    for (int row = F.gw; row < T; row += F.NGW) {
        f32x4 v[4];
#pragma unroll
        for (int j = 0; j < 4; ++j) { const v2u r = *(const v2u*)((const bf16*)(F.ws + WS_XB) + (size_t)row * D + 4 * F.lane + 256 * j); v[j] = (f32x4){bflo(r.x), bfhi(r.x), bflo(r.y), bfhi(r.y)}; }
        moe_combine_row(F, row, v, st);
#pragma unroll
        for (int j = 0; j < 4; ++j) *(f32x4*)(A.out + (size_t)row * D + 4 * F.lane + 256 * j) = v[j];
    }
}

__global__ void __launch_bounds__(NWAVES * 64, 2) mk_fwd(Args args) {
    extern __shared__ __attribute__((aligned(16))) unsigned char lds_raw[];
    Frame F; F.lds = (LAS unsigned char*)lds_raw; F.tid = threadIdx.x; F.lane = F.tid & 63; F.wave = __builtin_amdgcn_readfirstlane(F.tid >> 6);
    F.G = gridDim.x; { const int bx = blockIdx.x; F.vcu = (F.G % 8 == 0) ? (bx % 8) * (F.G / 8) + bx / 8 : bx; }
    F.gw = F.vcu * NWAVES + F.wave; F.NGW = F.G * NWAVES; F.a = &args; F.ws = args.ws;
    volatile LAS unsigned* MISC = (volatile LAS unsigned*)(F.lds + MISC_OFF);
    for (int u = F.tid; u < (LDS_BYTES - RING_BYTES) / 4; u += NWAVES * 64) ((LAS unsigned*)(F.lds + RING_BYTES))[u] = 0u;
    __syncthreads();
    unsigned* ctl = (unsigned*)(args.ws + WS_CTL);
    const bool multi = (args.gp_hi - args.gp_lo) > 1;
    XcdBarrier bar; bar.bar = ctl + CW_BAR; bar.x = 0; bar.st = nullptr;
    if (multi) bar = xcd_barrier_post(ctl + CW_BAR, MISC + 8);
    unsigned char* ws = args.ws;
    LAS unsigned char* ring = F.lds;

    const int gp_lo = args.gp_lo, gp_hi = args.gp_hi;
#define IN(p) (gp_lo <= layer * NPH + (p) && layer * NPH + (p) < gp_hi)
#define SEAM(p) do { if (IN(p) && layer * NPH + (p) + 1 < gp_hi) xcd_barrier(bar); } while (0)
#ifndef PH_MASK
#define PH_MASK 0xffff
#endif
#define ON(p) (((PH_MASK) >> (p)) & 1)
#ifndef PROBE_PH
#define PROBE_PH -1
#endif
#ifndef PROBE_N
#define PROBE_N 1
#endif
#ifndef PROBE_LAYERS
#define PROBE_LAYERS 15
#endif
#define REPS(p) ((((p) == PROBE_PH) && ((PROBE_LAYERS >> layer) & 1)) ? 1 + PROBE_N : 1)
#define ENTER() do { ws = args.ws; asm volatile("" : "+s"(ws)); F.ws = ws; int t_ = threadIdx.x; asm volatile("" : "+v"(t_)); F.tid = t_; F.lane = t_ & 63; F.wave = __builtin_amdgcn_readfirstlane(t_ >> 6); F.gw = F.vcu * NWAVES + F.wave; } while (0)
    for (int layer = gp_lo / NPH; layer < DEPTH && layer * NPH < gp_hi; ++layer) {
        const bool moe = (layer & 1) != 0;
#if ON(0)
        if (IN(0)) for (int rep_ = 0; rep_ < REPS(0); ++rep_) { ENTER(); for (int r2_ = 0; r2_ < ((PROBE_PH == 100) ? 1 + PROBE_N : 1); ++r2_) { phase_convert(F, layer); phase_kfun(F, layer); } phase_rows_mixer(F, layer); }
        SEAM(0);
#endif
#if ON(1)
        if (IN(1)) for (int rep_ = 0; rep_ < REPS(1); ++rep_) { ENTER();
            phase_s5_tables(F, layer); phase_cumsum(F);
#if F8_GATES
            { pg8::Gemm g8{(const bf16*)(ws + WS_XN8), (const bf16*)(ws + WS_WIN8), D / 2, D / 2, D / 2, (unsigned*)(ws + WS_DUMMY)}; pg8::StaticOrder S8; S8.init(T, 4096, F.G, (int)blockIdx.x, D / 2, D / 2);
              pg8::EpiGateSig E8; E8.gate = (bf16*)(ws + WS_GATE);
              pg8::gemm_phase<pg8::EpiGateSig, pg8::StaticOrder, true, true>(ring, g8, S8, E8); }
#endif
            pg8::Gemm g{(const bf16*)(ws + WS_XN), (const bf16*)(ws + WS_WIN), D, D, D, (unsigned*)(ws + WS_DUMMY)}; pg8::StaticOrder S; S.init(T, F8_GATES ? 2304 : NPROJ, F.G, (int)blockIdx.x, D, D);
            pg8::EpiInProj E; E.ua = (bf16*)(ws + WS_UA); E.qkv = (bf16*)(ws + WS_QKV); E.uc = (bf16*)(ws + WS_UC); E.gate = (bf16*)(ws + WS_GATE);
            { LAS float* gl = (LAS float*)(F.lds + GAIN_OFF);
              if (F.tid < 256) { const int w = F.tid >> 6, d = F.tid & 63; const float* src = (w == 0) ? args.in[I_FQG] : (w == 1) ? args.in[I_FKG] : (w == 2) ? args.in[I_SQG] : args.in[I_SKG];
                  gl[F.tid] = src[layer * 64 + d] * ((w == 0 || w == 2) ? QSCALE : 1.0f); }
              __syncthreads(); E.gl = gl; }
            pg8::gemm_phase<pg8::EpiInProj, pg8::StaticOrder, true>(ring, g, S, E);
        }
        SEAM(1);
#endif
#if ON(2)
        if (IN(2)) for (int rep_ = 0; rep_ < REPS(2); ++rep_) { ENTER();
            { pg8::Gemm g{(const bf16*)(ws + WS_UA), (const bf16*)(ws + WS_WZ), 1024, S5_LDA, 1024, (unsigned*)(ws + WS_DUMMY)};
              pg8::BatchOrder S; S.nM = 2; S.nN = 1; S.nZ = 16; S.G = F.G; S.c = (int)blockIdx.x; S.tA = (size_t)256 * S5_LDA * 2; S.tB = 0; S.zA = (size_t)512 * S5_LDA * 2; S.zB = (size_t)256 * 1024 * 2;
              pg8::EpiZ E; E.z = (float*)(ws + WS_Z);
              pg8::gemm_phase<pg8::EpiZ, pg8::BatchOrder, false>(ring, g, S, E);
              if ((int)blockIdx.x < 32) phase_s5_scan_unit(F, layer, (int)blockIdx.x >> 1, (int)blockIdx.x & 1); }
            phase_conv(F, layer);
            phase_attn_sb(F, layer, rep_);
        }
        SEAM(2);
#endif
#if ON(4)
        if (IN(4)) for (int rep_ = 0; rep_ < REPS(4); ++rep_) { ENTER();
            { pg8::Gemm g{(const bf16*)(ws + WS_UA), (const bf16*)(ws + WS_WY), S5_LDA, S5_LDA, S5_LDA, (unsigned*)(ws + WS_DUMMY)};
              pg8::BatchOrder S; S.nM = 2; S.nN = 4; S.nZ = 16; S.G = F.G; S.c = (int)blockIdx.x; S.tA = (size_t)256 * S5_LDA * 2; S.tB = (size_t)256 * S5_LDA * 2; S.zA = (size_t)512 * S5_LDA * 2; S.zB = (size_t)1024 * S5_LDA * 2;
              pg8::EpiY E; E.ua = (const bf16*)(ws + WS_UA); E.dskip = args.in[I_S5D] + layer * 256; E.yp = (bf16*)(ws + WS_YP);
              pg8::gemm_phase<pg8::EpiY, pg8::BatchOrder, false>(ring, g, S, E); }
            phase_attn_fox(F, layer, rep_);
        }
        SEAM(4);
#endif
#if ON(5)
        if (IN(5) && F.G != 256) for (int rep_ = 0; rep_ < REPS(5); ++rep_) { ENTER();
            pg8::Gemm g{(const bf16*)(ws + WS_YP), (const bf16*)(ws + WS_WGLU), 256, 256, 256, (unsigned*)(ws + WS_DUMMY)};
            pg8::BatchOrder S; S.nM = T / 256; S.nN = 1; S.nZ = 1; S.G = F.G; S.c = (int)blockIdx.x; S.tA = (size_t)256 * 256 * 2; S.tB = 0; S.zA = 0; S.zB = 0;
            pg8::EpiGlu E; E.yp = (const bf16*)(ws + WS_YP); E.ycat = (bf16*)(ws + WS_YCAT);
            pg8::gemm_phase<pg8::EpiGlu, pg8::BatchOrder, false>(ring, g, S, E);
        }
        if (F.G != 256) SEAM(5);
#endif
#if ON(6)
        if (IN(6)) for (int rep_ = 0; rep_ < REPS(6); ++rep_) { ENTER();
            const int paired = (F.G == 256) ? 1 : 0;
            if (paired) {
                pg8::Gemm g{(const bf16*)(ws + WS_YP), (const bf16*)(ws + WS_WGLU), 256, 256, 256, (unsigned*)(ws + WS_DUMMY)};
                pg8::OneUnit S; S.pm = F.vcu >> 1; S.tA = (size_t)256 * 256 * 2;
                pg8::EpiGlu E; E.yp = (const bf16*)(ws + WS_YP); E.ycat = (bf16*)(ws + WS_YCAT);
                pg8::gemm_phase<pg8::EpiGlu, pg8::OneUnit, false>(ring, g, S, E);
            }
            pg8::Gemm g{(const bf16*)(ws + WS_YCAT), (const bf16*)(ws + WS_WBR), 256, 1024, 256, (unsigned*)(ws + WS_DUMMY)};
            pg8::BranchOrder1 S; S.nM = T / 256; S.nN = 8; S.G = F.G; S.c = (int)blockIdx.x; S.tA = (size_t)256 * 1024 * 2; S.tB = (size_t)128 * 256 * 2; S.zA = 256 * 2; S.zB = (size_t)1024 * 256 * 2; S.paired = paired; S.vc = F.vcu;
            pg8::EpiGate1 E; E.gate = (const bf16*)(ws + WS_GATE); E.mb = (bf16*)(ws + WS_XN);
            pg8::gemm_phase_n1<pg8::EpiGate1, pg8::BranchOrder1>(ring, g, S, E);
        }
        SEAM(6);
#endif
#if ON(7)
        if (IN(7)) for (int rep_ = 0; rep_ < REPS(7); ++rep_) { ENTER();
            pg8::Gemm g{(const bf16*)(ws + WS_XN), (const bf16*)(ws + WS_WOUT), D, D, D, (unsigned*)(ws + WS_DUMMY)}; pg8::StaticOrder S; S.init(T, D, F.G, (int)blockIdx.x, D, D);
            pg8::EpiResid<false> E; E.base32 = args.in[I_X]; E.base16 = (const bf16*)(ws + WS_XB); E.out = (bf16*)(ws + WS_XB); E.ss = (float*)(ws + WS_SSP); E.out8 = ws + WS_XN8;
            E.flags = ((layer == 0) ? 1 : 0) | ((FUSE_DENSE_NORM && !moe) ? 2 : 0) | ((FUSE_DENSE_NORM && !moe && DENSE8(layer)) ? 4 : 0);
            pg8::gemm_phase<pg8::EpiResid<false>, pg8::StaticOrder, true>(ring, g, S, E);
        }
        SEAM(7);
#endif
#if ON(8)
        if (IN(8)) for (int rep_ = 0; rep_ < REPS(8); ++rep_) { ENTER(); if (moe || !FUSE_DENSE_NORM) phase_rows_ffn(F, layer); }
        if (moe || !FUSE_DENSE_NORM) SEAM(8);
#endif
#if ON(10)
        if (IN(10)) for (int rep_ = 0; rep_ < REPS(10); ++rep_) { ENTER();
            if (!moe) {
                if (DENSE8(layer)) {
                    constexpr int DQ = D / 2;
                    pg8::Gemm g{(const bf16*)(ws + (FUSE_DENSE_NORM ? WS_XN8 : WS_XN)), (const bf16*)(ws + WS_WUP), DQ, DQ, DQ, (unsigned*)(ws + WS_DUMMY)}; pg8::StaticOrder S; S.init(T, 2 * FF, F.G, (int)blockIdx.x, DQ, DQ);
                    pg8::EpiSwiGlu<true> E; E.h = (bf16*)(ws + WS_HH); E.sc = 1.0f / 64.0f; E.ss = (const float*)(ws + WS_SSP); E.use_ss = FUSE_DENSE_NORM;
                    pg8::gemm_phase<pg8::EpiSwiGlu<true>, pg8::StaticOrder, true, true>(ring, g, S, E);
                } else {
                    pg8::Gemm g{(const bf16*)(ws + (FUSE_DENSE_NORM ? WS_XB : WS_XN)), (const bf16*)(ws + WS_WUP), D, D, D, (unsigned*)(ws + WS_DUMMY)}; pg8::StaticOrder S; S.init(T, 2 * FF, F.G, (int)blockIdx.x, D, D);
                    pg8::EpiSwiGlu<false> E; E.h = (bf16*)(ws + WS_HH); E.sc = 1.0f; E.ss = (const float*)(ws + WS_SSP); E.use_ss = FUSE_DENSE_NORM;
                    pg8::gemm_phase<pg8::EpiSwiGlu<false>, pg8::StaticOrder, true, false>(ring, g, S, E);
                }
            } else {
                constexpr bool U8 = F8_MOE_UP != 0, H8 = F8_MOE_DN != 0; constexpr int DQ = U8 ? D / 2 : D;
                pg8::Gemm g{(const bf16*)(ws + WS_XNP), (const bf16*)(ws + WS_WUP), DQ, DQ, DQ, (unsigned*)(ws + WS_DUMMY)};
                pg8::GroupOrder S; S.nN = 22; S.G = F.G; S.c = (int)blockIdx.x; S.tA = (size_t)256 * DQ * 2; S.tB = (size_t)256 * DQ * 2; S.zB = (size_t)5632 * DQ * 2; S.zA = (size_t)T * DQ * 2;
                int st[NE + 1]; moe_starts(F, layer >> 1, st);
#pragma unroll
                for (int e = 0; e <= NE; ++e) S.ts[e] = __builtin_amdgcn_readfirstlane(st[e] >> 8);
                pg8::EpiSwiGlu<H8> E; E.h = (bf16*)(ws + WS_HP); E.sc = U8 ? (1.0f / 64.0f) : 1.0f; E.ss = (const float*)(ws + WS_SSP); E.use_ss = 0;
                pg8::gemm_phase<pg8::EpiSwiGlu<H8>, pg8::GroupOrder, true, U8>(ring, g, S, E);
            }
        }
        SEAM(10);
#endif
#if ON(11)
        if (IN(11)) for (int rep_ = 0; rep_ < REPS(11); ++rep_) { ENTER();
            if (!moe) {
                if (DENSE8(layer)) {
                    constexpr int FQ = FF / 2;
                    pg8::Gemm g{(const bf16*)(ws + WS_HH), (const bf16*)(ws + WS_WDN), FQ, FQ, FQ, (unsigned*)(ws + WS_DUMMY)}; pg8::StaticOrder S; S.init(T, D, F.G, (int)blockIdx.x, FQ, FQ);
                    pg8::EpiResid<true> E; E.base32 = args.in[I_X]; E.base16 = (const bf16*)(ws + WS_XB); E.out = (bf16*)(ws + WS_XB); E.ss = (float*)(ws + WS_SSP); E.out8 = ws + WS_XN8; E.flags = 0;
                    pg8::gemm_phase<pg8::EpiResid<true>, pg8::StaticOrder, true, true>(ring, g, S, E);
                } else {
                    pg8::Gemm g{(const bf16*)(ws + WS_HH), (const bf16*)(ws + WS_WDN), FF, FF, FF, (unsigned*)(ws + WS_DUMMY)}; pg8::StaticOrder S; S.init(T, D, F.G, (int)blockIdx.x, FF, FF);
                    pg8::EpiResid<false> E; E.base32 = args.in[I_X]; E.base16 = (const bf16*)(ws + WS_XB); E.out = (bf16*)(ws + WS_XB); E.ss = (float*)(ws + WS_SSP); E.out8 = ws + WS_XN8; E.flags = 0;
                    pg8::gemm_phase<pg8::EpiResid<false>, pg8::StaticOrder, true, false>(ring, g, S, E);
                }
            } else {
                constexpr bool F8 = F8_MOE_DN != 0; constexpr int FQ = F8 ? FF / 2 : FF;
                pg8::Gemm g{(const bf16*)(ws + WS_HP), (const bf16*)(ws + WS_WDN), FQ, FQ, FQ, (unsigned*)(ws + WS_DUMMY)};
                pg8::GroupOrder S; S.nN = 4; S.G = F.G; S.c = (int)blockIdx.x; S.tA = (size_t)256 * FQ * 2; S.tB = (size_t)256 * FQ * 2; S.zB = (size_t)D * FQ * 2; S.zA = 0;
                int st[NE + 1]; moe_starts(F, layer >> 1, st);
#pragma unroll
                for (int e = 0; e <= NE; ++e) S.ts[e] = __builtin_amdgcn_readfirstlane(st[e] >> 8);
                pg8::EpiStore E; E.o = (bf16*)(ws + WS_XNP); E.sc = F8 ? (1.0f / 64.0f) : 1.0f;
                pg8::gemm_phase<pg8::EpiStore, pg8::GroupOrder, true, F8>(ring, g, S, E);
            }
        }
        SEAM(11);
#endif
    }
#if ON(12)
    if (gp_lo <= GP_FINAL && GP_FINAL < gp_hi) phase_final_combine(F);
#endif
}

extern "C" void kernel_launch(void* const* d_in, const int* in_sizes, int n_in, void* d_out, int out_size, void* d_ws, size_t ws_size, hipStream_t stream) {
    static int grid = 0;
    if (grid == 0) {
        if (n_in != 32 || in_sizes[0] != T * D || out_size != T * D || ws_size < WS_END) { fprintf(stderr, "kernel_launch: unexpected shapes / workspace (n_in %d, ws %zu < %zu)\n", n_in, ws_size, (size_t)WS_END); grid = -1; return; }
        int dev = 0, cus = 0, per_cu = 0;
        if (hipGetDevice(&dev) != hipSuccess || hipDeviceGetAttribute(&cus, hipDeviceAttributeMultiprocessorCount, dev) != hipSuccess) { grid = -1; return; }
        if (hipFuncSetAttribute((const void*)mk_fwd, hipFuncAttributeMaxDynamicSharedMemorySize, LDS_BYTES) != hipSuccess) { grid = -1; return; }
        if (hipOccupancyMaxActiveBlocksPerMultiprocessor(&per_cu, (const void*)mk_fwd, NWAVES * 64, LDS_BYTES) != hipSuccess || per_cu < 1) fprintf(stderr, "kernel_launch: occupancy query says %d\n", per_cu);
        (void)hipGetLastError();
        grid = cus;
    }
    if (grid < 0) return;
    if (hipMemsetAsync((char*)d_ws + WS_CTL, 0, CTL_ZERO_BYTES, stream) != hipSuccess) return;
    Args a{};
    for (int i = 0; i < 32; ++i) a.in[i] = (const float*)d_in[i];
    a.out = (float*)d_out; a.ws = (unsigned char*)d_ws;
    a.gp_lo = 0; a.gp_hi = GP_TOTAL;
    hipLaunchKernelGGL(mk_fwd, dim3(grid), dim3(NWAVES * 64), LDS_BYTES, stream, a);
}
```

```cpp
#include <hip/hip_runtime.h>
#include <cstdio>
#include <cstdint>

#ifndef F8_DENSE_MASK
#define F8_DENSE_MASK 4
#endif
#define DENSE8(layer) (((F8_DENSE_MASK) >> (layer)) & 1)
#ifndef F8_MOE_UP
#define F8_MOE_UP 1
#endif
#ifndef FUSE_DENSE_NORM
#define FUSE_DENSE_NORM 1
#endif
#ifndef GATE8
#define GATE8 2
#endif
#ifndef BR_WG
#define BR_WG 4
#endif
#ifndef F8_GATES
#define F8_GATES 1
#endif
#ifndef F8_MOE_DN
#define F8_MOE_DN 1
#endif

#define GAS __attribute__((address_space(1)))
#define LAS __attribute__((address_space(3)))
typedef unsigned short bf16;
typedef unsigned v4u __attribute__((ext_vector_type(4)));
typedef unsigned v2u __attribute__((ext_vector_type(2)));
typedef float f32x4 __attribute__((ext_vector_type(4)));
typedef float f32x2 __attribute__((ext_vector_type(2)));
typedef short bf16x8 __attribute__((ext_vector_type(8)));

constexpr int NB = 8, SEQ = 4096, D = 1024, DEPTH = 4, T = NB * SEQ;
constexpr int DP = 6404, NPROJ = 6400, FF = 2816, NE = 8;
constexpr float EPS = 1e-6f, LOG2E = 1.4426950408889634f;
constexpr float QSCALE = 0.125f * LOG2E;
constexpr int MOE_ROWS = 2 * T + NE * 256;
constexpr int S5_LDA = 1152;

constexpr size_t MiB = 1u << 20;
constexpr size_t WS_CTL = 0, CTL_ZERO_BYTES = 1 * MiB;
constexpr size_t WS_WIN = 1 * MiB;
constexpr size_t WS_WIN8 = WS_WIN + (size_t)2304 * D * 2;
constexpr size_t WS_WBR = WS_WIN + (size_t)NPROJ * D * 2;
constexpr size_t WS_WOUT = WS_WBR + 2 * MiB;
constexpr size_t WS_WGLU = WS_WOUT + 2 * MiB;
constexpr size_t WS_WZ = WS_WGLU + 128 * 1024;
constexpr size_t WS_WY = WS_WZ + 8 * MiB;
constexpr size_t WS_WUP = WS_WY + 36 * MiB;
constexpr size_t WS_WDN = WS_WUP + 88 * MiB;
constexpr size_t WS_KFUN = WS_WDN + 44 * MiB;
constexpr size_t WS_ROUTE = WS_KFUN + 1 * MiB;
constexpr size_t WS_LF = WS_ROUTE + 1 * MiB;
constexpr size_t WS_CUM = WS_LF + 512 * 1024;
constexpr size_t WS_XN = 198 * MiB;
static_assert(WS_CUM + 512 * 1024 <= WS_XN, "ws map");
constexpr size_t WS_R = WS_XN + 64 * MiB;
constexpr size_t WS_GATE = WS_R;
constexpr size_t WS_QKV = WS_GATE + 256 * MiB;
constexpr size_t WS_UC = WS_QKV + 96 * MiB;
constexpr size_t WS_UA = WS_UC + 16 * MiB;
constexpr size_t WS_Z = WS_UA + 18 * MiB;
constexpr size_t WS_YP = WS_Z + 4 * MiB;
constexpr size_t WS_YCAT = WS_YP + 16 * MiB;
constexpr size_t WS_MIX_END = WS_YCAT + 64 * MiB;
constexpr size_t WS_XN8 = WS_YCAT;
constexpr size_t WS_HH = WS_R;
constexpr size_t WS_XNP = WS_R;
constexpr size_t WS_HP = WS_XNP + (size_t)NE * T * D;
constexpr size_t WS_FFN_END = WS_HP + (size_t)MOE_ROWS * FF;
static_assert(F8_MOE_UP && F8_MOE_DN, "the MoE path stores its rows and hidden activations as e4m3 bytes");
constexpr size_t WS_XB = ((WS_MIX_END > WS_FFN_END ? WS_MIX_END : WS_FFN_END) + MiB - 1) / MiB * MiB;
constexpr size_t WS_SSP = WS_XB + 64 * MiB;
constexpr size_t WS_END = WS_SSP + 2 * MiB;
static_assert(WS_END <= 856 * MiB, "ws budget");
constexpr int CW_BAR = 4096;
constexpr int CW_Q = 20480;
constexpr int CW_MOE = 16384;

constexpr int RING_BYTES = 131072, MISC_OFF = RING_BYTES + 320, GAIN_OFF = RING_BYTES + 1024, QSLOT_OFF = RING_BYTES + 64, LDS_BYTES = 147456;
constexpr int NWAVES = 8;

__device__ __forceinline__ unsigned f2bf(float f) { unsigned u = __builtin_bit_cast(unsigned, f); return (u + 0x7fffu + ((u >> 16) & 1u)) >> 16; }
__device__ __forceinline__ unsigned pk2(float lo, float hi) { return f2bf(lo) | (f2bf(hi) << 16); }
__device__ __forceinline__ float bflo(unsigned u) { return __builtin_bit_cast(float, u << 16); }
__device__ __forceinline__ float bfhi(unsigned u) { return __builtin_bit_cast(float, u & 0xffff0000u); }
__device__ __forceinline__ float bf2f(bf16 v) { return __builtin_bit_cast(float, (unsigned)v << 16); }
__device__ __forceinline__ float wave_sum(float v) {
#pragma unroll
    for (int o = 1; o < 64; o <<= 1) v += __shfl_xor(v, o);
    return v;
}
__device__ __forceinline__ float fast_exp2(float x) { return __builtin_amdgcn_exp2f(x); }
__device__ __forceinline__ float fast_rcp(float x) { return __builtin_amdgcn_rcpf(x); }
__device__ __forceinline__ float sigmoidf_(float x) { return fast_rcp(1.0f + fast_exp2(-x * LOG2E)); }
__device__ __forceinline__ f32x2 sigmoid2(f32x2 x) { const f32x2 a = x * (-LOG2E); f32x2 t = {fast_exp2(a[0]), fast_exp2(a[1])}; t = t + 1.0f; return (f32x2){fast_rcp(t[0]), fast_rcp(t[1])}; }
__device__ __forceinline__ float gelu_tanh(float y) { const float u = 0.7978845608028654f * (y + 0.044715f * y * y * y); return y * sigmoidf_(2.0f * u); }
__device__ __forceinline__ unsigned pk4_fp8(float a, float b, float c, float d) { unsigned w = 0u; w = (unsigned)__builtin_amdgcn_cvt_pk_fp8_f32(a, b, (int)w, false); w = (unsigned)__builtin_amdgcn_cvt_pk_fp8_f32(c, d, (int)w, true); return w; }
#define LDS_WAIT() asm volatile("s_waitcnt lgkmcnt(0)" ::: "memory")
#define VM_WAIT() asm volatile("s_waitcnt vmcnt(0)" ::: "memory")

namespace pg8 {
#define PG8_LAS __attribute__((address_space(3)))
typedef unsigned short bf16_t;
typedef unsigned u32x4 __attribute__((ext_vector_type(4)));
typedef int v4i __attribute__((ext_vector_type(4)));
typedef int v8i __attribute__((ext_vector_type(8)));
constexpr int BM = 256, BK = 64, HALF = 128, HTB = HALF * BK * 2, STAGE_BYTES = 8 * HTB, NXCD = 8, WGM = 8;
__host__ __device__ __forceinline__ int lds_byte(int r, int c) { const int st = (r >> 4) * 2 + (c >> 5), rr = r & 15, cc = c & 31, ob = rr * 64 + cc * 2; return st * 1024 + (ob ^ (((ob >> 9) & 1) << 5)); }
__host__ __device__ __forceinline__ void stage_rc(int b, int& R, int& C) { const int st = b / 1024, sb = b % 1024, swz = sb ^ (((sb >> 9) & 1) << 5); R = (st >> 1) * 16 + swz / 64; C = (st & 1) * 32 + (swz % 64) / 2; }
__host__ __device__ __forceinline__ int perm32(int rho) { const int n = rho >> 4, i = rho & 15; return 8 * (i >> 2) + 4 * n + (i & 3); }

struct Unit { int pm, pn, z; size_t offA, offB; };
struct Gemm { const bf16_t* A; const bf16_t* Bt; int K, lda, ldb; };

template <int WG = WGM> __device__ __forceinline__ void xcd_tile_map(int L, int nM, int nN, int& pm, int& pn) {
    const int nwg = nM * nN; int wgid = L; { const int q = nwg / NXCD, r = nwg % NXCD, xcd = wgid % NXCD, off = wgid / NXCD; wgid = (xcd < r ? xcd * (q + 1) : r * (q + 1) + (xcd - r) * q) + off; }
    const int nig = WG * nN, gid = wgid / nig, fm = gid * WG, gsz = (nM - fm) < WG ? (nM - fm) : WG;
    pm = fm + ((wgid % nig) % gsz); pn = (wgid % nig) / gsz;
}
struct StaticOrder {
    int nM, nN, nwg, G, c; size_t tA, tB;
    __device__ void init(int M, int N, int G_, int c_, int lda, int ldb) { nM = M / BM; nN = N / BM; nwg = nM * nN; G = G_; c = c_; tA = (size_t)BM * lda * 2; tB = (size_t)BM * ldb * 2; }
    __device__ bool next(int i, Unit& u) const {
        const long L = (long)i * G + c; if (L >= nwg) return false;
        int wgid = (int)L; { const int q = nwg / NXCD, r = nwg % NXCD, xcd = wgid % NXCD, off = wgid / NXCD; wgid = (xcd < r ? xcd * (q + 1) : r * (q + 1) + (xcd - r) * q) + off; }
        const int nig = WGM * nN, gid = wgid / nig, fm = gid * WGM, gsz = (nM - fm) < WGM ? (nM - fm) : WGM;
        u.pm = fm + ((wgid % nig) % gsz); u.pn = (wgid % nig) / gsz; u.z = 0; u.offA = (size_t)u.pm * tA; u.offB = (size_t)u.pn * tB; return true;
    }
};
struct BatchOrder {
    int nM, nN, nZ, G, c; size_t tA, tB, zA, zB;
    __device__ bool next(int i, Unit& u) const {
        const int L = i * G + c; if (L >= nM * nN * nZ) return false;
        u.z = L / (nM * nN); const int r = L % (nM * nN); u.pm = r / nN; u.pn = r % nN;
        u.offA = (size_t)u.z * zA + (size_t)u.pm * tA; u.offB = (size_t)u.z * zB + (size_t)u.pn * tB; return true;
    }
};
struct GroupOrder {
    int nN, G, c; int ts[NE + 1]; size_t tA, tB, zB, zA;
    __device__ bool next(int i, Unit& u) const {
        const int L = i * G + c; if (L >= ts[NE] * nN) return false;
        xcd_tile_map(L, ts[NE], nN, u.pm, u.pn); int e = 0, tse = 0;
#pragma unroll
        for (int k = 1; k < NE; ++k) if (u.pm >= ts[k]) { e = k; tse = ts[k]; }
        u.z = e; u.offA = zA ? (size_t)e * zA + (size_t)(u.pm - tse) * tA : (size_t)u.pm * tA; u.offB = (size_t)e * zB + (size_t)u.pn * tB; return true;
    }
};

typedef __bf16 bf16x2_t __attribute__((ext_vector_type(2)));
__device__ __forceinline__ unsigned cvt_pk_bf16(float lo, float hi) { const f32x2 v = {lo, hi}; const bf16x2_t b = __builtin_convertvector(v, bf16x2_t); return __builtin_bit_cast(unsigned, b); }

__device__ __forceinline__ u32x4 pack8(const f32x4 a, const f32x4 b) { u32x4 w; w.x = cvt_pk_bf16(a[0], a[1]); w.y = cvt_pk_bf16(a[2], a[3]); w.z = cvt_pk_bf16(b[0], b[1]); w.w = cvt_pk_bf16(b[2], b[3]); return w; }
template <class Epi, class Sched, bool ALIGN_EPI, bool FP8 = false>
__device__ __forceinline__ void gemm_phase(PG8_LAS unsigned char* lds, const Gemm g, const Sched& S, const Epi& E) {
    int tid = threadIdx.x; asm volatile("" : "+v"(tid));
    const int wid = __builtin_amdgcn_readfirstlane(tid >> 6), lane = tid & 63, wr = wid >> 2, wc = wid & 3, fr = lane & 15, fq = lane >> 4;
    int K = g.K; asm volatile("" : "+s"(K));
    const int nt = K / BK;
    unsigned voffA[2], voffB[2];
#pragma unroll
    for (int i = 0; i < 2; ++i) { int R, C; stage_rc(tid * 16 + i * 8192, R, C); const int Rb = Epi::PERM ? ((R & ~31) + perm32(R & 31)) : R;
        voffA[i] = (unsigned)(R * g.lda + C) * 2u; voffB[i] = (unsigned)(Rb * g.ldb + C) * 2u; }
    const size_t kstep = (size_t)(BK * 2);
    const size_t hstepA = (size_t)HALF * g.lda * 2, hstepB = (size_t)HALF * g.ldb * 2;
    const unsigned ldsw = (unsigned)wid * 1024u;
    const int aoff = lds_byte(wr * 64 + fr, fq * 8), boff = lds_byte(wc * 32 + fr, fq * 8);
#define PG8_SA(b, h) (((b) * 2 + (h)) * HTB)
#define PG8_SB(b, h) ((4 + (b) * 2 + (h)) * HTB)
#define PG8_STAGE(bufoff, gbase, voff) do { _Pragma("unroll") for (int _i = 0; _i < 2; ++_i) \
        __builtin_amdgcn_global_load_lds((const unsigned*)((const char*)(gbase) + (voff)[_i]), (PG8_LAS unsigned*)(lds + (bufoff) + ldsw + _i * 8192), 16, 0, 0); } while (0)
#define PG8_LDA(dst, b, h) do { _Pragma("unroll") for (int m = 0; m < 4; ++m) { if constexpr (FP8) dst##8[m] = __builtin_shufflevector(*(const PG8_LAS v4i*)(lds + PG8_SA(b, h) + aoff + m * 2048), *(const PG8_LAS v4i*)(lds + PG8_SA(b, h) + aoff + m * 2048 + 1024), 0, 1, 2, 3, 4, 5, 6, 7); \
        else { _Pragma("unroll") for (int k = 0; k < 2; ++k) dst[m][k] = *(const PG8_LAS bf16x8*)(lds + PG8_SA(b, h) + aoff + m * 2048 + k * 1024); } } } while (0)
#define PG8_LDB(dst, b, h) do { _Pragma("unroll") for (int n = 0; n < 2; ++n) { if constexpr (FP8) dst##8[n] = __builtin_shufflevector(*(const PG8_LAS v4i*)(lds + PG8_SB(b, h) + boff + n * 2048), *(const PG8_LAS v4i*)(lds + PG8_SB(b, h) + boff + n * 2048 + 1024), 0, 1, 2, 3, 4, 5, 6, 7); \
        else { _Pragma("unroll") for (int k = 0; k < 2; ++k) dst[n][k] = *(const PG8_LAS bf16x8*)(lds + PG8_SB(b, h) + boff + n * 2048 + k * 1024); } } } while (0)
#define PG8_MMA(ai, bj, At, Bt) do { __builtin_amdgcn_s_setprio(1); _Pragma("unroll") for (int m = 0; m < 4; ++m) _Pragma("unroll") for (int n = 0; n < 2; ++n) { \
        if constexpr (FP8) asm volatile("v_mfma_f32_16x16x128_f8f6f4 %0, %1, %2, %0" : "+v"(acc[ai][bj][m][n]) : "v"(Bt##8[n]), "v"(At##8[m])); \
        else { _Pragma("unroll") for (int k = 0; k < 2; ++k) acc[ai][bj][m][n] = __builtin_amdgcn_mfma_f32_16x16x32_bf16(Bt[n][k], At[m][k], acc[ai][bj][m][n], 0, 0, 0); } } \
        __builtin_amdgcn_s_setprio(0); } while (0)
#define PG8_WAIT_V(n) asm volatile("s_waitcnt vmcnt(" #n ")" ::: "memory")
#define PG8_WAIT_L(n) asm volatile("s_waitcnt lgkmcnt(" #n ")" ::: "memory")
#define PG8_BAR __builtin_amdgcn_s_barrier()
#define PG8_SCHED __builtin_amdgcn_sched_barrier(0)
    Unit cur, nxt; int ui = 0;
    if (!S.next(0, cur)) return;
    f32x4 acc[2][2][4][2];
#pragma unroll
    for (int a = 0; a < 2; ++a)
#pragma unroll
        for (int b = 0; b < 2; ++b)
#pragma unroll
            for (int m = 0; m < 4; ++m)
#pragma unroll
                for (int n = 0; n < 2; ++n) acc[a][b][m][n] = (f32x4){0.f, 0.f, 0.f, 0.f};
    bf16x8 At[4][2], B0[2][2], B1[2][2]; v8i At8[4], B08[2], B18[2];
    const char* cA = (const char*)g.A + cur.offA; const char* cB = (const char*)g.Bt + cur.offB;
    PG8_STAGE(PG8_SB(0, 0), cB, voffB); PG8_STAGE(PG8_SB(0, 1), cB + hstepB, voffB); PG8_STAGE(PG8_SA(0, 0), cA, voffA); PG8_STAGE(PG8_SA(0, 1), cA + hstepA, voffA);
    if (wr == 1) PG8_BAR;
    PG8_WAIT_V(2); PG8_BAR;
    PG8_STAGE(PG8_SB(1, 0), cB + kstep, voffB); PG8_STAGE(PG8_SA(1, 0), cA + kstep, voffA); PG8_STAGE(PG8_SB(1, 1), cB + hstepB + kstep, voffB);
    PG8_WAIT_V(6); PG8_BAR;
    for (;;) {
        const bool has_next = S.next(ui + 1, nxt);
        const char* nA = has_next ? (const char*)g.A + nxt.offA : cA; const char* nB = has_next ? (const char*)g.Bt + nxt.offB : cB;
        for (int t = 0; t < nt; t += 2) {
            const bool last = (t == nt - 2);
            const char* a1 = cA + (size_t)(t + 1) * kstep;
            const char* a2 = last ? nA : cA + (size_t)(t + 2) * kstep; const char* b2 = last ? nB : cB + (size_t)(t + 2) * kstep;
            const char* a3 = a2 + kstep; const char* b3 = b2 + kstep;
            PG8_LDB(B0, 0, 0); PG8_LDB(B1, 0, 1); PG8_SCHED; PG8_LDA(At, 0, 0); PG8_STAGE(PG8_SA(1, 1), a1 + hstepA, voffA);
            PG8_WAIT_V(8); PG8_WAIT_L(0); PG8_BAR; PG8_MMA(0, 0, At, B0); PG8_MMA(0, 1, At, B1); PG8_BAR; PG8_SCHED;
            PG8_LDA(At, 0, 1); PG8_STAGE(PG8_SB(0, 0), b2, voffB); PG8_STAGE(PG8_SB(0, 1), b2 + hstepB, voffB); PG8_STAGE(PG8_SA(0, 0), a2, voffA);
            PG8_WAIT_V(8); PG8_WAIT_L(0); PG8_BAR; PG8_MMA(1, 0, At, B0); PG8_MMA(1, 1, At, B1); PG8_BAR; PG8_SCHED;
            PG8_LDB(B0, 1, 0); PG8_LDB(B1, 1, 1); PG8_SCHED; PG8_LDA(At, 1, 0); PG8_STAGE(PG8_SA(0, 1), a2 + hstepA, voffA);
            PG8_WAIT_V(8); PG8_WAIT_L(0); PG8_BAR; PG8_MMA(0, 0, At, B0); PG8_MMA(0, 1, At, B1); PG8_BAR; PG8_SCHED;
            PG8_LDA(At, 1, 1); PG8_STAGE(PG8_SB(1, 0), b3, voffB); PG8_STAGE(PG8_SB(1, 1), b3 + hstepB, voffB); PG8_STAGE(PG8_SA(1, 0), a3, voffA);
            PG8_WAIT_V(8); PG8_WAIT_L(0); PG8_BAR; PG8_MMA(1, 0, At, B0); PG8_MMA(1, 1, At, B1); PG8_BAR; PG8_SCHED;
        }
        if constexpr (ALIGN_EPI) { if (wr == 0) PG8_BAR; }
        if constexpr (FP8) asm volatile("s_nop 15\n\ts_nop 15" ::: "memory");
        E(acc, cur, wr, wc, fr, fq);
        if (!has_next) break;
#pragma unroll
        for (int a = 0; a < 2; ++a)
#pragma unroll
            for (int b = 0; b < 2; ++b)
#pragma unroll
                for (int m = 0; m < 4; ++m)
#pragma unroll
                    for (int n = 0; n < 2; ++n) acc[a][b][m][n] = (f32x4){0.f, 0.f, 0.f, 0.f};
        cur = nxt; cA = nA; cB = nB; ++ui;
        if constexpr (ALIGN_EPI) { if (wr == 1) PG8_BAR; }
    }
    PG8_WAIT_V(0);
    if constexpr (!ALIGN_EPI) { if (wr == 0) PG8_BAR; }
    PG8_BAR;
#undef PG8_SA
#undef PG8_SB
#undef PG8_STAGE
#undef PG8_LDA
#undef PG8_LDB
#undef PG8_MMA
#undef PG8_WAIT_V
#undef PG8_WAIT_L
#undef PG8_BAR
#undef PG8_SCHED
}


template <class Epi, class Sched>
__device__ __forceinline__ void gemm_phase_n1(PG8_LAS unsigned char* lds, const Gemm g, const Sched& S, const Epi& E) {
    int tid = threadIdx.x; asm volatile("" : "+v"(tid));
    const int wid = __builtin_amdgcn_readfirstlane(tid >> 6), lane = tid & 63, wr = wid >> 2, wc = wid & 3, fr = lane & 15, fq = lane >> 4;
    int K = g.K; asm volatile("" : "+s"(K));
    const int nt = K / BK;
    unsigned voffA[2], voffB[2];
#pragma unroll
    for (int i = 0; i < 2; ++i) { int R, C; stage_rc(tid * 16 + i * 8192, R, C); const int Rb = Epi::PERM ? ((R & ~31) + perm32(R & 31)) : R;
        voffA[i] = (unsigned)(R * g.lda + C) * 2u; voffB[i] = (unsigned)(Rb * g.ldb + C) * 2u; }
    const size_t kstep = (size_t)(BK * 2);
    const size_t hstepA = (size_t)HALF * g.lda * 2;
    const unsigned ldsw = (unsigned)wid * 1024u;
    const int aoff = lds_byte(wr * 64 + fr, fq * 8), boff = lds_byte(wc * 32 + fr, fq * 8);
#define PG8_SA(b, h) (((b) * 2 + (h)) * HTB)
#define PG8_SB(b, h) ((4 + (b) * 2 + (h)) * HTB)
#define PG8_STAGE(bufoff, gbase, voff) do { _Pragma("unroll") for (int _i = 0; _i < 2; ++_i) \
        __builtin_amdgcn_global_load_lds((const unsigned*)((const char*)(gbase) + (voff)[_i]), (PG8_LAS unsigned*)(lds + (bufoff) + ldsw + _i * 8192), 16, 0, 0); } while (0)
#define PG8_LDA(dst, b, h) do { _Pragma("unroll") for (int m = 0; m < 4; ++m) _Pragma("unroll") for (int k = 0; k < 2; ++k) dst[m][k] = *(const PG8_LAS bf16x8*)(lds + PG8_SA(b, h) + aoff + m * 2048 + k * 1024); } while (0)
#define PG8_LDB(dst, b, h) do { _Pragma("unroll") for (int n = 0; n < 2; ++n) _Pragma("unroll") for (int k = 0; k < 2; ++k) dst[n][k] = *(const PG8_LAS bf16x8*)(lds + PG8_SB(b, h) + boff + n * 2048 + k * 1024); } while (0)
#define PG8_MMA1(ai, At, Bt) do { __builtin_amdgcn_s_setprio(1); _Pragma("unroll") for (int m = 0; m < 4; ++m) _Pragma("unroll") for (int n = 0; n < 2; ++n) _Pragma("unroll") for (int k = 0; k < 2; ++k) \
        acc[ai][m][n] = __builtin_amdgcn_mfma_f32_16x16x32_bf16(Bt[n][k], At[m][k], acc[ai][m][n], 0, 0, 0); __builtin_amdgcn_s_setprio(0); } while (0)
#define PG8_WAIT_V(n) asm volatile("s_waitcnt vmcnt(" #n ")" ::: "memory")
#define PG8_WAIT_L(n) asm volatile("s_waitcnt lgkmcnt(" #n ")" ::: "memory")
#define PG8_BAR __builtin_amdgcn_s_barrier()
#define PG8_SCHED __builtin_amdgcn_sched_barrier(0)
    Unit cur, nxt; int ui = 0;
    if (!S.next(0, cur)) return;
    f32x4 acc[2][4][2], st[2][4][2];
#pragma unroll
    for (int a = 0; a < 2; ++a)
#pragma unroll
        for (int m = 0; m < 4; ++m)
#pragma unroll
            for (int n = 0; n < 2; ++n) { acc[a][m][n] = (f32x4){0.f, 0.f, 0.f, 0.f}; st[a][m][n] = (f32x4){0.f, 0.f, 0.f, 0.f}; }
    bf16x8 At[4][2], B0[2][2];
    const char* cA = (const char*)g.A + cur.offA; const char* cB = (const char*)g.Bt + cur.offB;
    PG8_STAGE(PG8_SB(0, 0), cB, voffB); PG8_STAGE(PG8_SA(0, 0), cA, voffA); PG8_STAGE(PG8_SA(0, 1), cA + hstepA, voffA);
    if (wr == 1) PG8_BAR;
    PG8_WAIT_V(2); PG8_BAR;
    PG8_STAGE(PG8_SB(1, 0), cB + kstep, voffB); PG8_STAGE(PG8_SA(1, 0), cA + kstep, voffA);
    PG8_WAIT_V(4); PG8_BAR;
    for (;;) {
        const bool has_next = S.next(ui + 1, nxt);
        const char* nA = has_next ? (const char*)g.A + nxt.offA : cA; const char* nB = has_next ? (const char*)g.Bt + nxt.offB : cB;
        for (int t = 0; t < nt; t += 2) {
            const bool last = (t == nt - 2);
            const char* a1 = cA + (size_t)(t + 1) * kstep;
            const char* a2 = last ? nA : cA + (size_t)(t + 2) * kstep; const char* b2 = last ? nB : cB + (size_t)(t + 2) * kstep;
            const char* a3 = a2 + kstep; const char* b3 = b2 + kstep;
            PG8_LDB(B0, 0, 0); PG8_SCHED; PG8_LDA(At, 0, 0); PG8_STAGE(PG8_SA(1, 1), a1 + hstepA, voffA);
            PG8_WAIT_V(6); PG8_WAIT_L(0); PG8_BAR; PG8_MMA1(0, At, B0); PG8_BAR; PG8_SCHED;
            PG8_LDA(At, 0, 1); PG8_STAGE(PG8_SB(0, 0), b2, voffB); PG8_STAGE(PG8_SA(0, 0), a2, voffA);
            PG8_WAIT_V(6); PG8_WAIT_L(0); PG8_BAR; PG8_MMA1(1, At, B0); PG8_BAR; PG8_SCHED;
            PG8_LDB(B0, 1, 0); PG8_SCHED; PG8_LDA(At, 1, 0); PG8_STAGE(PG8_SA(0, 1), a2 + hstepA, voffA);
            PG8_WAIT_V(6); PG8_WAIT_L(0); PG8_BAR; PG8_MMA1(0, At, B0); PG8_BAR; PG8_SCHED;
            PG8_LDA(At, 1, 1); PG8_STAGE(PG8_SB(1, 0), b3, voffB); PG8_STAGE(PG8_SA(1, 0), a3, voffA);
            PG8_WAIT_V(6); PG8_WAIT_L(0); PG8_BAR; PG8_MMA1(1, At, B0); PG8_BAR; PG8_SCHED;
        }
        if (wr == 0) PG8_BAR;
        E(acc, st, cur, wr, wc, fr, fq);
        if (!has_next) break;
#pragma unroll
        for (int a = 0; a < 2; ++a)
#pragma unroll
            for (int m = 0; m < 4; ++m)
#pragma unroll
                for (int n = 0; n < 2; ++n) acc[a][m][n] = (f32x4){0.f, 0.f, 0.f, 0.f};
        cur = nxt; cA = nA; cB = nB; ++ui;
        if (wr == 1) PG8_BAR;
    }
    PG8_WAIT_V(0);
    PG8_BAR;
#undef PG8_SA
#undef PG8_SB
#undef PG8_STAGE
#undef PG8_LDA
#undef PG8_LDB
#undef PG8_MMA1
#undef PG8_WAIT_V
#undef PG8_WAIT_L
#undef PG8_BAR
#undef PG8_SCHED
}
typedef f32x4 Acc1[2][4][2];
struct OneUnit { int pm; size_t tA;
    __device__ bool next(int i, Unit& u) const { if (i) return false; u.pm = pm; u.pn = 0; u.z = 0; u.offA = (size_t)pm * tA; u.offB = 0; return true; } };
struct BranchOrder1 {
    int nM, nN, G, c; size_t tA, tB, zA, zB; int paired, vc;
    __device__ bool next(int i, Unit& u) const {
        if (paired) { if (i >= 16) return false; u.z = i & 3; u.pm = vc >> 1; u.pn = 4 * (vc & 1) + (i >> 2);
            u.offA = (size_t)u.z * zA + (size_t)u.pm * tA; u.offB = (size_t)u.z * zB + (size_t)u.pn * tB; return true; }
        const int tile = (i >> 2) * G + c; if (tile >= nM * nN) return false;
        u.z = i & 3; xcd_tile_map<BR_WG>(tile, nM, nN, u.pm, u.pn);
        u.offA = (size_t)u.z * zA + (size_t)u.pm * tA; u.offB = (size_t)u.z * zB + (size_t)u.pn * tB; return true;
    }
};
struct EpiGate1 {
    static constexpr bool PERM = true;
    const bf16_t* gate; bf16_t* mb;
    __device__ __forceinline__ void operator()(const Acc1& acc, Acc1& st, const Unit& u, int wr, int wc, int fr, int fq) const {
        const int z = u.z; const int row0 = u.pm * BM + wr * 64 + fr, col = u.pn * HALF + wc * 32 + 8 * fq;
#pragma unroll
        for (int ai = 0; ai < 2; ++ai)
#pragma unroll
            for (int m = 0; m < 4; ++m) { const int row = row0 + ai * HALF + m * 16;
                f32x4 a = acc[ai][m][0], b = acc[ai][m][1];
                if (GATE8 == 2) { const v2u g8 = *(const v2u*)((const unsigned char*)gate + (size_t)row * 4096 + z * 1024 + col); const float k = 1.0f / 255.0f;
                    a[0] *= (float)(g8.x & 0xffu) * k; a[1] *= (float)((g8.x >> 8) & 0xffu) * k; a[2] *= (float)((g8.x >> 16) & 0xffu) * k; a[3] *= (float)(g8.x >> 24) * k;
                    b[0] *= (float)(g8.y & 0xffu) * k; b[1] *= (float)((g8.y >> 8) & 0xffu) * k; b[2] *= (float)((g8.y >> 16) & 0xffu) * k; b[3] *= (float)(g8.y >> 24) * k; }
                else if (GATE8 == 1) { const v2u g8 = *(const v2u*)((const unsigned char*)gate + (size_t)row * 4096 + z * 1024 + col);
                    const f32x2 g0 = __builtin_amdgcn_cvt_pk_f32_fp8((int)g8.x, false), g1 = __builtin_amdgcn_cvt_pk_f32_fp8((int)g8.x, true), g2 = __builtin_amdgcn_cvt_pk_f32_fp8((int)g8.y, false), g3 = __builtin_amdgcn_cvt_pk_f32_fp8((int)g8.y, true);
                    a[0] *= g0[0]; a[1] *= g0[1]; a[2] *= g1[0]; a[3] *= g1[1]; b[0] *= g2[0]; b[1] *= g2[1]; b[2] *= g3[0]; b[3] *= g3[1]; }
                else { const u32x4 gg = *(const u32x4*)(gate + (size_t)row * 4096 + z * 1024 + col);
                    a[0] *= bflo(gg.x); a[1] *= bfhi(gg.x); a[2] *= bflo(gg.y); a[3] *= bfhi(gg.y); b[0] *= bflo(gg.z); b[1] *= bfhi(gg.z); b[2] *= bflo(gg.w); b[3] *= bfhi(gg.w); }
                if (z == 0) { st[ai][m][0] = a; st[ai][m][1] = b; } else { st[ai][m][0] += a; st[ai][m][1] += b; }
                if (z == 3) *(u32x4*)(mb + (size_t)row * 1024 + col) = pack8(st[ai][m][0], st[ai][m][1]); }
    }
};
typedef f32x4 Acc[2][2][4][2];
#define EPI_ROWS_BEGIN const int row0 = u.pm * BM + wr * 64 + fr; _Pragma("unroll") for (int ai = 0; ai < 2; ++ai) _Pragma("unroll") for (int m = 0; m < 4; ++m) { const int row = row0 + ai * HALF + m * 16;
#define EPI_ROWS_END }

struct EpiInProj {
    static constexpr bool PERM = true;
    bf16_t *ua, *qkv, *uc, *gate; const PG8_LAS float* gl;
    __device__ __forceinline__ void operator()(const Acc& acc, const Unit& u, int wr, int wc, int fr, int fq) const {
        const int pn = u.pn;
        if (pn == 0) {
            EPI_ROWS_BEGIN
#pragma unroll
            for (int bj = 0; bj < 2; ++bj) { const int c8 = bj * HALF + wc * 32 + 8 * fq, gI = c8 >> 4, h0 = c8 & 15;
                *(u32x4*)(ua + ((size_t)(gI * 512 + (row >> 6)) * S5_LDA + (row & 63) * 16 + h0)) = pack8(acc[ai][bj][m][0], acc[ai][bj][m][1]); }
            EPI_ROWS_END
        } else if (pn == 1 || pn == 2 || pn == 6 || pn == 7) {
            const int which = (pn == 1) ? 0 : (pn == 2) ? 1 : (pn == 6) ? 2 : 3;
            const PG8_LAS float* gp = gl + which * 64;
            bf16_t* dst = qkv + (size_t)((pn < 6) ? (pn - 1) : (pn - 3)) * ((size_t)T * 256);
            f32x4 gv[2][2];
#pragma unroll
            for (int bj = 0; bj < 2; ++bj)
#pragma unroll
                for (int n = 0; n < 2; ++n) gv[bj][n] = *(const PG8_LAS f32x4*)(gp + bj * 32 + 8 * fq + 4 * n);
            EPI_ROWS_BEGIN
            float ss = 0.f;
#pragma unroll
            for (int bj = 0; bj < 2; ++bj)
#pragma unroll
                for (int n = 0; n < 2; ++n) { const f32x4 x = acc[ai][bj][m][n]; ss += (x[0] * x[0] + x[1] * x[1]) + (x[2] * x[2] + x[3] * x[3]); }
            ss += __shfl_xor(ss, 16); ss += __shfl_xor(ss, 32);
            const float rs = __builtin_amdgcn_rsqf(ss * (1.0f / 64.0f) + EPS);
#pragma unroll
            for (int bj = 0; bj < 2; ++bj)
                *(u32x4*)(dst + (size_t)row * 256 + wc * 64 + bj * 32 + 8 * fq) = pack8(acc[ai][bj][m][0] * rs * gv[bj][0], acc[ai][bj][m][1] * rs * gv[bj][1]);
            EPI_ROWS_END
        } else if (pn == 3 || pn == 8) {
            bf16_t* dst = qkv + (size_t)((pn == 3) ? 2 : 5) * ((size_t)T * 256);
            EPI_ROWS_BEGIN
#pragma unroll
            for (int bj = 0; bj < 2; ++bj) *(u32x4*)(dst + (size_t)row * 256 + bj * HALF + wc * 32 + 8 * fq) = pack8(acc[ai][bj][m][0], acc[ai][bj][m][1]);
            EPI_ROWS_END
        } else if (pn == 4 || pn == 5) {
            EPI_ROWS_BEGIN
            f32x4 o[2];
#pragma unroll
            for (int n = 0; n < 2; ++n)
#pragma unroll
                for (int e = 0; e < 4; ++e) o[n][e] = acc[ai][0][m][n][e] * sigmoidf_(acc[ai][1][m][n][e]);
            *(u32x4*)(uc + (size_t)row * 256 + (pn - 4) * 128 + wc * 32 + 8 * fq) = pack8(o[0], o[1]);
            EPI_ROWS_END
        } else {
            const int gt = pn - 9;
            EPI_ROWS_BEGIN
#pragma unroll
            for (int bj = 0; bj < 2; ++bj) { f32x4 o[2];
#pragma unroll
                for (int n = 0; n < 2; ++n)
#pragma unroll
                    for (int e = 0; e < 4; ++e) o[n][e] = sigmoidf_(acc[ai][bj][m][n][e]);
                *(u32x4*)(gate + (size_t)row * 4096 + gt * 256 + bj * HALF + wc * 32 + 8 * fq) = pack8(o[0], o[1]); }
            EPI_ROWS_END
        }
    }
};
struct EpiGateSig {
    static constexpr bool PERM = true;
    bf16_t* gate;
    __device__ __forceinline__ void operator()(const Acc& acc, const Unit& u, int wr, int wc, int fr, int fq) const {
        EPI_ROWS_BEGIN
#pragma unroll
        for (int bj = 0; bj < 2; ++bj) { f32x4 o[2];
#pragma unroll
            for (int n = 0; n < 2; ++n)
#pragma unroll
                for (int e = 0; e < 4; e += 2) { const f32x2 r = sigmoid2((f32x2){acc[ai][bj][m][n][e], acc[ai][bj][m][n][e + 1]} * (1.0f / 64.0f)) * ((GATE8 == 2) ? 255.0f : 1.0f); o[n][e] = r[0]; o[n][e + 1] = r[1]; }
            if (GATE8 == 2) { v2u w = {0u, 0u};
#pragma unroll
                for (int e = 0; e < 4; ++e) { w.x = __builtin_amdgcn_cvt_pk_u8_f32(o[0][e], e, w.x); w.y = __builtin_amdgcn_cvt_pk_u8_f32(o[1][e], e, w.y); }
                *(v2u*)((unsigned char*)gate + (size_t)row * 4096 + u.pn * BM + bj * HALF + wc * 32 + 8 * fq) = w; }
            else if (GATE8 == 1) { v2u w; w.x = pk4_fp8(o[0][0], o[0][1], o[0][2], o[0][3]); w.y = pk4_fp8(o[1][0], o[1][1], o[1][2], o[1][3]); *(v2u*)((unsigned char*)gate + (size_t)row * 4096 + u.pn * BM + bj * HALF + wc * 32 + 8 * fq) = w; }
            else *(u32x4*)(gate + (size_t)row * 4096 + u.pn * BM + bj * HALF + wc * 32 + 8 * fq) = pack8(o[0], o[1]); }
        EPI_ROWS_END
    }
};
struct EpiZ {
    static constexpr bool PERM = false;
    float* z;
    __device__ __forceinline__ void operator()(const Acc& acc, const Unit& u, int wr, int wc, int fr, int fq) const {
        EPI_ROWS_BEGIN
#pragma unroll
        for (int n = 0; n < 2; ++n) *(f32x4*)(z + ((size_t)(u.z * 512 + row)) * 128 + wc * 32 + 16 * n + 4 * fq) = acc[ai][0][m][n];
        EPI_ROWS_END
    }
};
struct EpiY {
    static constexpr bool PERM = true;
    const bf16_t* ua; const float* dskip; bf16_t* yp;
    __device__ __forceinline__ void operator()(const Acc& acc, const Unit& u, int wr, int wc, int fr, int fq) const {
        const int gI = u.z, h0 = 8 * (fq & 1);
        const f32x4 d0 = *(const f32x4*)(dskip + gI * 16 + h0), d1 = *(const f32x4*)(dskip + gI * 16 + h0 + 4);
        EPI_ROWS_BEGIN
#pragma unroll
        for (int bj = 0; bj < 2; ++bj) { const int col = u.pn * BM + bj * HALF + wc * 32 + 8 * fq;
            const u32x4 uu = *(const u32x4*)(ua + ((size_t)(gI * 512 + row)) * S5_LDA + col);
            f32x4 a = acc[ai][bj][m][0], b = acc[ai][bj][m][1];
            a[0] += d0[0] * bflo(uu.x); a[1] += d0[1] * bfhi(uu.x); a[2] += d0[2] * bflo(uu.y); a[3] += d0[3] * bfhi(uu.y);
            b[0] += d1[0] * bflo(uu.z); b[1] += d1[1] * bfhi(uu.z); b[2] += d1[2] * bflo(uu.w); b[3] += d1[3] * bfhi(uu.w);
#pragma unroll
            for (int e = 0; e < 4; ++e) { a[e] = gelu_tanh(a[e]); b[e] = gelu_tanh(b[e]); }
            *(u32x4*)(yp + ((size_t)row * 64 + (col >> 4)) * 256 + gI * 16 + h0) = pack8(a, b); }
        EPI_ROWS_END
    }
};
struct EpiGlu {
    static constexpr bool PERM = true;
    const bf16_t* yp; bf16_t* ycat;
    __device__ __forceinline__ void operator()(const Acc& acc, const Unit& u, int wr, int wc, int fr, int fq) const {
        EPI_ROWS_BEGIN
#pragma unroll
        for (int bj = 0; bj < 2; ++bj) { const int col = bj * HALF + wc * 32 + 8 * fq;
            const u32x4 yy = *(const u32x4*)(yp + (size_t)row * 256 + col);
            f32x4 a = acc[ai][bj][m][0], b = acc[ai][bj][m][1];
            a[0] = bflo(yy.x) * sigmoidf_(a[0]); a[1] = bfhi(yy.x) * sigmoidf_(a[1]); a[2] = bflo(yy.y) * sigmoidf_(a[2]); a[3] = bfhi(yy.y) * sigmoidf_(a[3]);
            b[0] = bflo(yy.z) * sigmoidf_(b[0]); b[1] = bfhi(yy.z) * sigmoidf_(b[1]); b[2] = bflo(yy.w) * sigmoidf_(b[2]); b[3] = bfhi(yy.w) * sigmoidf_(b[3]);
            *(u32x4*)(ycat + (size_t)row * 1024 + col) = pack8(a, b); }
        EPI_ROWS_END
    }
};
template <bool SC64> struct EpiResid {
    static constexpr bool PERM = true; static constexpr float sc = SC64 ? (1.0f / 64.0f) : 1.0f;
    const float* base32; const bf16_t* base16; bf16_t* out; float* ss; unsigned char* out8; int flags;
    __device__ __forceinline__ void operator()(const Acc& acc, const Unit& u, int wr, int wc, int fr, int fq) const {
        EPI_ROWS_BEGIN
        float q = 0.f;
#pragma unroll
        for (int bj = 0; bj < 2; ++bj) { const size_t off = (size_t)row * 1024 + u.pn * BM + bj * HALF + wc * 32 + 8 * fq;
            f32x4 a, b;
            if (flags & 1) { a = *(const f32x4*)(base32 + off); b = *(const f32x4*)(base32 + off + 4); }
            else { const u32x4 r = *(const u32x4*)(base16 + off); a = (f32x4){bflo(r.x), bfhi(r.x), bflo(r.y), bfhi(r.y)}; b = (f32x4){bflo(r.z), bfhi(r.z), bflo(r.w), bfhi(r.w)}; }
            const u32x4 w = pack8(a + acc[ai][bj][m][0] * sc, b + acc[ai][bj][m][1] * sc); *(u32x4*)(out + off) = w;
            if (flags & 2) { const float x0 = bflo(w.x), x1 = bfhi(w.x), x2 = bflo(w.y), x3 = bfhi(w.y), x4 = bflo(w.z), x5 = bfhi(w.z), x6 = bflo(w.w), x7 = bfhi(w.w);
                q += ((x0 * x0 + x1 * x1) + (x2 * x2 + x3 * x3)) + ((x4 * x4 + x5 * x5) + (x6 * x6 + x7 * x7));
                if (flags & 4) { v2u w8; w8.x = pk4_fp8(x0, x1, x2, x3); w8.y = pk4_fp8(x4, x5, x6, x7); *(v2u*)(out8 + off) = w8; } } }
        if (flags & 2) { q += __shfl_xor(q, 16); q += __shfl_xor(q, 32); if (fq == 0) ss[(size_t)row * 16 + u.pn * 4 + wc] = q; }
        EPI_ROWS_END
    }
};
template <bool H8> struct EpiSwiGlu {
    static constexpr bool PERM = true;
    bf16_t* h; float sc; const float* ss; int use_ss;
    __device__ __forceinline__ void operator()(const Acc& acc, const Unit& u, int wr, int wc, int fr, int fq) const {
        EPI_ROWS_BEGIN
        float rsc = sc;
        if (use_ss) { const f32x4 s0 = *(const f32x4*)(ss + (size_t)row * 16), s1 = *(const f32x4*)(ss + (size_t)row * 16 + 4), s2 = *(const f32x4*)(ss + (size_t)row * 16 + 8), s3 = *(const f32x4*)(ss + (size_t)row * 16 + 12);
            const f32x4 t = (s0 + s1) + (s2 + s3); rsc = sc * __builtin_amdgcn_rsqf(((t[0] + t[1]) + (t[2] + t[3])) * (1.0f / D) + EPS); }
        f32x4 o[2];
#pragma unroll
        for (int n = 0; n < 2; ++n)
#pragma unroll
            for (int e = 0; e < 4; e += 2) { const f32x2 a = (f32x2){acc[ai][0][m][n][e], acc[ai][0][m][n][e + 1]} * rsc, b = (f32x2){acc[ai][1][m][n][e], acc[ai][1][m][n][e + 1]} * rsc;
                const f32x2 r = (a * b) * sigmoid2(a); o[n][e] = r[0]; o[n][e + 1] = r[1]; }
        if constexpr (H8) { v2u w; w.x = pk4_fp8(o[0][0], o[0][1], o[0][2], o[0][3]); w.y = pk4_fp8(o[1][0], o[1][1], o[1][2], o[1][3]); *(v2u*)((unsigned char*)h + (size_t)row * FF + u.pn * 128 + wc * 32 + 8 * fq) = w; }
        else *(u32x4*)(h + (size_t)row * FF + u.pn * 128 + wc * 32 + 8 * fq) = pack8(o[0], o[1]);
        EPI_ROWS_END
    }
};
struct EpiStore {
    static constexpr bool PERM = true;
    bf16_t* o; float sc;
    __device__ __forceinline__ void operator()(const Acc& acc, const Unit& u, int wr, int wc, int fr, int fq) const {
        EPI_ROWS_BEGIN
#pragma unroll
        for (int bj = 0; bj < 2; ++bj) *(u32x4*)(o + (size_t)row * 1024 + u.pn * BM + bj * HALF + wc * 32 + 8 * fq) = pack8(acc[ai][bj][m][0] * sc, acc[ai][bj][m][1] * sc);
        EPI_ROWS_END
    }
};
}

#define XB_TMO      128
#define XB_XCNT(j)  (256  + 64 * (j))
#define XB_XSUB(j)  (1280 + 64 * (j))
#define XB_XGEN(j)  (2304 + 64 * (j))
#define XB_TOP      3328
#define XB_TOPGEN   3392
#define XCD_BAR_WORDS 3456
#define XB_SPIN_CAP (1u << 18)
__device__ __forceinline__ unsigned xb_ld(unsigned* p)              { return __hip_atomic_load(p, __ATOMIC_RELAXED, __HIP_MEMORY_SCOPE_AGENT); }
__device__ __forceinline__ unsigned xb_add(unsigned* p, unsigned v) { return __hip_atomic_fetch_add(p, v, __ATOMIC_RELAXED, __HIP_MEMORY_SCOPE_AGENT); }
__device__ __forceinline__ unsigned xb_xcc_id() { return (unsigned)__builtin_amdgcn_s_getreg((3 << 11) | 20) & 0xFu; }
#define XB_SPIN(cond, bar) do { unsigned _sp = 0; while (cond) { __builtin_amdgcn_s_sleep(1); \
    if ((++_sp & 255u) == 0u) { if (xb_ld(&(bar)[XB_TMO])) break; if (_sp > XB_SPIN_CAP) { atomicAdd(&(bar)[XB_TMO], 1u); break; } } } } while (0)
struct XcdBarrier { unsigned* bar; unsigned x; volatile LAS unsigned* st; };
__device__ __forceinline__ XcdBarrier xcd_barrier_post(unsigned* bar, volatile LAS unsigned* st) {
    XcdBarrier b; b.bar = bar; b.x = xb_xcc_id(); b.st = st;
    if (threadIdx.x == 0) (void)xb_add(&bar[XB_XCNT(b.x)], 1u);
    return b;
}
__device__ __forceinline__ void xcd_barrier_complete(unsigned* bar, unsigned x, unsigned& nloc, unsigned& nx) {
    const unsigned G = gridDim.x * gridDim.y * gridDim.z;
    unsigned sum, cnt, mine, sp = 0u;
    for (;;) {
        sum = 0u; cnt = 0u; mine = 0u;
#pragma unroll
        for (unsigned j = 0; j < 16; ++j) { const unsigned c = xb_ld(&bar[XB_XCNT(j)]); sum += c; cnt += (c > 0u) ? 1u : 0u; mine = (j == x) ? c : mine; }
        if (sum == G) break;
        __builtin_amdgcn_s_sleep(1);
        if ((++sp & 255u) == 0u) { if (xb_ld(&bar[XB_TMO])) break; if (sp > XB_SPIN_CAP) { atomicAdd(&bar[XB_TMO], 1u); break; } }
    }
    nloc = mine > 0u ? mine : 1u; nx = cnt > 0u ? cnt : 1u;
}
__device__ __forceinline__ void xcd_barrier(const XcdBarrier& b) {
    asm volatile("s_waitcnt vmcnt(0)" ::: "memory");
    __syncthreads();
    if (threadIdx.x == 0) {
        unsigned* bar = b.bar;
        __builtin_amdgcn_s_waitcnt(0);
        unsigned nloc = b.st[0], nx = b.st[1];
        if (nloc == 0u) { xcd_barrier_complete(bar, b.x, nloc, nx); b.st[0] = nloc; b.st[1] = nx; }
        const unsigned old = xb_add(&bar[XB_XSUB(b.x)], 1u);
        const unsigned gen = old / nloc;
        if (old + 1u == (gen + 1u) * nloc) {
            __builtin_amdgcn_fence(__ATOMIC_RELEASE, "agent");
            asm volatile("s_waitcnt vmcnt(0)" ::: "memory");
            const unsigned og = xb_add(&bar[XB_TOP], 1u);
            const unsigned tg = og / nx;
            if (og + 1u == (tg + 1u) * nx) xb_add(&bar[XB_TOPGEN], 1u);
            else XB_SPIN(xb_ld(&bar[XB_TOPGEN]) == tg, bar);
            __builtin_amdgcn_fence(__ATOMIC_ACQUIRE, "agent");
            xb_add(&bar[XB_XGEN(b.x)], 1u);
            asm volatile("s_waitcnt vmcnt(0)" ::: "memory");
        } else {
            XB_SPIN(xb_ld(&bar[XB_XGEN(b.x)]) == gen, bar);
            __builtin_amdgcn_fence(__ATOMIC_ACQUIRE, "agent");
            asm volatile("s_waitcnt vmcnt(0)" ::: "memory");
        }
    }
    __syncthreads();
}

struct Args { const float* in[32]; float* out; unsigned char* ws; int gp_lo, gp_hi; };
enum { I_X = 0, I_GMIX, I_WIN, I_BFORGET, I_FQG, I_FKG, I_SQG, I_SKG, I_LRE, I_LIM, I_LDT, I_BRE, I_BIM, I_CRE, I_CIM, I_S5D, I_WGLU, I_CONVW, I_CONVB, I_LNG, I_LNB,
       I_WBR, I_WOUT, I_GFFN, I_W1, I_W3, I_W2, I_RW, I_RB, I_MW1, I_MW3, I_MW2 };
constexpr int NPH = 12, GP_FINAL = DEPTH * NPH, GP_TOTAL = GP_FINAL + 1;

struct Frame { LAS unsigned char* lds; int tid, lane, wave, vcu, G, gw, NGW; const Args* a; unsigned char* ws; };

__device__ __forceinline__ void transpose_item(const float* W, int ldw, bf16* WT, int ldt, int k0, int src_col0, int dst_row0, LAS float* scr, int lane, const float* ks = nullptr) {
    f32x4 ld[8];
#pragma unroll
    for (int i = 0; i < 8; ++i) ld[i] = *(const f32x4*)(W + (size_t)(k0 + 8 * i + (lane >> 3)) * ldw + src_col0 + 4 * (lane & 7));
#pragma unroll
    for (int i = 0; i < 8; ++i) { LAS float* d = scr + (8 * i + (lane >> 3)) * 33 + 4 * (lane & 7); const float s = ks ? ks[k0 + 8 * i + (lane >> 3)] : 1.0f; d[0] = ld[i][0] * s; d[1] = ld[i][1] * s; d[2] = ld[i][2] * s; d[3] = ld[i][3] * s; }
    LDS_WAIT(); asm volatile("" ::: "memory");
    const int c = lane & 7;
#pragma unroll
    for (int j = 0; j < 4; ++j) { const int n = (lane >> 3) + 8 * j; const LAS float* s = scr + (8 * c) * 33 + n;
        v4u o; o.x = pk2(s[0 * 33], s[1 * 33]); o.y = pk2(s[2 * 33], s[3 * 33]); o.z = pk2(s[4 * 33], s[5 * 33]); o.w = pk2(s[6 * 33], s[7 * 33]);
        *(GAS v4u*)(WT + (size_t)(dst_row0 + n) * ldt + k0 + 8 * c) = o; }
    LDS_WAIT(); asm volatile("" ::: "memory");
}
__device__ __forceinline__ void transpose_item_f8(const float* W, int ldw, unsigned char* WT, int ldt, int k0, int src_col0, int dst_row0, LAS float* scr, int lane, float sc, const float* ks = nullptr) {
    f32x4 ld[8];
#pragma unroll
    for (int i = 0; i < 8; ++i) ld[i] = *(const f32x4*)(W + (size_t)(k0 + 8 * i + (lane >> 3)) * ldw + src_col0 + 4 * (lane & 7));
#pragma unroll
    for (int i = 0; i < 8; ++i) { LAS float* d = scr + (8 * i + (lane >> 3)) * 33 + 4 * (lane & 7); const float s = ks ? sc * ks[k0 + 8 * i + (lane >> 3)] : sc; d[0] = ld[i][0] * s; d[1] = ld[i][1] * s; d[2] = ld[i][2] * s; d[3] = ld[i][3] * s; }
    LDS_WAIT(); asm volatile("" ::: "memory");
    const int c = lane & 7;
#pragma unroll
    for (int j = 0; j < 4; ++j) { const int n = (lane >> 3) + 8 * j; const LAS float* s = scr + (8 * c) * 33 + n;
        v2u o; o.x = pk4_fp8(s[0 * 33], s[1 * 33], s[2 * 33], s[3 * 33]); o.y = pk4_fp8(s[4 * 33], s[5 * 33], s[6 * 33], s[7 * 33]);
        *(GAS v2u*)(WT + (size_t)(dst_row0 + n) * ldt + k0 + 8 * c) = o; }
    LDS_WAIT(); asm volatile("" ::: "memory");
}
__device__ __forceinline__ int win_src_col(int blk) {
    const int tile = blk >> 3, j = blk & 7, bj = j >> 2, hh = j & 3;
    if (tile == 0) return 32 * j;
    if (tile == 1 || tile == 2) return 256 + 256 * (tile - 1) + 64 * hh + 32 * bj;
    if (tile == 3) return 768 + 32 * j;
    if (tile == 4 || tile == 5) return (j < 4) ? (1028 + 128 * (tile - 4) + 32 * j) : (1284 + 128 * (tile - 4) + 32 * (j - 4));
    if (tile == 6 || tile == 7) return 1540 + 256 * (tile - 6) + 64 * hh + 32 * bj;
    if (tile == 8) return 2052 + 32 * j;
    return 2308 + 256 * (tile - 9) + 32 * j;
}
constexpr int CONV_NIN = 200 * 16, CONV_NBR = 4 * 32 * 4, CONV_NOUT = 32 * 16, CONV_NGLU = 8 * 4, CONV_NUP1 = 176 * 16, CONV_NDN1 = 32 * 44;
constexpr int CONV_NMIX = CONV_NIN + CONV_NBR + CONV_NOUT + CONV_NGLU, CONV_CHUNK = 64;
__device__ __forceinline__ int conv_ffn_items(int layer) { return (CONV_NUP1 + CONV_NDN1) * ((layer & 1) ? NE : 1); }
__device__ __forceinline__ void convert_item(Frame& F, int layer, int it, LAS float* scr) {
    const Args& A = *F.a; unsigned char* ws = F.ws;
    const bool moe = (layer & 1) != 0; const int j2 = layer >> 1, ne = moe ? NE : 1;
    const int n_up = CONV_NUP1 * ne;
    int r = it;
    if (r < CONV_NIN) { const int blk = r >> 4, kb = r & 15;
        if (F8_GATES && blk >= 72) transpose_item_f8(A.in[I_WIN] + (size_t)layer * D * DP, DP, (unsigned char*)(ws + WS_WIN8), D, 64 * kb, win_src_col(blk), 32 * (blk - 72), scr, F.lane, 64.0f);
        else transpose_item(A.in[I_WIN] + (size_t)layer * D * DP, DP, (bf16*)(ws + WS_WIN), D, 64 * kb, win_src_col(blk), 32 * blk, scr, F.lane);
        return; } r -= CONV_NIN;
    if (r < CONV_NBR) { const int z = r >> 7, q = r & 127, blk = q >> 2, kb = q & 3;
        transpose_item(A.in[I_WBR] + ((size_t)layer * 4 + z) * 256 * D, D, (bf16*)(ws + WS_WBR) + (size_t)z * D * 256, 256, 64 * kb, 32 * blk, 32 * blk, scr, F.lane); return; } r -= CONV_NBR;
    if (r < CONV_NOUT) { const int blk = r >> 4, kb = r & 15; transpose_item(A.in[I_WOUT] + (size_t)layer * D * D, D, (bf16*)(ws + WS_WOUT), D, 64 * kb, 32 * blk, 32 * blk, scr, F.lane); return; } r -= CONV_NOUT;
    if (r < CONV_NGLU) { const int blk = r >> 2, kb = r & 3; transpose_item(A.in[I_WGLU] + (size_t)layer * 256 * 256, 256, (bf16*)(ws + WS_WGLU), 256, 64 * kb, 32 * blk, 32 * blk, scr, F.lane); return; } r -= CONV_NGLU;
    if (r < n_up) { const int e = r / CONV_NUP1, q = r % CONV_NUP1, blk = q >> 4, kb = q & 15, tile = blk >> 3, jj = blk & 7;
        const float* w1 = moe ? A.in[I_MW1] + ((size_t)j2 * NE + e) * D * FF : A.in[I_W1] + (size_t)j2 * D * FF;
        const float* w3 = moe ? A.in[I_MW3] + ((size_t)j2 * NE + e) * D * FF : A.in[I_W3] + (size_t)j2 * D * FF;
        const float* ks = (FUSE_DENSE_NORM && !moe) ? A.in[I_GFFN] + layer * D : nullptr;
        if (moe ? (F8_MOE_UP != 0) : (DENSE8(layer) != 0)) transpose_item_f8(jj < 4 ? w1 : w3, FF, (unsigned char*)(ws + WS_WUP) + (size_t)e * 5632 * D, D, 64 * kb, 128 * tile + 32 * (jj & 3), 32 * blk, scr, F.lane, 64.0f, ks);
        else transpose_item(jj < 4 ? w1 : w3, FF, (bf16*)(ws + WS_WUP) + (size_t)e * 5632 * D, D, 64 * kb, 128 * tile + 32 * (jj & 3), 32 * blk, scr, F.lane, ks);
        return; } r -= n_up;
    { const int e = r / CONV_NDN1, q = r % CONV_NDN1, blk = q / 44, kb = q % 44;
        const float* w2 = moe ? A.in[I_MW2] + ((size_t)j2 * NE + e) * FF * D : A.in[I_W2] + (size_t)j2 * FF * D;
        if (moe ? (F8_MOE_DN != 0) : (DENSE8(layer) != 0)) transpose_item_f8(w2, D, (unsigned char*)(ws + WS_WDN) + (size_t)e * D * FF, FF, 64 * kb, 32 * blk, 32 * blk, scr, F.lane, 64.0f);
        else transpose_item(w2, D, (bf16*)(ws + WS_WDN) + (size_t)e * D * FF, FF, 64 * kb, 32 * blk, 32 * blk, scr, F.lane); }
}
__device__ __forceinline__ void phase_convert(Frame& F, int layer) {
    LAS float* scr = (LAS float*)(F.lds + F.wave * 16384);
    for (int it = F.gw; it < CONV_NMIX; it += F.NGW) convert_item(F, layer, it, scr);
}
__device__ __forceinline__ void convert_ffn_chunk(Frame& F, int layer, int chunk) {
    LAS float* scr = (LAS float*)(F.lds + F.wave * 16384); const int nf = conv_ffn_items(layer);
    for (int j = F.wave; j < CONV_CHUNK; j += NWAVES) { const int it = chunk * CONV_CHUNK + j; if (it < nf) convert_item(F, layer, CONV_NMIX + it, scr); }
}
struct S5P { float lr, li, dt, kr, ki; };
__device__ __forceinline__ S5P s5_params(const Args& A, int layer, int g, int p) {
    S5P q; q.lr = A.in[I_LRE][(layer * 16 + g) * 64 + p]; q.li = A.in[I_LIM][(layer * 16 + g) * 64 + p]; q.dt = expf(A.in[I_LDT][layer * 16 + g]);
    const float mag = expf(q.lr * q.dt), abr = mag * cosf(q.li * q.dt), abi = mag * sinf(q.li * q.dt);
    const float nr = abr - 1.0f, ni = abi, den = q.lr * q.lr + q.li * q.li;
    q.kr = (nr * q.lr + ni * q.li) / den; q.ki = (ni * q.lr - nr * q.li) / den; return q;
}
__device__ __forceinline__ void s5_pow(const S5P& q, float n, float& pr, float& pi) { const float m = expf(n * q.lr * q.dt), a = n * q.li * q.dt; pr = m * cosf(a); pi = m * sinf(a); }
__device__ __forceinline__ void phase_kfun(Frame& F, int layer) {
    const Args& A = *F.a; float* kf = (float*)(F.ws + WS_KFUN);
    for (int it = F.gw; it < 16 * 64; it += F.NGW) {
        const int g = it >> 6, tau = it & 63, lane = F.lane;
        const S5P q = s5_params(A, layer, g, lane); float pr, pi; s5_pow(q, (float)tau, pr, pi);
        const float wr_ = pr * q.kr - pi * q.ki, wi_ = pr * q.ki + pi * q.kr;
        const int h = lane >> 2, hp0 = 4 * (lane & 3);
        const float* cre = A.in[I_CRE] + ((size_t)(layer * 16 + g) * 16 + h) * 64; const float* cim = A.in[I_CIM] + ((size_t)(layer * 16 + g) * 16 + h) * 64;
        const float* bre = A.in[I_BRE] + (size_t)(layer * 16 + g) * 64 * 16 + hp0; const float* bim = A.in[I_BIM] + (size_t)(layer * 16 + g) * 64 * 16 + hp0;
        f32x4 acc = {0.f, 0.f, 0.f, 0.f};
        for (int p = 0; p < 64; ++p) {
            const float wpr = __shfl(wr_, p), wpi = __shfl(wi_, p);
            const float cr = cre[p], ci = cim[p], cwr = cr * wpr - ci * wpi, cwi = cr * wpi + ci * wpr;
            const f32x4 br = *(const f32x4*)(bre + p * 16), bi = *(const f32x4*)(bim + p * 16);
            acc += cwr * br - cwi * bi;
        }
        *(f32x4*)(kf + ((size_t)(g * 64 + tau) * 16 + h) * 16 + hp0) = acc;
    }
}
__device__ __forceinline__ void moe_starts(Frame& F, int j2, int (&st)[NE + 1]) {
    const unsigned* cnt = (const unsigned*)(F.ws + WS_CTL) + CW_MOE + 64 * j2; int s = 0;
#pragma unroll
    for (int e = 0; e < NE; ++e) { st[e] = s; const int c = (int)__hip_atomic_load(cnt + e, __ATOMIC_RELAXED, __HIP_MEMORY_SCOPE_AGENT); s += (c + 255) & ~255; }
    st[NE] = s;
}
__device__ __forceinline__ void moe_combine_row(Frame& F, int row, f32x4 (&v)[4], const int (&st)[NE + 1]) {
    const unsigned* rt = (const unsigned*)(F.ws + WS_ROUTE) + (size_t)row * 8;
    const v4u rr = *(const v4u*)rt; unsigned s0 = rr.z, s1 = rr.w;
#pragma unroll
    for (int e = 0; e < NE; ++e) { if ((int)rr.x == e) s0 += (unsigned)st[e]; if ((int)rr.y == e) s1 += (unsigned)st[e]; }
    const float w0 = __builtin_bit_cast(float, rt[4]), w1 = __builtin_bit_cast(float, rt[5]);
    const bf16* yp = (const bf16*)(F.ws + WS_XNP);
#pragma unroll
    for (int j = 0; j < 4; ++j) { const v2u a = *(const v2u*)(yp + (size_t)s0 * D + 4 * F.lane + 256 * j), b = *(const v2u*)(yp + (size_t)s1 * D + 4 * F.lane + 256 * j);
        v[j][0] += w0 * bflo(a.x) + w1 * bflo(b.x); v[j][1] += w0 * bfhi(a.x) + w1 * bfhi(b.x); v[j][2] += w0 * bflo(a.y) + w1 * bflo(b.y); v[j][3] += w0 * bfhi(a.y) + w1 * bfhi(b.y); }
}
__device__ __forceinline__ void phase_rows_mixer(Frame& F, int layer) {
    const Args& A = *F.a; const int lane = F.lane;
    const float* xin = A.in[I_X]; bf16* xb = (bf16*)(F.ws + WS_XB); const bool first = (layer == 0), comb = (layer > 0) && (((layer - 1) & 1) != 0);
    f32x4 gv[4]; f32x4 wf[4][4];
#pragma unroll
    for (int j = 0; j < 4; ++j) { gv[j] = *(const f32x4*)(A.in[I_GMIX] + layer * D + 4 * lane + 256 * j);
#pragma unroll
        for (int e = 0; e < 4; ++e) wf[j][e] = *(const f32x4*)(A.in[I_WIN] + (size_t)layer * D * DP + (size_t)(4 * lane + 256 * j + e) * DP + 1024); }
    const f32x4 bf = *(const f32x4*)(A.in[I_BFORGET] + layer * 4);
    bf16* xn = (bf16*)(F.ws + WS_XN); float* lf = (float*)(F.ws + WS_LF); unsigned char* xn8 = F.ws + WS_XN8;
    int st[NE + 1];
#pragma unroll
    for (int e = 0; e <= NE; ++e) st[e] = 0;
    if (comb) moe_starts(F, (layer - 1) >> 1, st);
    for (int row = F.gw; row < T; row += F.NGW) {
        f32x4 v[4]; float ss = 0.f;
        if (first) {
#pragma unroll
            for (int j = 0; j < 4; ++j) v[j] = *(const f32x4*)(xin + (size_t)row * D + 4 * lane + 256 * j);
        } else {
#pragma unroll
            for (int j = 0; j < 4; ++j) { const v2u r = *(const v2u*)(xb + (size_t)row * D + 4 * lane + 256 * j); v[j] = (f32x4){bflo(r.x), bfhi(r.x), bflo(r.y), bfhi(r.y)}; }
        }
        if (comb) { moe_combine_row(F, row, v, st);
#pragma unroll
            for (int j = 0; j < 4; ++j) { v2u o; o.x = pk2(v[j][0], v[j][1]); o.y = pk2(v[j][2], v[j][3]); *(v2u*)(xb + (size_t)row * D + 4 * lane + 256 * j) = o;
                v[j] = (f32x4){bflo(o.x), bfhi(o.x), bflo(o.y), bfhi(o.y)}; } }
#pragma unroll
        for (int j = 0; j < 4; ++j) ss += (v[j][0] * v[j][0] + v[j][1] * v[j][1]) + (v[j][2] * v[j][2] + v[j][3] * v[j][3]);
        const float rs = 1.0f / sqrtf(wave_sum(ss) * (1.0f / D) + EPS);
        f32x4 fl = {0.f, 0.f, 0.f, 0.f};
#pragma unroll
        for (int j = 0; j < 4; ++j) { const f32x4 h = v[j] * rs * gv[j];
            v2u o; o.x = pk2(h[0], h[1]); o.y = pk2(h[2], h[3]); *(v2u*)(xn + (size_t)row * D + 4 * lane + 256 * j) = o;
            if (F8_GATES) *(unsigned*)(xn8 + (size_t)row * D + 4 * lane + 256 * j) = pk4_fp8(h[0], h[1], h[2], h[3]);
#pragma unroll
            for (int e = 0; e < 4; ++e) fl += h[e] * wf[j][e]; }
#pragma unroll
        for (int e = 0; e < 4; ++e) fl[e] = wave_sum(fl[e]);
        if (lane == 0) { f32x4 o;
#pragma unroll
            for (int e = 0; e < 4; ++e) { const float xx = fl[e] + bf[e]; o[e] = (fminf(xx, 0.f) - log1pf(expf(-fabsf(xx)))) * LOG2E; }
            *(f32x4*)(lf + (size_t)row * 4) = o; }
    }
}
__device__ __forceinline__ void phase_s5_tables(Frame& F, int layer) {
    const Args& A = *F.a; const int lane = F.lane;
    bf16* wz = (bf16*)(F.ws + WS_WZ); bf16* wy = (bf16*)(F.ws + WS_WY); const float* kf = (const float*)(F.ws + WS_KFUN);
    for (int it = F.gw; it < 16 * 256; it += F.NGW) {
        const int g = it >> 8, rowz = it & 255; bf16* dst = wz + ((size_t)(g * 256 + rowz)) * 1024 + lane * 16;
        v4u o0 = {0u, 0u, 0u, 0u}, o1 = {0u, 0u, 0u, 0u};
        if (rowz < 128) { const int p = rowz >> 1, ri = rowz & 1; const S5P q = s5_params(A, layer, g, p); float pr, pi; s5_pow(q, (float)(63 - lane), pr, pi);
            const float wr_ = pr * q.kr - pi * q.ki, wi_ = pr * q.ki + pi * q.kr;
            const float* bre = A.in[I_BRE] + ((size_t)(layer * 16 + g) * 64 + p) * 16; const float* bim = A.in[I_BIM] + ((size_t)(layer * 16 + g) * 64 + p) * 16;
            float val[16];
#pragma unroll
            for (int h = 0; h < 16; ++h) { const float br = bre[h], bi = bim[h]; val[h] = ri == 0 ? (wr_ * br - wi_ * bi) : (wr_ * bi + wi_ * br); }
            o0 = (v4u){pk2(val[0], val[1]), pk2(val[2], val[3]), pk2(val[4], val[5]), pk2(val[6], val[7])};
            o1 = (v4u){pk2(val[8], val[9]), pk2(val[10], val[11]), pk2(val[12], val[13]), pk2(val[14], val[15])}; }
        *(v4u*)dst = o0; *(v4u*)(dst + 8) = o1;
    }
    for (int it = F.gw; it < 16 * 1024; it += F.NGW) {
        const int g = it >> 10, n = it & 1023, t = n >> 4, h = n & 15; bf16* dst = wy + ((size_t)(g * 1024 + n)) * S5_LDA;
        v4u o0 = {0u, 0u, 0u, 0u}, o1 = {0u, 0u, 0u, 0u};
        if (lane <= t) { const float* src = kf + ((size_t)(g * 64 + (t - lane)) * 16 + h) * 16;
            const f32x4 a = *(const f32x4*)src, b = *(const f32x4*)(src + 4), c = *(const f32x4*)(src + 8), d = *(const f32x4*)(src + 12);
            o0 = (v4u){pk2(a[0], a[1]), pk2(a[2], a[3]), pk2(b[0], b[1]), pk2(b[2], b[3])}; o1 = (v4u){pk2(c[0], c[1]), pk2(c[2], c[3]), pk2(d[0], d[1]), pk2(d[2], d[3])}; }
        *(v4u*)(dst + lane * 16) = o0; *(v4u*)(dst + lane * 16 + 8) = o1;
        const S5P q = s5_params(A, layer, g, lane); float pr, pi; s5_pow(q, (float)(t + 1), pr, pi);
        const float cr = A.in[I_CRE][((size_t)(layer * 16 + g) * 16 + h) * 64 + lane], ci = A.in[I_CIM][((size_t)(layer * 16 + g) * 16 + h) * 64 + lane];
        *(unsigned*)(dst + 1024 + 2 * lane) = pk2(cr * pr - ci * pi, -(cr * pi + ci * pr));
    }
}
__device__ __forceinline__ void phase_cumsum(Frame& F) {
    const int first = (gridDim.x >= 160) ? 128 : 0;
    if ((int)blockIdx.x < first || (int)blockIdx.x >= first + 32) return;
    const int bh = (int)blockIdx.x - first, b = bh >> 2, h = bh & 3, tid = F.tid;
    const float* lf = (const float*)(F.ws + WS_LF); float* cum = (float*)(F.ws + WS_CUM);
    LAS float* wtot = (LAS float*)(F.lds);
    float v[8]; float run = 0.f;
#pragma unroll
    for (int i = 0; i < 8; ++i) { run += lf[((size_t)b * SEQ + tid * 8 + i) * 4 + h]; v[i] = run; }
    float incl = run;
#pragma unroll
    for (int o = 1; o < 64; o <<= 1) { const float n = __shfl_up(incl, o); if (F.lane >= o) incl += n; }
    if (F.lane == 63) wtot[F.wave] = incl;
    __syncthreads();
    float base = incl - run;
    for (int w = 0; w < F.wave; ++w) base += wtot[w];
#pragma unroll
    for (int i = 0; i < 8; ++i) cum[(size_t)bh * SEQ + tid * 8 + i] = base + v[i];
    __syncthreads();
}
__device__ __forceinline__ void phase_conv(Frame& F, int layer) {
    const Args& A = *F.a; const int lane = F.lane;
    LAS f32x4* wl = (LAS f32x4*)F.lds;
    for (int i = F.tid; i < 31 * 64; i += NWAVES * 64) wl[i] = *(const f32x4*)(A.in[I_CONVW] + (size_t)layer * 31 * 256 + (size_t)i * 4);
    __syncthreads();
    const f32x4 cb = *(const f32x4*)(A.in[I_CONVB] + layer * 256 + 4 * lane), lg = *(const f32x4*)(A.in[I_LNG] + layer * 256 + 4 * lane), lb = *(const f32x4*)(A.in[I_LNB] + layer * 256 + 4 * lane);
    const bf16* uc = (const bf16*)(F.ws + WS_UC); bf16* ycat = (bf16*)(F.ws + WS_YCAT);
    for (int run = F.gw; run < T / 8; run += F.NGW) {
        const int t0 = run * 8, tl0 = t0 & (SEQ - 1);
        f32x4 acc[8];
#pragma unroll
        for (int i = 0; i < 8; ++i) acc[i] = cb;
#pragma unroll
        for (int r = 0; r < 38; ++r) {
            v2u raw = {0u, 0u};
            if (tl0 - 30 + r >= 0) raw = *(const v2u*)(uc + (size_t)(t0 - 30 + r) * 256 + 4 * lane);
            const f32x4 x = {bflo(raw.x), bfhi(raw.x), bflo(raw.y), bfhi(raw.y)};
#pragma unroll
            for (int i = 0; i < 8; ++i) { const int j = r - i; if (j >= 0 && j < 31) acc[i] += wl[j * 64 + lane] * x; }
        }
#pragma unroll
        for (int i = 0; i < 8; ++i) {
            const f32x4 a = acc[i];
            const float mean = wave_sum((a[0] + a[1]) + (a[2] + a[3])) * (1.0f / 256.0f);
            const f32x4 dlt = a - mean;
            const float var = wave_sum((dlt[0] * dlt[0] + dlt[1] * dlt[1]) + (dlt[2] * dlt[2] + dlt[3] * dlt[3])) * (1.0f / 256.0f);
            const float rs = 1.0f / sqrtf(var + EPS);
            f32x4 y = dlt * rs * lg + lb;
#pragma unroll
            for (int e = 0; e < 4; ++e) y[e] = y[e] * sigmoidf_(y[e]);
            v2u o; o.x = pk2(y[0], y[1]); o.y = pk2(y[2], y[3]);
            *(v2u*)(ycat + (size_t)(t0 + i) * 1024 + 512 + 4 * lane) = o;
        }
    }
    __syncthreads();
}

typedef float f32x16 __attribute__((ext_vector_type(16)));
typedef short s16x4 __attribute__((ext_vector_type(4)));
constexpr int AT_PITCH = 72, AT_VOFF = 64 * AT_PITCH * 2, AT_COFF = 2 * AT_VOFF, AT_BUF = AT_COFF + 256, AT_FLAG = 2 * AT_BUF;
constexpr float SB_DEAD = -136.0f;
__device__ __forceinline__ s16x4 tr_read(const LAS unsigned char* p) { return __builtin_bit_cast(s16x4, __builtin_amdgcn_ds_read_tr16_b64_v4i16((LAS s16x4*)p)); }

template <int MODE>
__device__ __forceinline__ void attn_unit(Frame& F, int bh, int qb, const bf16* Q, const bf16* K, const bf16* V, const float* CUM, bf16* Y, float z2max) {
    const int tid = F.tid, lane = F.lane, w = F.wave, l31 = lane & 31, hh = lane >> 5;
    const int b = bh >> 2, h = bh & 3, Q0 = qb * 256, qw0 = Q0 + 32 * w, qrow = qw0 + l31;
    const size_t rowbase = (size_t)b * SEQ;
    LAS unsigned char* lds = F.lds;
    bf16x8 qf[4];
#pragma unroll
    for (int s = 0; s < 4; ++s) qf[s] = *(const bf16x8*)(Q + (rowbase + qrow) * 256 + h * 64 + 16 * s + 8 * hh);
    const float cq = (MODE == 0) ? CUM[(size_t)bh * SEQ + qrow] : 0.f;
    f32x16 ot[2];
#pragma unroll
    for (int r = 0; r < 16; ++r) { ot[0][r] = 0.f; ot[1][r] = 0.f; }
    float m_run = -INFINITY, l_run = 0.f, carry = 0.f; bool fdead = false;
    const int tmax = (Q0 + 255) >> 6, srow = tid >> 3, sch = tid & 7;
    const bf16* kg = K + (rowbase + srow) * 256 + h * 64 + sch * 8; const bf16* vg = V + (rowbase + srow) * 256 + h * 64 + sch * 8;
    const int sofs = (srow * AT_PITCH + sch * 8) * 2;
    v4u kreg = *(const v4u*)(kg + (size_t)(64 * tmax) * 256), vreg = *(const v4u*)(vg + (size_t)(64 * tmax) * 256);
    float creg = (MODE == 0 && tid < 64) ? -CUM[(size_t)bh * SEQ + 64 * tmax + tid] : 0.f;
    LAS unsigned* flags = (LAS unsigned*)(lds + AT_FLAG);
    if (tid < 3) flags[tid] = 0u;
    *(LAS v4u*)(lds + sofs) = kreg; *(LAS v4u*)(lds + AT_VOFF + sofs) = vreg; if (MODE == 0 && tid < 64) *(LAS float*)(lds + AT_COFF + tid * 4) = creg;
    __syncthreads();
    int cur = 0, it = 0;
    const int ti = lane & 15, tq = ti >> 2, tp = ti & 3, tg = (lane >> 4) & 1;
    const int vlane = (tq * AT_PITCH + 16 * tg + 4 * tp) * 2;
    for (int t = tmax; t >= 0; --t, ++it) {
        const bool more = t > 0;
        if (more) { kreg = *(const v4u*)(kg + (size_t)(64 * (t - 1)) * 256); vreg = *(const v4u*)(vg + (size_t)(64 * (t - 1)) * 256); if (MODE == 0 && tid < 64) creg = -CUM[(size_t)bh * SEQ + 64 * (t - 1) + tid]; }
        const LAS unsigned char* Kb = lds + cur * AT_BUF; const LAS unsigned char* Vb = Kb + AT_VOFF; const LAS unsigned char* Cb = Kb + AT_COFF;
        const int kv0 = 64 * t;
        bool alive = false;
        if (kv0 <= qw0 + 31 && !__all(MODE == 0 ? fdead : (carry < SB_DEAD))) {
            f32x16 p[2];
            if (MODE == 0) {
#pragma unroll
                for (int hf = 0; hf < 2; ++hf)
#pragma unroll
                    for (int c = 0; c < 4; ++c) { const f32x4 ck = *(const LAS f32x4*)(Cb + (32 * hf + 8 * c + 4 * hh) * 4);
#pragma unroll
                        for (int i = 0; i < 4; ++i) p[hf][4 * c + i] = ck[i]; }
            } else {
#pragma unroll
                for (int r = 0; r < 16; ++r) { p[0][r] = 0.f; p[1][r] = 0.f; }
            }
#pragma unroll
            for (int s = 0; s < 4; ++s) {
                const bf16x8 k0 = *(const LAS bf16x8*)(Kb + (l31 * AT_PITCH + 16 * s + 8 * hh) * 2), k1 = *(const LAS bf16x8*)(Kb + ((32 + l31) * AT_PITCH + 16 * s + 8 * hh) * 2);
                p[0] = __builtin_amdgcn_mfma_f32_32x32x16_bf16(k0, qf[s], p[0], 0, 0, 0);
                p[1] = __builtin_amdgcn_mfma_f32_32x32x16_bf16(k1, qf[s], p[1], 0, 0, 0);
            }
            const bool diag = (kv0 + 63 > qw0);
            if (MODE == 0) {
                if (diag) {
#pragma unroll
                    for (int hf = 0; hf < 2; ++hf)
#pragma unroll
                        for (int r = 0; r < 16; ++r) { const int kvg = kv0 + 32 * hf + (r & 3) + 8 * (r >> 2) + 4 * hh; if (kvg > qrow) p[hf][r] = -INFINITY; }
                }
                float mt = p[0][0];
#pragma unroll
                for (int r = 0; r < 16; ++r) { mt = fmaxf(mt, p[0][r]); mt = fmaxf(mt, p[1][r]); }
                mt = fmaxf(mt, __shfl_xor(mt, 32));
                const float mn = fmaxf(m_run, mt), alpha = fast_exp2(m_run - mn); m_run = mn;
                float rs = 0.f;
#pragma unroll
                for (int r = 0; r < 16; ++r) { p[0][r] = fast_exp2(p[0][r] - mn); p[1][r] = fast_exp2(p[1][r] - mn); rs += p[0][r] + p[1][r]; }
                l_run = l_run * alpha + rs;
                if (__any(alpha != 1.0f)) {
#pragma unroll
                    for (int r = 0; r < 16; ++r) { ot[0][r] *= alpha; ot[1][r] *= alpha; } }
                if (more) { const float cnext = CUM[(size_t)bh * SEQ + kv0 - 1]; fdead = (z2max - cnext - m_run) < SB_DEAD; alive = !__all(fdead); }
            } else {
                f32x16 lk[2];
#pragma unroll
                for (int hf = 0; hf < 2; ++hf)
#pragma unroll
                    for (int r = 0; r < 16; ++r) { const float z = p[hf][r], e = fast_exp2(-fabsf(z)), lg = __builtin_amdgcn_logf(1.0f + e);
                        float lb = fminf(z, 0.f) - lg, k_ = -(fmaxf(z, 0.f) + lg);
                        if (diag) { const int kvg = kv0 + 32 * hf + (r & 3) + 8 * (r >> 2) + 4 * hh; if (kvg >= qrow) { k_ = 0.f; lb = -INFINITY; } }
                        p[hf][r] = lb; lk[hf][r] = k_; }
                float T[8], To[8], PS[8];
#pragma unroll
                for (int mI = 0; mI < 8; ++mI) { const int hf = mI >> 2, c = mI & 3; T[mI] = (lk[hf][4 * c] + lk[hf][4 * c + 1]) + (lk[hf][4 * c + 2] + lk[hf][4 * c + 3]); To[mI] = __shfl_xor(T[mI], 32); }
                float run = 0.f;
#pragma unroll
                for (int mI = 7; mI >= 0; --mI) { PS[mI] = run; run += T[mI] + To[mI]; }
#pragma unroll
                for (int mI = 0; mI < 8; ++mI) { const int hf = mI >> 2, c = mI & 3; const float base = carry + PS[mI] + (hh == 0 ? To[mI] : 0.f);
                    const float s3 = lk[hf][4 * c + 3], s2 = s3 + lk[hf][4 * c + 2], s1 = s2 + lk[hf][4 * c + 1];
                    p[hf][4 * c + 3] = fast_exp2(p[hf][4 * c + 3] + base); p[hf][4 * c + 2] = fast_exp2(p[hf][4 * c + 2] + base + s3);
                    p[hf][4 * c + 1] = fast_exp2(p[hf][4 * c + 1] + base + s2); p[hf][4 * c] = fast_exp2(p[hf][4 * c] + base + s1); }
                carry += run;
                alive = __any(carry >= SB_DEAD);
            }
            bf16x8 pb[2][2];
#pragma unroll
            for (int hf = 0; hf < 2; ++hf)
#pragma unroll
                for (int c2 = 0; c2 < 2; ++c2) { v4u wv; wv.x = pg8::cvt_pk_bf16(p[hf][8 * c2], p[hf][8 * c2 + 1]); wv.y = pg8::cvt_pk_bf16(p[hf][8 * c2 + 2], p[hf][8 * c2 + 3]);
                    wv.z = pg8::cvt_pk_bf16(p[hf][8 * c2 + 4], p[hf][8 * c2 + 5]); wv.w = pg8::cvt_pk_bf16(p[hf][8 * c2 + 6], p[hf][8 * c2 + 7]); pb[hf][c2] = __builtin_bit_cast(bf16x8, wv); }
#pragma unroll
            for (int db = 0; db < 2; ++db)
#pragma unroll
                for (int hf = 0; hf < 2; ++hf)
#pragma unroll
                    for (int c2 = 0; c2 < 2; ++c2) { const LAS unsigned char* vp = Vb + ((32 * hf + 16 * c2 + 4 * hh) * AT_PITCH + 32 * db) * 2 + vlane;
                        const s16x4 lo = tr_read(vp), hi = tr_read(vp + 8 * AT_PITCH * 2);
                        const bf16x8 va = {lo[0], lo[1], lo[2], lo[3], hi[0], hi[1], hi[2], hi[3]};
                        ot[db] = __builtin_amdgcn_mfma_f32_32x32x16_bf16(va, pb[hf][c2], ot[db], 0, 0, 0); }
        } else { alive = (kv0 > qw0 + 31); }
        if (more) { const int o = (cur ^ 1) * AT_BUF + sofs; *(LAS v4u*)(lds + o) = kreg; *(LAS v4u*)(lds + o + AT_VOFF) = vreg; if (MODE == 0 && tid < 64) *(LAS float*)(lds + (cur ^ 1) * AT_BUF + AT_COFF + tid * 4) = creg; }
        { const int sl = it % 3, sn = (it + 1) % 3;
            if (alive && lane == 0) flags[sl] = 1u;
            if (tid == 0) flags[sn] = 0u;
            __syncthreads();
            if (flags[sl] == 0u) break; }
        cur ^= 1;
    }
    float inv = 1.0f;
    if (MODE == 0) { const float lt = l_run + __shfl_xor(l_run, 32); inv = 1.0f / lt; }
    bf16* yrow = Y + (rowbase + qrow) * 1024 + h * 64;
#pragma unroll
    for (int db = 0; db < 2; ++db)
#pragma unroll
        for (int c = 0; c < 4; ++c) { v2u o; o.x = pg8::cvt_pk_bf16(ot[db][4 * c] * inv, ot[db][4 * c + 1] * inv); o.y = pg8::cvt_pk_bf16(ot[db][4 * c + 2] * inv, ot[db][4 * c + 3] * inv);
            *(v2u*)(yrow + 32 * db + 8 * c + 4 * hh) = o; }
    __syncthreads();
}
__device__ __forceinline__ int q_pop(Frame& F, unsigned* ctr) {
    LAS int* slot = (LAS int*)(F.lds + QSLOT_OFF);
    __syncthreads();
    if (F.tid == 0) *slot = (int)__hip_atomic_fetch_add(ctr, 1u, __ATOMIC_RELAXED, __HIP_MEMORY_SCOPE_AGENT);
    __syncthreads();
    return *slot;
}
__device__ __forceinline__ void phase_attn_sb(Frame& F, int layer, int rep) {
    const bf16* qkv = (const bf16*)(F.ws + WS_QKV); const size_t sz = (size_t)T * 256; bf16* ycat = (bf16*)(F.ws + WS_YCAT);
    unsigned* ctr = (unsigned*)(F.ws + WS_CTL) + CW_Q + 128 * layer + 16 * rep;
    for (;;) { const int un = q_pop(F, ctr); if (un >= 512) break;
        attn_unit<1>(F, un & 31, 15 - (un >> 5), qkv + 3 * sz, qkv + 4 * sz, qkv + 5 * sz, nullptr, ycat + 768, 0.f); }
}
__device__ __forceinline__ void phase_attn_fox(Frame& F, int layer, int rep) {
    const bf16* qkv = (const bf16*)(F.ws + WS_QKV); const size_t sz = (size_t)T * 256; const float* cum = (const float*)(F.ws + WS_CUM); bf16* ycat = (bf16*)(F.ws + WS_YCAT);
    unsigned* ctr = (unsigned*)(F.ws + WS_CTL) + CW_Q + 128 * layer + 64 + 16 * rep;
    const float gq = fabsf(F.a->in[I_FQG][layer * 64 + F.lane]), gk = fabsf(F.a->in[I_FKG][layer * 64 + F.lane]);
    float mq = gq, mk = gk;
#pragma unroll
    for (int o = 1; o < 64; o <<= 1) { mq = fmaxf(mq, __shfl_xor(mq, o)); mk = fmaxf(mk, __shfl_xor(mk, o)); }
    const float z2max = 8.0f * mq * mk * LOG2E * 1.02f + 0.25f;
    const int nchunk = (conv_ffn_items(layer) + CONV_CHUNK - 1) / CONV_CHUNK;
    const int total = 512 + nchunk;
    for (;;) { const int t = q_pop(F, ctr); if (t >= total) break;
        const int na0 = (int)(((long)t * 512) / total), na1 = (int)(((long)(t + 1) * 512) / total);
        if (na1 > na0) attn_unit<0>(F, na0 & 31, 15 - (na0 >> 5), qkv, qkv + sz, qkv + 2 * sz, cum, ycat + 256, z2max);
        else convert_ffn_chunk(F, layer, t - na0); }
}
__device__ __forceinline__ void phase_s5_scan_unit(Frame& F, int layer, int g, int pm) {
    __builtin_amdgcn_fence(__ATOMIC_ACQUIRE, "agent");
    if (F.tid < 256) {
        const int b = 4 * pm + (F.tid >> 6), p = F.tid & 63;
        const S5P q = s5_params(*F.a, layer, g, p); float ar, ai; s5_pow(q, 64.0f, ar, ai);
        const float* z = (const float*)(F.ws + WS_Z); bf16* ua = (bf16*)(F.ws + WS_UA);
        float sr = 0.f, si = 0.f;
        for (int n0 = 0; n0 < 64; n0 += 16) {
            f32x2 zz[16];
#pragma unroll
            for (int j = 0; j < 16; ++j) zz[j] = *(const f32x2*)(z + ((size_t)g * 512 + b * 64 + n0 + j) * 128 + 2 * p);
#pragma unroll
            for (int j = 0; j < 16; ++j) { const size_t ch = (size_t)g * 512 + b * 64 + n0 + j;
                *(unsigned*)(ua + ch * S5_LDA + 1024 + 2 * p) = pk2(sr, si);
                const float nr = ar * sr - ai * si + zz[j][0], ni = ar * si + ai * sr + zz[j][1]; sr = nr; si = ni; }
        }
    }
    __syncthreads();
}
__device__ __forceinline__ void phase_rows_ffn(Frame& F, int layer) {
    const Args& A = *F.a; const int lane = F.lane; const int j2 = layer >> 1;
    f32x4 gv[4];
#pragma unroll
    for (int j = 0; j < 4; ++j) gv[j] = *(const f32x4*)(A.in[I_GFFN] + layer * D + 4 * lane + 256 * j);
    const bf16* xb = (const bf16*)(F.ws + WS_XB); unsigned char* seg = F.ws + WS_XNP; unsigned* route = (unsigned*)(F.ws + WS_ROUTE); unsigned* cnt = (unsigned*)(F.ws + WS_CTL) + CW_MOE + 64 * j2;
    unsigned my_e0 = 0, my_e1 = 0, my_r0 = 0, my_r1 = 0; float my_w0 = 0.f, my_w1 = 0.f, my_rs = 0.f; unsigned long long lc = 0ull; int nrow = 0;
    for (int row = F.gw; row < T; row += F.NGW, ++nrow) {
        f32x4 v[4]; float ss = 0.f;
#pragma unroll
        for (int j = 0; j < 4; ++j) { const v2u r = *(const v2u*)(xb + (size_t)row * D + 4 * lane + 256 * j); v[j] = (f32x4){bflo(r.x), bfhi(r.x), bflo(r.y), bfhi(r.y)};
            ss += (v[j][0] * v[j][0] + v[j][1] * v[j][1]) + (v[j][2] * v[j][2] + v[j][3] * v[j][3]); }
        const float rs = 1.0f / sqrtf(wave_sum(ss) * (1.0f / D) + EPS);
        float lg[8];
#pragma unroll
        for (int e = 0; e < 8; ++e) lg[e] = 0.f;
#pragma unroll
        for (int j = 0; j < 4; ++j) { const f32x4 h = v[j] * rs * gv[j];
#pragma unroll
            for (int e4 = 0; e4 < 4; ++e4) { const float* wr = A.in[I_RW] + ((size_t)j2 * D + 4 * lane + 256 * j + e4) * NE; const f32x4 a = *(const f32x4*)wr, b = *(const f32x4*)(wr + 4);
                lg[0] += h[e4] * a[0]; lg[1] += h[e4] * a[1]; lg[2] += h[e4] * a[2]; lg[3] += h[e4] * a[3]; lg[4] += h[e4] * b[0]; lg[5] += h[e4] * b[1]; lg[6] += h[e4] * b[2]; lg[7] += h[e4] * b[3]; } }
#pragma unroll
        for (int e = 0; e < 8; ++e) lg[e] = wave_sum(lg[e]) + A.in[I_RB][j2 * NE + e];
        int e0 = 0; float v0 = lg[0];
#pragma unroll
        for (int e = 1; e < 8; ++e) if (lg[e] > v0) { v0 = lg[e]; e0 = e; }
        int e1 = -1; float v1 = -INFINITY;
#pragma unroll
        for (int e = 0; e < 8; ++e) if (e != e0 && lg[e] > v1) { v1 = lg[e]; e1 = e; }
        const float w1 = 1.0f / (1.0f + expf(v0 - v1)), w0 = 1.0f - w1;
        const unsigned r0 = (unsigned)(lc >> (8 * e0)) & 0xffu; lc += 1ull << (8 * e0);
        const unsigned r1 = (unsigned)(lc >> (8 * e1)) & 0xffu; lc += 1ull << (8 * e1);
        if (lane == nrow) { my_e0 = e0; my_e1 = e1; my_r0 = r0; my_r1 = r1; my_w0 = w0; my_w1 = w1; my_rs = rs; }
    }
    unsigned basev = 0;
    if (lane < 8) { const unsigned c = (unsigned)(lc >> (8 * lane)) & 0xffu; basev = c ? __hip_atomic_fetch_add(cnt + lane, c, __ATOMIC_RELAXED, __HIP_MEMORY_SCOPE_AGENT) : 0u; }
    const unsigned my_p0 = __shfl(basev, (int)my_e0) + my_r0, my_p1 = __shfl(basev, (int)my_e1) + my_r1;
    if (lane < nrow) { const int row = F.gw + lane * F.NGW; unsigned* rt = route + (size_t)row * 8;
        *(v4u*)rt = (v4u){my_e0, my_e1, my_p0, my_p1}; *(v4u*)(rt + 4) = (v4u){__builtin_bit_cast(unsigned, my_w0), __builtin_bit_cast(unsigned, my_w1), 0u, 0u}; }
    for (int i = 0; i < nrow; ++i) {
        const int row = F.gw + i * F.NGW; const float rs = __shfl(my_rs, i);
        const size_t d0 = ((size_t)__shfl((int)my_e0, i) * T + (size_t)__shfl((int)my_p0, i)) * D, d1 = ((size_t)__shfl((int)my_e1, i) * T + (size_t)__shfl((int)my_p1, i)) * D;
#pragma unroll
        for (int j = 0; j < 4; ++j) { const v2u r = *(const v2u*)(xb + (size_t)row * D + 4 * lane + 256 * j);
            const f32x4 h = (f32x4){bflo(r.x), bfhi(r.x), bflo(r.y), bfhi(r.y)} * rs * gv[j]; const unsigned w = pk4_fp8(h[0], h[1], h[2], h[3]);
            *(unsigned*)(seg + d0 + 4 * lane + 256 * j) = w; *(unsigned*)(seg + d1 + 4 * lane + 256 * j) = w; }
    }
}
__device__ __forceinline__ void phase_final_combine(Frame& F) {
    const Args& A = *F.a; int st[NE + 1]; moe_starts(F, (DEPTH - 1) >> 1, st);
    for (int row = F.gw; row < T; row += F.NGW) {
        f32x4 v[4];
#pragma unroll
        for (int j = 0; j < 4; ++j) { const v2u r = *(const v2u*)((const bf16*)(F.ws + WS_XB) + (size_t)row * D + 4 * F.lane + 256 * j); v[j] = (f32x4){bflo(r.x), bfhi(r.x), bflo(r.y), bfhi(r.y)}; }
        moe_combine_row(F, row, v, st);
#pragma unroll
        for (int j = 0; j < 4; ++j) *(f32x4*)(A.out + (size_t)row * D + 4 * F.lane + 256 * j) = v[j];
    }
}

__global__ void __launch_bounds__(NWAVES * 64, 2) mk_fwd(Args args) {
    extern __shared__ __attribute__((aligned(16))) unsigned char lds_raw[];
    Frame F; F.lds = (LAS unsigned char*)lds_raw; F.tid = threadIdx.x; F.lane = F.tid & 63; F.wave = __builtin_amdgcn_readfirstlane(F.tid >> 6);
    F.G = gridDim.x; { const int bx = blockIdx.x; F.vcu = (F.G % 8 == 0) ? (bx % 8) * (F.G / 8) + bx / 8 : bx; }
    F.gw = F.vcu * NWAVES + F.wave; F.NGW = F.G * NWAVES; F.a = &args; F.ws = args.ws;
    volatile LAS unsigned* MISC = (volatile LAS unsigned*)(F.lds + MISC_OFF);
    for (int u = F.tid; u < (LDS_BYTES - RING_BYTES) / 4; u += NWAVES * 64) ((LAS unsigned*)(F.lds + RING_BYTES))[u] = 0u;
    __syncthreads();
    unsigned* ctl = (unsigned*)(args.ws + WS_CTL);
    const bool multi = (args.gp_hi - args.gp_lo) > 1;
    XcdBarrier bar; bar.bar = ctl + CW_BAR; bar.x = 0; bar.st = nullptr;
    if (multi) bar = xcd_barrier_post(ctl + CW_BAR, MISC + 8);
    unsigned char* ws = args.ws;
    LAS unsigned char* ring = F.lds;

    const int gp_lo = args.gp_lo, gp_hi = args.gp_hi;
#define IN(p) (gp_lo <= layer * NPH + (p) && layer * NPH + (p) < gp_hi)
#define SEAM(p) do { if (IN(p) && layer * NPH + (p) + 1 < gp_hi) xcd_barrier(bar); } while (0)
#ifndef PH_MASK
#define PH_MASK 0xffff
#endif
#define ON(p) (((PH_MASK) >> (p)) & 1)
#ifndef PROBE_PH
#define PROBE_PH -1
#endif
#ifndef PROBE_N
#define PROBE_N 1
#endif
#ifndef PROBE_LAYERS
#define PROBE_LAYERS 15
#endif
#define REPS(p) ((((p) == PROBE_PH) && ((PROBE_LAYERS >> layer) & 1)) ? 1 + PROBE_N : 1)
#define ENTER() do { ws = args.ws; asm volatile("" : "+s"(ws)); F.ws = ws; int t_ = threadIdx.x; asm volatile("" : "+v"(t_)); F.tid = t_; F.lane = t_ & 63; F.wave = __builtin_amdgcn_readfirstlane(t_ >> 6); F.gw = F.vcu * NWAVES + F.wave; } while (0)
    for (int layer = gp_lo / NPH; layer < DEPTH && layer * NPH < gp_hi; ++layer) {
        const bool moe = (layer & 1) != 0;
#if ON(0)
        if (IN(0)) for (int rep_ = 0; rep_ < REPS(0); ++rep_) { ENTER(); for (int r2_ = 0; r2_ < ((PROBE_PH == 100) ? 1 + PROBE_N : 1); ++r2_) { phase_convert(F, layer); phase_kfun(F, layer); } phase_rows_mixer(F, layer); }
        SEAM(0);
#endif
#if ON(1)
        if (IN(1)) for (int rep_ = 0; rep_ < REPS(1); ++rep_) { ENTER();
            phase_s5_tables(F, layer); phase_cumsum(F);
#if F8_GATES
            { pg8::Gemm g8{(const bf16*)(ws + WS_XN8), (const bf16*)(ws + WS_WIN8), D / 2, D / 2, D / 2}; pg8::StaticOrder S8; S8.init(T, 4096, F.G, (int)blockIdx.x, D / 2, D / 2);
              pg8::EpiGateSig E8; E8.gate = (bf16*)(ws + WS_GATE);
              pg8::gemm_phase<pg8::EpiGateSig, pg8::StaticOrder, true, true>(ring, g8, S8, E8); }
#endif
            pg8::Gemm g{(const bf16*)(ws + WS_XN), (const bf16*)(ws + WS_WIN), D, D, D}; pg8::StaticOrder S; S.init(T, F8_GATES ? 2304 : NPROJ, F.G, (int)blockIdx.x, D, D);
            pg8::EpiInProj E; E.ua = (bf16*)(ws + WS_UA); E.qkv = (bf16*)(ws + WS_QKV); E.uc = (bf16*)(ws + WS_UC); E.gate = (bf16*)(ws + WS_GATE);
            { LAS float* gl = (LAS float*)(F.lds + GAIN_OFF);
              if (F.tid < 256) { const int w = F.tid >> 6, d = F.tid & 63; const float* src = (w == 0) ? args.in[I_FQG] : (w == 1) ? args.in[I_FKG] : (w == 2) ? args.in[I_SQG] : args.in[I_SKG];
                  gl[F.tid] = src[layer * 64 + d] * ((w == 0 || w == 2) ? QSCALE : 1.0f); }
              __syncthreads(); E.gl = gl; }
            pg8::gemm_phase<pg8::EpiInProj, pg8::StaticOrder, true>(ring, g, S, E);
        }
        SEAM(1);
#endif
#if ON(2)
        if (IN(2)) for (int rep_ = 0; rep_ < REPS(2); ++rep_) { ENTER();
            { pg8::Gemm g{(const bf16*)(ws + WS_UA), (const bf16*)(ws + WS_WZ), 1024, S5_LDA, 1024};
              pg8::BatchOrder S; S.nM = 2; S.nN = 1; S.nZ = 16; S.G = F.G; S.c = (int)blockIdx.x; S.tA = (size_t)256 * S5_LDA * 2; S.tB = 0; S.zA = (size_t)512 * S5_LDA * 2; S.zB = (size_t)256 * 1024 * 2;
              pg8::EpiZ E; E.z = (float*)(ws + WS_Z);
              pg8::gemm_phase<pg8::EpiZ, pg8::BatchOrder, false>(ring, g, S, E);
              if ((int)blockIdx.x < 32) phase_s5_scan_unit(F, layer, (int)blockIdx.x >> 1, (int)blockIdx.x & 1); }
            phase_conv(F, layer);
            phase_attn_sb(F, layer, rep_);
        }
        SEAM(2);
#endif
#if ON(4)
        if (IN(4)) for (int rep_ = 0; rep_ < REPS(4); ++rep_) { ENTER();
            { pg8::Gemm g{(const bf16*)(ws + WS_UA), (const bf16*)(ws + WS_WY), S5_LDA, S5_LDA, S5_LDA};
              pg8::BatchOrder S; S.nM = 2; S.nN = 4; S.nZ = 16; S.G = F.G; S.c = (int)blockIdx.x; S.tA = (size_t)256 * S5_LDA * 2; S.tB = (size_t)256 * S5_LDA * 2; S.zA = (size_t)512 * S5_LDA * 2; S.zB = (size_t)1024 * S5_LDA * 2;
              pg8::EpiY E; E.ua = (const bf16*)(ws + WS_UA); E.dskip = args.in[I_S5D] + layer * 256; E.yp = (bf16*)(ws + WS_YP);
              pg8::gemm_phase<pg8::EpiY, pg8::BatchOrder, false>(ring, g, S, E); }
            phase_attn_fox(F, layer, rep_);
        }
        SEAM(4);
#endif
#if ON(5)
        if (IN(5) && F.G != 256) for (int rep_ = 0; rep_ < REPS(5); ++rep_) { ENTER();
            pg8::Gemm g{(const bf16*)(ws + WS_YP), (const bf16*)(ws + WS_WGLU), 256, 256, 256};
            pg8::BatchOrder S; S.nM = T / 256; S.nN = 1; S.nZ = 1; S.G = F.G; S.c = (int)blockIdx.x; S.tA = (size_t)256 * 256 * 2; S.tB = 0; S.zA = 0; S.zB = 0;
            pg8::EpiGlu E; E.yp = (const bf16*)(ws + WS_YP); E.ycat = (bf16*)(ws + WS_YCAT);
            pg8::gemm_phase<pg8::EpiGlu, pg8::BatchOrder, false>(ring, g, S, E);
        }
        if (F.G != 256) SEAM(5);
#endif
#if ON(6)
        if (IN(6)) for (int rep_ = 0; rep_ < REPS(6); ++rep_) { ENTER();
            const int paired = (F.G == 256) ? 1 : 0;
            if (paired) {
                pg8::Gemm g{(const bf16*)(ws + WS_YP), (const bf16*)(ws + WS_WGLU), 256, 256, 256};
                pg8::OneUnit S; S.pm = F.vcu >> 1; S.tA = (size_t)256 * 256 * 2;
                pg8::EpiGlu E; E.yp = (const bf16*)(ws + WS_YP); E.ycat = (bf16*)(ws + WS_YCAT);
                pg8::gemm_phase<pg8::EpiGlu, pg8::OneUnit, false>(ring, g, S, E);
            }
            pg8::Gemm g{(const bf16*)(ws + WS_YCAT), (const bf16*)(ws + WS_WBR), 256, 1024, 256};
            pg8::BranchOrder1 S; S.nM = T / 256; S.nN = 8; S.G = F.G; S.c = (int)blockIdx.x; S.tA = (size_t)256 * 1024 * 2; S.tB = (size_t)128 * 256 * 2; S.zA = 256 * 2; S.zB = (size_t)1024 * 256 * 2; S.paired = paired; S.vc = F.vcu;
            pg8::EpiGate1 E; E.gate = (const bf16*)(ws + WS_GATE); E.mb = (bf16*)(ws + WS_XN);
            pg8::gemm_phase_n1<pg8::EpiGate1, pg8::BranchOrder1>(ring, g, S, E);
        }
        SEAM(6);
#endif
#if ON(7)
        if (IN(7)) for (int rep_ = 0; rep_ < REPS(7); ++rep_) { ENTER();
            pg8::Gemm g{(const bf16*)(ws + WS_XN), (const bf16*)(ws + WS_WOUT), D, D, D}; pg8::StaticOrder S; S.init(T, D, F.G, (int)blockIdx.x, D, D);
            pg8::EpiResid<false> E; E.base32 = args.in[I_X]; E.base16 = (const bf16*)(ws + WS_XB); E.out = (bf16*)(ws + WS_XB); E.ss = (float*)(ws + WS_SSP); E.out8 = ws + WS_XN8;
            E.flags = ((layer == 0) ? 1 : 0) | ((FUSE_DENSE_NORM && !moe) ? 2 : 0) | ((FUSE_DENSE_NORM && !moe && DENSE8(layer)) ? 4 : 0);
            pg8::gemm_phase<pg8::EpiResid<false>, pg8::StaticOrder, true>(ring, g, S, E);
        }
        SEAM(7);
#endif
#if ON(8)
        if (IN(8)) for (int rep_ = 0; rep_ < REPS(8); ++rep_) { ENTER(); if (moe || !FUSE_DENSE_NORM) phase_rows_ffn(F, layer); }
        if (moe || !FUSE_DENSE_NORM) SEAM(8);
#endif
#if ON(10)
        if (IN(10)) for (int rep_ = 0; rep_ < REPS(10); ++rep_) { ENTER();
            if (!moe) {
                if (DENSE8(layer)) {
                    constexpr int DQ = D / 2;
                    pg8::Gemm g{(const bf16*)(ws + (FUSE_DENSE_NORM ? WS_XN8 : WS_XN)), (const bf16*)(ws + WS_WUP), DQ, DQ, DQ}; pg8::StaticOrder S; S.init(T, 2 * FF, F.G, (int)blockIdx.x, DQ, DQ);
                    pg8::EpiSwiGlu<true> E; E.h = (bf16*)(ws + WS_HH); E.sc = 1.0f / 64.0f; E.ss = (const float*)(ws + WS_SSP); E.use_ss = FUSE_DENSE_NORM;
                    pg8::gemm_phase<pg8::EpiSwiGlu<true>, pg8::StaticOrder, true, true>(ring, g, S, E);
                } else {
                    pg8::Gemm g{(const bf16*)(ws + (FUSE_DENSE_NORM ? WS_XB : WS_XN)), (const bf16*)(ws + WS_WUP), D, D, D}; pg8::StaticOrder S; S.init(T, 2 * FF, F.G, (int)blockIdx.x, D, D);
                    pg8::EpiSwiGlu<false> E; E.h = (bf16*)(ws + WS_HH); E.sc = 1.0f; E.ss = (const float*)(ws + WS_SSP); E.use_ss = FUSE_DENSE_NORM;
                    pg8::gemm_phase<pg8::EpiSwiGlu<false>, pg8::StaticOrder, true, false>(ring, g, S, E);
                }
            } else {
                constexpr bool U8 = F8_MOE_UP != 0, H8 = F8_MOE_DN != 0; constexpr int DQ = U8 ? D / 2 : D;
                pg8::Gemm g{(const bf16*)(ws + WS_XNP), (const bf16*)(ws + WS_WUP), DQ, DQ, DQ};
                pg8::GroupOrder S; S.nN = 22; S.G = F.G; S.c = (int)blockIdx.x; S.tA = (size_t)256 * DQ * 2; S.tB = (size_t)256 * DQ * 2; S.zB = (size_t)5632 * DQ * 2; S.zA = (size_t)T * DQ * 2;
                int st[NE + 1]; moe_starts(F, layer >> 1, st);
#pragma unroll
                for (int e = 0; e <= NE; ++e) S.ts[e] = __builtin_amdgcn_readfirstlane(st[e] >> 8);
                pg8::EpiSwiGlu<H8> E; E.h = (bf16*)(ws + WS_HP); E.sc = U8 ? (1.0f / 64.0f) : 1.0f; E.ss = (const float*)(ws + WS_SSP); E.use_ss = 0;
                pg8::gemm_phase<pg8::EpiSwiGlu<H8>, pg8::GroupOrder, true, U8>(ring, g, S, E);
            }
        }
        SEAM(10);
#endif
#if ON(11)
        if (IN(11)) for (int rep_ = 0; rep_ < REPS(11); ++rep_) { ENTER();
            if (!moe) {
                if (DENSE8(layer)) {
                    constexpr int FQ = FF / 2;
                    pg8::Gemm g{(const bf16*)(ws + WS_HH), (const bf16*)(ws + WS_WDN), FQ, FQ, FQ}; pg8::StaticOrder S; S.init(T, D, F.G, (int)blockIdx.x, FQ, FQ);
                    pg8::EpiResid<true> E; E.base32 = args.in[I_X]; E.base16 = (const bf16*)(ws + WS_XB); E.out = (bf16*)(ws + WS_XB); E.ss = (float*)(ws + WS_SSP); E.out8 = ws + WS_XN8; E.flags = 0;
                    pg8::gemm_phase<pg8::EpiResid<true>, pg8::StaticOrder, true, true>(ring, g, S, E);
                } else {
                    pg8::Gemm g{(const bf16*)(ws + WS_HH), (const bf16*)(ws + WS_WDN), FF, FF, FF}; pg8::StaticOrder S; S.init(T, D, F.G, (int)blockIdx.x, FF, FF);
                    pg8::EpiResid<false> E; E.base32 = args.in[I_X]; E.base16 = (const bf16*)(ws + WS_XB); E.out = (bf16*)(ws + WS_XB); E.ss = (float*)(ws + WS_SSP); E.out8 = ws + WS_XN8; E.flags = 0;
                    pg8::gemm_phase<pg8::EpiResid<false>, pg8::StaticOrder, true, false>(ring, g, S, E);
                }
            } else {
                constexpr bool F8 = F8_MOE_DN != 0; constexpr int FQ = F8 ? FF / 2 : FF;
                pg8::Gemm g{(const bf16*)(ws + WS_HP), (const bf16*)(ws + WS_WDN), FQ, FQ, FQ};
                pg8::GroupOrder S; S.nN = 4; S.G = F.G; S.c = (int)blockIdx.x; S.tA = (size_t)256 * FQ * 2; S.tB = (size_t)256 * FQ * 2; S.zB = (size_t)D * FQ * 2; S.zA = 0;
                int st[NE + 1]; moe_starts(F, layer >> 1, st);
#pragma unroll
                for (int e = 0; e <= NE; ++e) S.ts[e] = __builtin_amdgcn_readfirstlane(st[e] >> 8);
                pg8::EpiStore E; E.o = (bf16*)(ws + WS_XNP); E.sc = F8 ? (1.0f / 64.0f) : 1.0f;
                pg8::gemm_phase<pg8::EpiStore, pg8::GroupOrder, true, F8>(ring, g, S, E);
            }
        }
        SEAM(11);
#endif
    }
#if ON(12)
    if (gp_lo <= GP_FINAL && GP_FINAL < gp_hi) phase_final_combine(F);
#endif
}

extern "C" void kernel_launch(void* const* d_in, const int* in_sizes, int n_in, void* d_out, int out_size, void* d_ws, size_t ws_size, hipStream_t stream) {
    static int grid = 0;
    if (grid == 0) {
        if (n_in != 32 || in_sizes[0] != T * D || out_size != T * D || ws_size < WS_END) { fprintf(stderr, "kernel_launch: unexpected shapes / workspace (n_in %d, ws %zu < %zu)\n", n_in, ws_size, (size_t)WS_END); grid = -1; return; }
        int dev = 0, cus = 0, per_cu = 0;
        if (hipGetDevice(&dev) != hipSuccess || hipDeviceGetAttribute(&cus, hipDeviceAttributeMultiprocessorCount, dev) != hipSuccess) { grid = -1; return; }
        if (hipFuncSetAttribute((const void*)mk_fwd, hipFuncAttributeMaxDynamicSharedMemorySize, LDS_BYTES) != hipSuccess) { grid = -1; return; }
        if (hipOccupancyMaxActiveBlocksPerMultiprocessor(&per_cu, (const void*)mk_fwd, NWAVES * 64, LDS_BYTES) != hipSuccess || per_cu < 1) fprintf(stderr, "kernel_launch: occupancy query says %d\n", per_cu);
        (void)hipGetLastError();
        grid = cus;
    }
    if (grid < 0) return;
    if (hipMemsetAsync((char*)d_ws + WS_CTL, 0, CTL_ZERO_BYTES, stream) != hipSuccess) return;
    Args a{};
    for (int i = 0; i < 32; ++i) a.in[i] = (const float*)d_in[i];
    a.out = (float*)d_out; a.ws = (unsigned char*)d_ws;
    a.gp_lo = 0; a.gp_hi = GP_TOTAL;
    hipLaunchKernelGGL(mk_fwd, dim3(grid), dim3(NWAVES * 64), LDS_BYTES, stream, a);
}
```

```cpp
#include <hip/hip_runtime.h>
#include <cstdio>
#include <cstdint>

#ifndef F8_DENSE_MASK
#define F8_DENSE_MASK 4
#endif
#define DENSE8(layer) (((F8_DENSE_MASK) >> (layer)) & 1)
#ifndef F8_MOE_UP
#define F8_MOE_UP 1
#endif
#ifndef FUSE_DENSE_NORM
#define FUSE_DENSE_NORM 1
#endif
#ifndef GATE8
#define GATE8 2
#endif
#ifndef BR_WG
#define BR_WG 4
#endif
#ifndef F8_GATES
#define F8_GATES 1
#endif
#ifndef F8_MOE_DN
#define F8_MOE_DN 1
#endif

#define GAS __attribute__((address_space(1)))
#define LAS __attribute__((address_space(3)))
typedef unsigned short bf16;
typedef unsigned v4u __attribute__((ext_vector_type(4)));
typedef unsigned v2u __attribute__((ext_vector_type(2)));
typedef float f32x4 __attribute__((ext_vector_type(4)));
typedef float f32x2 __attribute__((ext_vector_type(2)));
typedef short bf16x8 __attribute__((ext_vector_type(8)));

constexpr int NB = 8, SEQ = 4096, D = 1024, DEPTH = 4, T = NB * SEQ;
constexpr int DP = 6404, NPROJ = 6400, FF = 2816, NE = 8;
constexpr float EPS = 1e-6f, LOG2E = 1.4426950408889634f;
constexpr float QSCALE = 0.125f * LOG2E;
constexpr int MOE_ROWS = 2 * T + NE * 256;
constexpr int S5_LDA = 1152;

constexpr size_t MiB = 1u << 20;
constexpr size_t WS_CTL = 0, CTL_ZERO_BYTES = 1 * MiB;
constexpr size_t WS_WIN = 1 * MiB;
constexpr size_t WS_WIN8 = WS_WIN + (size_t)2304 * D * 2;
constexpr size_t WS_WBR = WS_WIN + (size_t)NPROJ * D * 2;
constexpr size_t WS_WOUT = WS_WBR + 2 * MiB;
constexpr size_t WS_WGLU = WS_WOUT + 2 * MiB;
constexpr size_t WS_WZ = WS_WGLU + 128 * 1024;
constexpr size_t WS_WY = WS_WZ + 8 * MiB;
constexpr size_t WS_WUP = WS_WY + 36 * MiB;
constexpr size_t WS_WDN = WS_WUP + 88 * MiB;
constexpr size_t WS_KFUN = WS_WDN + 44 * MiB;
constexpr size_t WS_ROUTE = WS_KFUN + 1 * MiB;
constexpr size_t WS_LF = WS_ROUTE + 1 * MiB;
constexpr size_t WS_CUM = WS_LF + 512 * 1024;
constexpr size_t WS_XN = 198 * MiB;
static_assert(WS_CUM + 512 * 1024 <= WS_XN, "ws map");
constexpr size_t WS_R = WS_XN + 64 * MiB;
constexpr size_t WS_GATE = WS_R;
constexpr size_t WS_QKV = WS_GATE + 256 * MiB;
constexpr size_t WS_UC = WS_QKV + 96 * MiB;
constexpr size_t WS_UA = WS_UC + 16 * MiB;
constexpr size_t WS_Z = WS_UA + 18 * MiB;
constexpr size_t WS_YP = WS_Z + 4 * MiB;
constexpr size_t WS_YCAT = WS_YP + 16 * MiB;
constexpr size_t WS_MIX_END = WS_YCAT + 64 * MiB;
constexpr size_t WS_XN8 = WS_YCAT;
constexpr size_t WS_HH = WS_R;
constexpr size_t WS_XNP = WS_R;
constexpr size_t WS_HP = WS_XNP + (size_t)NE * T * D;
constexpr size_t WS_FFN_END = WS_HP + (size_t)MOE_ROWS * FF;
static_assert(F8_MOE_UP && F8_MOE_DN, "the MoE path stores its rows and hidden activations as e4m3 bytes");
constexpr size_t WS_XB = ((WS_MIX_END > WS_FFN_END ? WS_MIX_END : WS_FFN_END) + MiB - 1) / MiB * MiB;
constexpr size_t WS_SSP = WS_XB + 64 * MiB;
constexpr size_t WS_END = WS_SSP + 2 * MiB;
static_assert(WS_END <= 856 * MiB, "ws budget");
constexpr int CW_BAR = 4096;
constexpr int CW_Q = 20480;
constexpr int CW_MOE = 16384;

constexpr int RING_BYTES = 131072, MISC_OFF = RING_BYTES + 320, GAIN_OFF = RING_BYTES + 1024, QSLOT_OFF = RING_BYTES + 64, LDS_BYTES = 147456;
constexpr int NWAVES = 8;

__device__ __forceinline__ unsigned f2bf(float f) { unsigned u = __builtin_bit_cast(unsigned, f); return (u + 0x7fffu + ((u >> 16) & 1u)) >> 16; }
__device__ __forceinline__ unsigned pk2(float lo, float hi) { return f2bf(lo) | (f2bf(hi) << 16); }
__device__ __forceinline__ float bflo(unsigned u) { return __builtin_bit_cast(float, u << 16); }
__device__ __forceinline__ float bfhi(unsigned u) { return __builtin_bit_cast(float, u & 0xffff0000u); }
__device__ __forceinline__ float bf2f(bf16 v) { return __builtin_bit_cast(float, (unsigned)v << 16); }
__device__ __forceinline__ float wave_sum(float v) {
#pragma unroll
    for (int o = 1; o < 64; o <<= 1) v += __shfl_xor(v, o);
    return v;
}
__device__ __forceinline__ float fast_exp2(float x) { return __builtin_amdgcn_exp2f(x); }
__device__ __forceinline__ float fast_rcp(float x) { return __builtin_amdgcn_rcpf(x); }
__device__ __forceinline__ float sigmoidf_(float x) { return fast_rcp(1.0f + fast_exp2(-x * LOG2E)); }
__device__ __forceinline__ f32x2 sigmoid2(f32x2 x) { const f32x2 a = x * (-LOG2E); f32x2 t = {fast_exp2(a[0]), fast_exp2(a[1])}; t = t + 1.0f; return (f32x2){fast_rcp(t[0]), fast_rcp(t[1])}; }
__device__ __forceinline__ float gelu_tanh(float y) { const float u = 0.7978845608028654f * (y + 0.044715f * y * y * y); return y * sigmoidf_(2.0f * u); }
__device__ __forceinline__ unsigned pk4_fp8(float a, float b, float c, float d) { unsigned w = 0u; w = (unsigned)__builtin_amdgcn_cvt_pk_fp8_f32(a, b, (int)w, false); w = (unsigned)__builtin_amdgcn_cvt_pk_fp8_f32(c, d, (int)w, true); return w; }
#define LDS_WAIT() asm volatile("s_waitcnt lgkmcnt(0)" ::: "memory")
#define VM_WAIT() asm volatile("s_waitcnt vmcnt(0)" ::: "memory")

namespace pg8 {
#define PG8_LAS __attribute__((address_space(3)))
typedef unsigned short bf16_t;
typedef unsigned u32x4 __attribute__((ext_vector_type(4)));
typedef int v4i __attribute__((ext_vector_type(4)));
typedef int v8i __attribute__((ext_vector_type(8)));
constexpr int BM = 256, BK = 64, HALF = 128, HTB = HALF * BK * 2, STAGE_BYTES = 8 * HTB, NXCD = 8, WGM = 8;
__host__ __device__ __forceinline__ int lds_byte(int r, int c) { const int st = (r >> 4) * 2 + (c >> 5), rr = r & 15, cc = c & 31, ob = rr * 64 + cc * 2; return st * 1024 + (ob ^ (((ob >> 9) & 1) << 5)); }
__host__ __device__ __forceinline__ void stage_rc(int b, int& R, int& C) { const int st = b / 1024, sb = b % 1024, swz = sb ^ (((sb >> 9) & 1) << 5); R = (st >> 1) * 16 + swz / 64; C = (st & 1) * 32 + (swz % 64) / 2; }
__host__ __device__ __forceinline__ int perm32(int rho) { const int n = rho >> 4, i = rho & 15; return 8 * (i >> 2) + 4 * n + (i & 3); }

struct Unit { int pm, pn, z; size_t offA, offB; };
struct Gemm { const bf16_t* A; const bf16_t* Bt; int K, lda, ldb; };

template <int WG = WGM> __device__ __forceinline__ void xcd_tile_map(int L, int nM, int nN, int& pm, int& pn) {
    const int nwg = nM * nN; int wgid = L; { const int q = nwg / NXCD, r = nwg % NXCD, xcd = wgid % NXCD, off = wgid / NXCD; wgid = (xcd < r ? xcd * (q + 1) : r * (q + 1) + (xcd - r) * q) + off; }
    const int nig = WG * nN, gid = wgid / nig, fm = gid * WG, gsz = (nM - fm) < WG ? (nM - fm) : WG;
    pm = fm + ((wgid % nig) % gsz); pn = (wgid % nig) / gsz;
}
struct StaticOrder {
    int nM, nN, nwg, G, c; size_t tA, tB;
    __device__ void init(int M, int N, int G_, int c_, int lda, int ldb) { nM = M / BM; nN = N / BM; nwg = nM * nN; G = G_; c = c_; tA = (size_t)BM * lda * 2; tB = (size_t)BM * ldb * 2; }
    __device__ bool next(int i, Unit& u) const {
        const long L = (long)i * G + c; if (L >= nwg) return false;
        int wgid = (int)L; { const int q = nwg / NXCD, r = nwg % NXCD, xcd = wgid % NXCD, off = wgid / NXCD; wgid = (xcd < r ? xcd * (q + 1) : r * (q + 1) + (xcd - r) * q) + off; }
        const int nig = WGM * nN, gid = wgid / nig, fm = gid * WGM, gsz = (nM - fm) < WGM ? (nM - fm) : WGM;
        u.pm = fm + ((wgid % nig) % gsz); u.pn = (wgid % nig) / gsz; u.z = 0; u.offA = (size_t)u.pm * tA; u.offB = (size_t)u.pn * tB; return true;
    }
};
struct BatchOrder {
    int nM, nN, nZ, G, c; size_t tA, tB, zA, zB;
    __device__ bool next(int i, Unit& u) const {
        const int L = i * G + c; if (L >= nM * nN * nZ) return false;
        u.z = L / (nM * nN); const int r = L % (nM * nN); u.pm = r / nN; u.pn = r % nN;
        u.offA = (size_t)u.z * zA + (size_t)u.pm * tA; u.offB = (size_t)u.z * zB + (size_t)u.pn * tB; return true;
    }
};
struct GroupOrder {
    int nN, G, c; int ts[NE + 1]; size_t tA, tB, zB, zA;
    __device__ bool next(int i, Unit& u) const {
        const int L = i * G + c; if (L >= ts[NE] * nN) return false;
        xcd_tile_map(L, ts[NE], nN, u.pm, u.pn); int e = 0, tse = 0;
#pragma unroll
        for (int k = 1; k < NE; ++k) if (u.pm >= ts[k]) { e = k; tse = ts[k]; }
        u.z = e; u.offA = zA ? (size_t)e * zA + (size_t)(u.pm - tse) * tA : (size_t)u.pm * tA; u.offB = (size_t)e * zB + (size_t)u.pn * tB; return true;
    }
};

typedef __bf16 bf16x2_t __attribute__((ext_vector_type(2)));
__device__ __forceinline__ unsigned cvt_pk_bf16(float lo, float hi) { const f32x2 v = {lo, hi}; const bf16x2_t b = __builtin_convertvector(v, bf16x2_t); return __builtin_bit_cast(unsigned, b); }

__device__ __forceinline__ u32x4 pack8(const f32x4 a, const f32x4 b) { u32x4 w; w.x = cvt_pk_bf16(a[0], a[1]); w.y = cvt_pk_bf16(a[2], a[3]); w.z = cvt_pk_bf16(b[0], b[1]); w.w = cvt_pk_bf16(b[2], b[3]); return w; }
template <class Epi, class Sched, bool ALIGN_EPI, bool FP8 = false>
__device__ __forceinline__ void gemm_phase(PG8_LAS unsigned char* lds, const Gemm g, const Sched& S, const Epi& E) {
    int tid = threadIdx.x; asm volatile("" : "+v"(tid));
    const int wid = __builtin_amdgcn_readfirstlane(tid >> 6), lane = tid & 63, wr = wid >> 2, wc = wid & 3, fr = lane & 15, fq = lane >> 4;
    int K = g.K; asm volatile("" : "+s"(K));
    const int nt = K / BK;
    unsigned voffA[2], voffB[2];
#pragma unroll
    for (int i = 0; i < 2; ++i) { int R, C; stage_rc(tid * 16 + i * 8192, R, C); const int Rb = Epi::PERM ? ((R & ~31) + perm32(R & 31)) : R;
        voffA[i] = (unsigned)(R * g.lda + C) * 2u; voffB[i] = (unsigned)(Rb * g.ldb + C) * 2u; }
    const size_t kstep = (size_t)(BK * 2);
    const size_t hstepA = (size_t)HALF * g.lda * 2, hstepB = (size_t)HALF * g.ldb * 2;
    const unsigned ldsw = (unsigned)wid * 1024u;
    const int aoff = lds_byte(wr * 64 + fr, fq * 8), boff = lds_byte(wc * 32 + fr, fq * 8);
#define PG8_SA(b, h) (((b) * 2 + (h)) * HTB)
#define PG8_SB(b, h) ((4 + (b) * 2 + (h)) * HTB)
#define PG8_STAGE(bufoff, gbase, voff) do { _Pragma("unroll") for (int _i = 0; _i < 2; ++_i) \
        __builtin_amdgcn_global_load_lds((const unsigned*)((const char*)(gbase) + (voff)[_i]), (PG8_LAS unsigned*)(lds + (bufoff) + ldsw + _i * 8192), 16, 0, 0); } while (0)
#define PG8_LDA(dst, b, h) do { _Pragma("unroll") for (int m = 0; m < 4; ++m) { if constexpr (FP8) dst##8[m] = __builtin_shufflevector(*(const PG8_LAS v4i*)(lds + PG8_SA(b, h) + aoff + m * 2048), *(const PG8_LAS v4i*)(lds + PG8_SA(b, h) + aoff + m * 2048 + 1024), 0, 1, 2, 3, 4, 5, 6, 7); \
        else { _Pragma("unroll") for (int k = 0; k < 2; ++k) dst[m][k] = *(const PG8_LAS bf16x8*)(lds + PG8_SA(b, h) + aoff + m * 2048 + k * 1024); } } } while (0)
#define PG8_LDB(dst, b, h) do { _Pragma("unroll") for (int n = 0; n < 2; ++n) { if constexpr (FP8) dst##8[n] = __builtin_shufflevector(*(const PG8_LAS v4i*)(lds + PG8_SB(b, h) + boff + n * 2048), *(const PG8_LAS v4i*)(lds + PG8_SB(b, h) + boff + n * 2048 + 1024), 0, 1, 2, 3, 4, 5, 6, 7); \
        else { _Pragma("unroll") for (int k = 0; k < 2; ++k) dst[n][k] = *(const PG8_LAS bf16x8*)(lds + PG8_SB(b, h) + boff + n * 2048 + k * 1024); } } } while (0)
#define PG8_MMA(ai, bj, At, Bt) do { __builtin_amdgcn_s_setprio(1); _Pragma("unroll") for (int m = 0; m < 4; ++m) _Pragma("unroll") for (int n = 0; n < 2; ++n) { \
        if constexpr (FP8) asm volatile("v_mfma_f32_16x16x128_f8f6f4 %0, %1, %2, %0" : "+v"(acc[ai][bj][m][n]) : "v"(Bt##8[n]), "v"(At##8[m])); \
        else { _Pragma("unroll") for (int k = 0; k < 2; ++k) acc[ai][bj][m][n] = __builtin_amdgcn_mfma_f32_16x16x32_bf16(Bt[n][k], At[m][k], acc[ai][bj][m][n], 0, 0, 0); } } \
        __builtin_amdgcn_s_setprio(0); } while (0)
#define PG8_WAIT_V(n) asm volatile("s_waitcnt vmcnt(" #n ")" ::: "memory")
#define PG8_WAIT_L(n) asm volatile("s_waitcnt lgkmcnt(" #n ")" ::: "memory")
#define PG8_BAR __builtin_amdgcn_s_barrier()
#define PG8_SCHED __builtin_amdgcn_sched_barrier(0)
    Unit cur, nxt; int ui = 0;
    if (!S.next(0, cur)) return;
    f32x4 acc[2][2][4][2];
#pragma unroll
    for (int a = 0; a < 2; ++a)
#pragma unroll
        for (int b = 0; b < 2; ++b)
#pragma unroll
            for (int m = 0; m < 4; ++m)
#pragma unroll
                for (int n = 0; n < 2; ++n) acc[a][b][m][n] = (f32x4){0.f, 0.f, 0.f, 0.f};
    bf16x8 At[4][2], B0[2][2], B1[2][2]; v8i At8[4], B08[2], B18[2];
    const char* cA = (const char*)g.A + cur.offA; const char* cB = (const char*)g.Bt + cur.offB;
    PG8_STAGE(PG8_SB(0, 0), cB, voffB); PG8_STAGE(PG8_SB(0, 1), cB + hstepB, voffB); PG8_STAGE(PG8_SA(0, 0), cA, voffA); PG8_STAGE(PG8_SA(0, 1), cA + hstepA, voffA);
    if (wr == 1) PG8_BAR;
    PG8_WAIT_V(2); PG8_BAR;
    PG8_STAGE(PG8_SB(1, 0), cB + kstep, voffB); PG8_STAGE(PG8_SA(1, 0), cA + kstep, voffA); PG8_STAGE(PG8_SB(1, 1), cB + hstepB + kstep, voffB);
    PG8_WAIT_V(6); PG8_BAR;
    for (;;) {
        const bool has_next = S.next(ui + 1, nxt);
        const char* nA = has_next ? (const char*)g.A + nxt.offA : cA; const char* nB = has_next ? (const char*)g.Bt + nxt.offB : cB;
        for (int t = 0; t < nt; t += 2) {
            const bool last = (t == nt - 2);
            const char* a1 = cA + (size_t)(t + 1) * kstep;
            const char* a2 = last ? nA : cA + (size_t)(t + 2) * kstep; const char* b2 = last ? nB : cB + (size_t)(t + 2) * kstep;
            const char* a3 = a2 + kstep; const char* b3 = b2 + kstep;
            PG8_LDB(B0, 0, 0); PG8_LDB(B1, 0, 1); PG8_SCHED; PG8_LDA(At, 0, 0); PG8_STAGE(PG8_SA(1, 1), a1 + hstepA, voffA);
            PG8_WAIT_V(8); PG8_WAIT_L(0); PG8_BAR; PG8_MMA(0, 0, At, B0); PG8_MMA(0, 1, At, B1); PG8_BAR; PG8_SCHED;
            PG8_LDA(At, 0, 1); PG8_STAGE(PG8_SB(0, 0), b2, voffB); PG8_STAGE(PG8_SB(0, 1), b2 + hstepB, voffB); PG8_STAGE(PG8_SA(0, 0), a2, voffA);
            PG8_WAIT_V(8); PG8_WAIT_L(0); PG8_BAR; PG8_MMA(1, 0, At, B0); PG8_MMA(1, 1, At, B1); PG8_BAR; PG8_SCHED;
            PG8_LDB(B0, 1, 0); PG8_LDB(B1, 1, 1); PG8_SCHED; PG8_LDA(At, 1, 0); PG8_STAGE(PG8_SA(0, 1), a2 + hstepA, voffA);
            PG8_WAIT_V(8); PG8_WAIT_L(0); PG8_BAR; PG8_MMA(0, 0, At, B0); PG8_MMA(0, 1, At, B1); PG8_BAR; PG8_SCHED;
            PG8_LDA(At, 1, 1); PG8_STAGE(PG8_SB(1, 0), b3, voffB); PG8_STAGE(PG8_SB(1, 1), b3 + hstepB, voffB); PG8_STAGE(PG8_SA(1, 0), a3, voffA);
            PG8_WAIT_V(8); PG8_WAIT_L(0); PG8_BAR; PG8_MMA(1, 0, At, B0); PG8_MMA(1, 1, At, B1); PG8_BAR; PG8_SCHED;
        }
        if constexpr (ALIGN_EPI) { if (wr == 0) PG8_BAR; }
        if constexpr (FP8) asm volatile("s_nop 15\n\ts_nop 15" ::: "memory");
        E(acc, cur, wr, wc, fr, fq);
        if (!has_next) break;
#pragma unroll
        for (int a = 0; a < 2; ++a)
#pragma unroll
            for (int b = 0; b < 2; ++b)
#pragma unroll
                for (int m = 0; m < 4; ++m)
#pragma unroll
                    for (int n = 0; n < 2; ++n) acc[a][b][m][n] = (f32x4){0.f, 0.f, 0.f, 0.f};
        cur = nxt; cA = nA; cB = nB; ++ui;
        if constexpr (ALIGN_EPI) { if (wr == 1) PG8_BAR; }
    }
    PG8_WAIT_V(0);
    if constexpr (!ALIGN_EPI) { if (wr == 0) PG8_BAR; }
    PG8_BAR;
#undef PG8_SA
#undef PG8_SB
#undef PG8_STAGE
#undef PG8_LDA
#undef PG8_LDB
#undef PG8_MMA
#undef PG8_WAIT_V
#undef PG8_WAIT_L
#undef PG8_BAR
#undef PG8_SCHED
}


template <class Epi, class Sched>
__device__ __forceinline__ void gemm_phase_n1(PG8_LAS unsigned char* lds, const Gemm g, const Sched& S, const Epi& E) {
    int tid = threadIdx.x; asm volatile("" : "+v"(tid));
    const int wid = __builtin_amdgcn_readfirstlane(tid >> 6), lane = tid & 63, wr = wid >> 2, wc = wid & 3, fr = lane & 15, fq = lane >> 4;
    int K = g.K; asm volatile("" : "+s"(K));
    const int nt = K / BK;
    unsigned voffA[2], voffB[2];
#pragma unroll
    for (int i = 0; i < 2; ++i) { int R, C; stage_rc(tid * 16 + i * 8192, R, C); const int Rb = Epi::PERM ? ((R & ~31) + perm32(R & 31)) : R;
        voffA[i] = (unsigned)(R * g.lda + C) * 2u; voffB[i] = (unsigned)(Rb * g.ldb + C) * 2u; }
    const size_t kstep = (size_t)(BK * 2);
    const size_t hstepA = (size_t)HALF * g.lda * 2;
    const unsigned ldsw = (unsigned)wid * 1024u;
    const int aoff = lds_byte(wr * 64 + fr, fq * 8), boff = lds_byte(wc * 32 + fr, fq * 8);
#define PG8_SA(b, h) (((b) * 2 + (h)) * HTB)
#define PG8_SB(b, h) ((4 + (b) * 2 + (h)) * HTB)
#define PG8_STAGE(bufoff, gbase, voff) do { _Pragma("unroll") for (int _i = 0; _i < 2; ++_i) \
        __builtin_amdgcn_global_load_lds((const unsigned*)((const char*)(gbase) + (voff)[_i]), (PG8_LAS unsigned*)(lds + (bufoff) + ldsw + _i * 8192), 16, 0, 0); } while (0)
#define PG8_LDA(dst, b, h) do { _Pragma("unroll") for (int m = 0; m < 4; ++m) _Pragma("unroll") for (int k = 0; k < 2; ++k) dst[m][k] = *(const PG8_LAS bf16x8*)(lds + PG8_SA(b, h) + aoff + m * 2048 + k * 1024); } while (0)
#define PG8_LDB(dst, b, h) do { _Pragma("unroll") for (int n = 0; n < 2; ++n) _Pragma("unroll") for (int k = 0; k < 2; ++k) dst[n][k] = *(const PG8_LAS bf16x8*)(lds + PG8_SB(b, h) + boff + n * 2048 + k * 1024); } while (0)
#define PG8_MMA1(ai, At, Bt) do { __builtin_amdgcn_s_setprio(1); _Pragma("unroll") for (int m = 0; m < 4; ++m) _Pragma("unroll") for (int n = 0; n < 2; ++n) _Pragma("unroll") for (int k = 0; k < 2; ++k) \
        acc[ai][m][n] = __builtin_amdgcn_mfma_f32_16x16x32_bf16(Bt[n][k], At[m][k], acc[ai][m][n], 0, 0, 0); __builtin_amdgcn_s_setprio(0); } while (0)
#define PG8_WAIT_V(n) asm volatile("s_waitcnt vmcnt(" #n ")" ::: "memory")
#define PG8_WAIT_L(n) asm volatile("s_waitcnt lgkmcnt(" #n ")" ::: "memory")
#define PG8_BAR __builtin_amdgcn_s_barrier()
#define PG8_SCHED __builtin_amdgcn_sched_barrier(0)
    Unit cur, nxt; int ui = 0;
    if (!S.next(0, cur)) return;
    f32x4 acc[2][4][2], st[2][4][2];
#pragma unroll
    for (int a = 0; a < 2; ++a)
#pragma unroll
        for (int m = 0; m < 4; ++m)
#pragma unroll
            for (int n = 0; n < 2; ++n) { acc[a][m][n] = (f32x4){0.f, 0.f, 0.f, 0.f}; st[a][m][n] = (f32x4){0.f, 0.f, 0.f, 0.f}; }
    bf16x8 At[4][2], B0[2][2];
    const char* cA = (const char*)g.A + cur.offA; const char* cB = (const char*)g.Bt + cur.offB;
    PG8_STAGE(PG8_SB(0, 0), cB, voffB); PG8_STAGE(PG8_SA(0, 0), cA, voffA); PG8_STAGE(PG8_SA(0, 1), cA + hstepA, voffA);
    if (wr == 1) PG8_BAR;
    PG8_WAIT_V(2); PG8_BAR;
    PG8_STAGE(PG8_SB(1, 0), cB + kstep, voffB); PG8_STAGE(PG8_SA(1, 0), cA + kstep, voffA);
    PG8_WAIT_V(4); PG8_BAR;
    for (;;) {
        const bool has_next = S.next(ui + 1, nxt);
        const char* nA = has_next ? (const char*)g.A + nxt.offA : cA; const char* nB = has_next ? (const char*)g.Bt + nxt.offB : cB;
        for (int t = 0; t < nt; t += 2) {
            const bool last = (t == nt - 2);
            const char* a1 = cA + (size_t)(t + 1) * kstep;
            const char* a2 = last ? nA : cA + (size_t)(t + 2) * kstep; const char* b2 = last ? nB : cB + (size_t)(t + 2) * kstep;
            const char* a3 = a2 + kstep; const char* b3 = b2 + kstep;
            PG8_LDB(B0, 0, 0); PG8_SCHED; PG8_LDA(At, 0, 0); PG8_STAGE(PG8_SA(1, 1), a1 + hstepA, voffA);
            PG8_WAIT_V(6); PG8_WAIT_L(0); PG8_BAR; PG8_MMA1(0, At, B0); PG8_BAR; PG8_SCHED;
            PG8_LDA(At, 0, 1); PG8_STAGE(PG8_SB(0, 0), b2, voffB); PG8_STAGE(PG8_SA(0, 0), a2, voffA);
            PG8_WAIT_V(6); PG8_WAIT_L(0); PG8_BAR; PG8_MMA1(1, At, B0); PG8_BAR; PG8_SCHED;
            PG8_LDB(B0, 1, 0); PG8_SCHED; PG8_LDA(At, 1, 0); PG8_STAGE(PG8_SA(0, 1), a2 + hstepA, voffA);
            PG8_WAIT_V(6); PG8_WAIT_L(0); PG8_BAR; PG8_MMA1(0, At, B0); PG8_BAR; PG8_SCHED;
            PG8_LDA(At, 1, 1); PG8_STAGE(PG8_SB(1, 0), b3, voffB); PG8_STAGE(PG8_SA(1, 0), a3, voffA);
            PG8_WAIT_V(6); PG8_WAIT_L(0); PG8_BAR; PG8_MMA1(1, At, B0); PG8_BAR; PG8_SCHED;
        }
        if (wr == 0) PG8_BAR;
        E(acc, st, cur, wr, wc, fr, fq);
        if (!has_next) break;
#pragma unroll
        for (int a = 0; a < 2; ++a)
#pragma unroll
            for (int m = 0; m < 4; ++m)
#pragma unroll
                for (int n = 0; n < 2; ++n) acc[a][m][n] = (f32x4){0.f, 0.f, 0.f, 0.f};
        cur = nxt; cA = nA; cB = nB; ++ui;
        if (wr == 1) PG8_BAR;
    }
    PG8_WAIT_V(0);
    PG8_BAR;
#undef PG8_SA
#undef PG8_SB
#undef PG8_STAGE
#undef PG8_LDA
#undef PG8_LDB
#undef PG8_MMA1
#undef PG8_WAIT_V
#undef PG8_WAIT_L
#undef PG8_BAR
#undef PG8_SCHED
}
typedef f32x4 Acc1[2][4][2];
struct OneUnit { int pm; size_t tA;
    __device__ bool next(int i, Unit& u) const { if (i) return false; u.pm = pm; u.pn = 0; u.z = 0; u.offA = (size_t)pm * tA; u.offB = 0; return true; } };
struct BranchOrder1 {
    int nM, nN, G, c; size_t tA, tB, zA, zB; int paired, vc;
    __device__ bool next(int i, Unit& u) const {
        if (paired) { if (i >= 16) return false; u.z = i & 3; u.pm = vc >> 1; u.pn = 4 * (vc & 1) + (i >> 2);
            u.offA = (size_t)u.z * zA + (size_t)u.pm * tA; u.offB = (size_t)u.z * zB + (size_t)u.pn * tB; return true; }
        const int tile = (i >> 2) * G + c; if (tile >= nM * nN) return false;
        u.z = i & 3; xcd_tile_map<BR_WG>(tile, nM, nN, u.pm, u.pn);
        u.offA = (size_t)u.z * zA + (size_t)u.pm * tA; u.offB = (size_t)u.z * zB + (size_t)u.pn * tB; return true;
    }
};
struct EpiGate1 {
    static constexpr bool PERM = true;
    const bf16_t* gate; bf16_t* mb;
    __device__ __forceinline__ void operator()(const Acc1& acc, Acc1& st, const Unit& u, int wr, int wc, int fr, int fq) const {
        const int z = u.z; const int row0 = u.pm * BM + wr * 64 + fr, col = u.pn * HALF + wc * 32 + 8 * fq;
#pragma unroll
        for (int ai = 0; ai < 2; ++ai)
#pragma unroll
            for (int m = 0; m < 4; ++m) { const int row = row0 + ai * HALF + m * 16;
                f32x4 a = acc[ai][m][0], b = acc[ai][m][1];
                if (GATE8 == 2) { const v2u g8 = *(const v2u*)((const unsigned char*)gate + (size_t)row * 4096 + z * 1024 + col); const float k = 1.0f / 255.0f;
                    a[0] *= (float)(g8.x & 0xffu) * k; a[1] *= (float)((g8.x >> 8) & 0xffu) * k; a[2] *= (float)((g8.x >> 16) & 0xffu) * k; a[3] *= (float)(g8.x >> 24) * k;
                    b[0] *= (float)(g8.y & 0xffu) * k; b[1] *= (float)((g8.y >> 8) & 0xffu) * k; b[2] *= (float)((g8.y >> 16) & 0xffu) * k; b[3] *= (float)(g8.y >> 24) * k; }
                else if (GATE8 == 1) { const v2u g8 = *(const v2u*)((const unsigned char*)gate + (size_t)row * 4096 + z * 1024 + col);
                    const f32x2 g0 = __builtin_amdgcn_cvt_pk_f32_fp8((int)g8.x, false), g1 = __builtin_amdgcn_cvt_pk_f32_fp8((int)g8.x, true), g2 = __builtin_amdgcn_cvt_pk_f32_fp8((int)g8.y, false), g3 = __builtin_amdgcn_cvt_pk_f32_fp8((int)g8.y, true);
                    a[0] *= g0[0]; a[1] *= g0[1]; a[2] *= g1[0]; a[3] *= g1[1]; b[0] *= g2[0]; b[1] *= g2[1]; b[2] *= g3[0]; b[3] *= g3[1]; }
                else { const u32x4 gg = *(const u32x4*)(gate + (size_t)row * 4096 + z * 1024 + col);
                    a[0] *= bflo(gg.x); a[1] *= bfhi(gg.x); a[2] *= bflo(gg.y); a[3] *= bfhi(gg.y); b[0] *= bflo(gg.z); b[1] *= bfhi(gg.z); b[2] *= bflo(gg.w); b[3] *= bfhi(gg.w); }
                if (z == 0) { st[ai][m][0] = a; st[ai][m][1] = b; } else { st[ai][m][0] += a; st[ai][m][1] += b; }
                if (z == 3) *(u32x4*)(mb + (size_t)row * 1024 + col) = pack8(st[ai][m][0], st[ai][m][1]); }
    }
};
typedef f32x4 Acc[2][2][4][2];
#define EPI_ROWS_BEGIN const int row0 = u.pm * BM + wr * 64 + fr; _Pragma("unroll") for (int ai = 0; ai < 2; ++ai) _Pragma("unroll") for (int m = 0; m < 4; ++m) { const int row = row0 + ai * HALF + m * 16;
#define EPI_ROWS_END }

struct EpiInProj {
    static constexpr bool PERM = true;
    bf16_t *ua, *qkv, *uc, *gate; const PG8_LAS float* gl;
    __device__ __forceinline__ void operator()(const Acc& acc, const Unit& u, int wr, int wc, int fr, int fq) const {
        const int pn = u.pn;
        if (pn == 0) {
            EPI_ROWS_BEGIN
#pragma unroll
            for (int bj = 0; bj < 2; ++bj) { const int c8 = bj * HALF + wc * 32 + 8 * fq, gI = c8 >> 4, h0 = c8 & 15;
                *(u32x4*)(ua + ((size_t)(gI * 512 + (row >> 6)) * S5_LDA + (row & 63) * 16 + h0)) = pack8(acc[ai][bj][m][0], acc[ai][bj][m][1]); }
            EPI_ROWS_END
        } else if (pn == 1 || pn == 2 || pn == 6 || pn == 7) {
            const int which = (pn == 1) ? 0 : (pn == 2) ? 1 : (pn == 6) ? 2 : 3;
            const PG8_LAS float* gp = gl + which * 64;
            bf16_t* dst = qkv + (size_t)((pn < 6) ? (pn - 1) : (pn - 3)) * ((size_t)T * 256);
            f32x4 gv[2][2];
#pragma unroll
            for (int bj = 0; bj < 2; ++bj)
#pragma unroll
                for (int n = 0; n < 2; ++n) gv[bj][n] = *(const PG8_LAS f32x4*)(gp + bj * 32 + 8 * fq + 4 * n);
            EPI_ROWS_BEGIN
            float ss = 0.f;
#pragma unroll
            for (int bj = 0; bj < 2; ++bj)
#pragma unroll
                for (int n = 0; n < 2; ++n) { const f32x4 x = acc[ai][bj][m][n]; ss += (x[0] * x[0] + x[1] * x[1]) + (x[2] * x[2] + x[3] * x[3]); }
            ss += __shfl_xor(ss, 16); ss += __shfl_xor(ss, 32);
            const float rs = __builtin_amdgcn_rsqf(ss * (1.0f / 64.0f) + EPS);
#pragma unroll
            for (int bj = 0; bj < 2; ++bj)
                *(u32x4*)(dst + (size_t)row * 256 + wc * 64 + bj * 32 + 8 * fq) = pack8(acc[ai][bj][m][0] * rs * gv[bj][0], acc[ai][bj][m][1] * rs * gv[bj][1]);
            EPI_ROWS_END
        } else if (pn == 3 || pn == 8) {
            bf16_t* dst = qkv + (size_t)((pn == 3) ? 2 : 5) * ((size_t)T * 256);
            EPI_ROWS_BEGIN
#pragma unroll
            for (int bj = 0; bj < 2; ++bj) *(u32x4*)(dst + (size_t)row * 256 + bj * HALF + wc * 32 + 8 * fq) = pack8(acc[ai][bj][m][0], acc[ai][bj][m][1]);
            EPI_ROWS_END
        } else if (pn == 4 || pn == 5) {
            EPI_ROWS_BEGIN
            f32x4 o[2];
#pragma unroll
            for (int n = 0; n < 2; ++n)
#pragma unroll
                for (int e = 0; e < 4; ++e) o[n][e] = acc[ai][0][m][n][e] * sigmoidf_(acc[ai][1][m][n][e]);
            *(u32x4*)(uc + (size_t)row * 256 + (pn - 4) * 128 + wc * 32 + 8 * fq) = pack8(o[0], o[1]);
            EPI_ROWS_END
        } else {
            const int gt = pn - 9;
            EPI_ROWS_BEGIN
#pragma unroll
            for (int bj = 0; bj < 2; ++bj) { f32x4 o[2];
#pragma unroll
                for (int n = 0; n < 2; ++n)
#pragma unroll
                    for (int e = 0; e < 4; ++e) o[n][e] = sigmoidf_(acc[ai][bj][m][n][e]);
                *(u32x4*)(gate + (size_t)row * 4096 + gt * 256 + bj * HALF + wc * 32 + 8 * fq) = pack8(o[0], o[1]); }
            EPI_ROWS_END
        }
    }
};
struct EpiGateSig {
    static constexpr bool PERM = true;
    bf16_t* gate;
    __device__ __forceinline__ void operator()(const Acc& acc, const Unit& u, int wr, int wc, int fr, int fq) const {
        EPI_ROWS_BEGIN
#pragma unroll
        for (int bj = 0; bj < 2; ++bj) { f32x4 o[2];
#pragma unroll
            for (int n = 0; n < 2; ++n)
#pragma unroll
                for (int e = 0; e < 4; e += 2) { const f32x2 r = sigmoid2((f32x2){acc[ai][bj][m][n][e], acc[ai][bj][m][n][e + 1]} * (1.0f / 64.0f)) * ((GATE8 == 2) ? 255.0f : 1.0f); o[n][e] = r[0]; o[n][e + 1] = r[1]; }
            if (GATE8 == 2) { v2u w = {0u, 0u};
#pragma unroll
                for (int e = 0; e < 4; ++e) { w.x = __builtin_amdgcn_cvt_pk_u8_f32(o[0][e], e, w.x); w.y = __builtin_amdgcn_cvt_pk_u8_f32(o[1][e], e, w.y); }
                *(v2u*)((unsigned char*)gate + (size_t)row * 4096 + u.pn * BM + bj * HALF + wc * 32 + 8 * fq) = w; }
            else if (GATE8 == 1) { v2u w; w.x = pk4_fp8(o[0][0], o[0][1], o[0][2], o[0][3]); w.y = pk4_fp8(o[1][0], o[1][1], o[1][2], o[1][3]); *(v2u*)((unsigned char*)gate + (size_t)row * 4096 + u.pn * BM + bj * HALF + wc * 32 + 8 * fq) = w; }
            else *(u32x4*)(gate + (size_t)row * 4096 + u.pn * BM + bj * HALF + wc * 32 + 8 * fq) = pack8(o[0], o[1]); }
        EPI_ROWS_END
    }
};
struct EpiZ {
    static constexpr bool PERM = false;
    float* z;
    __device__ __forceinline__ void operator()(const Acc& acc, const Unit& u, int wr, int wc, int fr, int fq) const {
        EPI_ROWS_BEGIN
#pragma unroll
        for (int n = 0; n < 2; ++n) *(f32x4*)(z + ((size_t)(u.z * 512 + row)) * 128 + wc * 32 + 16 * n + 4 * fq) = acc[ai][0][m][n];
        EPI_ROWS_END
    }
};
struct EpiY {
    static constexpr bool PERM = true;
    const bf16_t* ua; const float* dskip; bf16_t* yp;
    __device__ __forceinline__ void operator()(const Acc& acc, const Unit& u, int wr, int wc, int fr, int fq) const {
        const int gI = u.z, h0 = 8 * (fq & 1);
        const f32x4 d0 = *(const f32x4*)(dskip + gI * 16 + h0), d1 = *(const f32x4*)(dskip + gI * 16 + h0 + 4);
        EPI_ROWS_BEGIN
#pragma unroll
        for (int bj = 0; bj < 2; ++bj) { const int col = u.pn * BM + bj * HALF + wc * 32 + 8 * fq;
            const u32x4 uu = *(const u32x4*)(ua + ((size_t)(gI * 512 + row)) * S5_LDA + col);
            f32x4 a = acc[ai][bj][m][0], b = acc[ai][bj][m][1];
            a[0] += d0[0] * bflo(uu.x); a[1] += d0[1] * bfhi(uu.x); a[2] += d0[2] * bflo(uu.y); a[3] += d0[3] * bfhi(uu.y);
            b[0] += d1[0] * bflo(uu.z); b[1] += d1[1] * bfhi(uu.z); b[2] += d1[2] * bflo(uu.w); b[3] += d1[3] * bfhi(uu.w);
#pragma unroll
            for (int e = 0; e < 4; ++e) { a[e] = gelu_tanh(a[e]); b[e] = gelu_tanh(b[e]); }
            *(u32x4*)(yp + ((size_t)row * 64 + (col >> 4)) * 256 + gI * 16 + h0) = pack8(a, b); }
        EPI_ROWS_END
    }
};
struct EpiGlu {
    static constexpr bool PERM = true;
    const bf16_t* yp; bf16_t* ycat;
    __device__ __forceinline__ void operator()(const Acc& acc, const Unit& u, int wr, int wc, int fr, int fq) const {
        EPI_ROWS_BEGIN
#pragma unroll
        for (int bj = 0; bj < 2; ++bj) { const int col = bj * HALF + wc * 32 + 8 * fq;
            const u32x4 yy = *(const u32x4*)(yp + (size_t)row * 256 + col);
            f32x4 a = acc[ai][bj][m][0], b = acc[ai][bj][m][1];
            a[0] = bflo(yy.x) * sigmoidf_(a[0]); a[1] = bfhi(yy.x) * sigmoidf_(a[1]); a[2] = bflo(yy.y) * sigmoidf_(a[2]); a[3] = bfhi(yy.y) * sigmoidf_(a[3]);
            b[0] = bflo(yy.z) * sigmoidf_(b[0]); b[1] = bfhi(yy.z) * sigmoidf_(b[1]); b[2] = bflo(yy.w) * sigmoidf_(b[2]); b[3] = bfhi(yy.w) * sigmoidf_(b[3]);
            *(u32x4*)(ycat + (size_t)row * 1024 + col) = pack8(a, b); }
        EPI_ROWS_END
    }
};
template <bool SC64> struct EpiResid {
    static constexpr bool PERM = true; static constexpr float sc = SC64 ? (1.0f / 64.0f) : 1.0f;
    const float* base32; const bf16_t* base16; bf16_t* out; float* ss; unsigned char* out8; int flags;
    __device__ __forceinline__ void operator()(const Acc& acc, const Unit& u, int wr, int wc, int fr, int fq) const {
        EPI_ROWS_BEGIN
        float q = 0.f;
#pragma unroll
        for (int bj = 0; bj < 2; ++bj) { const size_t off = (size_t)row * 1024 + u.pn * BM + bj * HALF + wc * 32 + 8 * fq;
            f32x4 a, b;
            if (flags & 1) { a = *(const f32x4*)(base32 + off); b = *(const f32x4*)(base32 + off + 4); }
            else { const u32x4 r = *(const u32x4*)(base16 + off); a = (f32x4){bflo(r.x), bfhi(r.x), bflo(r.y), bfhi(r.y)}; b = (f32x4){bflo(r.z), bfhi(r.z), bflo(r.w), bfhi(r.w)}; }
            const u32x4 w = pack8(a + acc[ai][bj][m][0] * sc, b + acc[ai][bj][m][1] * sc); *(u32x4*)(out + off) = w;
            if (flags & 2) { const float x0 = bflo(w.x), x1 = bfhi(w.x), x2 = bflo(w.y), x3 = bfhi(w.y), x4 = bflo(w.z), x5 = bfhi(w.z), x6 = bflo(w.w), x7 = bfhi(w.w);
                q += ((x0 * x0 + x1 * x1) + (x2 * x2 + x3 * x3)) + ((x4 * x4 + x5 * x5) + (x6 * x6 + x7 * x7));
                if (flags & 4) { v2u w8; w8.x = pk4_fp8(x0, x1, x2, x3); w8.y = pk4_fp8(x4, x5, x6, x7); *(v2u*)(out8 + off) = w8; } } }
        if (flags & 2) { q += __shfl_xor(q, 16); q += __shfl_xor(q, 32); if (fq == 0) ss[(size_t)row * 16 + u.pn * 4 + wc] = q; }
        EPI_ROWS_END
    }
};
template <bool H8> struct EpiSwiGlu {
    static constexpr bool PERM = true;
    bf16_t* h; float sc; const float* ss; int use_ss;
    __device__ __forceinline__ void operator()(const Acc& acc, const Unit& u, int wr, int wc, int fr, int fq) const {
        EPI_ROWS_BEGIN
        float rsc = sc;
        if (use_ss) { const f32x4 s0 = *(const f32x4*)(ss + (size_t)row * 16), s1 = *(const f32x4*)(ss + (size_t)row * 16 + 4), s2 = *(const f32x4*)(ss + (size_t)row * 16 + 8), s3 = *(const f32x4*)(ss + (size_t)row * 16 + 12);
            const f32x4 t = (s0 + s1) + (s2 + s3); rsc = sc * __builtin_amdgcn_rsqf(((t[0] + t[1]) + (t[2] + t[3])) * (1.0f / D) + EPS); }
        f32x4 o[2];
#pragma unroll
        for (int n = 0; n < 2; ++n)
#pragma unroll
            for (int e = 0; e < 4; e += 2) { const f32x2 a = (f32x2){acc[ai][0][m][n][e], acc[ai][0][m][n][e + 1]} * rsc, b = (f32x2){acc[ai][1][m][n][e], acc[ai][1][m][n][e + 1]} * rsc;
                const f32x2 r = (a * b) * sigmoid2(a); o[n][e] = r[0]; o[n][e + 1] = r[1]; }
        if constexpr (H8) { v2u w; w.x = pk4_fp8(o[0][0], o[0][1], o[0][2], o[0][3]); w.y = pk4_fp8(o[1][0], o[1][1], o[1][2], o[1][3]); *(v2u*)((unsigned char*)h + (size_t)row * FF + u.pn * 128 + wc * 32 + 8 * fq) = w; }
        else *(u32x4*)(h + (size_t)row * FF + u.pn * 128 + wc * 32 + 8 * fq) = pack8(o[0], o[1]);
        EPI_ROWS_END
    }
};
struct EpiStore {
    static constexpr bool PERM = true;
    bf16_t* o; float sc;
    __device__ __forceinline__ void operator()(const Acc& acc, const Unit& u, int wr, int wc, int fr, int fq) const {
        EPI_ROWS_BEGIN
#pragma unroll
        for (int bj = 0; bj < 2; ++bj) *(u32x4*)(o + (size_t)row * 1024 + u.pn * BM + bj * HALF + wc * 32 + 8 * fq) = pack8(acc[ai][bj][m][0] * sc, acc[ai][bj][m][1] * sc);
        EPI_ROWS_END
    }
};
}

#define XB_TMO      128
#define XB_XCNT(j)  (256  + 64 * (j))
#define XB_XSUB(j)  (1280 + 64 * (j))
#define XB_XGEN(j)  (2304 + 64 * (j))
#define XB_TOP      3328
#define XB_TOPGEN   3392
#define XCD_BAR_WORDS 3456
#define XB_SPIN_CAP (1u << 18)
__device__ __forceinline__ unsigned xb_ld(unsigned* p)              { return __hip_atomic_load(p, __ATOMIC_RELAXED, __HIP_MEMORY_SCOPE_AGENT); }
__device__ __forceinline__ unsigned xb_add(unsigned* p, unsigned v) { return __hip_atomic_fetch_add(p, v, __ATOMIC_RELAXED, __HIP_MEMORY_SCOPE_AGENT); }
__device__ __forceinline__ unsigned xb_xcc_id() { return (unsigned)__builtin_amdgcn_s_getreg((3 << 11) | 20) & 0xFu; }
#define XB_SPIN(cond, bar) do { unsigned _sp = 0; while (cond) { __builtin_amdgcn_s_sleep(1); \
    if ((++_sp & 255u) == 0u) { if (xb_ld(&(bar)[XB_TMO])) break; if (_sp > XB_SPIN_CAP) { atomicAdd(&(bar)[XB_TMO], 1u); break; } } } } while (0)
struct XcdBarrier { unsigned* bar; unsigned x; volatile LAS unsigned* st; };
__device__ __forceinline__ XcdBarrier xcd_barrier_post(unsigned* bar, volatile LAS unsigned* st) {
    XcdBarrier b; b.bar = bar; b.x = xb_xcc_id(); b.st = st;
    if (threadIdx.x == 0) (void)xb_add(&bar[XB_XCNT(b.x)], 1u);
    return b;
}
__device__ __forceinline__ void xcd_barrier_complete(unsigned* bar, unsigned x, unsigned& nloc, unsigned& nx) {
    const unsigned G = gridDim.x * gridDim.y * gridDim.z;
    unsigned sum, cnt, mine, sp = 0u;
    for (;;) {
        sum = 0u; cnt = 0u; mine = 0u;
#pragma unroll
        for (unsigned j = 0; j < 16; ++j) { const unsigned c = xb_ld(&bar[XB_XCNT(j)]); sum += c; cnt += (c > 0u) ? 1u : 0u; mine = (j == x) ? c : mine; }
        if (sum == G) break;
        __builtin_amdgcn_s_sleep(1);
        if ((++sp & 255u) == 0u) { if (xb_ld(&bar[XB_TMO])) break; if (sp > XB_SPIN_CAP) { atomicAdd(&bar[XB_TMO], 1u); break; } }
    }
    nloc = mine > 0u ? mine : 1u; nx = cnt > 0u ? cnt : 1u;
}
__device__ __forceinline__ void xcd_barrier(const XcdBarrier& b) {
    asm volatile("s_waitcnt vmcnt(0)" ::: "memory");
    __syncthreads();
    if (threadIdx.x == 0) {
        unsigned* bar = b.bar;
        __builtin_amdgcn_s_waitcnt(0);
        unsigned nloc = b.st[0], nx = b.st[1];
        if (nloc == 0u) { xcd_barrier_complete(bar, b.x, nloc, nx); b.st[0] = nloc; b.st[1] = nx; }
        const unsigned old = xb_add(&bar[XB_XSUB(b.x)], 1u);
        const unsigned gen = old / nloc;
        if (old + 1u == (gen + 1u) * nloc) {
            __builtin_amdgcn_fence(__ATOMIC_RELEASE, "agent");
            asm volatile("s_waitcnt vmcnt(0)" ::: "memory");
            const unsigned og = xb_add(&bar[XB_TOP], 1u);
            const unsigned tg = og / nx;
            if (og + 1u == (tg + 1u) * nx) xb_add(&bar[XB_TOPGEN], 1u);
            else XB_SPIN(xb_ld(&bar[XB_TOPGEN]) == tg, bar);
            __builtin_amdgcn_fence(__ATOMIC_ACQUIRE, "agent");
            xb_add(&bar[XB_XGEN(b.x)], 1u);
            asm volatile("s_waitcnt vmcnt(0)" ::: "memory");
        } else {
            XB_SPIN(xb_ld(&bar[XB_XGEN(b.x)]) == gen, bar);
            __builtin_amdgcn_fence(__ATOMIC_ACQUIRE, "agent");
            asm volatile("s_waitcnt vmcnt(0)" ::: "memory");
        }
    }
    __syncthreads();
}

struct Args { const float* in[32]; float* out; unsigned char* ws; int gp_lo, gp_hi; };
enum { I_X = 0, I_GMIX, I_WIN, I_BFORGET, I_FQG, I_FKG, I_SQG, I_SKG, I_LRE, I_LIM, I_LDT, I_BRE, I_BIM, I_CRE, I_CIM, I_S5D, I_WGLU, I_CONVW, I_CONVB, I_LNG, I_LNB,
       I_WBR, I_WOUT, I_GFFN, I_W1, I_W3, I_W2, I_RW, I_RB, I_MW1, I_MW3, I_MW2 };
constexpr int NPH = 12, GP_FINAL = DEPTH * NPH, GP_TOTAL = GP_FINAL + 1;

struct Frame { LAS unsigned char* lds; int tid, lane, wave, vcu, G, gw, NGW; const Args* a; unsigned char* ws; };

__device__ __forceinline__ void transpose_item(const float* W, int ldw, bf16* WT, int ldt, int k0, int src_col0, int dst_row0, LAS float* scr, int lane, const float* ks = nullptr) {
    f32x4 ld[8];
#pragma unroll
    for (int i = 0; i < 8; ++i) ld[i] = *(const f32x4*)(W + (size_t)(k0 + 8 * i + (lane >> 3)) * ldw + src_col0 + 4 * (lane & 7));
#pragma unroll
    for (int i = 0; i < 8; ++i) { LAS float* d = scr + (8 * i + (lane >> 3)) * 33 + 4 * (lane & 7); const float s = ks ? ks[k0 + 8 * i + (lane >> 3)] : 1.0f; d[0] = ld[i][0] * s; d[1] = ld[i][1] * s; d[2] = ld[i][2] * s; d[3] = ld[i][3] * s; }
    LDS_WAIT(); asm volatile("" ::: "memory");
    const int c = lane & 7;
#pragma unroll
    for (int j = 0; j < 4; ++j) { const int n = (lane >> 3) + 8 * j; const LAS float* s = scr + (8 * c) * 33 + n;
        v4u o; o.x = pk2(s[0 * 33], s[1 * 33]); o.y = pk2(s[2 * 33], s[3 * 33]); o.z = pk2(s[4 * 33], s[5 * 33]); o.w = pk2(s[6 * 33], s[7 * 33]);
        *(GAS v4u*)(WT + (size_t)(dst_row0 + n) * ldt + k0 + 8 * c) = o; }
    LDS_WAIT(); asm volatile("" ::: "memory");
}
__device__ __forceinline__ void transpose_item_f8(const float* W, int ldw, unsigned char* WT, int ldt, int k0, int src_col0, int dst_row0, LAS float* scr, int lane, float sc, const float* ks = nullptr) {
    f32x4 ld[8];
#pragma unroll
    for (int i = 0; i < 8; ++i) ld[i] = *(const f32x4*)(W + (size_t)(k0 + 8 * i + (lane >> 3)) * ldw + src_col0 + 4 * (lane & 7));
#pragma unroll
    for (int i = 0; i < 8; ++i) { LAS float* d = scr + (8 * i + (lane >> 3)) * 33 + 4 * (lane & 7); const float s = ks ? sc * ks[k0 + 8 * i + (lane >> 3)] : sc; d[0] = ld[i][0] * s; d[1] = ld[i][1] * s; d[2] = ld[i][2] * s; d[3] = ld[i][3] * s; }
    LDS_WAIT(); asm volatile("" ::: "memory");
    const int c = lane & 7;
#pragma unroll
    for (int j = 0; j < 4; ++j) { const int n = (lane >> 3) + 8 * j; const LAS float* s = scr + (8 * c) * 33 + n;
        v2u o; o.x = pk4_fp8(s[0 * 33], s[1 * 33], s[2 * 33], s[3 * 33]); o.y = pk4_fp8(s[4 * 33], s[5 * 33], s[6 * 33], s[7 * 33]);
        *(GAS v2u*)(WT + (size_t)(dst_row0 + n) * ldt + k0 + 8 * c) = o; }
    LDS_WAIT(); asm volatile("" ::: "memory");
}
__device__ __forceinline__ int win_src_col(int blk) {
    const int tile = blk >> 3, j = blk & 7, bj = j >> 2, hh = j & 3;
    if (tile == 0) return 32 * j;
    if (tile == 1 || tile == 2) return 256 + 256 * (tile - 1) + 64 * hh + 32 * bj;
    if (tile == 3) return 768 + 32 * j;
    if (tile == 4 || tile == 5) return (j < 4) ? (1028 + 128 * (tile - 4) + 32 * j) : (1284 + 128 * (tile - 4) + 32 * (j - 4));
    if (tile == 6 || tile == 7) return 1540 + 256 * (tile - 6) + 64 * hh + 32 * bj;
    if (tile == 8) return 2052 + 32 * j;
    return 2308 + 256 * (tile - 9) + 32 * j;
}
constexpr int CONV_NIN = 200 * 16, CONV_NBR = 4 * 32 * 4, CONV_NOUT = 32 * 16, CONV_NGLU = 8 * 4, CONV_NUP1 = 176 * 16, CONV_NDN1 = 32 * 44;
constexpr int CONV_NMIX = CONV_NIN + CONV_NBR + CONV_NOUT + CONV_NGLU, CONV_CHUNK = 64;
__device__ __forceinline__ int conv_ffn_items(int layer) { return (CONV_NUP1 + CONV_NDN1) * ((layer & 1) ? NE : 1); }
__device__ __forceinline__ void convert_item(Frame& F, int layer, int it, LAS float* scr) {
    const Args& A = *F.a; unsigned char* ws = F.ws;
    const bool moe = (layer & 1) != 0; const int j2 = layer >> 1, ne = moe ? NE : 1;
    const int n_up = CONV_NUP1 * ne;
    int r = it;
    if (r < CONV_NIN) { const int blk = r >> 4, kb = r & 15;
        if (F8_GATES && blk >= 72) transpose_item_f8(A.in[I_WIN] + (size_t)layer * D * DP, DP, (unsigned char*)(ws + WS_WIN8), D, 64 * kb, win_src_col(blk), 32 * (blk - 72), scr, F.lane, 64.0f);
        else transpose_item(A.in[I_WIN] + (size_t)layer * D * DP, DP, (bf16*)(ws + WS_WIN), D, 64 * kb, win_src_col(blk), 32 * blk, scr, F.lane);
        return; } r -= CONV_NIN;
    if (r < CONV_NBR) { const int z = r >> 7, q = r & 127, blk = q >> 2, kb = q & 3;
        transpose_item(A.in[I_WBR] + ((size_t)layer * 4 + z) * 256 * D, D, (bf16*)(ws + WS_WBR) + (size_t)z * D * 256, 256, 64 * kb, 32 * blk, 32 * blk, scr, F.lane); return; } r -= CONV_NBR;
    if (r < CONV_NOUT) { const int blk = r >> 4, kb = r & 15; transpose_item(A.in[I_WOUT] + (size_t)layer * D * D, D, (bf16*)(ws + WS_WOUT), D, 64 * kb, 32 * blk, 32 * blk, scr, F.lane); return; } r -= CONV_NOUT;
    if (r < CONV_NGLU) { const int blk = r >> 2, kb = r & 3; transpose_item(A.in[I_WGLU] + (size_t)layer * 256 * 256, 256, (bf16*)(ws + WS_WGLU), 256, 64 * kb, 32 * blk, 32 * blk, scr, F.lane); return; } r -= CONV_NGLU;
    if (r < n_up) { const int e = r / CONV_NUP1, q = r % CONV_NUP1, blk = q >> 4, kb = q & 15, tile = blk >> 3, jj = blk & 7;
        const float* w1 = moe ? A.in[I_MW1] + ((size_t)j2 * NE + e) * D * FF : A.in[I_W1] + (size_t)j2 * D * FF;
        const float* w3 = moe ? A.in[I_MW3] + ((size_t)j2 * NE + e) * D * FF : A.in[I_W3] + (size_t)j2 * D * FF;
        const float* ks = (FUSE_DENSE_NORM && !moe) ? A.in[I_GFFN] + layer * D : nullptr;
        if (moe ? (F8_MOE_UP != 0) : (DENSE8(layer) != 0)) transpose_item_f8(jj < 4 ? w1 : w3, FF, (unsigned char*)(ws + WS_WUP) + (size_t)e * 5632 * D, D, 64 * kb, 128 * tile + 32 * (jj & 3), 32 * blk, scr, F.lane, 64.0f, ks);
        else transpose_item(jj < 4 ? w1 : w3, FF, (bf16*)(ws + WS_WUP) + (size_t)e * 5632 * D, D, 64 * kb, 128 * tile + 32 * (jj & 3), 32 * blk, scr, F.lane, ks);
        return; } r -= n_up;
    { const int e = r / CONV_NDN1, q = r % CONV_NDN1, blk = q / 44, kb = q % 44;
        const float* w2 = moe ? A.in[I_MW2] + ((size_t)j2 * NE + e) * FF * D : A.in[I_W2] + (size_t)j2 * FF * D;
        if (moe ? (F8_MOE_DN != 0) : (DENSE8(layer) != 0)) transpose_item_f8(w2, D, (unsigned char*)(ws + WS_WDN) + (size_t)e * D * FF, FF, 64 * kb, 32 * blk, 32 * blk, scr, F.lane, 64.0f);
        else transpose_item(w2, D, (bf16*)(ws + WS_WDN) + (size_t)e * D * FF, FF, 64 * kb, 32 * blk, 32 * blk, scr, F.lane); }
}
__device__ __forceinline__ void phase_convert(Frame& F, int layer) {
    LAS float* scr = (LAS float*)(F.lds + F.wave * 16384);
    for (int it = F.gw; it < CONV_NMIX; it += F.NGW) convert_item(F, layer, it, scr);
}
__device__ __forceinline__ void convert_ffn_chunk(Frame& F, int layer, int chunk) {
    LAS float* scr = (LAS float*)(F.lds + F.wave * 16384); const int nf = conv_ffn_items(layer);
    for (int j = F.wave; j < CONV_CHUNK; j += NWAVES) { const int it = chunk * CONV_CHUNK + j; if (it < nf) convert_item(F, layer, CONV_NMIX + it, scr); }
}
struct S5P { float lr, li, dt, kr, ki; };
__device__ __forceinline__ S5P s5_params(const Args& A, int layer, int g, int p) {
    S5P q; q.lr = A.in[I_LRE][(layer * 16 + g) * 64 + p]; q.li = A.in[I_LIM][(layer * 16 + g) * 64 + p]; q.dt = expf(A.in[I_LDT][layer * 16 + g]);
    const float mag = expf(q.lr * q.dt), abr = mag * cosf(q.li * q.dt), abi = mag * sinf(q.li * q.dt);
    const float nr = abr - 1.0f, ni = abi, den = q.lr * q.lr + q.li * q.li;
    q.kr = (nr * q.lr + ni * q.li) / den; q.ki = (ni * q.lr - nr * q.li) / den; return q;
}
__device__ __forceinline__ void s5_pow(const S5P& q, float n, float& pr, float& pi) { const float m = expf(n * q.lr * q.dt), a = n * q.li * q.dt; pr = m * cosf(a); pi = m * sinf(a); }
__device__ __forceinline__ void phase_kfun(Frame& F, int layer) {
    const Args& A = *F.a; float* kf = (float*)(F.ws + WS_KFUN);
    for (int it = F.gw; it < 16 * 64; it += F.NGW) {
        const int g = it >> 6, tau = it & 63, lane = F.lane;
        const S5P q = s5_params(A, layer, g, lane); float pr, pi; s5_pow(q, (float)tau, pr, pi);
        const float wr_ = pr * q.kr - pi * q.ki, wi_ = pr * q.ki + pi * q.kr;
        const int h = lane >> 2, hp0 = 4 * (lane & 3);
        const float* cre = A.in[I_CRE] + ((size_t)(layer * 16 + g) * 16 + h) * 64; const float* cim = A.in[I_CIM] + ((size_t)(layer * 16 + g) * 16 + h) * 64;
        const float* bre = A.in[I_BRE] + (size_t)(layer * 16 + g) * 64 * 16 + hp0; const float* bim = A.in[I_BIM] + (size_t)(layer * 16 + g) * 64 * 16 + hp0;
        f32x4 acc = {0.f, 0.f, 0.f, 0.f};
        for (int p = 0; p < 64; ++p) {
            const float wpr = __shfl(wr_, p), wpi = __shfl(wi_, p);
            const float cr = cre[p], ci = cim[p], cwr = cr * wpr - ci * wpi, cwi = cr * wpi + ci * wpr;
            const f32x4 br = *(const f32x4*)(bre + p * 16), bi = *(const f32x4*)(bim + p * 16);
            acc += cwr * br - cwi * bi;
        }
        *(f32x4*)(kf + ((size_t)(g * 64 + tau) * 16 + h) * 16 + hp0) = acc;
    }
}
__device__ __forceinline__ void moe_starts(Frame& F, int j2, int (&st)[NE + 1]) {
    const unsigned* cnt = (const unsigned*)(F.ws + WS_CTL) + CW_MOE + 64 * j2; int s = 0;
#pragma unroll
    for (int e = 0; e < NE; ++e) { st[e] = s; const int c = (int)__hip_atomic_load(cnt + e, __ATOMIC_RELAXED, __HIP_MEMORY_SCOPE_AGENT); s += (c + 255) & ~255; }
    st[NE] = s;
}
__device__ __forceinline__ void moe_combine_row(Frame& F, int row, f32x4 (&v)[4], const int (&st)[NE + 1]) {
    const unsigned* rt = (const unsigned*)(F.ws + WS_ROUTE) + (size_t)row * 8;
    const v4u rr = *(const v4u*)rt; unsigned s0 = rr.z, s1 = rr.w;
#pragma unroll
    for (int e = 0; e < NE; ++e) { if ((int)rr.x == e) s0 += (unsigned)st[e]; if ((int)rr.y == e) s1 += (unsigned)st[e]; }
    const float w0 = __builtin_bit_cast(float, rt[4]), w1 = __builtin_bit_cast(float, rt[5]);
    const bf16* yp = (const bf16*)(F.ws + WS_XNP);
#pragma unroll
    for (int j = 0; j < 4; ++j) { const v2u a = *(const v2u*)(yp + (size_t)s0 * D + 4 * F.lane + 256 * j), b = *(const v2u*)(yp + (size_t)s1 * D + 4 * F.lane + 256 * j);
        v[j][0] += w0 * bflo(a.x) + w1 * bflo(b.x); v[j][1] += w0 * bfhi(a.x) + w1 * bfhi(b.x); v[j][2] += w0 * bflo(a.y) + w1 * bflo(b.y); v[j][3] += w0 * bfhi(a.y) + w1 * bfhi(b.y); }
}
__device__ __forceinline__ void phase_rows_mixer(Frame& F, int layer) {
    const Args& A = *F.a; const int lane = F.lane;
    const float* xin = A.in[I_X]; bf16* xb = (bf16*)(F.ws + WS_XB); const bool first = (layer == 0), comb = (layer > 0) && (((layer - 1) & 1) != 0);
    f32x4 gv[4]; f32x4 wf[4][4];
#pragma unroll
    for (int j = 0; j < 4; ++j) { gv[j] = *(const f32x4*)(A.in[I_GMIX] + layer * D + 4 * lane + 256 * j);
#pragma unroll
        for (int e = 0; e < 4; ++e) wf[j][e] = *(const f32x4*)(A.in[I_WIN] + (size_t)layer * D * DP + (size_t)(4 * lane + 256 * j + e) * DP + 1024); }
    const f32x4 bf = *(const f32x4*)(A.in[I_BFORGET] + layer * 4);
    bf16* xn = (bf16*)(F.ws + WS_XN); float* lf = (float*)(F.ws + WS_LF); unsigned char* xn8 = F.ws + WS_XN8;
    int st[NE + 1];
#pragma unroll
    for (int e = 0; e <= NE; ++e) st[e] = 0;
    if (comb) moe_starts(F, (layer - 1) >> 1, st);
    for (int row = F.gw; row < T; row += F.NGW) {
        f32x4 v[4]; float ss = 0.f;
        if (first) {
#pragma unroll
            for (int j = 0; j < 4; ++j) v[j] = *(const f32x4*)(xin + (size_t)row * D + 4 * lane + 256 * j);
        } else {
#pragma unroll
            for (int j = 0; j < 4; ++j) { const v2u r = *(const v2u*)(xb + (size_t)row * D + 4 * lane + 256 * j); v[j] = (f32x4){bflo(r.x), bfhi(r.x), bflo(r.y), bfhi(r.y)}; }
        }
        if (comb) { moe_combine_row(F, row, v, st);
#pragma unroll
            for (int j = 0; j < 4; ++j) { v2u o; o.x = pk2(v[j][0], v[j][1]); o.y = pk2(v[j][2], v[j][3]); *(v2u*)(xb + (size_t)row * D + 4 * lane + 256 * j) = o;
                v[j] = (f32x4){bflo(o.x), bfhi(o.x), bflo(o.y), bfhi(o.y)}; } }
#pragma unroll
        for (int j = 0; j < 4; ++j) ss += (v[j][0] * v[j][0] + v[j][1] * v[j][1]) + (v[j][2] * v[j][2] + v[j][3] * v[j][3]);
        const float rs = 1.0f / sqrtf(wave_sum(ss) * (1.0f / D) + EPS);
        f32x4 fl = {0.f, 0.f, 0.f, 0.f};
#pragma unroll
        for (int j = 0; j < 4; ++j) { const f32x4 h = v[j] * rs * gv[j];
            v2u o; o.x = pk2(h[0], h[1]); o.y = pk2(h[2], h[3]); *(v2u*)(xn + (size_t)row * D + 4 * lane + 256 * j) = o;
            if (F8_GATES) *(unsigned*)(xn8 + (size_t)row * D + 4 * lane + 256 * j) = pk4_fp8(h[0], h[1], h[2], h[3]);
#pragma unroll
            for (int e = 0; e < 4; ++e) fl += h[e] * wf[j][e]; }
#pragma unroll
        for (int e = 0; e < 4; ++e) fl[e] = wave_sum(fl[e]);
        if (lane == 0) { f32x4 o;
#pragma unroll
            for (int e = 0; e < 4; ++e) { const float xx = fl[e] + bf[e]; o[e] = (fminf(xx, 0.f) - log1pf(expf(-fabsf(xx)))) * LOG2E; }
            *(f32x4*)(lf + (size_t)row * 4) = o; }
    }
}
__device__ __forceinline__ void phase_s5_tables(Frame& F, int layer) {
    const Args& A = *F.a; const int lane = F.lane;
    bf16* wz = (bf16*)(F.ws + WS_WZ); bf16* wy = (bf16*)(F.ws + WS_WY); const float* kf = (const float*)(F.ws + WS_KFUN);
    for (int it = F.gw; it < 16 * 256; it += F.NGW) {
        const int g = it >> 8, rowz = it & 255; bf16* dst = wz + ((size_t)(g * 256 + rowz)) * 1024 + lane * 16;
        v4u o0 = {0u, 0u, 0u, 0u}, o1 = {0u, 0u, 0u, 0u};
        if (rowz < 128) { const int p = rowz >> 1, ri = rowz & 1; const S5P q = s5_params(A, layer, g, p); float pr, pi; s5_pow(q, (float)(63 - lane), pr, pi);
            const float wr_ = pr * q.kr - pi * q.ki, wi_ = pr * q.ki + pi * q.kr;
            const float* bre = A.in[I_BRE] + ((size_t)(layer * 16 + g) * 64 + p) * 16; const float* bim = A.in[I_BIM] + ((size_t)(layer * 16 + g) * 64 + p) * 16;
            float val[16];
#pragma unroll
            for (int h = 0; h < 16; ++h) { const float br = bre[h], bi = bim[h]; val[h] = ri == 0 ? (wr_ * br - wi_ * bi) : (wr_ * bi + wi_ * br); }
            o0 = (v4u){pk2(val[0], val[1]), pk2(val[2], val[3]), pk2(val[4], val[5]), pk2(val[6], val[7])};
            o1 = (v4u){pk2(val[8], val[9]), pk2(val[10], val[11]), pk2(val[12], val[13]), pk2(val[14], val[15])}; }
        *(v4u*)dst = o0; *(v4u*)(dst + 8) = o1;
    }
    for (int it = F.gw; it < 16 * 1024; it += F.NGW) {
        const int g = it >> 10, n = it & 1023, t = n >> 4, h = n & 15; bf16* dst = wy + ((size_t)(g * 1024 + n)) * S5_LDA;
        v4u o0 = {0u, 0u, 0u, 0u}, o1 = {0u, 0u, 0u, 0u};
        if (lane <= t) { const float* src = kf + ((size_t)(g * 64 + (t - lane)) * 16 + h) * 16;
            const f32x4 a = *(const f32x4*)src, b = *(const f32x4*)(src + 4), c = *(const f32x4*)(src + 8), d = *(const f32x4*)(src + 12);
            o0 = (v4u){pk2(a[0], a[1]), pk2(a[2], a[3]), pk2(b[0], b[1]), pk2(b[2], b[3])}; o1 = (v4u){pk2(c[0], c[1]), pk2(c[2], c[3]), pk2(d[0], d[1]), pk2(d[2], d[3])}; }
        *(v4u*)(dst + lane * 16) = o0; *(v4u*)(dst + lane * 16 + 8) = o1;
        const S5P q = s5_params(A, layer, g, lane); float pr, pi; s5_pow(q, (float)(t + 1), pr, pi);
        const float cr = A.in[I_CRE][((size_t)(layer * 16 + g) * 16 + h) * 64 + lane], ci = A.in[I_CIM][((size_t)(layer * 16 + g) * 16 + h) * 64 + lane];
        *(unsigned*)(dst + 1024 + 2 * lane) = pk2(cr * pr - ci * pi, -(cr * pi + ci * pr));
    }
}
__device__ __forceinline__ void phase_cumsum(Frame& F) {
    const int first = (gridDim.x >= 160) ? 128 : 0;
    if ((int)blockIdx.x < first || (int)blockIdx.x >= first + 32) return;
    const int bh = (int)blockIdx.x - first, b = bh >> 2, h = bh & 3, tid = F.tid;
    const float* lf = (const float*)(F.ws + WS_LF); float* cum = (float*)(F.ws + WS_CUM);
    LAS float* wtot = (LAS float*)(F.lds);
    float v[8]; float run = 0.f;
#pragma unroll
    for (int i = 0; i < 8; ++i) { run += lf[((size_t)b * SEQ + tid * 8 + i) * 4 + h]; v[i] = run; }
    float incl = run;
#pragma unroll
    for (int o = 1; o < 64; o <<= 1) { const float n = __shfl_up(incl, o); if (F.lane >= o) incl += n; }
    if (F.lane == 63) wtot[F.wave] = incl;
    __syncthreads();
    float base = incl - run;
    for (int w = 0; w < F.wave; ++w) base += wtot[w];
#pragma unroll
    for (int i = 0; i < 8; ++i) cum[(size_t)bh * SEQ + tid * 8 + i] = base + v[i];
    __syncthreads();
}
__device__ __forceinline__ void phase_conv(Frame& F, int layer) {
    const Args& A = *F.a; const int lane = F.lane;
    LAS f32x4* wl = (LAS f32x4*)F.lds;
    for (int i = F.tid; i < 31 * 64; i += NWAVES * 64) wl[i] = *(const f32x4*)(A.in[I_CONVW] + (size_t)layer * 31 * 256 + (size_t)i * 4);
    __syncthreads();
    const f32x4 cb = *(const f32x4*)(A.in[I_CONVB] + layer * 256 + 4 * lane), lg = *(const f32x4*)(A.in[I_LNG] + layer * 256 + 4 * lane), lb = *(const f32x4*)(A.in[I_LNB] + layer * 256 + 4 * lane);
    const bf16* uc = (const bf16*)(F.ws + WS_UC); bf16* ycat = (bf16*)(F.ws + WS_YCAT);
    for (int run = F.gw; run < T / 8; run += F.NGW) {
        const int t0 = run * 8, tl0 = t0 & (SEQ - 1);
        f32x4 acc[8];
#pragma unroll
        for (int i = 0; i < 8; ++i) acc[i] = cb;
#pragma unroll
        for (int r = 0; r < 38; ++r) {
            v2u raw = {0u, 0u};
            if (tl0 - 30 + r >= 0) raw = *(const v2u*)(uc + (size_t)(t0 - 30 + r) * 256 + 4 * lane);
            const f32x4 x = {bflo(raw.x), bfhi(raw.x), bflo(raw.y), bfhi(raw.y)};
#pragma unroll
            for (int i = 0; i < 8; ++i) { const int j = r - i; if (j >= 0 && j < 31) acc[i] += wl[j * 64 + lane] * x; }
        }
#pragma unroll
        for (int i = 0; i < 8; ++i) {
            const f32x4 a = acc[i];
            const float mean = wave_sum((a[0] + a[1]) + (a[2] + a[3])) * (1.0f / 256.0f);
            const f32x4 dlt = a - mean;
            const float var = wave_sum((dlt[0] * dlt[0] + dlt[1] * dlt[1]) + (dlt[2] * dlt[2] + dlt[3] * dlt[3])) * (1.0f / 256.0f);
            const float rs = 1.0f / sqrtf(var + EPS);
            f32x4 y = dlt * rs * lg + lb;
#pragma unroll
            for (int e = 0; e < 4; ++e) y[e] = y[e] * sigmoidf_(y[e]);
            v2u o; o.x = pk2(y[0], y[1]); o.y = pk2(y[2], y[3]);
            *(v2u*)(ycat + (size_t)(t0 + i) * 1024 + 512 + 4 * lane) = o;
        }
    }
    __syncthreads();
}

typedef float f32x16 __attribute__((ext_vector_type(16)));
typedef short s16x4 __attribute__((ext_vector_type(4)));
constexpr int AT_PITCH = 72, AT_VOFF = 64 * AT_PITCH * 2, AT_COFF = 2 * AT_VOFF, AT_BUF = AT_COFF + 256, AT_FLAG = 2 * AT_BUF;
constexpr float SB_DEAD = -64.0f;
__device__ __forceinline__ s16x4 tr_read(const LAS unsigned char* p) { return __builtin_bit_cast(s16x4, __builtin_amdgcn_ds_read_tr16_b64_v4i16((LAS s16x4*)p)); }

template <int MODE>
__device__ __forceinline__ void attn_unit(Frame& F, int bh, int qb, const bf16* Q, const bf16* K, const bf16* V, const float* CUM, bf16* Y, float z2max) {
    const int tid = F.tid, lane = F.lane, w = F.wave, l31 = lane & 31, hh = lane >> 5;
    const int b = bh >> 2, h = bh & 3, Q0 = qb * 256, qw0 = Q0 + 32 * w, qrow = qw0 + l31;
    const size_t rowbase = (size_t)b * SEQ;
    LAS unsigned char* lds = F.lds;
    bf16x8 qf[4];
#pragma unroll
    for (int s = 0; s < 4; ++s) qf[s] = *(const bf16x8*)(Q + (rowbase + qrow) * 256 + h * 64 + 16 * s + 8 * hh);
    const float cq = (MODE == 0) ? CUM[(size_t)bh * SEQ + qrow] : 0.f;
    f32x16 ot[2];
#pragma unroll
    for (int r = 0; r < 16; ++r) { ot[0][r] = 0.f; ot[1][r] = 0.f; }
    float m_run = -INFINITY, l_run = 0.f, carry = 0.f; bool fdead = false;
    const int tmax = (Q0 + 255) >> 6, srow = tid >> 3, sch = tid & 7;
    const bf16* kg = K + (rowbase + srow) * 256 + h * 64 + sch * 8; const bf16* vg = V + (rowbase + srow) * 256 + h * 64 + sch * 8;
    const int sofs = (srow * AT_PITCH + sch * 8) * 2;
    v4u kreg = *(const v4u*)(kg + (size_t)(64 * tmax) * 256), vreg = *(const v4u*)(vg + (size_t)(64 * tmax) * 256);
    float creg = (MODE == 0 && tid < 64) ? -CUM[(size_t)bh * SEQ + 64 * tmax + tid] : 0.f;
    LAS unsigned* flags = (LAS unsigned*)(lds + AT_FLAG);
    if (tid < 3) flags[tid] = 0u;
    *(LAS v4u*)(lds + sofs) = kreg; *(LAS v4u*)(lds + AT_VOFF + sofs) = vreg; if (MODE == 0 && tid < 64) *(LAS float*)(lds + AT_COFF + tid * 4) = creg;
    __syncthreads();
    int cur = 0, it = 0;
    const int ti = lane & 15, tq = ti >> 2, tp = ti & 3, tg = (lane >> 4) & 1;
    const int vlane = (tq * AT_PITCH + 16 * tg + 4 * tp) * 2;
    for (int t = tmax; t >= 0; --t, ++it) {
        const bool more = t > 0;
        if (more) { kreg = *(const v4u*)(kg + (size_t)(64 * (t - 1)) * 256); vreg = *(const v4u*)(vg + (size_t)(64 * (t - 1)) * 256); if (MODE == 0 && tid < 64) creg = -CUM[(size_t)bh * SEQ + 64 * (t - 1) + tid]; }
        const LAS unsigned char* Kb = lds + cur * AT_BUF; const LAS unsigned char* Vb = Kb + AT_VOFF; const LAS unsigned char* Cb = Kb + AT_COFF;
        const int kv0 = 64 * t;
        bool alive = false;
        if (kv0 <= qw0 + 31 && !__all(MODE == 0 ? fdead : (carry < SB_DEAD))) {
            f32x16 p[2];
            if (MODE == 0) {
#pragma unroll
                for (int hf = 0; hf < 2; ++hf)
#pragma unroll
                    for (int c = 0; c < 4; ++c) { const f32x4 ck = *(const LAS f32x4*)(Cb + (32 * hf + 8 * c + 4 * hh) * 4);
#pragma unroll
                        for (int i = 0; i < 4; ++i) p[hf][4 * c + i] = ck[i]; }
            } else {
#pragma unroll
                for (int r = 0; r < 16; ++r) { p[0][r] = 0.f; p[1][r] = 0.f; }
            }
#pragma unroll
            for (int s = 0; s < 4; ++s) {
                const bf16x8 k0 = *(const LAS bf16x8*)(Kb + (l31 * AT_PITCH + 16 * s + 8 * hh) * 2), k1 = *(const LAS bf16x8*)(Kb + ((32 + l31) * AT_PITCH + 16 * s + 8 * hh) * 2);
                p[0] = __builtin_amdgcn_mfma_f32_32x32x16_bf16(k0, qf[s], p[0], 0, 0, 0);
                p[1] = __builtin_amdgcn_mfma_f32_32x32x16_bf16(k1, qf[s], p[1], 0, 0, 0);
            }
            const bool diag = (kv0 + 63 > qw0);
            if (MODE == 0) {
                if (diag) {
#pragma unroll
                    for (int hf = 0; hf < 2; ++hf)
#pragma unroll
                        for (int r = 0; r < 16; ++r) { const int kvg = kv0 + 32 * hf + (r & 3) + 8 * (r >> 2) + 4 * hh; if (kvg > qrow) p[hf][r] = -INFINITY; }
                }
                float mt = p[0][0];
#pragma unroll
                for (int r = 0; r < 16; ++r) { mt = fmaxf(mt, p[0][r]); mt = fmaxf(mt, p[1][r]); }
                mt = fmaxf(mt, __shfl_xor(mt, 32));
                const float mn = fmaxf(m_run, mt), alpha = fast_exp2(m_run - mn); m_run = mn;
                float rs = 0.f;
#pragma unroll
                for (int r = 0; r < 16; ++r) { p[0][r] = fast_exp2(p[0][r] - mn); p[1][r] = fast_exp2(p[1][r] - mn); rs += p[0][r] + p[1][r]; }
                l_run = l_run * alpha + rs;
                if (__any(alpha != 1.0f)) {
#pragma unroll
                    for (int r = 0; r < 16; ++r) { ot[0][r] *= alpha; ot[1][r] *= alpha; } }
                if (more) { const float cnext = CUM[(size_t)bh * SEQ + kv0 - 1]; fdead = (z2max - cnext - m_run) < SB_DEAD; alive = !__all(fdead); }
            } else {
                f32x16 lk[2];
#pragma unroll
                for (int hf = 0; hf < 2; ++hf)
#pragma unroll
                    for (int r = 0; r < 16; ++r) { const float z = p[hf][r], e = fast_exp2(-fabsf(z)), lg = __builtin_amdgcn_logf(1.0f + e);
                        float lb = fminf(z, 0.f) - lg, k_ = -(fmaxf(z, 0.f) + lg);
                        if (diag) { const int kvg = kv0 + 32 * hf + (r & 3) + 8 * (r >> 2) + 4 * hh; if (kvg >= qrow) { k_ = 0.f; lb = -INFINITY; } }
                        p[hf][r] = lb; lk[hf][r] = k_; }
                float T[8], To[8], PS[8];
#pragma unroll
                for (int mI = 0; mI < 8; ++mI) { const int hf = mI >> 2, c = mI & 3; T[mI] = (lk[hf][4 * c] + lk[hf][4 * c + 1]) + (lk[hf][4 * c + 2] + lk[hf][4 * c + 3]); To[mI] = __shfl_xor(T[mI], 32); }
                float run = 0.f;
#pragma unroll
                for (int mI = 7; mI >= 0; --mI) { PS[mI] = run; run += T[mI] + To[mI]; }
#pragma unroll
                for (int mI = 0; mI < 8; ++mI) { const int hf = mI >> 2, c = mI & 3; const float base = carry + PS[mI] + (hh == 0 ? To[mI] : 0.f);
                    const float s3 = lk[hf][4 * c + 3], s2 = s3 + lk[hf][4 * c + 2], s1 = s2 + lk[hf][4 * c + 1];
                    p[hf][4 * c + 3] = fast_exp2(p[hf][4 * c + 3] + base); p[hf][4 * c + 2] = fast_exp2(p[hf][4 * c + 2] + base + s3);
                    p[hf][4 * c + 1] = fast_exp2(p[hf][4 * c + 1] + base + s2); p[hf][4 * c] = fast_exp2(p[hf][4 * c] + base + s1); }
                carry += run;
                alive = __any(carry >= SB_DEAD);
            }
            bf16x8 pb[2][2];
#pragma unroll
            for (int hf = 0; hf < 2; ++hf)
#pragma unroll
                for (int c2 = 0; c2 < 2; ++c2) { v4u wv; wv.x = pg8::cvt_pk_bf16(p[hf][8 * c2], p[hf][8 * c2 + 1]); wv.y = pg8::cvt_pk_bf16(p[hf][8 * c2 + 2], p[hf][8 * c2 + 3]);
                    wv.z = pg8::cvt_pk_bf16(p[hf][8 * c2 + 4], p[hf][8 * c2 + 5]); wv.w = pg8::cvt_pk_bf16(p[hf][8 * c2 + 6], p[hf][8 * c2 + 7]); pb[hf][c2] = __builtin_bit_cast(bf16x8, wv); }
#pragma unroll
            for (int db = 0; db < 2; ++db)
#pragma unroll
                for (int hf = 0; hf < 2; ++hf)
#pragma unroll
                    for (int c2 = 0; c2 < 2; ++c2) { const LAS unsigned char* vp = Vb + ((32 * hf + 16 * c2 + 4 * hh) * AT_PITCH + 32 * db) * 2 + vlane;
                        const s16x4 lo = tr_read(vp), hi = tr_read(vp + 8 * AT_PITCH * 2);
                        const bf16x8 va = {lo[0], lo[1], lo[2], lo[3], hi[0], hi[1], hi[2], hi[3]};
                        ot[db] = __builtin_amdgcn_mfma_f32_32x32x16_bf16(va, pb[hf][c2], ot[db], 0, 0, 0); }
        } else { alive = (kv0 > qw0 + 31); }
        if (more) { const int o = (cur ^ 1) * AT_BUF + sofs; *(LAS v4u*)(lds + o) = kreg; *(LAS v4u*)(lds + o + AT_VOFF) = vreg; if (MODE == 0 && tid < 64) *(LAS float*)(lds + (cur ^ 1) * AT_BUF + AT_COFF + tid * 4) = creg; }
        { const int sl = it % 3, sn = (it + 1) % 3;
            if (alive && lane == 0) flags[sl] = 1u;
            if (tid == 0) flags[sn] = 0u;
            __syncthreads();
            if (flags[sl] == 0u) break; }
        cur ^= 1;
    }
    float inv = 1.0f;
    if (MODE == 0) { const float lt = l_run + __shfl_xor(l_run, 32); inv = 1.0f / lt; }
    bf16* yrow = Y + (rowbase + qrow) * 1024 + h * 64;
#pragma unroll
    for (int db = 0; db < 2; ++db)
#pragma unroll
        for (int c = 0; c < 4; ++c) { v2u o; o.x = pg8::cvt_pk_bf16(ot[db][4 * c] * inv, ot[db][4 * c + 1] * inv); o.y = pg8::cvt_pk_bf16(ot[db][4 * c + 2] * inv, ot[db][4 * c + 3] * inv);
            *(v2u*)(yrow + 32 * db + 8 * c + 4 * hh) = o; }
    __syncthreads();
}
__device__ __forceinline__ int q_pop(Frame& F, unsigned* ctr) {
    LAS int* slot = (LAS int*)(F.lds + QSLOT_OFF);
    __syncthreads();
    if (F.tid == 0) *slot = (int)__hip_atomic_fetch_add(ctr, 1u, __ATOMIC_RELAXED, __HIP_MEMORY_SCOPE_AGENT);
    __syncthreads();
    return *slot;
}
__device__ __forceinline__ void phase_attn_sb(Frame& F, int layer, int rep) {
    const bf16* qkv = (const bf16*)(F.ws + WS_QKV); const size_t sz = (size_t)T * 256; bf16* ycat = (bf16*)(F.ws + WS_YCAT);
    unsigned* ctr = (unsigned*)(F.ws + WS_CTL) + CW_Q + 128 * layer + 16 * rep;
    for (;;) { const int un = q_pop(F, ctr); if (un >= 512) break;
        attn_unit<1>(F, un & 31, 15 - (un >> 5), qkv + 3 * sz, qkv + 4 * sz, qkv + 5 * sz, nullptr, ycat + 768, 0.f); }
}
__device__ __forceinline__ void phase_attn_fox(Frame& F, int layer, int rep) {
    const bf16* qkv = (const bf16*)(F.ws + WS_QKV); const size_t sz = (size_t)T * 256; const float* cum = (const float*)(F.ws + WS_CUM); bf16* ycat = (bf16*)(F.ws + WS_YCAT);
    unsigned* ctr = (unsigned*)(F.ws + WS_CTL) + CW_Q + 128 * layer + 64 + 16 * rep;
    const float gq = fabsf(F.a->in[I_FQG][layer * 64 + F.lane]), gk = fabsf(F.a->in[I_FKG][layer * 64 + F.lane]);
    float mq = gq, mk = gk;
#pragma unroll
    for (int o = 1; o < 64; o <<= 1) { mq = fmaxf(mq, __shfl_xor(mq, o)); mk = fmaxf(mk, __shfl_xor(mk, o)); }
    const float z2max = 8.0f * mq * mk * LOG2E * 1.02f + 0.25f;
    const int nchunk = (conv_ffn_items(layer) + CONV_CHUNK - 1) / CONV_CHUNK;
    const int total = 512 + nchunk;
    for (;;) { const int t = q_pop(F, ctr); if (t >= total) break;
        const int na0 = (int)(((long)t * 512) / total), na1 = (int)(((long)(t + 1) * 512) / total);
        if (na1 > na0) attn_unit<0>(F, na0 & 31, 15 - (na0 >> 5), qkv, qkv + sz, qkv + 2 * sz, cum, ycat + 256, z2max);
        else convert_ffn_chunk(F, layer, t - na0); }
}
__device__ __forceinline__ void phase_s5_scan_unit(Frame& F, int layer, int g, int pm) {
    __builtin_amdgcn_fence(__ATOMIC_ACQUIRE, "agent");
    if (F.tid < 256) {
        const int b = 4 * pm + (F.tid >> 6), p = F.tid & 63;
        const S5P q = s5_params(*F.a, layer, g, p); float ar, ai; s5_pow(q, 64.0f, ar, ai);
        const float* z = (const float*)(F.ws + WS_Z); bf16* ua = (bf16*)(F.ws + WS_UA);
        float sr = 0.f, si = 0.f;
        for (int n0 = 0; n0 < 64; n0 += 16) {
            f32x2 zz[16];
#pragma unroll
            for (int j = 0; j < 16; ++j) zz[j] = *(const f32x2*)(z + ((size_t)g * 512 + b * 64 + n0 + j) * 128 + 2 * p);
#pragma unroll
            for (int j = 0; j < 16; ++j) { const size_t ch = (size_t)g * 512 + b * 64 + n0 + j;
                *(unsigned*)(ua + ch * S5_LDA + 1024 + 2 * p) = pk2(sr, si);
                const float nr = ar * sr - ai * si + zz[j][0], ni = ar * si + ai * sr + zz[j][1]; sr = nr; si = ni; }
        }
    }
    __syncthreads();
}
__device__ __forceinline__ void phase_rows_ffn(Frame& F, int layer) {
    const Args& A = *F.a; const int lane = F.lane; const int j2 = layer >> 1;
    f32x4 gv[4];
#pragma unroll
    for (int j = 0; j < 4; ++j) gv[j] = *(const f32x4*)(A.in[I_GFFN] + layer * D + 4 * lane + 256 * j);
    const bf16* xb = (const bf16*)(F.ws + WS_XB); unsigned char* seg = F.ws + WS_XNP; unsigned* route = (unsigned*)(F.ws + WS_ROUTE); unsigned* cnt = (unsigned*)(F.ws + WS_CTL) + CW_MOE + 64 * j2;
    unsigned my_e0 = 0, my_e1 = 0, my_r0 = 0, my_r1 = 0; float my_w0 = 0.f, my_w1 = 0.f, my_rs = 0.f; unsigned long long lc = 0ull; int nrow = 0;
    for (int row = F.gw; row < T; row += F.NGW, ++nrow) {
        f32x4 v[4]; float ss = 0.f;
#pragma unroll
        for (int j = 0; j < 4; ++j) { const v2u r = *(const v2u*)(xb + (size_t)row * D + 4 * lane + 256 * j); v[j] = (f32x4){bflo(r.x), bfhi(r.x), bflo(r.y), bfhi(r.y)};
            ss += (v[j][0] * v[j][0] + v[j][1] * v[j][1]) + (v[j][2] * v[j][2] + v[j][3] * v[j][3]); }
        const float rs = 1.0f / sqrtf(wave_sum(ss) * (1.0f / D) + EPS);
        float lg[8];
#pragma unroll
        for (int e = 0; e < 8; ++e) lg[e] = 0.f;
#pragma unroll
        for (int j = 0; j < 4; ++j) { const f32x4 h = v[j] * rs * gv[j];
#pragma unroll
            for (int e4 = 0; e4 < 4; ++e4) { const float* wr = A.in[I_RW] + ((size_t)j2 * D + 4 * lane + 256 * j + e4) * NE; const f32x4 a = *(const f32x4*)wr, b = *(const f32x4*)(wr + 4);
                lg[0] += h[e4] * a[0]; lg[1] += h[e4] * a[1]; lg[2] += h[e4] * a[2]; lg[3] += h[e4] * a[3]; lg[4] += h[e4] * b[0]; lg[5] += h[e4] * b[1]; lg[6] += h[e4] * b[2]; lg[7] += h[e4] * b[3]; } }
#pragma unroll
        for (int e = 0; e < 8; ++e) lg[e] = wave_sum(lg[e]) + A.in[I_RB][j2 * NE + e];
        int e0 = 0; float v0 = lg[0];
#pragma unroll
        for (int e = 1; e < 8; ++e) if (lg[e] > v0) { v0 = lg[e]; e0 = e; }
        int e1 = -1; float v1 = -INFINITY;
#pragma unroll
        for (int e = 0; e < 8; ++e) if (e != e0 && lg[e] > v1) { v1 = lg[e]; e1 = e; }
        const float w1 = 1.0f / (1.0f + expf(v0 - v1)), w0 = 1.0f - w1;
        const unsigned r0 = (unsigned)(lc >> (8 * e0)) & 0xffu; lc += 1ull << (8 * e0);
        const unsigned r1 = (unsigned)(lc >> (8 * e1)) & 0xffu; lc += 1ull << (8 * e1);
        if (lane == nrow) { my_e0 = e0; my_e1 = e1; my_r0 = r0; my_r1 = r1; my_w0 = w0; my_w1 = w1; my_rs = rs; }
    }
    unsigned basev = 0;
    if (lane < 8) { const unsigned c = (unsigned)(lc >> (8 * lane)) & 0xffu; basev = c ? __hip_atomic_fetch_add(cnt + lane, c, __ATOMIC_RELAXED, __HIP_MEMORY_SCOPE_AGENT) : 0u; }
    const unsigned my_p0 = __shfl(basev, (int)my_e0) + my_r0, my_p1 = __shfl(basev, (int)my_e1) + my_r1;
    if (lane < nrow) { const int row = F.gw + lane * F.NGW; unsigned* rt = route + (size_t)row * 8;
        *(v4u*)rt = (v4u){my_e0, my_e1, my_p0, my_p1}; *(v4u*)(rt + 4) = (v4u){__builtin_bit_cast(unsigned, my_w0), __builtin_bit_cast(unsigned, my_w1), 0u, 0u}; }
    for (int i = 0; i < nrow; ++i) {
        const int row = F.gw + i * F.NGW; const float rs = __shfl(my_rs, i);
        const size_t d0 = ((size_t)__shfl((int)my_e0, i) * T + (size_t)__shfl((int)my_p0, i)) * D, d1 = ((size_t)__shfl((int)my_e1, i) * T + (size_t)__shfl((int)my_p1, i)) * D;
#pragma unroll
        for (int j = 0; j < 4; ++j) { const v2u r = *(const v2u*)(xb + (size_t)row * D + 4 * lane + 256 * j);
            const f32x4 h = (f32x4){bflo(r.x), bfhi(r.x), bflo(r.y), bfhi(r.y)} * rs * gv[j]; const unsigned w = pk4_fp8(h[0], h[1], h[2], h[3]);
            *(unsigned*)(seg + d0 + 4 * lane + 256 * j) = w; *(unsigned*)(seg + d1 + 4 * lane + 256 * j) = w; }
    }
}
__device__ __forceinline__ void phase_final_combine(Frame& F) {
    const Args& A = *F.a; int st[NE + 1]; moe_starts(F, (DEPTH - 1) >> 1, st);
    for (int row = F.gw; row < T; row += F.NGW) {
        f32x4 v[4];
#pragma unroll
        for (int j = 0; j < 4; ++j) { const v2u r = *(const v2u*)((const bf16*)(F.ws + WS_XB) + (size_t)row * D + 4 * F.lane + 256 * j); v[j] = (f32x4){bflo(r.x), bfhi(r.x), bflo(r.y), bfhi(r.y)}; }
        moe_combine_row(F, row, v, st);
#pragma unroll
        for (int j = 0; j < 4; ++j) *(f32x4*)(A.out + (size_t)row * D + 4 * F.lane + 256 * j) = v[j];
    }
}

__global__ void __launch_bounds__(NWAVES * 64, 2) mk_fwd(Args args) {
    extern __shared__ __attribute__((aligned(16))) unsigned char lds_raw[];
    Frame F; F.lds = (LAS unsigned char*)lds_raw; F.tid = threadIdx.x; F.lane = F.tid & 63; F.wave = __builtin_amdgcn_readfirstlane(F.tid >> 6);
    F.G = gridDim.x; { const int bx = blockIdx.x; F.vcu = (F.G % 8 == 0) ? (bx % 8) * (F.G / 8) + bx / 8 : bx; }
    F.gw = F.vcu * NWAVES + F.wave; F.NGW = F.G * NWAVES; F.a = &args; F.ws = args.ws;
    volatile LAS unsigned* MISC = (volatile LAS unsigned*)(F.lds + MISC_OFF);
    for (int u = F.tid; u < (LDS_BYTES - RING_BYTES) / 4; u += NWAVES * 64) ((LAS unsigned*)(F.lds + RING_BYTES))[u] = 0u;
    __syncthreads();
    unsigned* ctl = (unsigned*)(args.ws + WS_CTL);
    const bool multi = (args.gp_hi - args.gp_lo) > 1;
    XcdBarrier bar; bar.bar = ctl + CW_BAR; bar.x = 0; bar.st = nullptr;
    if (multi) bar = xcd_barrier_post(ctl + CW_BAR, MISC + 8);
    unsigned char* ws = args.ws;
    LAS unsigned char* ring = F.lds;

    const int gp_lo = args.gp_lo, gp_hi = args.gp_hi;
#define IN(p) (gp_lo <= layer * NPH + (p) && layer * NPH + (p) < gp_hi)
#define SEAM(p) do { if (IN(p) && layer * NPH + (p) + 1 < gp_hi) xcd_barrier(bar); } while (0)
#ifndef PH_MASK
#define PH_MASK 0xffff
#endif
#define ON(p) (((PH_MASK) >> (p)) & 1)
#ifndef PROBE_PH
#define PROBE_PH -1
#endif
#ifndef PROBE_N
#define PROBE_N 1
#endif
#ifndef PROBE_LAYERS
#define PROBE_LAYERS 15
#endif
#define REPS(p) ((((p) == PROBE_PH) && ((PROBE_LAYERS >> layer) & 1)) ? 1 + PROBE_N : 1)
#define ENTER() do { ws = args.ws; asm volatile("" : "+s"(ws)); F.ws = ws; int t_ = threadIdx.x; asm volatile("" : "+v"(t_)); F.tid = t_; F.lane = t_ & 63; F.wave = __builtin_amdgcn_readfirstlane(t_ >> 6); F.gw = F.vcu * NWAVES + F.wave; } while (0)
    for (int layer = gp_lo / NPH; layer < DEPTH && layer * NPH < gp_hi; ++layer) {
        const bool moe = (layer & 1) != 0;
#if ON(0)
        if (IN(0)) for (int rep_ = 0; rep_ < REPS(0); ++rep_) { ENTER(); for (int r2_ = 0; r2_ < ((PROBE_PH == 100) ? 1 + PROBE_N : 1); ++r2_) { phase_convert(F, layer); phase_kfun(F, layer); } phase_rows_mixer(F, layer); }
        SEAM(0);
#endif
#if ON(1)
        if (IN(1)) for (int rep_ = 0; rep_ < REPS(1); ++rep_) { ENTER();
            phase_s5_tables(F, layer); phase_cumsum(F);
#if F8_GATES
            { pg8::Gemm g8{(const bf16*)(ws + WS_XN8), (const bf16*)(ws + WS_WIN8), D / 2, D / 2, D / 2}; pg8::StaticOrder S8; S8.init(T, 4096, F.G, (int)blockIdx.x, D / 2, D / 2);
              pg8::EpiGateSig E8; E8.gate = (bf16*)(ws + WS_GATE);
              pg8::gemm_phase<pg8::EpiGateSig, pg8::StaticOrder, true, true>(ring, g8, S8, E8); }
#endif
            pg8::Gemm g{(const bf16*)(ws + WS_XN), (const bf16*)(ws + WS_WIN), D, D, D}; pg8::StaticOrder S; S.init(T, F8_GATES ? 2304 : NPROJ, F.G, (int)blockIdx.x, D, D);
            pg8::EpiInProj E; E.ua = (bf16*)(ws + WS_UA); E.qkv = (bf16*)(ws + WS_QKV); E.uc = (bf16*)(ws + WS_UC); E.gate = (bf16*)(ws + WS_GATE);
            { LAS float* gl = (LAS float*)(F.lds + GAIN_OFF);
              if (F.tid < 256) { const int w = F.tid >> 6, d = F.tid & 63; const float* src = (w == 0) ? args.in[I_FQG] : (w == 1) ? args.in[I_FKG] : (w == 2) ? args.in[I_SQG] : args.in[I_SKG];
                  gl[F.tid] = src[layer * 64 + d] * ((w == 0 || w == 2) ? QSCALE : 1.0f); }
              __syncthreads(); E.gl = gl; }
            pg8::gemm_phase<pg8::EpiInProj, pg8::StaticOrder, true>(ring, g, S, E);
        }
        SEAM(1);
#endif
#if ON(2)
        if (IN(2)) for (int rep_ = 0; rep_ < REPS(2); ++rep_) { ENTER();
            { pg8::Gemm g{(const bf16*)(ws + WS_UA), (const bf16*)(ws + WS_WZ), 1024, S5_LDA, 1024};
              pg8::BatchOrder S; S.nM = 2; S.nN = 1; S.nZ = 16; S.G = F.G; S.c = (int)blockIdx.x; S.tA = (size_t)256 * S5_LDA * 2; S.tB = 0; S.zA = (size_t)512 * S5_LDA * 2; S.zB = (size_t)256 * 1024 * 2;
              pg8::EpiZ E; E.z = (float*)(ws + WS_Z);
              pg8::gemm_phase<pg8::EpiZ, pg8::BatchOrder, false>(ring, g, S, E);
              if ((int)blockIdx.x < 32) phase_s5_scan_unit(F, layer, (int)blockIdx.x >> 1, (int)blockIdx.x & 1); }
            phase_conv(F, layer);
            phase_attn_sb(F, layer, rep_);
        }
        SEAM(2);
#endif
#if ON(4)
        if (IN(4)) for (int rep_ = 0; rep_ < REPS(4); ++rep_) { ENTER();
            { pg8::Gemm g{(const bf16*)(ws + WS_UA), (const bf16*)(ws + WS_WY), S5_LDA, S5_LDA, S5_LDA};
              pg8::BatchOrder S; S.nM = 2; S.nN = 4; S.nZ = 16; S.G = F.G; S.c = (int)blockIdx.x; S.tA = (size_t)256 * S5_LDA * 2; S.tB = (size_t)256 * S5_LDA * 2; S.zA = (size_t)512 * S5_LDA * 2; S.zB = (size_t)1024 * S5_LDA * 2;
              pg8::EpiY E; E.ua = (const bf16*)(ws + WS_UA); E.dskip = args.in[I_S5D] + layer * 256; E.yp = (bf16*)(ws + WS_YP);
              pg8::gemm_phase<pg8::EpiY, pg8::BatchOrder, false>(ring, g, S, E); }
            phase_attn_fox(F, layer, rep_);
        }
        SEAM(4);
#endif
#if ON(5)
        if (IN(5) && F.G != 256) for (int rep_ = 0; rep_ < REPS(5); ++rep_) { ENTER();
            pg8::Gemm g{(const bf16*)(ws + WS_YP), (const bf16*)(ws + WS_WGLU), 256, 256, 256};
            pg8::BatchOrder S; S.nM = T / 256; S.nN = 1; S.nZ = 1; S.G = F.G; S.c = (int)blockIdx.x; S.tA = (size_t)256 * 256 * 2; S.tB = 0; S.zA = 0; S.zB = 0;
            pg8::EpiGlu E; E.yp = (const bf16*)(ws + WS_YP); E.ycat = (bf16*)(ws + WS_YCAT);
            pg8::gemm_phase<pg8::EpiGlu, pg8::BatchOrder, false>(ring, g, S, E);
        }
        if (F.G != 256) SEAM(5);
#endif
#if ON(6)
        if (IN(6)) for (int rep_ = 0; rep_ < REPS(6); ++rep_) { ENTER();
            const int paired = (F.G == 256) ? 1 : 0;
            if (paired) {
                pg8::Gemm g{(const bf16*)(ws + WS_YP), (const bf16*)(ws + WS_WGLU), 256, 256, 256};
                pg8::OneUnit S; S.pm = F.vcu >> 1; S.tA = (size_t)256 * 256 * 2;
                pg8::EpiGlu E; E.yp = (const bf16*)(ws + WS_YP); E.ycat = (bf16*)(ws + WS_YCAT);
                pg8::gemm_phase<pg8::EpiGlu, pg8::OneUnit, false>(ring, g, S, E);
            }
            pg8::Gemm g{(const bf16*)(ws + WS_YCAT), (const bf16*)(ws + WS_WBR), 256, 1024, 256};
            pg8::BranchOrder1 S; S.nM = T / 256; S.nN = 8; S.G = F.G; S.c = (int)blockIdx.x; S.tA = (size_t)256 * 1024 * 2; S.tB = (size_t)128 * 256 * 2; S.zA = 256 * 2; S.zB = (size_t)1024 * 256 * 2; S.paired = paired; S.vc = F.vcu;
            pg8::EpiGate1 E; E.gate = (const bf16*)(ws + WS_GATE); E.mb = (bf16*)(ws + WS_XN);
            pg8::gemm_phase_n1<pg8::EpiGate1, pg8::BranchOrder1>(ring, g, S, E);
        }
        SEAM(6);
#endif
#if ON(7)
        if (IN(7)) for (int rep_ = 0; rep_ < REPS(7); ++rep_) { ENTER();
            pg8::Gemm g{(const bf16*)(ws + WS_XN), (const bf16*)(ws + WS_WOUT), D, D, D}; pg8::StaticOrder S; S.init(T, D, F.G, (int)blockIdx.x, D, D);
            pg8::EpiResid<false> E; E.base32 = args.in[I_X]; E.base16 = (const bf16*)(ws + WS_XB); E.out = (bf16*)(ws + WS_XB); E.ss = (float*)(ws + WS_SSP); E.out8 = ws + WS_XN8;
            E.flags = ((layer == 0) ? 1 : 0) | ((FUSE_DENSE_NORM && !moe) ? 2 : 0) | ((FUSE_DENSE_NORM && !moe && DENSE8(layer)) ? 4 : 0);
            pg8::gemm_phase<pg8::EpiResid<false>, pg8::StaticOrder, true>(ring, g, S, E);
        }
        SEAM(7);
#endif
#if ON(8)
        if (IN(8)) for (int rep_ = 0; rep_ < REPS(8); ++rep_) { ENTER(); if (moe || !FUSE_DENSE_NORM) phase_rows_ffn(F, layer); }
        if (moe || !FUSE_DENSE_NORM) SEAM(8);
#endif
#if ON(10)
        if (IN(10)) for (int rep_ = 0; rep_ < REPS(10); ++rep_) { ENTER();
            if (!moe) {
                if (DENSE8(layer)) {
                    constexpr int DQ = D / 2;
                    pg8::Gemm g{(const bf16*)(ws + (FUSE_DENSE_NORM ? WS_XN8 : WS_XN)), (const bf16*)(ws + WS_WUP), DQ, DQ, DQ}; pg8::StaticOrder S; S.init(T, 2 * FF, F.G, (int)blockIdx.x, DQ, DQ);
                    pg8::EpiSwiGlu<true> E; E.h = (bf16*)(ws + WS_HH); E.sc = 1.0f / 64.0f; E.ss = (const float*)(ws + WS_SSP); E.use_ss = FUSE_DENSE_NORM;
                    pg8::gemm_phase<pg8::EpiSwiGlu<true>, pg8::StaticOrder, true, true>(ring, g, S, E);
                } else {
                    pg8::Gemm g{(const bf16*)(ws + (FUSE_DENSE_NORM ? WS_XB : WS_XN)), (const bf16*)(ws + WS_WUP), D, D, D}; pg8::StaticOrder S; S.init(T, 2 * FF, F.G, (int)blockIdx.x, D, D);
                    pg8::EpiSwiGlu<false> E; E.h = (bf16*)(ws + WS_HH); E.sc = 1.0f; E.ss = (const float*)(ws + WS_SSP); E.use_ss = FUSE_DENSE_NORM;
                    pg8::gemm_phase<pg8::EpiSwiGlu<false>, pg8::StaticOrder, true, false>(ring, g, S, E);
                }
            } else {
                constexpr bool U8 = F8_MOE_UP != 0, H8 = F8_MOE_DN != 0; constexpr int DQ = U8 ? D / 2 : D;
                pg8::Gemm g{(const bf16*)(ws + WS_XNP), (const bf16*)(ws + WS_WUP), DQ, DQ, DQ};
                pg8::GroupOrder S; S.nN = 22; S.G = F.G; S.c = (int)blockIdx.x; S.tA = (size_t)256 * DQ * 2; S.tB = (size_t)256 * DQ * 2; S.zB = (size_t)5632 * DQ * 2; S.zA = (size_t)T * DQ * 2;
                int st[NE + 1]; moe_starts(F, layer >> 1, st);
#pragma unroll
                for (int e = 0; e <= NE; ++e) S.ts[e] = __builtin_amdgcn_readfirstlane(st[e] >> 8);
                pg8::EpiSwiGlu<H8> E; E.h = (bf16*)(ws + WS_HP); E.sc = U8 ? (1.0f / 64.0f) : 1.0f; E.ss = (const float*)(ws + WS_SSP); E.use_ss = 0;
                pg8::gemm_phase<pg8::EpiSwiGlu<H8>, pg8::GroupOrder, true, U8>(ring, g, S, E);
            }
        }
        SEAM(10);
#endif
#if ON(11)
        if (IN(11)) for (int rep_ = 0; rep_ < REPS(11); ++rep_) { ENTER();
            if (!moe) {
                if (DENSE8(layer)) {
                    constexpr int FQ = FF / 2;
                    pg8::Gemm g{(const bf16*)(ws + WS_HH), (const bf16*)(ws + WS_WDN), FQ, FQ, FQ}; pg8::StaticOrder S; S.init(T, D, F.G, (int)blockIdx.x, FQ, FQ);
                    pg8::EpiResid<true> E; E.base32 = args.in[I_X]; E.base16 = (const bf16*)(ws + WS_XB); E.out = (bf16*)(ws + WS_XB); E.ss = (float*)(ws + WS_SSP); E.out8 = ws + WS_XN8; E.flags = 0;
                    pg8::gemm_phase<pg8::EpiResid<true>, pg8::StaticOrder, true, true>(ring, g, S, E);
                } else {
                    pg8::Gemm g{(const bf16*)(ws + WS_HH), (const bf16*)(ws + WS_WDN), FF, FF, FF}; pg8::StaticOrder S; S.init(T, D, F.G, (int)blockIdx.x, FF, FF);
                    pg8::EpiResid<false> E; E.base32 = args.in[I_X]; E.base16 = (const bf16*)(ws + WS_XB); E.out = (bf16*)(ws + WS_XB); E.ss = (float*)(ws + WS_SSP); E.out8 = ws + WS_XN8; E.flags = 0;
                    pg8::gemm_phase<pg8::EpiResid<false>, pg8::StaticOrder, true, false>(ring, g, S, E);
                }
            } else {
                constexpr bool F8 = F8_MOE_DN != 0; constexpr int FQ = F8 ? FF / 2 : FF;
                pg8::Gemm g{(const bf16*)(ws + WS_HP), (const bf16*)(ws + WS_WDN), FQ, FQ, FQ};
                pg8::GroupOrder S; S.nN = 4; S.G = F.G; S.c = (int)blockIdx.x; S.tA = (size_t)256 * FQ * 2; S.tB = (size_t)256 * FQ * 2; S.zB = (size_t)D * FQ * 2; S.zA = 0;
                int st[NE + 1]; moe_starts(F, layer >> 1, st);
#pragma unroll
                for (int e = 0; e <= NE; ++e) S.ts[e] = __builtin_amdgcn_readfirstlane(st[e] >> 8);
                pg8::EpiStore E; E.o = (bf16*)(ws + WS_XNP); E.sc = F8 ? (1.0f / 64.0f) : 1.0f;
                pg8::gemm_phase<pg8::EpiStore, pg8::GroupOrder, true, F8>(ring, g, S, E);
            }
        }
        SEAM(11);
#endif
    }
#if ON(12)
    if (gp_lo <= GP_FINAL && GP_FINAL < gp_hi) phase_final_combine(F);
#endif
}

extern "C" void kernel_launch(void* const* d_in, const int* in_sizes, int n_in, void* d_out, int out_size, void* d_ws, size_t ws_size, hipStream_t stream) {
    static int grid = 0;
    if (grid == 0) {
        if (n_in != 32 || in_sizes[0] != T * D || out_size != T * D || ws_size < WS_END) { fprintf(stderr, "kernel_launch: unexpected shapes / workspace (n_in %d, ws %zu < %zu)\n", n_in, ws_size, (size_t)WS_END); grid = -1; return; }
        int dev = 0, cus = 0, per_cu = 0;
        if (hipGetDevice(&dev) != hipSuccess || hipDeviceGetAttribute(&cus, hipDeviceAttributeMultiprocessorCount, dev) != hipSuccess) { grid = -1; return; }
        if (hipFuncSetAttribute((const void*)mk_fwd, hipFuncAttributeMaxDynamicSharedMemorySize, LDS_BYTES) != hipSuccess) { grid = -1; return; }
        if (hipOccupancyMaxActiveBlocksPerMultiprocessor(&per_cu, (const void*)mk_fwd, NWAVES * 64, LDS_BYTES) != hipSuccess || per_cu < 1) fprintf(stderr, "kernel_launch: occupancy query says %d\n", per_cu);
        (void)hipGetLastError();
        grid = cus;
    }
    if (grid < 0) return;
    if (hipMemsetAsync((char*)d_ws + WS_CTL, 0, CTL_ZERO_BYTES, stream) != hipSuccess) return;
    Args a{};
    for (int i = 0; i < 32; ++i) a.in[i] = (const float*)d_in[i];
    a.out = (float*)d_out; a.ws = (unsigned char*)d_ws;
    a.gp_lo = 0; a.gp_hi = GP_TOTAL;
    hipLaunchKernelGGL(mk_fwd, dim3(grid), dim3(NWAVES * 64), LDS_BYTES, stream, a);
}
```

```cpp
#include <hip/hip_runtime.h>
#include <cstdio>
#include <cstdint>

#ifndef F8_DENSE_MASK
#define F8_DENSE_MASK 4
#endif
#define DENSE8(layer) (((F8_DENSE_MASK) >> (layer)) & 1)
#ifndef F8_MOE_UP
#define F8_MOE_UP 1
#endif
#ifndef FUSE_DENSE_NORM
#define FUSE_DENSE_NORM 1
#endif
#ifndef GATE8
#define GATE8 2
#endif
#ifndef BR_WG
#define BR_WG 4
#endif
#ifndef F8_GATES
#define F8_GATES 1
#endif
#ifndef F8_MOE_DN
#define F8_MOE_DN 1
#endif

#define GAS __attribute__((address_space(1)))
#define LAS __attribute__((address_space(3)))
typedef unsigned short bf16;
typedef unsigned v4u __attribute__((ext_vector_type(4)));
typedef unsigned v2u __attribute__((ext_vector_type(2)));
typedef float f32x4 __attribute__((ext_vector_type(4)));
typedef float f32x2 __attribute__((ext_vector_type(2)));
typedef short bf16x8 __attribute__((ext_vector_type(8)));

constexpr int NB = 8, SEQ = 4096, D = 1024, DEPTH = 4, T = NB * SEQ;
constexpr int DP = 6404, NPROJ = 6400, FF = 2816, NE = 8;
constexpr float EPS = 1e-6f, LOG2E = 1.4426950408889634f;
constexpr float QSCALE = 0.125f * LOG2E;
constexpr int MOE_ROWS = 2 * T + NE * 256;
constexpr int S5_LDA = 1152;

constexpr size_t MiB = 1u << 20;
constexpr size_t WS_CTL = 0, CTL_ZERO_BYTES = 1 * MiB;
constexpr size_t WS_WIN = 1 * MiB;
constexpr size_t WS_WIN8 = WS_WIN + (size_t)2304 * D * 2;
constexpr size_t WS_WBR = WS_WIN + (size_t)NPROJ * D * 2;
constexpr size_t WS_WOUT = WS_WBR + 2 * MiB;
constexpr size_t WS_WGLU = WS_WOUT + 2 * MiB;
constexpr size_t WS_WZ = WS_WGLU + 128 * 1024;
constexpr size_t WS_WY = WS_WZ + 8 * MiB;
constexpr size_t WS_WUP = WS_WY + 36 * MiB;
constexpr size_t WS_WDN = WS_WUP + 88 * MiB;
constexpr size_t WS_KFUN = WS_WDN + 44 * MiB;
constexpr size_t WS_ROUTE = WS_KFUN + 1 * MiB;
constexpr size_t WS_LF = WS_ROUTE + 1 * MiB;
constexpr size_t WS_CUM = WS_LF + 512 * 1024;
constexpr size_t WS_XN = 198 * MiB;
static_assert(WS_CUM + 512 * 1024 <= WS_XN, "ws map");
constexpr size_t WS_R = WS_XN + 64 * MiB;
constexpr size_t WS_GATE = WS_R;
constexpr size_t WS_QKV = WS_GATE + 256 * MiB;
constexpr size_t WS_UC = WS_QKV + 96 * MiB;
constexpr size_t WS_UA = WS_UC + 16 * MiB;
constexpr size_t WS_Z = WS_UA + 18 * MiB;
constexpr size_t WS_YP = WS_Z + 4 * MiB;
constexpr size_t WS_YCAT = WS_YP + 16 * MiB;
constexpr size_t WS_MIX_END = WS_YCAT + 64 * MiB;
constexpr size_t WS_XN8 = WS_YCAT;
constexpr size_t WS_HH = WS_R;
constexpr size_t WS_XNP = WS_R;
constexpr size_t WS_HP = WS_XNP + (size_t)NE * T * D;
constexpr size_t WS_FFN_END = WS_HP + (size_t)MOE_ROWS * FF;
static_assert(F8_MOE_UP && F8_MOE_DN, "the MoE path stores its rows and hidden activations as e4m3 bytes");
constexpr size_t WS_XB = ((WS_MIX_END > WS_FFN_END ? WS_MIX_END : WS_FFN_END) + MiB - 1) / MiB * MiB;
constexpr size_t WS_SSP = WS_XB + 64 * MiB;
constexpr size_t WS_END = WS_SSP + 2 * MiB;
static_assert(WS_END <= 856 * MiB, "ws budget");
constexpr int CW_BAR = 4096;
constexpr int CW_Q = 20480;
constexpr int CW_MOE = 16384;

constexpr int RING_BYTES = 131072, MISC_OFF = RING_BYTES + 320, GAIN_OFF = RING_BYTES + 1024, QSLOT_OFF = RING_BYTES + 64, LDS_BYTES = 147456;
constexpr int NWAVES = 8;

__device__ __forceinline__ unsigned f2bf(float f) { unsigned u = __builtin_bit_cast(unsigned, f); return (u + 0x7fffu + ((u >> 16) & 1u)) >> 16; }
__device__ __forceinline__ unsigned pk2(float lo, float hi) { return f2bf(lo) | (f2bf(hi) << 16); }
__device__ __forceinline__ float bflo(unsigned u) { return __builtin_bit_cast(float, u << 16); }
__device__ __forceinline__ float bfhi(unsigned u) { return __builtin_bit_cast(float, u & 0xffff0000u); }
__device__ __forceinline__ float bf2f(bf16 v) { return __builtin_bit_cast(float, (unsigned)v << 16); }
__device__ __forceinline__ float wave_sum(float v) {
#pragma unroll
    for (int o = 1; o < 64; o <<= 1) v += __shfl_xor(v, o);
    return v;
}
__device__ __forceinline__ float fast_exp2(float x) { return __builtin_amdgcn_exp2f(x); }
__device__ __forceinline__ float fast_rcp(float x) { return __builtin_amdgcn_rcpf(x); }
__device__ __forceinline__ float sigmoidf_(float x) { return fast_rcp(1.0f + fast_exp2(-x * LOG2E)); }
__device__ __forceinline__ f32x2 sigmoid2(f32x2 x) { const f32x2 a = x * (-LOG2E); f32x2 t = {fast_exp2(a[0]), fast_exp2(a[1])}; t = t + 1.0f; return (f32x2){fast_rcp(t[0]), fast_rcp(t[1])}; }
__device__ __forceinline__ float gelu_tanh(float y) { const float u = 0.7978845608028654f * (y + 0.044715f * y * y * y); return y * sigmoidf_(2.0f * u); }
__device__ __forceinline__ unsigned pk4_fp8(float a, float b, float c, float d) { unsigned w = 0u; w = (unsigned)__builtin_amdgcn_cvt_pk_fp8_f32(a, b, (int)w, false); w = (unsigned)__builtin_amdgcn_cvt_pk_fp8_f32(c, d, (int)w, true); return w; }
#define LDS_WAIT() asm volatile("s_waitcnt lgkmcnt(0)" ::: "memory")
#define VM_WAIT() asm volatile("s_waitcnt vmcnt(0)" ::: "memory")

namespace pg8 {
#define PG8_LAS __attribute__((address_space(3)))
typedef unsigned short bf16_t;
typedef unsigned u32x4 __attribute__((ext_vector_type(4)));
typedef int v4i __attribute__((ext_vector_type(4)));
typedef int v8i __attribute__((ext_vector_type(8)));
constexpr int BM = 256, BK = 64, HALF = 128, HTB = HALF * BK * 2, STAGE_BYTES = 8 * HTB, NXCD = 8, WGM = 8;
__host__ __device__ __forceinline__ int lds_byte(int r, int c) { const int st = (r >> 4) * 2 + (c >> 5), rr = r & 15, cc = c & 31, ob = rr * 64 + cc * 2; return st * 1024 + (ob ^ (((ob >> 9) & 1) << 5)); }
__host__ __device__ __forceinline__ void stage_rc(int b, int& R, int& C) { const int st = b / 1024, sb = b % 1024, swz = sb ^ (((sb >> 9) & 1) << 5); R = (st >> 1) * 16 + swz / 64; C = (st & 1) * 32 + (swz % 64) / 2; }
__host__ __device__ __forceinline__ int perm32(int rho) { const int n = rho >> 4, i = rho & 15; return 8 * (i >> 2) + 4 * n + (i & 3); }

struct Unit { int pm, pn, z; size_t offA, offB; };
struct Gemm { const bf16_t* A; const bf16_t* Bt; int K, lda, ldb; };

template <int WG = WGM> __device__ __forceinline__ void xcd_tile_map(int L, int nM, int nN, int& pm, int& pn) {
    const int nwg = nM * nN; int wgid = L; { const int q = nwg / NXCD, r = nwg % NXCD, xcd = wgid % NXCD, off = wgid / NXCD; wgid = (xcd < r ? xcd * (q + 1) : r * (q + 1) + (xcd - r) * q) + off; }
    const int nig = WG * nN, gid = wgid / nig, fm = gid * WG, gsz = (nM - fm) < WG ? (nM - fm) : WG;
    pm = fm + ((wgid % nig) % gsz); pn = (wgid % nig) / gsz;
}
struct StaticOrder {
    int nM, nN, nwg, G, c; size_t tA, tB;
    __device__ void init(int M, int N, int G_, int c_, int lda, int ldb) { nM = M / BM; nN = N / BM; nwg = nM * nN; G = G_; c = c_; tA = (size_t)BM * lda * 2; tB = (size_t)BM * ldb * 2; }
    __device__ bool next(int i, Unit& u) const {
        const long L = (long)i * G + c; if (L >= nwg) return false;
        int wgid = (int)L; { const int q = nwg / NXCD, r = nwg % NXCD, xcd = wgid % NXCD, off = wgid / NXCD; wgid = (xcd < r ? xcd * (q + 1) : r * (q + 1) + (xcd - r) * q) + off; }
        const int nig = WGM * nN, gid = wgid / nig, fm = gid * WGM, gsz = (nM - fm) < WGM ? (nM - fm) : WGM;
        u.pm = fm + ((wgid % nig) % gsz); u.pn = (wgid % nig) / gsz; u.z = 0; u.offA = (size_t)u.pm * tA; u.offB = (size_t)u.pn * tB; return true;
    }
};
struct BatchOrder {
    int nM, nN, nZ, G, c; size_t tA, tB, zA, zB;
    __device__ bool next(int i, Unit& u) const {
        const int L = i * G + c; if (L >= nM * nN * nZ) return false;
        u.z = L / (nM * nN); const int r = L % (nM * nN); u.pm = r / nN; u.pn = r % nN;
        u.offA = (size_t)u.z * zA + (size_t)u.pm * tA; u.offB = (size_t)u.z * zB + (size_t)u.pn * tB; return true;
    }
};
struct GroupOrder {
    int nN, G, c; int ts[NE + 1]; size_t tA, tB, zB, zA;
    __device__ bool next(int i, Unit& u) const {
        const int L = i * G + c; if (L >= ts[NE] * nN) return false;
        xcd_tile_map(L, ts[NE], nN, u.pm, u.pn); int e = 0, tse = 0;
#pragma unroll
        for (int k = 1; k < NE; ++k) if (u.pm >= ts[k]) { e = k; tse = ts[k]; }
        u.z = e; u.offA = zA ? (size_t)e * zA + (size_t)(u.pm - tse) * tA : (size_t)u.pm * tA; u.offB = (size_t)e * zB + (size_t)u.pn * tB; return true;
    }
};

typedef __bf16 bf16x2_t __attribute__((ext_vector_type(2)));
__device__ __forceinline__ unsigned cvt_pk_bf16(float lo, float hi) { const f32x2 v = {lo, hi}; const bf16x2_t b = __builtin_convertvector(v, bf16x2_t); return __builtin_bit_cast(unsigned, b); }

__device__ __forceinline__ u32x4 pack8(const f32x4 a, const f32x4 b) { u32x4 w; w.x = cvt_pk_bf16(a[0], a[1]); w.y = cvt_pk_bf16(a[2], a[3]); w.z = cvt_pk_bf16(b[0], b[1]); w.w = cvt_pk_bf16(b[2], b[3]); return w; }
template <class Epi, class Sched, bool ALIGN_EPI, bool FP8 = false>
__device__ __forceinline__ void gemm_phase(PG8_LAS unsigned char* lds, const Gemm g, const Sched& S, const Epi& E) {
    int tid = threadIdx.x; asm volatile("" : "+v"(tid));
    const int wid = __builtin_amdgcn_readfirstlane(tid >> 6), lane = tid & 63, wr = wid >> 2, wc = wid & 3, fr = lane & 15, fq = lane >> 4;
    int K = g.K; asm volatile("" : "+s"(K));
    const int nt = K / BK;
    unsigned voffA[2], voffB[2];
#pragma unroll
    for (int i = 0; i < 2; ++i) { int R, C; stage_rc(tid * 16 + i * 8192, R, C); const int Rb = Epi::PERM ? ((R & ~31) + perm32(R & 31)) : R;
        voffA[i] = (unsigned)(R * g.lda + C) * 2u; voffB[i] = (unsigned)(Rb * g.ldb + C) * 2u; }
    const size_t kstep = (size_t)(BK * 2);
    const size_t hstepA = (size_t)HALF * g.lda * 2, hstepB = (size_t)HALF * g.ldb * 2;
    const unsigned ldsw = (unsigned)wid * 1024u;
    const int aoff = lds_byte(wr * 64 + fr, fq * 8), boff = lds_byte(wc * 32 + fr, fq * 8);
#define PG8_SA(b, h) (((b) * 2 + (h)) * HTB)
#define PG8_SB(b, h) ((4 + (b) * 2 + (h)) * HTB)
#define PG8_STAGE(bufoff, gbase, voff) do { _Pragma("unroll") for (int _i = 0; _i < 2; ++_i) \
        __builtin_amdgcn_global_load_lds((const unsigned*)((const char*)(gbase) + (voff)[_i]), (PG8_LAS unsigned*)(lds + (bufoff) + ldsw + _i * 8192), 16, 0, 0); } while (0)
#define PG8_LDA(dst, b, h) do { _Pragma("unroll") for (int m = 0; m < 4; ++m) { if constexpr (FP8) dst##8[m] = __builtin_shufflevector(*(const PG8_LAS v4i*)(lds + PG8_SA(b, h) + aoff + m * 2048), *(const PG8_LAS v4i*)(lds + PG8_SA(b, h) + aoff + m * 2048 + 1024), 0, 1, 2, 3, 4, 5, 6, 7); \
        else { _Pragma("unroll") for (int k = 0; k < 2; ++k) dst[m][k] = *(const PG8_LAS bf16x8*)(lds + PG8_SA(b, h) + aoff + m * 2048 + k * 1024); } } } while (0)
#define PG8_LDB(dst, b, h) do { _Pragma("unroll") for (int n = 0; n < 2; ++n) { if constexpr (FP8) dst##8[n] = __builtin_shufflevector(*(const PG8_LAS v4i*)(lds + PG8_SB(b, h) + boff + n * 2048), *(const PG8_LAS v4i*)(lds + PG8_SB(b, h) + boff + n * 2048 + 1024), 0, 1, 2, 3, 4, 5, 6, 7); \
        else { _Pragma("unroll") for (int k = 0; k < 2; ++k) dst[n][k] = *(const PG8_LAS bf16x8*)(lds + PG8_SB(b, h) + boff + n * 2048 + k * 1024); } } } while (0)
#define PG8_MMA(ai, bj, At, Bt) do { __builtin_amdgcn_s_setprio(1); _Pragma("unroll") for (int m = 0; m < 4; ++m) _Pragma("unroll") for (int n = 0; n < 2; ++n) { \
        if constexpr (FP8) asm volatile("v_mfma_f32_16x16x128_f8f6f4 %0, %1, %2, %0" : "+v"(acc[ai][bj][m][n]) : "v"(Bt##8[n]), "v"(At##8[m])); \
        else { _Pragma("unroll") for (int k = 0; k < 2; ++k) acc[ai][bj][m][n] = __builtin_amdgcn_mfma_f32_16x16x32_bf16(Bt[n][k], At[m][k], acc[ai][bj][m][n], 0, 0, 0); } } \
        __builtin_amdgcn_s_setprio(0); } while (0)
#define PG8_WAIT_V(n) asm volatile("s_waitcnt vmcnt(" #n ")" ::: "memory")
#define PG8_WAIT_L(n) asm volatile("s_waitcnt lgkmcnt(" #n ")" ::: "memory")
#define PG8_BAR __builtin_amdgcn_s_barrier()
#define PG8_SCHED __builtin_amdgcn_sched_barrier(0)
    Unit cur, nxt; int ui = 0;
    if (!S.next(0, cur)) return;
    f32x4 acc[2][2][4][2];
#pragma unroll
    for (int a = 0; a < 2; ++a)
#pragma unroll
        for (int b = 0; b < 2; ++b)
#pragma unroll
            for (int m = 0; m < 4; ++m)
#pragma unroll
                for (int n = 0; n < 2; ++n) acc[a][b][m][n] = (f32x4){0.f, 0.f, 0.f, 0.f};
    bf16x8 At[4][2], B0[2][2], B1[2][2]; v8i At8[4], B08[2], B18[2];
    const char* cA = (const char*)g.A + cur.offA; const char* cB = (const char*)g.Bt + cur.offB;
    PG8_STAGE(PG8_SB(0, 0), cB, voffB); PG8_STAGE(PG8_SB(0, 1), cB + hstepB, voffB); PG8_STAGE(PG8_SA(0, 0), cA, voffA); PG8_STAGE(PG8_SA(0, 1), cA + hstepA, voffA);
    if (wr == 1) PG8_BAR;
    PG8_WAIT_V(2); PG8_BAR;
    PG8_STAGE(PG8_SB(1, 0), cB + kstep, voffB); PG8_STAGE(PG8_SA(1, 0), cA + kstep, voffA); PG8_STAGE(PG8_SB(1, 1), cB + hstepB + kstep, voffB);
    PG8_WAIT_V(6); PG8_BAR;
    for (;;) {
        const bool has_next = S.next(ui + 1, nxt);
        const char* nA = has_next ? (const char*)g.A + nxt.offA : cA; const char* nB = has_next ? (const char*)g.Bt + nxt.offB : cB;
        for (int t = 0; t < nt; t += 2) {
            const bool last = (t == nt - 2);
            const char* a1 = cA + (size_t)(t + 1) * kstep;
            const char* a2 = last ? nA : cA + (size_t)(t + 2) * kstep; const char* b2 = last ? nB : cB + (size_t)(t + 2) * kstep;
            const char* a3 = a2 + kstep; const char* b3 = b2 + kstep;
            PG8_LDB(B0, 0, 0); PG8_LDB(B1, 0, 1); PG8_SCHED; PG8_LDA(At, 0, 0); PG8_STAGE(PG8_SA(1, 1), a1 + hstepA, voffA);
            PG8_WAIT_V(8); PG8_WAIT_L(0); PG8_BAR; PG8_MMA(0, 0, At, B0); PG8_MMA(0, 1, At, B1); PG8_BAR; PG8_SCHED;
            PG8_LDA(At, 0, 1); PG8_STAGE(PG8_SB(0, 0), b2, voffB); PG8_STAGE(PG8_SB(0, 1), b2 + hstepB, voffB); PG8_STAGE(PG8_SA(0, 0), a2, voffA);
            PG8_WAIT_V(8); PG8_WAIT_L(0); PG8_BAR; PG8_MMA(1, 0, At, B0); PG8_MMA(1, 1, At, B1); PG8_BAR; PG8_SCHED;
            PG8_LDB(B0, 1, 0); PG8_LDB(B1, 1, 1); PG8_SCHED; PG8_LDA(At, 1, 0); PG8_STAGE(PG8_SA(0, 1), a2 + hstepA, voffA);
            PG8_WAIT_V(8); PG8_WAIT_L(0); PG8_BAR; PG8_MMA(0, 0, At, B0); PG8_MMA(0, 1, At, B1); PG8_BAR; PG8_SCHED;
            PG8_LDA(At, 1, 1); PG8_STAGE(PG8_SB(1, 0), b3, voffB); PG8_STAGE(PG8_SB(1, 1), b3 + hstepB, voffB); PG8_STAGE(PG8_SA(1, 0), a3, voffA);
            PG8_WAIT_V(8); PG8_WAIT_L(0); PG8_BAR; PG8_MMA(1, 0, At, B0); PG8_MMA(1, 1, At, B1); PG8_BAR; PG8_SCHED;
        }
        if constexpr (ALIGN_EPI) { if (wr == 0) PG8_BAR; }
        if constexpr (FP8) asm volatile("s_nop 15\n\ts_nop 15" ::: "memory");
        E(acc, cur, wr, wc, fr, fq);
        if (!has_next) break;
#pragma unroll
        for (int a = 0; a < 2; ++a)
#pragma unroll
            for (int b = 0; b < 2; ++b)
#pragma unroll
                for (int m = 0; m < 4; ++m)
#pragma unroll
                    for (int n = 0; n < 2; ++n) acc[a][b][m][n] = (f32x4){0.f, 0.f, 0.f, 0.f};
        cur = nxt; cA = nA; cB = nB; ++ui;
        if constexpr (ALIGN_EPI) { if (wr == 1) PG8_BAR; }
    }
    PG8_WAIT_V(0);
    if constexpr (!ALIGN_EPI) { if (wr == 0) PG8_BAR; }
    PG8_BAR;
#undef PG8_SA
#undef PG8_SB
#undef PG8_STAGE
#undef PG8_LDA
#undef PG8_LDB
#undef PG8_MMA
#undef PG8_WAIT_V
#undef PG8_WAIT_L
#undef PG8_BAR
#undef PG8_SCHED
}


template <class Epi, class Sched>
__device__ __forceinline__ void gemm_phase_n1(PG8_LAS unsigned char* lds, const Gemm g, const Sched& S, const Epi& E) {
    int tid = threadIdx.x; asm volatile("" : "+v"(tid));
    const int wid = __builtin_amdgcn_readfirstlane(tid >> 6), lane = tid & 63, wr = wid >> 2, wc = wid & 3, fr = lane & 15, fq = lane >> 4;
    int K = g.K; asm volatile("" : "+s"(K));
    const int nt = K / BK;
    unsigned voffA[2], voffB[2];
#pragma unroll
    for (int i = 0; i < 2; ++i) { int R, C; stage_rc(tid * 16 + i * 8192, R, C); const int Rb = Epi::PERM ? ((R & ~31) + perm32(R & 31)) : R;
        voffA[i] = (unsigned)(R * g.lda + C) * 2u; voffB[i] = (unsigned)(Rb * g.ldb + C) * 2u; }
    const size_t kstep = (size_t)(BK * 2);
    const size_t hstepA = (size_t)HALF * g.lda * 2;
    const unsigned ldsw = (unsigned)wid * 1024u;
    const int aoff = lds_byte(wr * 64 + fr, fq * 8), boff = lds_byte(wc * 32 + fr, fq * 8);
#define PG8_SA(b, h) (((b) * 2 + (h)) * HTB)
#define PG8_SB(b, h) ((4 + (b) * 2 + (h)) * HTB)
#define PG8_STAGE(bufoff, gbase, voff) do { _Pragma("unroll") for (int _i = 0; _i < 2; ++_i) \
        __builtin_amdgcn_global_load_lds((const unsigned*)((const char*)(gbase) + (voff)[_i]), (PG8_LAS unsigned*)(lds + (bufoff) + ldsw + _i * 8192), 16, 0, 0); } while (0)
#define PG8_LDA(dst, b, h) do { _Pragma("unroll") for (int m = 0; m < 4; ++m) _Pragma("unroll") for (int k = 0; k < 2; ++k) dst[m][k] = *(const PG8_LAS bf16x8*)(lds + PG8_SA(b, h) + aoff + m * 2048 + k * 1024); } while (0)
#define PG8_LDB(dst, b, h) do { _Pragma("unroll") for (int n = 0; n < 2; ++n) _Pragma("unroll") for (int k = 0; k < 2; ++k) dst[n][k] = *(const PG8_LAS bf16x8*)(lds + PG8_SB(b, h) + boff + n * 2048 + k * 1024); } while (0)
#define PG8_MMA1(ai, At, Bt) do { __builtin_amdgcn_s_setprio(1); _Pragma("unroll") for (int m = 0; m < 4; ++m) _Pragma("unroll") for (int n = 0; n < 2; ++n) _Pragma("unroll") for (int k = 0; k < 2; ++k) \
        acc[ai][m][n] = __builtin_amdgcn_mfma_f32_16x16x32_bf16(Bt[n][k], At[m][k], acc[ai][m][n], 0, 0, 0); __builtin_amdgcn_s_setprio(0); } while (0)
#define PG8_WAIT_V(n) asm volatile("s_waitcnt vmcnt(" #n ")" ::: "memory")
#define PG8_WAIT_L(n) asm volatile("s_waitcnt lgkmcnt(" #n ")" ::: "memory")
#define PG8_BAR __builtin_amdgcn_s_barrier()
#define PG8_SCHED __builtin_amdgcn_sched_barrier(0)
    Unit cur, nxt; int ui = 0;
    if (!S.next(0, cur)) return;
    f32x4 acc[2][4][2], st[2][4][2];
#pragma unroll
    for (int a = 0; a < 2; ++a)
#pragma unroll
        for (int m = 0; m < 4; ++m)
#pragma unroll
            for (int n = 0; n < 2; ++n) { acc[a][m][n] = (f32x4){0.f, 0.f, 0.f, 0.f}; st[a][m][n] = (f32x4){0.f, 0.f, 0.f, 0.f}; }
    bf16x8 At[4][2], B0[2][2];
    const char* cA = (const char*)g.A + cur.offA; const char* cB = (const char*)g.Bt + cur.offB;
    PG8_STAGE(PG8_SB(0, 0), cB, voffB); PG8_STAGE(PG8_SA(0, 0), cA, voffA); PG8_STAGE(PG8_SA(0, 1), cA + hstepA, voffA);
    if (wr == 1) PG8_BAR;
    PG8_WAIT_V(2); PG8_BAR;
    PG8_STAGE(PG8_SB(1, 0), cB + kstep, voffB); PG8_STAGE(PG8_SA(1, 0), cA + kstep, voffA);
    PG8_WAIT_V(4); PG8_BAR;
    for (;;) {
        const bool has_next = S.next(ui + 1, nxt);
        const char* nA = has_next ? (const char*)g.A + nxt.offA : cA; const char* nB = has_next ? (const char*)g.Bt + nxt.offB : cB;
        for (int t = 0; t < nt; t += 2) {
            const bool last = (t == nt - 2);
            const char* a1 = cA + (size_t)(t + 1) * kstep;
            const char* a2 = last ? nA : cA + (size_t)(t + 2) * kstep; const char* b2 = last ? nB : cB + (size_t)(t + 2) * kstep;
            const char* a3 = a2 + kstep; const char* b3 = b2 + kstep;
            PG8_LDB(B0, 0, 0); PG8_SCHED; PG8_LDA(At, 0, 0); PG8_STAGE(PG8_SA(1, 1), a1 + hstepA, voffA);
            PG8_WAIT_V(6); PG8_WAIT_L(0); PG8_BAR; PG8_MMA1(0, At, B0); PG8_BAR; PG8_SCHED;
            PG8_LDA(At, 0, 1); PG8_STAGE(PG8_SB(0, 0), b2, voffB); PG8_STAGE(PG8_SA(0, 0), a2, voffA);
            PG8_WAIT_V(6); PG8_WAIT_L(0); PG8_BAR; PG8_MMA1(1, At, B0); PG8_BAR; PG8_SCHED;
            PG8_LDB(B0, 1, 0); PG8_SCHED; PG8_LDA(At, 1, 0); PG8_STAGE(PG8_SA(0, 1), a2 + hstepA, voffA);
            PG8_WAIT_V(6); PG8_WAIT_L(0); PG8_BAR; PG8_MMA1(0, At, B0); PG8_BAR; PG8_SCHED;
            PG8_LDA(At, 1, 1); PG8_STAGE(PG8_SB(1, 0), b3, voffB); PG8_STAGE(PG8_SA(1, 0), a3, voffA);
            PG8_WAIT_V(6); PG8_WAIT_L(0); PG8_BAR; PG8_MMA1(1, At, B0); PG8_BAR; PG8_SCHED;
        }
        if (wr == 0) PG8_BAR;
        E(acc, st, cur, wr, wc, fr, fq);
        if (!has_next) break;
#pragma unroll
        for (int a = 0; a < 2; ++a)
#pragma unroll
            for (int m = 0; m < 4; ++m)
#pragma unroll
                for (int n = 0; n < 2; ++n) acc[a][m][n] = (f32x4){0.f, 0.f, 0.f, 0.f};
        cur = nxt; cA = nA; cB = nB; ++ui;
        if (wr == 1) PG8_BAR;
    }
    PG8_WAIT_V(0);
    PG8_BAR;
#undef PG8_SA
#undef PG8_SB
#undef PG8_STAGE
#undef PG8_LDA
#undef PG8_LDB
#undef PG8_MMA1
#undef PG8_WAIT_V
#undef PG8_WAIT_L
#undef PG8_BAR
#undef PG8_SCHED
}
typedef f32x4 Acc1[2][4][2];
struct OneUnit { int pm; size_t tA;
    __device__ bool next(int i, Unit& u) const { if (i) return false; u.pm = pm; u.pn = 0; u.z = 0; u.offA = (size_t)pm * tA; u.offB = 0; return true; } };
struct BranchOrder1 {
    int nM, nN, G, c; size_t tA, tB, zA, zB; int paired, vc;
    __device__ bool next(int i, Unit& u) const {
        if (paired) { if (i >= 16) return false; u.z = i & 3; u.pm = vc >> 1; u.pn = 4 * (vc & 1) + (i >> 2);
            u.offA = (size_t)u.z * zA + (size_t)u.pm * tA; u.offB = (size_t)u.z * zB + (size_t)u.pn * tB; return true; }
        const int tile = (i >> 2) * G + c; if (tile >= nM * nN) return false;
        u.z = i & 3; xcd_tile_map<BR_WG>(tile, nM, nN, u.pm, u.pn);
        u.offA = (size_t)u.z * zA + (size_t)u.pm * tA; u.offB = (size_t)u.z * zB + (size_t)u.pn * tB; return true;
    }
};
struct EpiGate1 {
    static constexpr bool PERM = true;
    const bf16_t* gate; bf16_t* mb;
    __device__ __forceinline__ void operator()(const Acc1& acc, Acc1& st, const Unit& u, int wr, int wc, int fr, int fq) const {
        const int z = u.z; const int row0 = u.pm * BM + wr * 64 + fr, col = u.pn * HALF + wc * 32 + 8 * fq;
#pragma unroll
        for (int ai = 0; ai < 2; ++ai)
#pragma unroll
            for (int m = 0; m < 4; ++m) { const int row = row0 + ai * HALF + m * 16;
                f32x4 a = acc[ai][m][0], b = acc[ai][m][1];
                if (GATE8 == 2) { const v2u g8 = *(const v2u*)((const unsigned char*)gate + (size_t)row * 4096 + z * 1024 + col); const float k = 1.0f / 255.0f;
                    a[0] *= (float)(g8.x & 0xffu) * k; a[1] *= (float)((g8.x >> 8) & 0xffu) * k; a[2] *= (float)((g8.x >> 16) & 0xffu) * k; a[3] *= (float)(g8.x >> 24) * k;
                    b[0] *= (float)(g8.y & 0xffu) * k; b[1] *= (float)((g8.y >> 8) & 0xffu) * k; b[2] *= (float)((g8.y >> 16) & 0xffu) * k; b[3] *= (float)(g8.y >> 24) * k; }
                else if (GATE8 == 1) { const v2u g8 = *(const v2u*)((const unsigned char*)gate + (size_t)row * 4096 + z * 1024 + col);
                    const f32x2 g0 = __builtin_amdgcn_cvt_pk_f32_fp8((int)g8.x, false), g1 = __builtin_amdgcn_cvt_pk_f32_fp8((int)g8.x, true), g2 = __builtin_amdgcn_cvt_pk_f32_fp8((int)g8.y, false), g3 = __builtin_amdgcn_cvt_pk_f32_fp8((int)g8.y, true);
                    a[0] *= g0[0]; a[1] *= g0[1]; a[2] *= g1[0]; a[3] *= g1[1]; b[0] *= g2[0]; b[1] *= g2[1]; b[2] *= g3[0]; b[3] *= g3[1]; }
                else { const u32x4 gg = *(const u32x4*)(gate + (size_t)row * 4096 + z * 1024 + col);
                    a[0] *= bflo(gg.x); a[1] *= bfhi(gg.x); a[2] *= bflo(gg.y); a[3] *= bfhi(gg.y); b[0] *= bflo(gg.z); b[1] *= bfhi(gg.z); b[2] *= bflo(gg.w); b[3] *= bfhi(gg.w); }
                if (z == 0) { st[ai][m][0] = a; st[ai][m][1] = b; } else { st[ai][m][0] += a; st[ai][m][1] += b; }
                if (z == 3) *(u32x4*)(mb + (size_t)row * 1024 + col) = pack8(st[ai][m][0], st[ai][m][1]); }
    }
};
typedef f32x4 Acc[2][2][4][2];
#define EPI_ROWS_BEGIN const int row0 = u.pm * BM + wr * 64 + fr; _Pragma("unroll") for (int ai = 0; ai < 2; ++ai) _Pragma("unroll") for (int m = 0; m < 4; ++m) { const int row = row0 + ai * HALF + m * 16;
#define EPI_ROWS_END }

struct EpiInProj {
    static constexpr bool PERM = true;
    bf16_t *ua, *qkv, *uc, *gate; const PG8_LAS float* gl;
    __device__ __forceinline__ void operator()(const Acc& acc, const Unit& u, int wr, int wc, int fr, int fq) const {
        const int pn = u.pn;
        if (pn == 0) {
            EPI_ROWS_BEGIN
#pragma unroll
            for (int bj = 0; bj < 2; ++bj) { const int c8 = bj * HALF + wc * 32 + 8 * fq, gI = c8 >> 4, h0 = c8 & 15;
                *(u32x4*)(ua + ((size_t)(gI * 512 + (row >> 6)) * S5_LDA + (row & 63) * 16 + h0)) = pack8(acc[ai][bj][m][0], acc[ai][bj][m][1]); }
            EPI_ROWS_END
        } else if (pn == 1 || pn == 2 || pn == 6 || pn == 7) {
            const int which = (pn == 1) ? 0 : (pn == 2) ? 1 : (pn == 6) ? 2 : 3;
            const PG8_LAS float* gp = gl + which * 64;
            bf16_t* dst = qkv + (size_t)((pn < 6) ? (pn - 1) : (pn - 3)) * ((size_t)T * 256);
            f32x4 gv[2][2];
#pragma unroll
            for (int bj = 0; bj < 2; ++bj)
#pragma unroll
                for (int n = 0; n < 2; ++n) gv[bj][n] = *(const PG8_LAS f32x4*)(gp + bj * 32 + 8 * fq + 4 * n);
            EPI_ROWS_BEGIN
            float ss = 0.f;
#pragma unroll
            for (int bj = 0; bj < 2; ++bj)
#pragma unroll
                for (int n = 0; n < 2; ++n) { const f32x4 x = acc[ai][bj][m][n]; ss += (x[0] * x[0] + x[1] * x[1]) + (x[2] * x[2] + x[3] * x[3]); }
            ss += __shfl_xor(ss, 16); ss += __shfl_xor(ss, 32);
            const float rs = __builtin_amdgcn_rsqf(ss * (1.0f / 64.0f) + EPS);
#pragma unroll
            for (int bj = 0; bj < 2; ++bj)
                *(u32x4*)(dst + (size_t)row * 256 + wc * 64 + bj * 32 + 8 * fq) = pack8(acc[ai][bj][m][0] * rs * gv[bj][0], acc[ai][bj][m][1] * rs * gv[bj][1]);
            EPI_ROWS_END
        } else if (pn == 3 || pn == 8) {
            bf16_t* dst = qkv + (size_t)((pn == 3) ? 2 : 5) * ((size_t)T * 256);
            EPI_ROWS_BEGIN
#pragma unroll
            for (int bj = 0; bj < 2; ++bj) *(u32x4*)(dst + (size_t)row * 256 + bj * HALF + wc * 32 + 8 * fq) = pack8(acc[ai][bj][m][0], acc[ai][bj][m][1]);
            EPI_ROWS_END
        } else if (pn == 4 || pn == 5) {
            EPI_ROWS_BEGIN
            f32x4 o[2];
#pragma unroll
            for (int n = 0; n < 2; ++n)
#pragma unroll
                for (int e = 0; e < 4; ++e) o[n][e] = acc[ai][0][m][n][e] * sigmoidf_(acc[ai][1][m][n][e]);
            *(u32x4*)(uc + (size_t)row * 256 + (pn - 4) * 128 + wc * 32 + 8 * fq) = pack8(o[0], o[1]);
            EPI_ROWS_END
        } else {
            const int gt = pn - 9;
            EPI_ROWS_BEGIN
#pragma unroll
            for (int bj = 0; bj < 2; ++bj) { f32x4 o[2];
#pragma unroll
                for (int n = 0; n < 2; ++n)
#pragma unroll
                    for (int e = 0; e < 4; ++e) o[n][e] = sigmoidf_(acc[ai][bj][m][n][e]);
                *(u32x4*)(gate + (size_t)row * 4096 + gt * 256 + bj * HALF + wc * 32 + 8 * fq) = pack8(o[0], o[1]); }
            EPI_ROWS_END
        }
    }
};
struct EpiGateSig {
    static constexpr bool PERM = true;
    bf16_t* gate;
    __device__ __forceinline__ void operator()(const Acc& acc, const Unit& u, int wr, int wc, int fr, int fq) const {
        EPI_ROWS_BEGIN
#pragma unroll
        for (int bj = 0; bj < 2; ++bj) { f32x4 o[2];
#pragma unroll
            for (int n = 0; n < 2; ++n)
#pragma unroll
                for (int e = 0; e < 4; e += 2) { const f32x2 r = sigmoid2((f32x2){acc[ai][bj][m][n][e], acc[ai][bj][m][n][e + 1]} * (1.0f / 64.0f)) * ((GATE8 == 2) ? 255.0f : 1.0f); o[n][e] = r[0]; o[n][e + 1] = r[1]; }
            if (GATE8 == 2) { v2u w = {0u, 0u};
#pragma unroll
                for (int e = 0; e < 4; ++e) { w.x = __builtin_amdgcn_cvt_pk_u8_f32(o[0][e], e, w.x); w.y = __builtin_amdgcn_cvt_pk_u8_f32(o[1][e], e, w.y); }
                *(v2u*)((unsigned char*)gate + (size_t)row * 4096 + u.pn * BM + bj * HALF + wc * 32 + 8 * fq) = w; }
            else if (GATE8 == 1) { v2u w; w.x = pk4_fp8(o[0][0], o[0][1], o[0][2], o[0][3]); w.y = pk4_fp8(o[1][0], o[1][1], o[1][2], o[1][3]); *(v2u*)((unsigned char*)gate + (size_t)row * 4096 + u.pn * BM + bj * HALF + wc * 32 + 8 * fq) = w; }
            else *(u32x4*)(gate + (size_t)row * 4096 + u.pn * BM + bj * HALF + wc * 32 + 8 * fq) = pack8(o[0], o[1]); }
        EPI_ROWS_END
    }
};
struct EpiZ {
    static constexpr bool PERM = false;
    float* z;
    __device__ __forceinline__ void operator()(const Acc& acc, const Unit& u, int wr, int wc, int fr, int fq) const {
        EPI_ROWS_BEGIN
#pragma unroll
        for (int n = 0; n < 2; ++n) *(f32x4*)(z + ((size_t)(u.z * 512 + row)) * 128 + wc * 32 + 16 * n + 4 * fq) = acc[ai][0][m][n];
        EPI_ROWS_END
    }
};
struct EpiY {
    static constexpr bool PERM = true;
    const bf16_t* ua; const float* dskip; bf16_t* yp;
    __device__ __forceinline__ void operator()(const Acc& acc, const Unit& u, int wr, int wc, int fr, int fq) const {
        const int gI = u.z, h0 = 8 * (fq & 1);
        const f32x4 d0 = *(const f32x4*)(dskip + gI * 16 + h0), d1 = *(const f32x4*)(dskip + gI * 16 + h0 + 4);
        EPI_ROWS_BEGIN
#pragma unroll
        for (int bj = 0; bj < 2; ++bj) { const int col = u.pn * BM + bj * HALF + wc * 32 + 8 * fq;
            const u32x4 uu = *(const u32x4*)(ua + ((size_t)(gI * 512 + row)) * S5_LDA + col);
            f32x4 a = acc[ai][bj][m][0], b = acc[ai][bj][m][1];
            a[0] += d0[0] * bflo(uu.x); a[1] += d0[1] * bfhi(uu.x); a[2] += d0[2] * bflo(uu.y); a[3] += d0[3] * bfhi(uu.y);
            b[0] += d1[0] * bflo(uu.z); b[1] += d1[1] * bfhi(uu.z); b[2] += d1[2] * bflo(uu.w); b[3] += d1[3] * bfhi(uu.w);
#pragma unroll
            for (int e = 0; e < 4; ++e) { a[e] = gelu_tanh(a[e]); b[e] = gelu_tanh(b[e]); }
            *(u32x4*)(yp + ((size_t)row * 64 + (col >> 4)) * 256 + gI * 16 + h0) = pack8(a, b); }
        EPI_ROWS_END
    }
};
struct EpiGlu {
    static constexpr bool PERM = true;
    const bf16_t* yp; bf16_t* ycat;
    __device__ __forceinline__ void operator()(const Acc& acc, const Unit& u, int wr, int wc, int fr, int fq) const {
        EPI_ROWS_BEGIN
#pragma unroll
        for (int bj = 0; bj < 2; ++bj) { const int col = bj * HALF + wc * 32 + 8 * fq;
            const u32x4 yy = *(const u32x4*)(yp + (size_t)row * 256 + col);
            f32x4 a = acc[ai][bj][m][0], b = acc[ai][bj][m][1];
            a[0] = bflo(yy.x) * sigmoidf_(a[0]); a[1] = bfhi(yy.x) * sigmoidf_(a[1]); a[2] = bflo(yy.y) * sigmoidf_(a[2]); a[3] = bfhi(yy.y) * sigmoidf_(a[3]);
            b[0] = bflo(yy.z) * sigmoidf_(b[0]); b[1] = bfhi(yy.z) * sigmoidf_(b[1]); b[2] = bflo(yy.w) * sigmoidf_(b[2]); b[3] = bfhi(yy.w) * sigmoidf_(b[3]);
            *(u32x4*)(ycat + (size_t)row * 1024 + col) = pack8(a, b); }
        EPI_ROWS_END
    }
};
template <bool SC64> struct EpiResid {
    static constexpr bool PERM = true; static constexpr float sc = SC64 ? (1.0f / 64.0f) : 1.0f;
    const float* base32; const bf16_t* base16; bf16_t* out; float* ss; unsigned char* out8; int flags;
    __device__ __forceinline__ void operator()(const Acc& acc, const Unit& u, int wr, int wc, int fr, int fq) const {
        EPI_ROWS_BEGIN
        float q = 0.f;
#pragma unroll
        for (int bj = 0; bj < 2; ++bj) { const size_t off = (size_t)row * 1024 + u.pn * BM + bj * HALF + wc * 32 + 8 * fq;
            f32x4 a, b;
            if (flags & 1) { a = *(const f32x4*)(base32 + off); b = *(const f32x4*)(base32 + off + 4); }
            else { const u32x4 r = *(const u32x4*)(base16 + off); a = (f32x4){bflo(r.x), bfhi(r.x), bflo(r.y), bfhi(r.y)}; b = (f32x4){bflo(r.z), bfhi(r.z), bflo(r.w), bfhi(r.w)}; }
            const u32x4 w = pack8(a + acc[ai][bj][m][0] * sc, b + acc[ai][bj][m][1] * sc); *(u32x4*)(out + off) = w;
            if (flags & 2) { const float x0 = bflo(w.x), x1 = bfhi(w.x), x2 = bflo(w.y), x3 = bfhi(w.y), x4 = bflo(w.z), x5 = bfhi(w.z), x6 = bflo(w.w), x7 = bfhi(w.w);
                q += ((x0 * x0 + x1 * x1) + (x2 * x2 + x3 * x3)) + ((x4 * x4 + x5 * x5) + (x6 * x6 + x7 * x7));
                if (flags & 4) { v2u w8; w8.x = pk4_fp8(x0, x1, x2, x3); w8.y = pk4_fp8(x4, x5, x6, x7); *(v2u*)(out8 + off) = w8; } } }
        if (flags & 2) { q += __shfl_xor(q, 16); q += __shfl_xor(q, 32); if (fq == 0) ss[(size_t)row * 16 + u.pn * 4 + wc] = q; }
        EPI_ROWS_END
    }
};
template <bool H8> struct EpiSwiGlu {
    static constexpr bool PERM = true;
    bf16_t* h; float sc; const float* ss; int use_ss;
    __device__ __forceinline__ void operator()(const Acc& acc, const Unit& u, int wr, int wc, int fr, int fq) const {
        EPI_ROWS_BEGIN
        float rsc = sc;
        if (use_ss) { const f32x4 s0 = *(const f32x4*)(ss + (size_t)row * 16), s1 = *(const f32x4*)(ss + (size_t)row * 16 + 4), s2 = *(const f32x4*)(ss + (size_t)row * 16 + 8), s3 = *(const f32x4*)(ss + (size_t)row * 16 + 12);
            const f32x4 t = (s0 + s1) + (s2 + s3); rsc = sc * __builtin_amdgcn_rsqf(((t[0] + t[1]) + (t[2] + t[3])) * (1.0f / D) + EPS); }
        f32x4 o[2];
#pragma unroll
        for (int n = 0; n < 2; ++n)
#pragma unroll
            for (int e = 0; e < 4; e += 2) { const f32x2 a = (f32x2){acc[ai][0][m][n][e], acc[ai][0][m][n][e + 1]} * rsc, b = (f32x2){acc[ai][1][m][n][e], acc[ai][1][m][n][e + 1]} * rsc;
                const f32x2 r = (a * b) * sigmoid2(a); o[n][e] = r[0]; o[n][e + 1] = r[1]; }
        if constexpr (H8) { v2u w; w.x = pk4_fp8(o[0][0], o[0][1], o[0][2], o[0][3]); w.y = pk4_fp8(o[1][0], o[1][1], o[1][2], o[1][3]); *(v2u*)((unsigned char*)h + (size_t)row * FF + u.pn * 128 + wc * 32 + 8 * fq) = w; }
        else *(u32x4*)(h + (size_t)row * FF + u.pn * 128 + wc * 32 + 8 * fq) = pack8(o[0], o[1]);
        EPI_ROWS_END
    }
};
struct EpiStore {
    static constexpr bool PERM = true;
    bf16_t* o; float sc;
    __device__ __forceinline__ void operator()(const Acc& acc, const Unit& u, int wr, int wc, int fr, int fq) const {
        EPI_ROWS_BEGIN
#pragma unroll
        for (int bj = 0; bj < 2; ++bj) *(u32x4*)(o + (size_t)row * 1024 + u.pn * BM + bj * HALF + wc * 32 + 8 * fq) = pack8(acc[ai][bj][m][0] * sc, acc[ai][bj][m][1] * sc);
        EPI_ROWS_END
    }
};
}

#define XB_TMO      128
#define XB_XCNT(j)  (256  + 64 * (j))
#define XB_XSUB(j)  (1280 + 64 * (j))
#define XB_XGEN(j)  (2304 + 64 * (j))
#define XB_TOP      3328
#define XB_TOPGEN   3392
#define XCD_BAR_WORDS 3456
#define XB_SPIN_CAP (1u << 18)
__device__ __forceinline__ unsigned xb_ld(unsigned* p)              { return __hip_atomic_load(p, __ATOMIC_RELAXED, __HIP_MEMORY_SCOPE_AGENT); }
__device__ __forceinline__ unsigned xb_add(unsigned* p, unsigned v) { return __hip_atomic_fetch_add(p, v, __ATOMIC_RELAXED, __HIP_MEMORY_SCOPE_AGENT); }
__device__ __forceinline__ unsigned xb_xcc_id() { return (unsigned)__builtin_amdgcn_s_getreg((3 << 11) | 20) & 0xFu; }
#define XB_SPIN(cond, bar) do { unsigned _sp = 0; while (cond) { __builtin_amdgcn_s_sleep(1); \
    if ((++_sp & 255u) == 0u) { if (xb_ld(&(bar)[XB_TMO])) break; if (_sp > XB_SPIN_CAP) { atomicAdd(&(bar)[XB_TMO], 1u); break; } } } } while (0)
struct XcdBarrier { unsigned* bar; unsigned x; volatile LAS unsigned* st; };
__device__ __forceinline__ XcdBarrier xcd_barrier_post(unsigned* bar, volatile LAS unsigned* st) {
    XcdBarrier b; b.bar = bar; b.x = xb_xcc_id(); b.st = st;
    if (threadIdx.x == 0) (void)xb_add(&bar[XB_XCNT(b.x)], 1u);
    return b;
}
__device__ __forceinline__ void xcd_barrier_complete(unsigned* bar, unsigned x, unsigned& nloc, unsigned& nx) {
    const unsigned G = gridDim.x * gridDim.y * gridDim.z;
    unsigned sum, cnt, mine, sp = 0u;
    for (;;) {
        sum = 0u; cnt = 0u; mine = 0u;
#pragma unroll
        for (unsigned j = 0; j < 16; ++j) { const unsigned c = xb_ld(&bar[XB_XCNT(j)]); sum += c; cnt += (c > 0u) ? 1u : 0u; mine = (j == x) ? c : mine; }
        if (sum == G) break;
        __builtin_amdgcn_s_sleep(1);
        if ((++sp & 255u) == 0u) { if (xb_ld(&bar[XB_TMO])) break; if (sp > XB_SPIN_CAP) { atomicAdd(&bar[XB_TMO], 1u); break; } }
    }
    nloc = mine > 0u ? mine : 1u; nx = cnt > 0u ? cnt : 1u;
}
__device__ __forceinline__ void xcd_barrier(const XcdBarrier& b) {
    asm volatile("s_waitcnt vmcnt(0)" ::: "memory");
    __syncthreads();
    if (threadIdx.x == 0) {
        unsigned* bar = b.bar;
        __builtin_amdgcn_s_waitcnt(0);
        unsigned nloc = b.st[0], nx = b.st[1];
        if (nloc == 0u) { xcd_barrier_complete(bar, b.x, nloc, nx); b.st[0] = nloc; b.st[1] = nx; }
        const unsigned old = xb_add(&bar[XB_XSUB(b.x)], 1u);
        const unsigned gen = old / nloc;
        if (old + 1u == (gen + 1u) * nloc) {
            __builtin_amdgcn_fence(__ATOMIC_RELEASE, "agent");
            asm volatile("s_waitcnt vmcnt(0)" ::: "memory");
            const unsigned og = xb_add(&bar[XB_TOP], 1u);
            const unsigned tg = og / nx;
            if (og + 1u == (tg + 1u) * nx) xb_add(&bar[XB_TOPGEN], 1u);
            else XB_SPIN(xb_ld(&bar[XB_TOPGEN]) == tg, bar);
            __builtin_amdgcn_fence(__ATOMIC_ACQUIRE, "agent");
            xb_add(&bar[XB_XGEN(b.x)], 1u);
            asm volatile("s_waitcnt vmcnt(0)" ::: "memory");
        } else {
            XB_SPIN(xb_ld(&bar[XB_XGEN(b.x)]) == gen, bar);
            __builtin_amdgcn_fence(__ATOMIC_ACQUIRE, "agent");
            asm volatile("s_waitcnt vmcnt(0)" ::: "memory");
        }
    }
    __syncthreads();
}

struct Args { const float* in[32]; float* out; unsigned char* ws; int gp_lo, gp_hi; };
enum { I_X = 0, I_GMIX, I_WIN, I_BFORGET, I_FQG, I_FKG, I_SQG, I_SKG, I_LRE, I_LIM, I_LDT, I_BRE, I_BIM, I_CRE, I_CIM, I_S5D, I_WGLU, I_CONVW, I_CONVB, I_LNG, I_LNB,
       I_WBR, I_WOUT, I_GFFN, I_W1, I_W3, I_W2, I_RW, I_RB, I_MW1, I_MW3, I_MW2 };
constexpr int NPH = 12, GP_FINAL = DEPTH * NPH, GP_TOTAL = GP_FINAL + 1;

struct Frame { LAS unsigned char* lds; int tid, lane, wave, vcu, G, gw, NGW; const Args* a; unsigned char* ws; };

__device__ __forceinline__ void transpose_item(const float* W, int ldw, bf16* WT, int ldt, int k0, int src_col0, int dst_row0, LAS float* scr, int lane, const float* ks = nullptr) {
    f32x4 ld[8];
#pragma unroll
    for (int i = 0; i < 8; ++i) ld[i] = *(const f32x4*)(W + (size_t)(k0 + 8 * i + (lane >> 3)) * ldw + src_col0 + 4 * (lane & 7));
#pragma unroll
    for (int i = 0; i < 8; ++i) { LAS float* d = scr + (8 * i + (lane >> 3)) * 33 + 4 * (lane & 7); const float s = ks ? ks[k0 + 8 * i + (lane >> 3)] : 1.0f; d[0] = ld[i][0] * s; d[1] = ld[i][1] * s; d[2] = ld[i][2] * s; d[3] = ld[i][3] * s; }
    LDS_WAIT(); asm volatile("" ::: "memory");
    const int c = lane & 7;
#pragma unroll
    for (int j = 0; j < 4; ++j) { const int n = (lane >> 3) + 8 * j; const LAS float* s = scr + (8 * c) * 33 + n;
        v4u o; o.x = pk2(s[0 * 33], s[1 * 33]); o.y = pk2(s[2 * 33], s[3 * 33]); o.z = pk2(s[4 * 33], s[5 * 33]); o.w = pk2(s[6 * 33], s[7 * 33]);
        *(GAS v4u*)(WT + (size_t)(dst_row0 + n) * ldt + k0 + 8 * c) = o; }
    LDS_WAIT(); asm volatile("" ::: "memory");
}
__device__ __forceinline__ void transpose_item_f8(const float* W, int ldw, unsigned char* WT, int ldt, int k0, int src_col0, int dst_row0, LAS float* scr, int lane, float sc, const float* ks = nullptr) {
    f32x4 ld[8];
#pragma unroll
    for (int i = 0; i < 8; ++i) ld[i] = *(const f32x4*)(W + (size_t)(k0 + 8 * i + (lane >> 3)) * ldw + src_col0 + 4 * (lane & 7));
#pragma unroll
    for (int i = 0; i < 8; ++i) { LAS float* d = scr + (8 * i + (lane >> 3)) * 33 + 4 * (lane & 7); const float s = ks ? sc * ks[k0 + 8 * i + (lane >> 3)] : sc; d[0] = ld[i][0] * s; d[1] = ld[i][1] * s; d[2] = ld[i][2] * s; d[3] = ld[i][3] * s; }
    LDS_WAIT(); asm volatile("" ::: "memory");
    const int c = lane & 7;
#pragma unroll
    for (int j = 0; j < 4; ++j) { const int n = (lane >> 3) + 8 * j; const LAS float* s = scr + (8 * c) * 33 + n;
        v2u o; o.x = pk4_fp8(s[0 * 33], s[1 * 33], s[2 * 33], s[3 * 33]); o.y = pk4_fp8(s[4 * 33], s[5 * 33], s[6 * 33], s[7 * 33]);
        *(GAS v2u*)(WT + (size_t)(dst_row0 + n) * ldt + k0 + 8 * c) = o; }
    LDS_WAIT(); asm volatile("" ::: "memory");
}
__device__ __forceinline__ int win_src_col(int blk) {
    const int tile = blk >> 3, j = blk & 7, bj = j >> 2, hh = j & 3;
    if (tile == 0) return 32 * j;
    if (tile == 1 || tile == 2) return 256 + 256 * (tile - 1) + 64 * hh + 32 * bj;
    if (tile == 3) return 768 + 32 * j;
    if (tile == 4 || tile == 5) return (j < 4) ? (1028 + 128 * (tile - 4) + 32 * j) : (1284 + 128 * (tile - 4) + 32 * (j - 4));
    if (tile == 6 || tile == 7) return 1540 + 256 * (tile - 6) + 64 * hh + 32 * bj;
    if (tile == 8) return 2052 + 32 * j;
    return 2308 + 256 * (tile - 9) + 32 * j;
}
constexpr int CONV_NIN = 200 * 16, CONV_NBR = 4 * 32 * 4, CONV_NOUT = 32 * 16, CONV_NGLU = 8 * 4, CONV_NUP1 = 176 * 16, CONV_NDN1 = 32 * 44;
constexpr int CONV_NMIX = CONV_NIN + CONV_NBR + CONV_NOUT + CONV_NGLU, CONV_CHUNK = 64;
__device__ __forceinline__ int conv_ffn_items(int layer) { return (CONV_NUP1 + CONV_NDN1) * ((layer & 1) ? NE : 1); }
__device__ __forceinline__ void convert_item(Frame& F, int layer, int it, LAS float* scr) {
    const Args& A = *F.a; unsigned char* ws = F.ws;
    const bool moe = (layer & 1) != 0; const int j2 = layer >> 1, ne = moe ? NE : 1;
    const int n_up = CONV_NUP1 * ne;
    int r = it;
    if (r < CONV_NIN) { const int blk = r >> 4, kb = r & 15;
        if (F8_GATES && blk >= 72) transpose_item_f8(A.in[I_WIN] + (size_t)layer * D * DP, DP, (unsigned char*)(ws + WS_WIN8), D, 64 * kb, win_src_col(blk), 32 * (blk - 72), scr, F.lane, 64.0f);
        else transpose_item(A.in[I_WIN] + (size_t)layer * D * DP, DP, (bf16*)(ws + WS_WIN), D, 64 * kb, win_src_col(blk), 32 * blk, scr, F.lane);
        return; } r -= CONV_NIN;
    if (r < CONV_NBR) { const int z = r >> 7, q = r & 127, blk = q >> 2, kb = q & 3;
        transpose_item(A.in[I_WBR] + ((size_t)layer * 4 + z) * 256 * D, D, (bf16*)(ws + WS_WBR) + (size_t)z * D * 256, 256, 64 * kb, 32 * blk, 32 * blk, scr, F.lane); return; } r -= CONV_NBR;
    if (r < CONV_NOUT) { const int blk = r >> 4, kb = r & 15; transpose_item(A.in[I_WOUT] + (size_t)layer * D * D, D, (bf16*)(ws + WS_WOUT), D, 64 * kb, 32 * blk, 32 * blk, scr, F.lane); return; } r -= CONV_NOUT;
    if (r < CONV_NGLU) { const int blk = r >> 2, kb = r & 3; transpose_item(A.in[I_WGLU] + (size_t)layer * 256 * 256, 256, (bf16*)(ws + WS_WGLU), 256, 64 * kb, 32 * blk, 32 * blk, scr, F.lane); return; } r -= CONV_NGLU;
    if (r < n_up) { const int e = r / CONV_NUP1, q = r % CONV_NUP1, blk = q >> 4, kb = q & 15, tile = blk >> 3, jj = blk & 7;
        const float* w1 = moe ? A.in[I_MW1] + ((size_t)j2 * NE + e) * D * FF : A.in[I_W1] + (size_t)j2 * D * FF;
        const float* w3 = moe ? A.in[I_MW3] + ((size_t)j2 * NE + e) * D * FF : A.in[I_W3] + (size_t)j2 * D * FF;
        const float* ks = (FUSE_DENSE_NORM && !moe) ? A.in[I_GFFN] + layer * D : nullptr;
        if (moe ? (F8_MOE_UP != 0) : (DENSE8(layer) != 0)) transpose_item_f8(jj < 4 ? w1 : w3, FF, (unsigned char*)(ws + WS_WUP) + (size_t)e * 5632 * D, D, 64 * kb, 128 * tile + 32 * (jj & 3), 32 * blk, scr, F.lane, 64.0f, ks);
        else transpose_item(jj < 4 ? w1 : w3, FF, (bf16*)(ws + WS_WUP) + (size_t)e * 5632 * D, D, 64 * kb, 128 * tile + 32 * (jj & 3), 32 * blk, scr, F.lane, ks);
        return; } r -= n_up;
    { const int e = r / CONV_NDN1, q = r % CONV_NDN1, blk = q / 44, kb = q % 44;
        const float* w2 = moe ? A.in[I_MW2] + ((size_t)j2 * NE + e) * FF * D : A.in[I_W2] + (size_t)j2 * FF * D;
        if (moe ? (F8_MOE_DN != 0) : (DENSE8(layer) != 0)) transpose_item_f8(w2, D, (unsigned char*)(ws + WS_WDN) + (size_t)e * D * FF, FF, 64 * kb, 32 * blk, 32 * blk, scr, F.lane, 64.0f);
        else transpose_item(w2, D, (bf16*)(ws + WS_WDN) + (size_t)e * D * FF, FF, 64 * kb, 32 * blk, 32 * blk, scr, F.lane); }
}
__device__ __forceinline__ void phase_convert(Frame& F, int layer) {
    LAS float* scr = (LAS float*)(F.lds + F.wave * 16384);
    for (int it = F.gw; it < CONV_NMIX; it += F.NGW) convert_item(F, layer, it, scr);
}
__device__ __forceinline__ void convert_ffn_chunk(Frame& F, int layer, int chunk) {
    LAS float* scr = (LAS float*)(F.lds + F.wave * 16384); const int nf = conv_ffn_items(layer);
    for (int j = F.wave; j < CONV_CHUNK; j += NWAVES) { const int it = chunk * CONV_CHUNK + j; if (it < nf) convert_item(F, layer, CONV_NMIX + it, scr); }
}
struct S5P { float lr, li, dt, kr, ki; };
__device__ __forceinline__ S5P s5_params(const Args& A, int layer, int g, int p) {
    S5P q; q.lr = A.in[I_LRE][(layer * 16 + g) * 64 + p]; q.li = A.in[I_LIM][(layer * 16 + g) * 64 + p]; q.dt = expf(A.in[I_LDT][layer * 16 + g]);
    const float mag = expf(q.lr * q.dt), abr = mag * cosf(q.li * q.dt), abi = mag * sinf(q.li * q.dt);
    const float nr = abr - 1.0f, ni = abi, den = q.lr * q.lr + q.li * q.li;
    q.kr = (nr * q.lr + ni * q.li) / den; q.ki = (ni * q.lr - nr * q.li) / den; return q;
}
__device__ __forceinline__ void s5_pow(const S5P& q, float n, float& pr, float& pi) { const float m = expf(n * q.lr * q.dt), a = n * q.li * q.dt; pr = m * cosf(a); pi = m * sinf(a); }
__device__ __forceinline__ void phase_kfun(Frame& F, int layer) {
    const Args& A = *F.a; float* kf = (float*)(F.ws + WS_KFUN);
    for (int it = F.gw; it < 16 * 64; it += F.NGW) {
        const int g = it >> 6, tau = it & 63, lane = F.lane;
        const S5P q = s5_params(A, layer, g, lane); float pr, pi; s5_pow(q, (float)tau, pr, pi);
        const float wr_ = pr * q.kr - pi * q.ki, wi_ = pr * q.ki + pi * q.kr;
        const int h = lane >> 2, hp0 = 4 * (lane & 3);
        const float* cre = A.in[I_CRE] + ((size_t)(layer * 16 + g) * 16 + h) * 64; const float* cim = A.in[I_CIM] + ((size_t)(layer * 16 + g) * 16 + h) * 64;
        const float* bre = A.in[I_BRE] + (size_t)(layer * 16 + g) * 64 * 16 + hp0; const float* bim = A.in[I_BIM] + (size_t)(layer * 16 + g) * 64 * 16 + hp0;
        f32x4 acc = {0.f, 0.f, 0.f, 0.f};
        for (int p = 0; p < 64; ++p) {
            const float wpr = __shfl(wr_, p), wpi = __shfl(wi_, p);
            const float cr = cre[p], ci = cim[p], cwr = cr * wpr - ci * wpi, cwi = cr * wpi + ci * wpr;
            const f32x4 br = *(const f32x4*)(bre + p * 16), bi = *(const f32x4*)(bim + p * 16);
            acc += cwr * br - cwi * bi;
        }
        *(f32x4*)(kf + ((size_t)(g * 64 + tau) * 16 + h) * 16 + hp0) = acc;
    }
}
__device__ __forceinline__ void moe_starts(Frame& F, int j2, int (&st)[NE + 1]) {
    const unsigned* cnt = (const unsigned*)(F.ws + WS_CTL) + CW_MOE + 64 * j2; int s = 0;
#pragma unroll
    for (int e = 0; e < NE; ++e) { st[e] = s; const int c = (int)__hip_atomic_load(cnt + e, __ATOMIC_RELAXED, __HIP_MEMORY_SCOPE_AGENT); s += (c + 255) & ~255; }
    st[NE] = s;
}
__device__ __forceinline__ void moe_combine_row(Frame& F, int row, f32x4 (&v)[4], const int (&st)[NE + 1]) {
    const unsigned* rt = (const unsigned*)(F.ws + WS_ROUTE) + (size_t)row * 8;
    const v4u rr = *(const v4u*)rt; unsigned s0 = rr.z, s1 = rr.w;
#pragma unroll
    for (int e = 0; e < NE; ++e) { if ((int)rr.x == e) s0 += (unsigned)st[e]; if ((int)rr.y == e) s1 += (unsigned)st[e]; }
    const float w0 = __builtin_bit_cast(float, rt[4]), w1 = __builtin_bit_cast(float, rt[5]);
    const bf16* yp = (const bf16*)(F.ws + WS_XNP);
#pragma unroll
    for (int j = 0; j < 4; ++j) { const v2u a = *(const v2u*)(yp + (size_t)s0 * D + 4 * F.lane + 256 * j), b = *(const v2u*)(yp + (size_t)s1 * D + 4 * F.lane + 256 * j);
        v[j][0] += w0 * bflo(a.x) + w1 * bflo(b.x); v[j][1] += w0 * bfhi(a.x) + w1 * bfhi(b.x); v[j][2] += w0 * bflo(a.y) + w1 * bflo(b.y); v[j][3] += w0 * bfhi(a.y) + w1 * bfhi(b.y); }
}
__device__ __forceinline__ void phase_rows_mixer(Frame& F, int layer) {
    const Args& A = *F.a; const int lane = F.lane;
    const float* xin = A.in[I_X]; bf16* xb = (bf16*)(F.ws + WS_XB); const bool first = (layer == 0), comb = (layer > 0) && (((layer - 1) & 1) != 0);
    f32x4 gv[4]; f32x4 wf[4][4];
#pragma unroll
    for (int j = 0; j < 4; ++j) { gv[j] = *(const f32x4*)(A.in[I_GMIX] + layer * D + 4 * lane + 256 * j);
#pragma unroll
        for (int e = 0; e < 4; ++e) wf[j][e] = *(const f32x4*)(A.in[I_WIN] + (size_t)layer * D * DP + (size_t)(4 * lane + 256 * j + e) * DP + 1024); }
    const f32x4 bf = *(const f32x4*)(A.in[I_BFORGET] + layer * 4);
    bf16* xn = (bf16*)(F.ws + WS_XN); float* lf = (float*)(F.ws + WS_LF); unsigned char* xn8 = F.ws + WS_XN8;
    int st[NE + 1];
#pragma unroll
    for (int e = 0; e <= NE; ++e) st[e] = 0;
    if (comb) moe_starts(F, (layer - 1) >> 1, st);
    for (int row = F.gw; row < T; row += F.NGW) {
        f32x4 v[4]; float ss = 0.f;
        if (first) {
#pragma unroll
            for (int j = 0; j < 4; ++j) v[j] = *(const f32x4*)(xin + (size_t)row * D + 4 * lane + 256 * j);
        } else {
#pragma unroll
            for (int j = 0; j < 4; ++j) { const v2u r = *(const v2u*)(xb + (size_t)row * D + 4 * lane + 256 * j); v[j] = (f32x4){bflo(r.x), bfhi(r.x), bflo(r.y), bfhi(r.y)}; }
        }
        if (comb) { moe_combine_row(F, row, v, st);
#pragma unroll
            for (int j = 0; j < 4; ++j) { v2u o; o.x = pk2(v[j][0], v[j][1]); o.y = pk2(v[j][2], v[j][3]); *(v2u*)(xb + (size_t)row * D + 4 * lane + 256 * j) = o;
                v[j] = (f32x4){bflo(o.x), bfhi(o.x), bflo(o.y), bfhi(o.y)}; } }
#pragma unroll
        for (int j = 0; j < 4; ++j) ss += (v[j][0] * v[j][0] + v[j][1] * v[j][1]) + (v[j][2] * v[j][2] + v[j][3] * v[j][3]);
        const float rs = 1.0f / sqrtf(wave_sum(ss) * (1.0f / D) + EPS);
        f32x4 fl = {0.f, 0.f, 0.f, 0.f};
#pragma unroll
        for (int j = 0; j < 4; ++j) { const f32x4 h = v[j] * rs * gv[j];
            v2u o; o.x = pk2(h[0], h[1]); o.y = pk2(h[2], h[3]); *(v2u*)(xn + (size_t)row * D + 4 * lane + 256 * j) = o;
            if (F8_GATES) *(unsigned*)(xn8 + (size_t)row * D + 4 * lane + 256 * j) = pk4_fp8(h[0], h[1], h[2], h[3]);
#pragma unroll
            for (int e = 0; e < 4; ++e) fl += h[e] * wf[j][e]; }
#pragma unroll
        for (int e = 0; e < 4; ++e) fl[e] = wave_sum(fl[e]);
        if (lane == 0) { f32x4 o;
#pragma unroll
            for (int e = 0; e < 4; ++e) { const float xx = fl[e] + bf[e]; o[e] = (fminf(xx, 0.f) - log1pf(expf(-fabsf(xx)))) * LOG2E; }
            *(f32x4*)(lf + (size_t)row * 4) = o; }
    }
}
__device__ __forceinline__ void phase_s5_tables(Frame& F, int layer) {
    const Args& A = *F.a; const int lane = F.lane;
    bf16* wz = (bf16*)(F.ws + WS_WZ); bf16* wy = (bf16*)(F.ws + WS_WY); const float* kf = (const float*)(F.ws + WS_KFUN);
    for (int it = F.gw; it < 16 * 256; it += F.NGW) {
        const int g = it >> 8, rowz = it & 255; bf16* dst = wz + ((size_t)(g * 256 + rowz)) * 1024 + lane * 16;
        v4u o0 = {0u, 0u, 0u, 0u}, o1 = {0u, 0u, 0u, 0u};
        if (rowz < 128) { const int p = rowz >> 1, ri = rowz & 1; const S5P q = s5_params(A, layer, g, p); float pr, pi; s5_pow(q, (float)(63 - lane), pr, pi);
            const float wr_ = pr * q.kr - pi * q.ki, wi_ = pr * q.ki + pi * q.kr;
            const float* bre = A.in[I_BRE] + ((size_t)(layer * 16 + g) * 64 + p) * 16; const float* bim = A.in[I_BIM] + ((size_t)(layer * 16 + g) * 64 + p) * 16;
            float val[16];
#pragma unroll
            for (int h = 0; h < 16; ++h) { const float br = bre[h], bi = bim[h]; val[h] = ri == 0 ? (wr_ * br - wi_ * bi) : (wr_ * bi + wi_ * br); }
            o0 = (v4u){pk2(val[0], val[1]), pk2(val[2], val[3]), pk2(val[4], val[5]), pk2(val[6], val[7])};
            o1 = (v4u){pk2(val[8], val[9]), pk2(val[10], val[11]), pk2(val[12], val[13]), pk2(val[14], val[15])}; }
        *(v4u*)dst = o0; *(v4u*)(dst + 8) = o1;
    }
    for (int it = F.gw; it < 16 * 1024; it += F.NGW) {
        const int g = it >> 10, n = it & 1023, t = n >> 4, h = n & 15; bf16* dst = wy + ((size_t)(g * 1024 + n)) * S5_LDA;
        v4u o0 = {0u, 0u, 0u, 0u}, o1 = {0u, 0u, 0u, 0u};
        if (lane <= t) { const float* src = kf + ((size_t)(g * 64 + (t - lane)) * 16 + h) * 16;
            const f32x4 a = *(const f32x4*)src, b = *(const f32x4*)(src + 4), c = *(const f32x4*)(src + 8), d = *(const f32x4*)(src + 12);
            o0 = (v4u){pk2(a[0], a[1]), pk2(a[2], a[3]), pk2(b[0], b[1]), pk2(b[2], b[3])}; o1 = (v4u){pk2(c[0], c[1]), pk2(c[2], c[3]), pk2(d[0], d[1]), pk2(d[2], d[3])}; }
        *(v4u*)(dst + lane * 16) = o0; *(v4u*)(dst + lane * 16 + 8) = o1;
        const S5P q = s5_params(A, layer, g, lane); float pr, pi; s5_pow(q, (float)(t + 1), pr, pi);
        const float cr = A.in[I_CRE][((size_t)(layer * 16 + g) * 16 + h) * 64 + lane], ci = A.in[I_CIM][((size_t)(layer * 16 + g) * 16 + h) * 64 + lane];
        *(unsigned*)(dst + 1024 + 2 * lane) = pk2(cr * pr - ci * pi, -(cr * pi + ci * pr));
    }
}
__device__ __forceinline__ void phase_cumsum(Frame& F) {
    const int first = (gridDim.x >= 160) ? 128 : 0;
    if ((int)blockIdx.x < first || (int)blockIdx.x >= first + 32) return;
    const int bh = (int)blockIdx.x - first, b = bh >> 2, h = bh & 3, tid = F.tid;
    const float* lf = (const float*)(F.ws + WS_LF); float* cum = (float*)(F.ws + WS_CUM);
    LAS float* wtot = (LAS float*)(F.lds);
    float v[8]; float run = 0.f;
#pragma unroll
    for (int i = 0; i < 8; ++i) { run += lf[((size_t)b * SEQ + tid * 8 + i) * 4 + h]; v[i] = run; }
    float incl = run;
#pragma unroll
    for (int o = 1; o < 64; o <<= 1) { const float n = __shfl_up(incl, o); if (F.lane >= o) incl += n; }
    if (F.lane == 63) wtot[F.wave] = incl;
    __syncthreads();
    float base = incl - run;
    for (int w = 0; w < F.wave; ++w) base += wtot[w];
#pragma unroll
    for (int i = 0; i < 8; ++i) cum[(size_t)bh * SEQ + tid * 8 + i] = base + v[i];
    __syncthreads();
}
__device__ __forceinline__ void phase_conv(Frame& F, int layer) {
    const Args& A = *F.a; const int lane = F.lane;
    LAS f32x4* wl = (LAS f32x4*)F.lds;
    for (int i = F.tid; i < 31 * 64; i += NWAVES * 64) wl[i] = *(const f32x4*)(A.in[I_CONVW] + (size_t)layer * 31 * 256 + (size_t)i * 4);
    __syncthreads();
    const f32x4 cb = *(const f32x4*)(A.in[I_CONVB] + layer * 256 + 4 * lane), lg = *(const f32x4*)(A.in[I_LNG] + layer * 256 + 4 * lane), lb = *(const f32x4*)(A.in[I_LNB] + layer * 256 + 4 * lane);
    const bf16* uc = (const bf16*)(F.ws + WS_UC); bf16* ycat = (bf16*)(F.ws + WS_YCAT);
    for (int run = F.gw; run < T / 8; run += F.NGW) {
        const int t0 = run * 8, tl0 = t0 & (SEQ - 1);
        f32x4 acc[8];
#pragma unroll
        for (int i = 0; i < 8; ++i) acc[i] = cb;
#pragma unroll
        for (int r = 0; r < 38; ++r) {
            v2u raw = {0u, 0u};
            if (tl0 - 30 + r >= 0) raw = *(const v2u*)(uc + (size_t)(t0 - 30 + r) * 256 + 4 * lane);
            const f32x4 x = {bflo(raw.x), bfhi(raw.x), bflo(raw.y), bfhi(raw.y)};
#pragma unroll
            for (int i = 0; i < 8; ++i) { const int j = r - i; if (j >= 0 && j < 31) acc[i] += wl[j * 64 + lane] * x; }
        }
#pragma unroll
        for (int i = 0; i < 8; ++i) {
            const f32x4 a = acc[i];
            const float mean = wave_sum((a[0] + a[1]) + (a[2] + a[3])) * (1.0f / 256.0f);
            const f32x4 dlt = a - mean;
            const float var = wave_sum((dlt[0] * dlt[0] + dlt[1] * dlt[1]) + (dlt[2] * dlt[2] + dlt[3] * dlt[3])) * (1.0f / 256.0f);
            const float rs = 1.0f / sqrtf(var + EPS);
            f32x4 y = dlt * rs * lg + lb;
#pragma unroll
            for (int e = 0; e < 4; ++e) y[e] = y[e] * sigmoidf_(y[e]);
            v2u o; o.x = pk2(y[0], y[1]); o.y = pk2(y[2], y[3]);
            *(v2u*)(ycat + (size_t)(t0 + i) * 1024 + 512 + 4 * lane) = o;
        }
    }
    __syncthreads();
}

typedef float f32x16 __attribute__((ext_vector_type(16)));
typedef short s16x4 __attribute__((ext_vector_type(4)));
constexpr int AW_BLKS = 11, AW_KEYS = 32 * AW_BLKS, AW_K = 0, AW_V = AW_KEYS * 128, AW_C = 2 * AW_KEYS * 128, AW_FLAG = AW_C + AW_KEYS * 4;
constexpr float SB_DEAD = -64.0f;
__device__ __forceinline__ s16x4 tr_read(const LAS unsigned char* p) { return __builtin_bit_cast(s16x4, __builtin_amdgcn_ds_read_tr16_b64_v4i16((LAS s16x4*)p)); }

template <int MODE>
__device__ __forceinline__ void attn_unit(Frame& F, int bh, int qb, const bf16* Q, const bf16* K, const bf16* V, const float* CUM, bf16* Y, float z2max) {
    const int tid = F.tid, lane = F.lane, w = F.wave, l31 = lane & 31, hh = lane >> 5;
    const int b = bh >> 2, h = bh & 3, qblk = qb * 8 + w, qw0 = 32 * qblk, qrow = qw0 + l31;
    const size_t rowbase = (size_t)b * SEQ;
    LAS unsigned char* lds = F.lds;
    LAS unsigned* flags = (LAS unsigned*)(lds + AW_FLAG);
    if (tid < 3) flags[tid] = 0u;
    bf16x8 qf[4];
#pragma unroll
    for (int s = 0; s < 4; ++s) qf[s] = *(const bf16x8*)(Q + (rowbase + qrow) * 256 + h * 64 + 16 * s + 8 * hh);
    f32x16 ot[2];
#pragma unroll
    for (int r = 0; r < 16; ++r) { ot[0][r] = 0.f; ot[1][r] = 0.f; }
    float m_run = -INFINITY, l_run = 0.f, carry = 0.f;
    const int ti = lane & 15, tq = ti >> 2, tp = ti & 3, tg = (lane >> 4) & 1;
    int kofs[4], vofs[2];
#pragma unroll
    for (int s = 0; s < 4; ++s) kofs[s] = AW_K + l31 * 128 + (((2 * s + hh) ^ (l31 & 7)) << 4);
#pragma unroll
    for (int db = 0; db < 2; ++db) vofs[db] = AW_V + (4 * hh + tq) * 128 + (((4 * db + 2 * tg + (tp >> 1)) ^ (4 * hh + tq)) << 4) + 8 * (tp & 1);
    const int srow = lane >> 3, sch = ((lane & 7) ^ srow) * 8;
    int kbw = qblk; bool done = false; int it = 0;
    for (int whi = qb * 8 + 7; whi >= 0; whi -= AW_BLKS, ++it) {
        const int wlo = whi - (AW_BLKS - 1), key0 = 32 * wlo;
        for (int g = w; g < 2 * AW_KEYS / 8; g += NWAVES) {
            const int gg = g < AW_KEYS / 8 ? g : g - AW_KEYS / 8; const int key = max(key0 + 8 * gg + srow, 0);
            const bf16* src = (g < AW_KEYS / 8 ? K : V) + (rowbase + key) * 256 + h * 64 + sch;
            __builtin_amdgcn_global_load_lds((const unsigned*)src, (LAS unsigned*)(lds + (g < AW_KEYS / 8 ? AW_K : AW_V) + gg * 1024), 16, 0, 0);
        }
        if (MODE == 0 && tid < AW_KEYS) *(LAS float*)(lds + AW_C + tid * 4) = -CUM[(size_t)bh * SEQ + max(key0 + tid, 0)];
        asm volatile("s_waitcnt vmcnt(0)" ::: "memory");
        __syncthreads();
        if (!done) {
            const int lo = max(wlo, 0);
            for (; kbw >= lo; --kbw) {
                const int kv0 = 32 * kbw, rb = (kbw - wlo) * 32;
                if (MODE == 0) { const float clast = *(const LAS float*)(lds + AW_C + (rb + 31) * 4); if (__all((z2max + clast - m_run) < SB_DEAD)) { done = true; break; } }
                else if (__all(carry < SB_DEAD)) { done = true; break; }
                f32x16 p;
                if (MODE == 0) {
#pragma unroll
                    for (int c = 0; c < 4; ++c) { const f32x4 ck = *(const LAS f32x4*)(lds + AW_C + (rb + 8 * c + 4 * hh) * 4); p[4 * c] = ck[0]; p[4 * c + 1] = ck[1]; p[4 * c + 2] = ck[2]; p[4 * c + 3] = ck[3]; }
                } else {
#pragma unroll
                    for (int r = 0; r < 16; ++r) p[r] = 0.f;
                }
#pragma unroll
                for (int s = 0; s < 4; ++s) { const bf16x8 kf = *(const LAS bf16x8*)(lds + rb * 128 + kofs[s]); p = __builtin_amdgcn_mfma_f32_32x32x16_bf16(kf, qf[s], p, 0, 0, 0); }
                const bool diag = (kbw == qblk);
                if (MODE == 0) {
                    if (diag) {
#pragma unroll
                        for (int r = 0; r < 16; ++r) { const int kvg = kv0 + (r & 3) + 8 * (r >> 2) + 4 * hh; if (kvg > qrow) p[r] = -INFINITY; }
                    }
                    float mt = p[0];
#pragma unroll
                    for (int r = 1; r < 16; ++r) mt = fmaxf(mt, p[r]);
                    mt = fmaxf(mt, __shfl_xor(mt, 32));
                    const float mn = fmaxf(m_run, mt), alpha = fast_exp2(m_run - mn); m_run = mn;
                    float rs = 0.f;
#pragma unroll
                    for (int r = 0; r < 16; ++r) { p[r] = fast_exp2(p[r] - mn); rs += p[r]; }
                    l_run = l_run * alpha + rs;
                    if (__any(alpha != 1.0f)) {
#pragma unroll
                        for (int r = 0; r < 16; ++r) { ot[0][r] *= alpha; ot[1][r] *= alpha; } }
                } else {
                    f32x16 lk;
#pragma unroll
                    for (int r = 0; r < 16; ++r) { const float z = p[r], e = fast_exp2(-fabsf(z)), lg = __builtin_amdgcn_logf(1.0f + e);
                        float lb = fminf(z, 0.f) - lg, k_ = -(fmaxf(z, 0.f) + lg);
                        if (diag) { const int kvg = kv0 + (r & 3) + 8 * (r >> 2) + 4 * hh; if (kvg >= qrow) { k_ = 0.f; lb = -INFINITY; } }
                        p[r] = lb; lk[r] = k_; }
                    float T4[4], To[4], PS[4];
#pragma unroll
                    for (int c = 0; c < 4; ++c) { T4[c] = (lk[4 * c] + lk[4 * c + 1]) + (lk[4 * c + 2] + lk[4 * c + 3]); To[c] = __shfl_xor(T4[c], 32); }
                    float run = 0.f;
#pragma unroll
                    for (int c = 3; c >= 0; --c) { PS[c] = run; run += T4[c] + To[c]; }
#pragma unroll
                    for (int c = 0; c < 4; ++c) { const float base = carry + PS[c] + (hh == 0 ? To[c] : 0.f);
                        const float s3 = lk[4 * c + 3], s2 = s3 + lk[4 * c + 2], s1 = s2 + lk[4 * c + 1];
                        p[4 * c + 3] = fast_exp2(p[4 * c + 3] + base); p[4 * c + 2] = fast_exp2(p[4 * c + 2] + base + s3);
                        p[4 * c + 1] = fast_exp2(p[4 * c + 1] + base + s2); p[4 * c] = fast_exp2(p[4 * c] + base + s1); }
                    carry += run;
                }
                bf16x8 pb[2];
#pragma unroll
                for (int c2 = 0; c2 < 2; ++c2) { v4u wv; wv.x = pg8::cvt_pk_bf16(p[8 * c2], p[8 * c2 + 1]); wv.y = pg8::cvt_pk_bf16(p[8 * c2 + 2], p[8 * c2 + 3]);
                    wv.z = pg8::cvt_pk_bf16(p[8 * c2 + 4], p[8 * c2 + 5]); wv.w = pg8::cvt_pk_bf16(p[8 * c2 + 6], p[8 * c2 + 7]); pb[c2] = __builtin_bit_cast(bf16x8, wv); }
#pragma unroll
                for (int db = 0; db < 2; ++db)
#pragma unroll
                    for (int c2 = 0; c2 < 2; ++c2) { const LAS unsigned char* vp = lds + (rb + 16 * c2) * 128 + vofs[db];
                        const s16x4 lo4 = tr_read(vp), hi4 = tr_read(vp + 8 * 128);
                        const bf16x8 va = {lo4[0], lo4[1], lo4[2], lo4[3], hi4[0], hi4[1], hi4[2], hi4[3]};
                        ot[db] = __builtin_amdgcn_mfma_f32_32x32x16_bf16(va, pb[c2], ot[db], 0, 0, 0); }
            }
            if (kbw < 0) done = true;
        }
        { const int sl = it % 3, sn = (it + 1) % 3;
            if (!done && lane == 0) flags[sl] = 1u;
            if (tid == 0) flags[sn] = 0u;
            __syncthreads();
            if (flags[sl] == 0u) break; }
    }
    float inv = 1.0f;
    if (MODE == 0) { const float lt = l_run + __shfl_xor(l_run, 32); inv = 1.0f / lt; }
    bf16* yrow = Y + (rowbase + qrow) * 1024 + h * 64;
#pragma unroll
    for (int db = 0; db < 2; ++db)
#pragma unroll
        for (int c = 0; c < 4; ++c) { v2u o; o.x = pg8::cvt_pk_bf16(ot[db][4 * c] * inv, ot[db][4 * c + 1] * inv); o.y = pg8::cvt_pk_bf16(ot[db][4 * c + 2] * inv, ot[db][4 * c + 3] * inv);
            *(v2u*)(yrow + 32 * db + 8 * c + 4 * hh) = o; }
}
__device__ __forceinline__ int q_pop(Frame& F, unsigned* ctr) {
    LAS int* slot = (LAS int*)(F.lds + QSLOT_OFF);
    __syncthreads();
    if (F.tid == 0) *slot = (int)__hip_atomic_fetch_add(ctr, 1u, __ATOMIC_RELAXED, __HIP_MEMORY_SCOPE_AGENT);
    __syncthreads();
    return *slot;
}
__device__ __forceinline__ void phase_attn_sb(Frame& F, int layer, int rep) {
    const bf16* qkv = (const bf16*)(F.ws + WS_QKV); const size_t sz = (size_t)T * 256; bf16* ycat = (bf16*)(F.ws + WS_YCAT);
    unsigned* ctr = (unsigned*)(F.ws + WS_CTL) + CW_Q + 128 * layer + 16 * rep;
    for (;;) { const int un = q_pop(F, ctr); if (un >= 512) break;
        attn_unit<1>(F, un & 31, 15 - (un >> 5), qkv + 3 * sz, qkv + 4 * sz, qkv + 5 * sz, nullptr, ycat + 768, 0.f); }
}
__device__ __forceinline__ void phase_attn_fox(Frame& F, int layer, int rep) {
    const bf16* qkv = (const bf16*)(F.ws + WS_QKV); const size_t sz = (size_t)T * 256; const float* cum = (const float*)(F.ws + WS_CUM); bf16* ycat = (bf16*)(F.ws + WS_YCAT);
    unsigned* ctr = (unsigned*)(F.ws + WS_CTL) + CW_Q + 128 * layer + 64 + 16 * rep;
    const float gq = fabsf(F.a->in[I_FQG][layer * 64 + F.lane]), gk = fabsf(F.a->in[I_FKG][layer * 64 + F.lane]);
    float mq = gq, mk = gk;
#pragma unroll
    for (int o = 1; o < 64; o <<= 1) { mq = fmaxf(mq, __shfl_xor(mq, o)); mk = fmaxf(mk, __shfl_xor(mk, o)); }
    const float z2max = 8.0f * mq * mk * LOG2E * 1.02f + 0.25f;
    const int nchunk = (conv_ffn_items(layer) + CONV_CHUNK - 1) / CONV_CHUNK;
    const int total = 512 + nchunk;
    for (;;) { const int t = q_pop(F, ctr); if (t >= total) break;
        const int na0 = (int)(((long)t * 512) / total), na1 = (int)(((long)(t + 1) * 512) / total);
        if (na1 > na0) attn_unit<0>(F, na0 & 31, 15 - (na0 >> 5), qkv, qkv + sz, qkv + 2 * sz, cum, ycat + 256, z2max);
        else convert_ffn_chunk(F, layer, t - na0); }
}
__device__ __forceinline__ void phase_s5_scan_unit(Frame& F, int layer, int g, int pm) {
    __builtin_amdgcn_fence(__ATOMIC_ACQUIRE, "agent");
    if (F.tid < 256) {
        const int b = 4 * pm + (F.tid >> 6), p = F.tid & 63;
        const S5P q = s5_params(*F.a, layer, g, p); float ar, ai; s5_pow(q, 64.0f, ar, ai);
        const float* z = (const float*)(F.ws + WS_Z); bf16* ua = (bf16*)(F.ws + WS_UA);
        float sr = 0.f, si = 0.f;
        for (int n0 = 0; n0 < 64; n0 += 16) {
            f32x2 zz[16];
#pragma unroll
            for (int j = 0; j < 16; ++j) zz[j] = *(const f32x2*)(z + ((size_t)g * 512 + b * 64 + n0 + j) * 128 + 2 * p);
#pragma unroll
            for (int j = 0; j < 16; ++j) { const size_t ch = (size_t)g * 512 + b * 64 + n0 + j;
                *(unsigned*)(ua + ch * S5_LDA + 1024 + 2 * p) = pk2(sr, si);
                const float nr = ar * sr - ai * si + zz[j][0], ni = ar * si + ai * sr + zz[j][1]; sr = nr; si = ni; }
        }
    }
    __syncthreads();
}
__device__ __forceinline__ void phase_rows_ffn(Frame& F, int layer) {
    const Args& A = *F.a; const int lane = F.lane; const int j2 = layer >> 1;
    f32x4 gv[4];
#pragma unroll
    for (int j = 0; j < 4; ++j) gv[j] = *(const f32x4*)(A.in[I_GFFN] + layer * D + 4 * lane + 256 * j);
    const bf16* xb = (const bf16*)(F.ws + WS_XB); unsigned char* seg = F.ws + WS_XNP; unsigned* route = (unsigned*)(F.ws + WS_ROUTE); unsigned* cnt = (unsigned*)(F.ws + WS_CTL) + CW_MOE + 64 * j2;
    unsigned my_e0 = 0, my_e1 = 0, my_r0 = 0, my_r1 = 0; float my_w0 = 0.f, my_w1 = 0.f, my_rs = 0.f; unsigned long long lc = 0ull; int nrow = 0;
    for (int row = F.gw; row < T; row += F.NGW, ++nrow) {
        f32x4 v[4]; float ss = 0.f;
#pragma unroll
        for (int j = 0; j < 4; ++j) { const v2u r = *(const v2u*)(xb + (size_t)row * D + 4 * lane + 256 * j); v[j] = (f32x4){bflo(r.x), bfhi(r.x), bflo(r.y), bfhi(r.y)};
            ss += (v[j][0] * v[j][0] + v[j][1] * v[j][1]) + (v[j][2] * v[j][2] + v[j][3] * v[j][3]); }
        const float rs = 1.0f / sqrtf(wave_sum(ss) * (1.0f / D) + EPS);
        float lg[8];
#pragma unroll
        for (int e = 0; e < 8; ++e) lg[e] = 0.f;
#pragma unroll
        for (int j = 0; j < 4; ++j) { const f32x4 h = v[j] * rs * gv[j];
#pragma unroll
            for (int e4 = 0; e4 < 4; ++e4) { const float* wr = A.in[I_RW] + ((size_t)j2 * D + 4 * lane + 256 * j + e4) * NE; const f32x4 a = *(const f32x4*)wr, b = *(const f32x4*)(wr + 4);
                lg[0] += h[e4] * a[0]; lg[1] += h[e4] * a[1]; lg[2] += h[e4] * a[2]; lg[3] += h[e4] * a[3]; lg[4] += h[e4] * b[0]; lg[5] += h[e4] * b[1]; lg[6] += h[e4] * b[2]; lg[7] += h[e4] * b[3]; } }
#pragma unroll
        for (int e = 0; e < 8; ++e) lg[e] = wave_sum(lg[e]) + A.in[I_RB][j2 * NE + e];
        int e0 = 0; float v0 = lg[0];
#pragma unroll
        for (int e = 1; e < 8; ++e) if (lg[e] > v0) { v0 = lg[e]; e0 = e; }
        int e1 = -1; float v1 = -INFINITY;
#pragma unroll
        for (int e = 0; e < 8; ++e) if (e != e0 && lg[e] > v1) { v1 = lg[e]; e1 = e; }
        const float w1 = 1.0f / (1.0f + expf(v0 - v1)), w0 = 1.0f - w1;
        const unsigned r0 = (unsigned)(lc >> (8 * e0)) & 0xffu; lc += 1ull << (8 * e0);
        const unsigned r1 = (unsigned)(lc >> (8 * e1)) & 0xffu; lc += 1ull << (8 * e1);
        if (lane == nrow) { my_e0 = e0; my_e1 = e1; my_r0 = r0; my_r1 = r1; my_w0 = w0; my_w1 = w1; my_rs = rs; }
    }
    unsigned basev = 0;
    if (lane < 8) { const unsigned c = (unsigned)(lc >> (8 * lane)) & 0xffu; basev = c ? __hip_atomic_fetch_add(cnt + lane, c, __ATOMIC_RELAXED, __HIP_MEMORY_SCOPE_AGENT) : 0u; }
    const unsigned my_p0 = __shfl(basev, (int)my_e0) + my_r0, my_p1 = __shfl(basev, (int)my_e1) + my_r1;
    if (lane < nrow) { const int row = F.gw + lane * F.NGW; unsigned* rt = route + (size_t)row * 8;
        *(v4u*)rt = (v4u){my_e0, my_e1, my_p0, my_p1}; *(v4u*)(rt + 4) = (v4u){__builtin_bit_cast(unsigned, my_w0), __builtin_bit_cast(unsigned, my_w1), 0u, 0u}; }
    for (int i = 0; i < nrow; ++i) {
        const int row = F.gw + i * F.NGW; const float rs = __shfl(my_rs, i);
        const size_t d0 = ((size_t)__shfl((int)my_e0, i) * T + (size_t)__shfl((int)my_p0, i)) * D, d1 = ((size_t)__shfl((int)my_e1, i) * T + (size_t)__shfl((int)my_p1, i)) * D;
#pragma unroll
        for (int j = 0; j < 4; ++j) { const v2u r = *(const v2u*)(xb + (size_t)row * D + 4 * lane + 256 * j);
            const f32x4 h = (f32x4){bflo(r.x), bfhi(r.x), bflo(r.y), bfhi(r.y)} * rs * gv[j]; const unsigned w = pk4_fp8(h[0], h[1], h[2], h[3]);
            *(unsigned*)(seg + d0 + 4 * lane + 256 * j) = w; *(unsigned*)(seg + d1 + 4 * lane + 256 * j) = w; }
    }
}
__device__ __forceinline__ void phase_final_combine(Frame& F) {
    const Args& A = *F.a; int st[NE + 1]; moe_starts(F, (DEPTH - 1) >> 1, st);
    for (int row = F.gw; row < T; row += F.NGW) {
        f32x4 v[4];
#pragma unroll
        for (int j = 0; j < 4; ++j) { const v2u r = *(const v2u*)((const bf16*)(F.ws + WS_XB) + (size_t)row * D + 4 * F.lane + 256 * j); v[j] = (f32x4){bflo(r.x), bfhi(r.x), bflo(r.y), bfhi(r.y)}; }
        moe_combine_row(F, row, v, st);
#pragma unroll
        for (int j = 0; j < 4; ++j) *(f32x4*)(A.out + (size_t)row * D + 4 * F.lane + 256 * j) = v[j];
    }
}

__global__ void __launch_bounds__(NWAVES * 64, 2) mk_fwd(Args args) {
    extern __shared__ __attribute__((aligned(16))) unsigned char lds_raw[];
    Frame F; F.lds = (LAS unsigned char*)lds_raw; F.tid = threadIdx.x; F.lane = F.tid & 63; F.wave = __builtin_amdgcn_readfirstlane(F.tid >> 6);
    F.G = gridDim.x; { const int bx = blockIdx.x; F.vcu = (F.G % 8 == 0) ? (bx % 8) * (F.G / 8) + bx / 8 : bx; }
    F.gw = F.vcu * NWAVES + F.wave; F.NGW = F.G * NWAVES; F.a = &args; F.ws = args.ws;
    volatile LAS unsigned* MISC = (volatile LAS unsigned*)(F.lds + MISC_OFF);
    for (int u = F.tid; u < (LDS_BYTES - RING_BYTES) / 4; u += NWAVES * 64) ((LAS unsigned*)(F.lds + RING_BYTES))[u] = 0u;
    __syncthreads();
    unsigned* ctl = (unsigned*)(args.ws + WS_CTL);
    const bool multi = (args.gp_hi - args.gp_lo) > 1;
    XcdBarrier bar; bar.bar = ctl + CW_BAR; bar.x = 0; bar.st = nullptr;
    if (multi) bar = xcd_barrier_post(ctl + CW_BAR, MISC + 8);
    unsigned char* ws = args.ws;
    LAS unsigned char* ring = F.lds;

    const int gp_lo = args.gp_lo, gp_hi = args.gp_hi;
#define IN(p) (gp_lo <= layer * NPH + (p) && layer * NPH + (p) < gp_hi)
#define SEAM(p) do { if (IN(p) && layer * NPH + (p) + 1 < gp_hi) xcd_barrier(bar); } while (0)
#ifndef PH_MASK
#define PH_MASK 0xffff
#endif
#define ON(p) (((PH_MASK) >> (p)) & 1)
#ifndef PROBE_PH
#define PROBE_PH -1
#endif
#ifndef PROBE_N
#define PROBE_N 1
#endif
#ifndef PROBE_LAYERS
#define PROBE_LAYERS 15
#endif
#define REPS(p) ((((p) == PROBE_PH) && ((PROBE_LAYERS >> layer) & 1)) ? 1 + PROBE_N : 1)
#define ENTER() do { ws = args.ws; asm volatile("" : "+s"(ws)); F.ws = ws; int t_ = threadIdx.x; asm volatile("" : "+v"(t_)); F.tid = t_; F.lane = t_ & 63; F.wave = __builtin_amdgcn_readfirstlane(t_ >> 6); F.gw = F.vcu * NWAVES + F.wave; } while (0)
    for (int layer = gp_lo / NPH; layer < DEPTH && layer * NPH < gp_hi; ++layer) {
        const bool moe = (layer & 1) != 0;
#if ON(0)
        if (IN(0)) for (int rep_ = 0; rep_ < REPS(0); ++rep_) { ENTER(); for (int r2_ = 0; r2_ < ((PROBE_PH == 100) ? 1 + PROBE_N : 1); ++r2_) { phase_convert(F, layer); phase_kfun(F, layer); } phase_rows_mixer(F, layer); }
        SEAM(0);
#endif
#if ON(1)
        if (IN(1)) for (int rep_ = 0; rep_ < REPS(1); ++rep_) { ENTER();
            phase_s5_tables(F, layer); phase_cumsum(F);
#if F8_GATES
            { pg8::Gemm g8{(const bf16*)(ws + WS_XN8), (const bf16*)(ws + WS_WIN8), D / 2, D / 2, D / 2}; pg8::StaticOrder S8; S8.init(T, 4096, F.G, (int)blockIdx.x, D / 2, D / 2);
              pg8::EpiGateSig E8; E8.gate = (bf16*)(ws + WS_GATE);
              pg8::gemm_phase<pg8::EpiGateSig, pg8::StaticOrder, true, true>(ring, g8, S8, E8); }
#endif
            pg8::Gemm g{(const bf16*)(ws + WS_XN), (const bf16*)(ws + WS_WIN), D, D, D}; pg8::StaticOrder S; S.init(T, F8_GATES ? 2304 : NPROJ, F.G, (int)blockIdx.x, D, D);
            pg8::EpiInProj E; E.ua = (bf16*)(ws + WS_UA); E.qkv = (bf16*)(ws + WS_QKV); E.uc = (bf16*)(ws + WS_UC); E.gate = (bf16*)(ws + WS_GATE);
            { LAS float* gl = (LAS float*)(F.lds + GAIN_OFF);
              if (F.tid < 256) { const int w = F.tid >> 6, d = F.tid & 63; const float* src = (w == 0) ? args.in[I_FQG] : (w == 1) ? args.in[I_FKG] : (w == 2) ? args.in[I_SQG] : args.in[I_SKG];
                  gl[F.tid] = src[layer * 64 + d] * ((w == 0 || w == 2) ? QSCALE : 1.0f); }
              __syncthreads(); E.gl = gl; }
            pg8::gemm_phase<pg8::EpiInProj, pg8::StaticOrder, true>(ring, g, S, E);
        }
        SEAM(1);
#endif
#if ON(2)
        if (IN(2)) for (int rep_ = 0; rep_ < REPS(2); ++rep_) { ENTER();
            { pg8::Gemm g{(const bf16*)(ws + WS_UA), (const bf16*)(ws + WS_WZ), 1024, S5_LDA, 1024};
              pg8::BatchOrder S; S.nM = 2; S.nN = 1; S.nZ = 16; S.G = F.G; S.c = (int)blockIdx.x; S.tA = (size_t)256 * S5_LDA * 2; S.tB = 0; S.zA = (size_t)512 * S5_LDA * 2; S.zB = (size_t)256 * 1024 * 2;
              pg8::EpiZ E; E.z = (float*)(ws + WS_Z);
              pg8::gemm_phase<pg8::EpiZ, pg8::BatchOrder, false>(ring, g, S, E);
              if ((int)blockIdx.x < 32) phase_s5_scan_unit(F, layer, (int)blockIdx.x >> 1, (int)blockIdx.x & 1); }
            phase_conv(F, layer);
            phase_attn_sb(F, layer, rep_);
        }
        SEAM(2);
#endif
#if ON(4)
        if (IN(4)) for (int rep_ = 0; rep_ < REPS(4); ++rep_) { ENTER();
            { pg8::Gemm g{(const bf16*)(ws + WS_UA), (const bf16*)(ws + WS_WY), S5_LDA, S5_LDA, S5_LDA};
              pg8::BatchOrder S; S.nM = 2; S.nN = 4; S.nZ = 16; S.G = F.G; S.c = (int)blockIdx.x; S.tA = (size_t)256 * S5_LDA * 2; S.tB = (size_t)256 * S5_LDA * 2; S.zA = (size_t)512 * S5_LDA * 2; S.zB = (size_t)1024 * S5_LDA * 2;
              pg8::EpiY E; E.ua = (const bf16*)(ws + WS_UA); E.dskip = args.in[I_S5D] + layer * 256; E.yp = (bf16*)(ws + WS_YP);
              pg8::gemm_phase<pg8::EpiY, pg8::BatchOrder, false>(ring, g, S, E); }
            phase_attn_fox(F, layer, rep_);
        }
        SEAM(4);
#endif
#if ON(5)
        if (IN(5) && F.G != 256) for (int rep_ = 0; rep_ < REPS(5); ++rep_) { ENTER();
            pg8::Gemm g{(const bf16*)(ws + WS_YP), (const bf16*)(ws + WS_WGLU), 256, 256, 256};
            pg8::BatchOrder S; S.nM = T / 256; S.nN = 1; S.nZ = 1; S.G = F.G; S.c = (int)blockIdx.x; S.tA = (size_t)256 * 256 * 2; S.tB = 0; S.zA = 0; S.zB = 0;
            pg8::EpiGlu E; E.yp = (const bf16*)(ws + WS_YP); E.ycat = (bf16*)(ws + WS_YCAT);
            pg8::gemm_phase<pg8::EpiGlu, pg8::BatchOrder, false>(ring, g, S, E);
        }
        if (F.G != 256) SEAM(5);
#endif
#if ON(6)
        if (IN(6)) for (int rep_ = 0; rep_ < REPS(6); ++rep_) { ENTER();
            const int paired = (F.G == 256) ? 1 : 0;
            if (paired) {
                pg8::Gemm g{(const bf16*)(ws + WS_YP), (const bf16*)(ws + WS_WGLU), 256, 256, 256};
                pg8::OneUnit S; S.pm = F.vcu >> 1; S.tA = (size_t)256 * 256 * 2;
                pg8::EpiGlu E; E.yp = (const bf16*)(ws + WS_YP); E.ycat = (bf16*)(ws + WS_YCAT);
                pg8::gemm_phase<pg8::EpiGlu, pg8::OneUnit, false>(ring, g, S, E);
            }
            pg8::Gemm g{(const bf16*)(ws + WS_YCAT), (const bf16*)(ws + WS_WBR), 256, 1024, 256};
            pg8::BranchOrder1 S; S.nM = T / 256; S.nN = 8; S.G = F.G; S.c = (int)blockIdx.x; S.tA = (size_t)256 * 1024 * 2; S.tB = (size_t)128 * 256 * 2; S.zA = 256 * 2; S.zB = (size_t)1024 * 256 * 2; S.paired = paired; S.vc = F.vcu;
            pg8::EpiGate1 E; E.gate = (const bf16*)(ws + WS_GATE); E.mb = (bf16*)(ws + WS_XN);
            pg8::gemm_phase_n1<pg8::EpiGate1, pg8::BranchOrder1>(ring, g, S, E);
        }
        SEAM(6);
#endif
#if ON(7)
        if (IN(7)) for (int rep_ = 0; rep_ < REPS(7); ++rep_) { ENTER();
            pg8::Gemm g{(const bf16*)(ws + WS_XN), (const bf16*)(ws + WS_WOUT), D, D, D}; pg8::StaticOrder S; S.init(T, D, F.G, (int)blockIdx.x, D, D);
            pg8::EpiResid<false> E; E.base32 = args.in[I_X]; E.base16 = (const bf16*)(ws + WS_XB); E.out = (bf16*)(ws + WS_XB); E.ss = (float*)(ws + WS_SSP); E.out8 = ws + WS_XN8;
            E.flags = ((layer == 0) ? 1 : 0) | ((FUSE_DENSE_NORM && !moe) ? 2 : 0) | ((FUSE_DENSE_NORM && !moe && DENSE8(layer)) ? 4 : 0);
            pg8::gemm_phase<pg8::EpiResid<false>, pg8::StaticOrder, true>(ring, g, S, E);
        }
        SEAM(7);
#endif
#if ON(8)
        if (IN(8)) for (int rep_ = 0; rep_ < REPS(8); ++rep_) { ENTER(); if (moe || !FUSE_DENSE_NORM) phase_rows_ffn(F, layer); }
        if (moe || !FUSE_DENSE_NORM) SEAM(8);
#endif
#if ON(10)
        if (IN(10)) for (int rep_ = 0; rep_ < REPS(10); ++rep_) { ENTER();
            if (!moe) {
                if (DENSE8(layer)) {
                    constexpr int DQ = D / 2;
                    pg8::Gemm g{(const bf16*)(ws + (FUSE_DENSE_NORM ? WS_XN8 : WS_XN)), (const bf16*)(ws + WS_WUP), DQ, DQ, DQ}; pg8::StaticOrder S; S.init(T, 2 * FF, F.G, (int)blockIdx.x, DQ, DQ);
                    pg8::EpiSwiGlu<true> E; E.h = (bf16*)(ws + WS_HH); E.sc = 1.0f / 64.0f; E.ss = (const float*)(ws + WS_SSP); E.use_ss = FUSE_DENSE_NORM;
                    pg8::gemm_phase<pg8::EpiSwiGlu<true>, pg8::StaticOrder, true, true>(ring, g, S, E);
                } else {
                    pg8::Gemm g{(const bf16*)(ws + (FUSE_DENSE_NORM ? WS_XB : WS_XN)), (const bf16*)(ws + WS_WUP), D, D, D}; pg8::StaticOrder S; S.init(T, 2 * FF, F.G, (int)blockIdx.x, D, D);
                    pg8::EpiSwiGlu<false> E; E.h = (bf16*)(ws + WS_HH); E.sc = 1.0f; E.ss = (const float*)(ws + WS_SSP); E.use_ss = FUSE_DENSE_NORM;
                    pg8::gemm_phase<pg8::EpiSwiGlu<false>, pg8::StaticOrder, true, false>(ring, g, S, E);
                }
            } else {
                constexpr bool U8 = F8_MOE_UP != 0, H8 = F8_MOE_DN != 0; constexpr int DQ = U8 ? D / 2 : D;
                pg8::Gemm g{(const bf16*)(ws + WS_XNP), (const bf16*)(ws + WS_WUP), DQ, DQ, DQ};
                pg8::GroupOrder S; S.nN = 22; S.G = F.G; S.c = (int)blockIdx.x; S.tA = (size_t)256 * DQ * 2; S.tB = (size_t)256 * DQ * 2; S.zB = (size_t)5632 * DQ * 2; S.zA = (size_t)T * DQ * 2;
                int st[NE + 1]; moe_starts(F, layer >> 1, st);
#pragma unroll
                for (int e = 0; e <= NE; ++e) S.ts[e] = __builtin_amdgcn_readfirstlane(st[e] >> 8);
                pg8::EpiSwiGlu<H8> E; E.h = (bf16*)(ws + WS_HP); E.sc = U8 ? (1.0f / 64.0f) : 1.0f; E.ss = (const float*)(ws + WS_SSP); E.use_ss = 0;
                pg8::gemm_phase<pg8::EpiSwiGlu<H8>, pg8::GroupOrder, true, U8>(ring, g, S, E);
            }
        }
        SEAM(10);
#endif
#if ON(11)
        if (IN(11)) for (int rep_ = 0; rep_ < REPS(11); ++rep_) { ENTER();
            if (!moe) {
                if (DENSE8(layer)) {
                    constexpr int FQ = FF / 2;
                    pg8::Gemm g{(const bf16*)(ws + WS_HH), (const bf16*)(ws + WS_WDN), FQ, FQ, FQ}; pg8::StaticOrder S; S.init(T, D, F.G, (int)blockIdx.x, FQ, FQ);
                    pg8::EpiResid<true> E; E.base32 = args.in[I_X]; E.base16 = (const bf16*)(ws + WS_XB); E.out = (bf16*)(ws + WS_XB); E.ss = (float*)(ws + WS_SSP); E.out8 = ws + WS_XN8; E.flags = 0;
                    pg8::gemm_phase<pg8::EpiResid<true>, pg8::StaticOrder, true, true>(ring, g, S, E);
                } else {
                    pg8::Gemm g{(const bf16*)(ws + WS_HH), (const bf16*)(ws + WS_WDN), FF, FF, FF}; pg8::StaticOrder S; S.init(T, D, F.G, (int)blockIdx.x, FF, FF);
                    pg8::EpiResid<false> E; E.base32 = args.in[I_X]; E.base16 = (const bf16*)(ws + WS_XB); E.out = (bf16*)(ws + WS_XB); E.ss = (float*)(ws + WS_SSP); E.out8 = ws + WS_XN8; E.flags = 0;
                    pg8::gemm_phase<pg8::EpiResid<false>, pg8::StaticOrder, true, false>(ring, g, S, E);
                }
            } else {
                constexpr bool F8 = F8_MOE_DN != 0; constexpr int FQ = F8 ? FF / 2 : FF;
                pg8::Gemm g{(const bf16*)(ws + WS_HP), (const bf16*)(ws + WS_WDN), FQ, FQ, FQ};
                pg8::GroupOrder S; S.nN = 4; S.G = F.G; S.c = (int)blockIdx.x; S.tA = (size_t)256 * FQ * 2; S.tB = (size_t)256 * FQ * 2; S.zB = (size_t)D * FQ * 2; S.zA = 0;
                int st[NE + 1]; moe_starts(F, layer >> 1, st);
#pragma unroll
                for (int e = 0; e <= NE; ++e) S.ts[e] = __builtin_amdgcn_readfirstlane(st[e] >> 8);
                pg8::EpiStore E; E.o = (bf16*)(ws + WS_XNP); E.sc = F8 ? (1.0f / 64.0f) : 1.0f;
                pg8::gemm_phase<pg8::EpiStore, pg8::GroupOrder, true, F8>(ring, g, S, E);
            }
        }
        SEAM(11);
#endif
    }
#if ON(12)
    if (gp_lo <= GP_FINAL && GP_FINAL < gp_hi) phase_final_combine(F);
#endif
}

extern "C" void kernel_launch(void* const* d_in, const int* in_sizes, int n_in, void* d_out, int out_size, void* d_ws, size_t ws_size, hipStream_t stream) {
    static int grid = 0;
    if (grid == 0) {
        if (n_in != 32 || in_sizes[0] != T * D || out_size != T * D || ws_size < WS_END) { fprintf(stderr, "kernel_launch: unexpected shapes / workspace (n_in %d, ws %zu < %zu)\n", n_in, ws_size, (size_t)WS_END); grid = -1; return; }
        int dev = 0, cus = 0, per_cu = 0;
        if (hipGetDevice(&dev) != hipSuccess || hipDeviceGetAttribute(&cus, hipDeviceAttributeMultiprocessorCount, dev) != hipSuccess) { grid = -1; return; }
        if (hipFuncSetAttribute((const void*)mk_fwd, hipFuncAttributeMaxDynamicSharedMemorySize, LDS_BYTES) != hipSuccess) { grid = -1; return; }
        if (hipOccupancyMaxActiveBlocksPerMultiprocessor(&per_cu, (const void*)mk_fwd, NWAVES * 64, LDS_BYTES) != hipSuccess || per_cu < 1) fprintf(stderr, "kernel_launch: occupancy query says %d\n", per_cu);
        (void)hipGetLastError();
        grid = cus;
    }
    if (grid < 0) return;
    if (hipMemsetAsync((char*)d_ws + WS_CTL, 0, CTL_ZERO_BYTES, stream) != hipSuccess) return;
    Args a{};
    for (int i = 0; i < 32; ++i) a.in[i] = (const float*)d_in[i];
    a.out = (float*)d_out; a.ws = (unsigned char*)d_ws;
    a.gp_lo = 0; a.gp_hi = GP_TOTAL;
    hipLaunchKernelGGL(mk_fwd, dim3(grid), dim3(NWAVES * 64), LDS_BYTES, stream, a);
}
```

```cpp
#include <hip/hip_runtime.h>
#include <cstdio>
#include <cstdint>

#ifndef F8_DENSE_MASK
#define F8_DENSE_MASK 4
#endif
#define DENSE8(layer) (((F8_DENSE_MASK) >> (layer)) & 1)
#ifndef F8_MOE_UP
#define F8_MOE_UP 1
#endif
#ifndef FUSE_DENSE_NORM
#define FUSE_DENSE_NORM 1
#endif
#ifndef GATE8
#define GATE8 2
#endif
#ifndef BR_WG
#define BR_WG 4
#endif
#ifndef F8_GATES
#define F8_GATES 1
#endif
#ifndef F8_MOE_DN
#define F8_MOE_DN 1
#endif

#define GAS __attribute__((address_space(1)))
#define LAS __attribute__((address_space(3)))
typedef unsigned short bf16;
typedef unsigned v4u __attribute__((ext_vector_type(4)));
typedef unsigned v2u __attribute__((ext_vector_type(2)));
typedef float f32x4 __attribute__((ext_vector_type(4)));
typedef float f32x2 __attribute__((ext_vector_type(2)));
typedef short bf16x8 __attribute__((ext_vector_type(8)));

constexpr int NB = 8, SEQ = 4096, D = 1024, DEPTH = 4, T = NB * SEQ;
constexpr int DP = 6404, NPROJ = 6400, FF = 2816, NE = 8;
constexpr float EPS = 1e-6f, LOG2E = 1.4426950408889634f;
constexpr float QSCALE = 0.125f * LOG2E;
constexpr int MOE_ROWS = 2 * T + NE * 256;
constexpr int S5_LDA = 1152;

constexpr size_t MiB = 1u << 20;
constexpr size_t WS_CTL = 0, CTL_ZERO_BYTES = 1 * MiB;
constexpr size_t WS_WIN = 1 * MiB;
constexpr size_t WS_WIN8 = WS_WIN + (size_t)2304 * D * 2;
constexpr size_t WS_WBR = WS_WIN + (size_t)NPROJ * D * 2;
constexpr size_t WS_WOUT = WS_WBR + 2 * MiB;
constexpr size_t WS_WGLU = WS_WOUT + 2 * MiB;
constexpr size_t WS_WZ = WS_WGLU + 128 * 1024;
constexpr size_t WS_WY = WS_WZ + 8 * MiB;
constexpr size_t WS_WUP = WS_WY + 36 * MiB;
constexpr size_t WS_WDN = WS_WUP + 88 * MiB;
constexpr size_t WS_KFUN = WS_WDN + 44 * MiB;
constexpr size_t WS_ROUTE = WS_KFUN + 1 * MiB;
constexpr size_t WS_LF = WS_ROUTE + 1 * MiB;
constexpr size_t WS_CUM = WS_LF + 512 * 1024;
constexpr size_t WS_XN = 198 * MiB;
static_assert(WS_CUM + 512 * 1024 <= WS_XN, "ws map");
constexpr size_t WS_R = WS_XN + 64 * MiB;
constexpr size_t WS_GATE = WS_R;
constexpr size_t WS_QKV = WS_GATE + 256 * MiB;
constexpr size_t WS_UC = WS_QKV + 96 * MiB;
constexpr size_t WS_UA = WS_UC + 16 * MiB;
constexpr size_t WS_Z = WS_UA + 18 * MiB;
constexpr size_t WS_YP = WS_Z + 4 * MiB;
constexpr size_t WS_YCAT = WS_YP + 16 * MiB;
constexpr size_t WS_MIX_END = WS_YCAT + 64 * MiB;
constexpr size_t WS_XN8 = WS_YCAT;
constexpr size_t WS_HH = WS_R;
constexpr size_t WS_XNP = WS_R;
constexpr size_t WS_HP = WS_XNP + (size_t)NE * T * D;
constexpr size_t WS_FFN_END = WS_HP + (size_t)MOE_ROWS * FF;
static_assert(F8_MOE_UP && F8_MOE_DN, "the MoE path stores its rows and hidden activations as e4m3 bytes");
constexpr size_t WS_XB = ((WS_MIX_END > WS_FFN_END ? WS_MIX_END : WS_FFN_END) + MiB - 1) / MiB * MiB;
constexpr size_t WS_SSP = WS_XB + 64 * MiB;
constexpr size_t WS_END = WS_SSP + 2 * MiB;
static_assert(WS_END <= 856 * MiB, "ws budget");
constexpr int CW_BAR = 4096;
constexpr int CW_Q = 20480;
constexpr int CW_MOE = 16384;

constexpr int RING_BYTES = 131072, MISC_OFF = RING_BYTES + 320, GAIN_OFF = RING_BYTES + 1024, QSLOT_OFF = RING_BYTES + 64, LDS_BYTES = 147456;
constexpr int NWAVES = 8;

__device__ __forceinline__ unsigned f2bf(float f) { unsigned u = __builtin_bit_cast(unsigned, f); return (u + 0x7fffu + ((u >> 16) & 1u)) >> 16; }
__device__ __forceinline__ unsigned pk2(float lo, float hi) { return f2bf(lo) | (f2bf(hi) << 16); }
__device__ __forceinline__ float bflo(unsigned u) { return __builtin_bit_cast(float, u << 16); }
__device__ __forceinline__ float bfhi(unsigned u) { return __builtin_bit_cast(float, u & 0xffff0000u); }
__device__ __forceinline__ float bf2f(bf16 v) { return __builtin_bit_cast(float, (unsigned)v << 16); }
__device__ __forceinline__ float wave_sum(float v) {
#pragma unroll
    for (int o = 1; o < 64; o <<= 1) v += __shfl_xor(v, o);
    return v;
}
__device__ __forceinline__ float fast_exp2(float x) { return __builtin_amdgcn_exp2f(x); }
__device__ __forceinline__ float fast_rcp(float x) { return __builtin_amdgcn_rcpf(x); }
__device__ __forceinline__ float sigmoidf_(float x) { return fast_rcp(1.0f + fast_exp2(-x * LOG2E)); }
__device__ __forceinline__ f32x2 sigmoid2(f32x2 x) { const f32x2 a = x * (-LOG2E); f32x2 t = {fast_exp2(a[0]), fast_exp2(a[1])}; t = t + 1.0f; return (f32x2){fast_rcp(t[0]), fast_rcp(t[1])}; }
__device__ __forceinline__ float gelu_tanh(float y) { const float u = 0.7978845608028654f * (y + 0.044715f * y * y * y); return y * sigmoidf_(2.0f * u); }
__device__ __forceinline__ unsigned pk4_fp8(float a, float b, float c, float d) { unsigned w = 0u; w = (unsigned)__builtin_amdgcn_cvt_pk_fp8_f32(a, b, (int)w, false); w = (unsigned)__builtin_amdgcn_cvt_pk_fp8_f32(c, d, (int)w, true); return w; }
#define LDS_WAIT() asm volatile("s_waitcnt lgkmcnt(0)" ::: "memory")
#define VM_WAIT() asm volatile("s_waitcnt vmcnt(0)" ::: "memory")

namespace pg8 {
#define PG8_LAS __attribute__((address_space(3)))
typedef unsigned short bf16_t;
typedef unsigned u32x4 __attribute__((ext_vector_type(4)));
typedef int v4i __attribute__((ext_vector_type(4)));
typedef int v8i __attribute__((ext_vector_type(8)));
constexpr int BM = 256, BK = 64, HALF = 128, HTB = HALF * BK * 2, STAGE_BYTES = 8 * HTB, NXCD = 8, WGM = 8;
__host__ __device__ __forceinline__ int lds_byte(int r, int c) { const int st = (r >> 4) * 2 + (c >> 5), rr = r & 15, cc = c & 31, ob = rr * 64 + cc * 2; return st * 1024 + (ob ^ (((ob >> 9) & 1) << 5)); }
__host__ __device__ __forceinline__ void stage_rc(int b, int& R, int& C) { const int st = b / 1024, sb = b % 1024, swz = sb ^ (((sb >> 9) & 1) << 5); R = (st >> 1) * 16 + swz / 64; C = (st & 1) * 32 + (swz % 64) / 2; }
__host__ __device__ __forceinline__ int perm32(int rho) { const int n = rho >> 4, i = rho & 15; return 8 * (i >> 2) + 4 * n + (i & 3); }

struct Unit { int pm, pn, z; size_t offA, offB; };
struct Gemm { const bf16_t* A; const bf16_t* Bt; int K, lda, ldb; };

template <int WG = WGM> __device__ __forceinline__ void xcd_tile_map(int L, int nM, int nN, int& pm, int& pn) {
    const int nwg = nM * nN; int wgid = L; { const int q = nwg / NXCD, r = nwg % NXCD, xcd = wgid % NXCD, off = wgid / NXCD; wgid = (xcd < r ? xcd * (q + 1) : r * (q + 1) + (xcd - r) * q) + off; }
    const int nig = WG * nN, gid = wgid / nig, fm = gid * WG, gsz = (nM - fm) < WG ? (nM - fm) : WG;
    pm = fm + ((wgid % nig) % gsz); pn = (wgid % nig) / gsz;
}
struct StaticOrder {
    int nM, nN, nwg, G, c; size_t tA, tB;
    __device__ void init(int M, int N, int G_, int c_, int lda, int ldb) { nM = M / BM; nN = N / BM; nwg = nM * nN; G = G_; c = c_; tA = (size_t)BM * lda * 2; tB = (size_t)BM * ldb * 2; }
    __device__ bool next(int i, Unit& u) const {
        const long L = (long)i * G + c; if (L >= nwg) return false;
        int wgid = (int)L; { const int q = nwg / NXCD, r = nwg % NXCD, xcd = wgid % NXCD, off = wgid / NXCD; wgid = (xcd < r ? xcd * (q + 1) : r * (q + 1) + (xcd - r) * q) + off; }
        const int nig = WGM * nN, gid = wgid / nig, fm = gid * WGM, gsz = (nM - fm) < WGM ? (nM - fm) : WGM;
        u.pm = fm + ((wgid % nig) % gsz); u.pn = (wgid % nig) / gsz; u.z = 0; u.offA = (size_t)u.pm * tA; u.offB = (size_t)u.pn * tB; return true;
    }
};
struct BatchOrder {
    int nM, nN, nZ, G, c; size_t tA, tB, zA, zB;
    __device__ bool next(int i, Unit& u) const {
        const int L = i * G + c; if (L >= nM * nN * nZ) return false;
        u.z = L / (nM * nN); const int r = L % (nM * nN); u.pm = r / nN; u.pn = r % nN;
        u.offA = (size_t)u.z * zA + (size_t)u.pm * tA; u.offB = (size_t)u.z * zB + (size_t)u.pn * tB; return true;
    }
};
struct GroupOrder {
    int nN, G, c; int ts[NE + 1]; size_t tA, tB, zB, zA;
    __device__ bool next(int i, Unit& u) const {
        const int L = i * G + c; if (L >= ts[NE] * nN) return false;
        xcd_tile_map(L, ts[NE], nN, u.pm, u.pn); int e = 0, tse = 0;
#pragma unroll
        for (int k = 1; k < NE; ++k) if (u.pm >= ts[k]) { e = k; tse = ts[k]; }
        u.z = e; u.offA = zA ? (size_t)e * zA + (size_t)(u.pm - tse) * tA : (size_t)u.pm * tA; u.offB = (size_t)e * zB + (size_t)u.pn * tB; return true;
    }
};

typedef __bf16 bf16x2_t __attribute__((ext_vector_type(2)));
__device__ __forceinline__ unsigned cvt_pk_bf16(float lo, float hi) { const f32x2 v = {lo, hi}; const bf16x2_t b = __builtin_convertvector(v, bf16x2_t); return __builtin_bit_cast(unsigned, b); }

__device__ __forceinline__ u32x4 pack8(const f32x4 a, const f32x4 b) { u32x4 w; w.x = cvt_pk_bf16(a[0], a[1]); w.y = cvt_pk_bf16(a[2], a[3]); w.z = cvt_pk_bf16(b[0], b[1]); w.w = cvt_pk_bf16(b[2], b[3]); return w; }
template <class Epi, class Sched, bool ALIGN_EPI, bool FP8 = false>
__device__ __forceinline__ void gemm_phase(PG8_LAS unsigned char* lds, const Gemm g, const Sched& S, const Epi& E) {
    int tid = threadIdx.x; asm volatile("" : "+v"(tid));
    const int wid = __builtin_amdgcn_readfirstlane(tid >> 6), lane = tid & 63, wr = wid >> 2, wc = wid & 3, fr = lane & 15, fq = lane >> 4;
    int K = g.K; asm volatile("" : "+s"(K));
    const int nt = K / BK;
    unsigned voffA[2], voffB[2];
#pragma unroll
    for (int i = 0; i < 2; ++i) { int R, C; stage_rc(tid * 16 + i * 8192, R, C); const int Rb = Epi::PERM ? ((R & ~31) + perm32(R & 31)) : R;
        voffA[i] = (unsigned)(R * g.lda + C) * 2u; voffB[i] = (unsigned)(Rb * g.ldb + C) * 2u; }
    const size_t kstep = (size_t)(BK * 2);
    const size_t hstepA = (size_t)HALF * g.lda * 2, hstepB = (size_t)HALF * g.ldb * 2;
    const unsigned ldsw = (unsigned)wid * 1024u;
    const int aoff = lds_byte(wr * 64 + fr, fq * 8), boff = lds_byte(wc * 32 + fr, fq * 8);
#define PG8_SA(b, h) (((b) * 2 + (h)) * HTB)
#define PG8_SB(b, h) ((4 + (b) * 2 + (h)) * HTB)
#define PG8_STAGE(bufoff, gbase, voff) do { _Pragma("unroll") for (int _i = 0; _i < 2; ++_i) \
        __builtin_amdgcn_global_load_lds((const unsigned*)((const char*)(gbase) + (voff)[_i]), (PG8_LAS unsigned*)(lds + (bufoff) + ldsw + _i * 8192), 16, 0, 0); } while (0)
#define PG8_LDA(dst, b, h) do { _Pragma("unroll") for (int m = 0; m < 4; ++m) { if constexpr (FP8) dst##8[m] = __builtin_shufflevector(*(const PG8_LAS v4i*)(lds + PG8_SA(b, h) + aoff + m * 2048), *(const PG8_LAS v4i*)(lds + PG8_SA(b, h) + aoff + m * 2048 + 1024), 0, 1, 2, 3, 4, 5, 6, 7); \
        else { _Pragma("unroll") for (int k = 0; k < 2; ++k) dst[m][k] = *(const PG8_LAS bf16x8*)(lds + PG8_SA(b, h) + aoff + m * 2048 + k * 1024); } } } while (0)
#define PG8_LDB(dst, b, h) do { _Pragma("unroll") for (int n = 0; n < 2; ++n) { if constexpr (FP8) dst##8[n] = __builtin_shufflevector(*(const PG8_LAS v4i*)(lds + PG8_SB(b, h) + boff + n * 2048), *(const PG8_LAS v4i*)(lds + PG8_SB(b, h) + boff + n * 2048 + 1024), 0, 1, 2, 3, 4, 5, 6, 7); \
        else { _Pragma("unroll") for (int k = 0; k < 2; ++k) dst[n][k] = *(const PG8_LAS bf16x8*)(lds + PG8_SB(b, h) + boff + n * 2048 + k * 1024); } } } while (0)
#define PG8_MMA(ai, bj, At, Bt) do { __builtin_amdgcn_s_setprio(1); _Pragma("unroll") for (int m = 0; m < 4; ++m) _Pragma("unroll") for (int n = 0; n < 2; ++n) { \
        if constexpr (FP8) asm volatile("v_mfma_f32_16x16x128_f8f6f4 %0, %1, %2, %0" : "+v"(acc[ai][bj][m][n]) : "v"(Bt##8[n]), "v"(At##8[m])); \
        else { _Pragma("unroll") for (int k = 0; k < 2; ++k) acc[ai][bj][m][n] = __builtin_amdgcn_mfma_f32_16x16x32_bf16(Bt[n][k], At[m][k], acc[ai][bj][m][n], 0, 0, 0); } } \
        __builtin_amdgcn_s_setprio(0); } while (0)
#define PG8_WAIT_V(n) asm volatile("s_waitcnt vmcnt(" #n ")" ::: "memory")
#define PG8_WAIT_L(n) asm volatile("s_waitcnt lgkmcnt(" #n ")" ::: "memory")
#define PG8_BAR __builtin_amdgcn_s_barrier()
#define PG8_SCHED __builtin_amdgcn_sched_barrier(0)
    Unit cur, nxt; int ui = 0;
    if (!S.next(0, cur)) return;
    f32x4 acc[2][2][4][2];
#pragma unroll
    for (int a = 0; a < 2; ++a)
#pragma unroll
        for (int b = 0; b < 2; ++b)
#pragma unroll
            for (int m = 0; m < 4; ++m)
#pragma unroll
                for (int n = 0; n < 2; ++n) acc[a][b][m][n] = (f32x4){0.f, 0.f, 0.f, 0.f};
    bf16x8 At[4][2], B0[2][2], B1[2][2]; v8i At8[4], B08[2], B18[2];
    const char* cA = (const char*)g.A + cur.offA; const char* cB = (const char*)g.Bt + cur.offB;
    PG8_STAGE(PG8_SB(0, 0), cB, voffB); PG8_STAGE(PG8_SB(0, 1), cB + hstepB, voffB); PG8_STAGE(PG8_SA(0, 0), cA, voffA); PG8_STAGE(PG8_SA(0, 1), cA + hstepA, voffA);
    if (wr == 1) PG8_BAR;
    PG8_WAIT_V(2); PG8_BAR;
    PG8_STAGE(PG8_SB(1, 0), cB + kstep, voffB); PG8_STAGE(PG8_SA(1, 0), cA + kstep, voffA); PG8_STAGE(PG8_SB(1, 1), cB + hstepB + kstep, voffB);
    PG8_WAIT_V(6); PG8_BAR;
    for (;;) {
        const bool has_next = S.next(ui + 1, nxt);
        const char* nA = has_next ? (const char*)g.A + nxt.offA : cA; const char* nB = has_next ? (const char*)g.Bt + nxt.offB : cB;
        for (int t = 0; t < nt; t += 2) {
            const bool last = (t == nt - 2);
            const char* a1 = cA + (size_t)(t + 1) * kstep;
            const char* a2 = last ? nA : cA + (size_t)(t + 2) * kstep; const char* b2 = last ? nB : cB + (size_t)(t + 2) * kstep;
            const char* a3 = a2 + kstep; const char* b3 = b2 + kstep;
            PG8_LDB(B0, 0, 0); PG8_LDB(B1, 0, 1); PG8_SCHED; PG8_LDA(At, 0, 0); PG8_STAGE(PG8_SA(1, 1), a1 + hstepA, voffA);
            PG8_WAIT_V(8); PG8_WAIT_L(0); PG8_BAR; PG8_MMA(0, 0, At, B0); PG8_MMA(0, 1, At, B1); PG8_BAR; PG8_SCHED;
            PG8_LDA(At, 0, 1); PG8_STAGE(PG8_SB(0, 0), b2, voffB); PG8_STAGE(PG8_SB(0, 1), b2 + hstepB, voffB); PG8_STAGE(PG8_SA(0, 0), a2, voffA);
            PG8_WAIT_V(8); PG8_WAIT_L(0); PG8_BAR; PG8_MMA(1, 0, At, B0); PG8_MMA(1, 1, At, B1); PG8_BAR; PG8_SCHED;
            PG8_LDB(B0, 1, 0); PG8_LDB(B1, 1, 1); PG8_SCHED; PG8_LDA(At, 1, 0); PG8_STAGE(PG8_SA(0, 1), a2 + hstepA, voffA);
            PG8_WAIT_V(8); PG8_WAIT_L(0); PG8_BAR; PG8_MMA(0, 0, At, B0); PG8_MMA(0, 1, At, B1); PG8_BAR; PG8_SCHED;
            PG8_LDA(At, 1, 1); PG8_STAGE(PG8_SB(1, 0), b3, voffB); PG8_STAGE(PG8_SB(1, 1), b3 + hstepB, voffB); PG8_STAGE(PG8_SA(1, 0), a3, voffA);
            PG8_WAIT_V(8); PG8_WAIT_L(0); PG8_BAR; PG8_MMA(1, 0, At, B0); PG8_MMA(1, 1, At, B1); PG8_BAR; PG8_SCHED;
        }
        if constexpr (ALIGN_EPI) { if (wr == 0) PG8_BAR; }
        if constexpr (FP8) asm volatile("s_nop 15\n\ts_nop 15" ::: "memory");
        E(acc, cur, wr, wc, fr, fq);
        if (!has_next) break;
#pragma unroll
        for (int a = 0; a < 2; ++a)
#pragma unroll
            for (int b = 0; b < 2; ++b)
#pragma unroll
                for (int m = 0; m < 4; ++m)
#pragma unroll
                    for (int n = 0; n < 2; ++n) acc[a][b][m][n] = (f32x4){0.f, 0.f, 0.f, 0.f};
        cur = nxt; cA = nA; cB = nB; ++ui;
        if constexpr (ALIGN_EPI) { if (wr == 1) PG8_BAR; }
    }
    PG8_WAIT_V(0);
    if constexpr (!ALIGN_EPI) { if (wr == 0) PG8_BAR; }
    PG8_BAR;
#undef PG8_SA
#undef PG8_SB
#undef PG8_STAGE
#undef PG8_LDA
#undef PG8_LDB
#undef PG8_MMA
#undef PG8_WAIT_V
#undef PG8_WAIT_L
#undef PG8_BAR
#undef PG8_SCHED
}


template <class Epi, class Sched>
__device__ __forceinline__ void gemm_phase_n1(PG8_LAS unsigned char* lds, const Gemm g, const Sched& S, const Epi& E) {
    int tid = threadIdx.x; asm volatile("" : "+v"(tid));
    const int wid = __builtin_amdgcn_readfirstlane(tid >> 6), lane = tid & 63, wr = wid >> 2, wc = wid & 3, fr = lane & 15, fq = lane >> 4;
    int K = g.K; asm volatile("" : "+s"(K));
    const int nt = K / BK;
    unsigned voffA[2], voffB[2];
#pragma unroll
    for (int i = 0; i < 2; ++i) { int R, C; stage_rc(tid * 16 + i * 8192, R, C); const int Rb = Epi::PERM ? ((R & ~31) + perm32(R & 31)) : R;
        voffA[i] = (unsigned)(R * g.lda + C) * 2u; voffB[i] = (unsigned)(Rb * g.ldb + C) * 2u; }
    const size_t kstep = (size_t)(BK * 2);
    const size_t hstepA = (size_t)HALF * g.lda * 2;
    const unsigned ldsw = (unsigned)wid * 1024u;
    const int aoff = lds_byte(wr * 64 + fr, fq * 8), boff = lds_byte(wc * 32 + fr, fq * 8);
#define PG8_SA(b, h) (((b) * 2 + (h)) * HTB)
#define PG8_SB(b, h) ((4 + (b) * 2 + (h)) * HTB)
#define PG8_STAGE(bufoff, gbase, voff) do { _Pragma("unroll") for (int _i = 0; _i < 2; ++_i) \
        __builtin_amdgcn_global_load_lds((const unsigned*)((const char*)(gbase) + (voff)[_i]), (PG8_LAS unsigned*)(lds + (bufoff) + ldsw + _i * 8192), 16, 0, 0); } while (0)
#define PG8_LDA(dst, b, h) do { _Pragma("unroll") for (int m = 0; m < 4; ++m) _Pragma("unroll") for (int k = 0; k < 2; ++k) dst[m][k] = *(const PG8_LAS bf16x8*)(lds + PG8_SA(b, h) + aoff + m * 2048 + k * 1024); } while (0)
#define PG8_LDB(dst, b, h) do { _Pragma("unroll") for (int n = 0; n < 2; ++n) _Pragma("unroll") for (int k = 0; k < 2; ++k) dst[n][k] = *(const PG8_LAS bf16x8*)(lds + PG8_SB(b, h) + boff + n * 2048 + k * 1024); } while (0)
#define PG8_MMA1(ai, At, Bt) do { __builtin_amdgcn_s_setprio(1); _Pragma("unroll") for (int m = 0; m < 4; ++m) _Pragma("unroll") for (int n = 0; n < 2; ++n) _Pragma("unroll") for (int k = 0; k < 2; ++k) \
        acc[ai][m][n] = __builtin_amdgcn_mfma_f32_16x16x32_bf16(Bt[n][k], At[m][k], acc[ai][m][n], 0, 0, 0); __builtin_amdgcn_s_setprio(0); } while (0)
#define PG8_WAIT_V(n) asm volatile("s_waitcnt vmcnt(" #n ")" ::: "memory")
#define PG8_WAIT_L(n) asm volatile("s_waitcnt lgkmcnt(" #n ")" ::: "memory")
#define PG8_BAR __builtin_amdgcn_s_barrier()
#define PG8_SCHED __builtin_amdgcn_sched_barrier(0)
    Unit cur, nxt; int ui = 0;
    if (!S.next(0, cur)) return;
    f32x4 acc[2][4][2], st[2][4][2];
#pragma unroll
    for (int a = 0; a < 2; ++a)
#pragma unroll
        for (int m = 0; m < 4; ++m)
#pragma unroll
            for (int n = 0; n < 2; ++n) { acc[a][m][n] = (f32x4){0.f, 0.f, 0.f, 0.f}; st[a][m][n] = (f32x4){0.f, 0.f, 0.f, 0.f}; }
    bf16x8 At[4][2], B0[2][2];
    const char* cA = (const char*)g.A + cur.offA; const char* cB = (const char*)g.Bt + cur.offB;
    PG8_STAGE(PG8_SB(0, 0), cB, voffB); PG8_STAGE(PG8_SA(0, 0), cA, voffA); PG8_STAGE(PG8_SA(0, 1), cA + hstepA, voffA);
    if (wr == 1) PG8_BAR;
    PG8_WAIT_V(2); PG8_BAR;
    PG8_STAGE(PG8_SB(1, 0), cB + kstep, voffB); PG8_STAGE(PG8_SA(1, 0), cA + kstep, voffA);
    PG8_WAIT_V(4); PG8_BAR;
    for (;;) {
        const bool has_next = S.next(ui + 1, nxt);
        const char* nA = has_next ? (const char*)g.A + nxt.offA : cA; const char* nB = has_next ? (const char*)g.Bt + nxt.offB : cB;
        for (int t = 0; t < nt; t += 2) {
            const bool last = (t == nt - 2);
            const char* a1 = cA + (size_t)(t + 1) * kstep;
            const char* a2 = last ? nA : cA + (size_t)(t + 2) * kstep; const char* b2 = last ? nB : cB + (size_t)(t + 2) * kstep;
            const char* a3 = a2 + kstep; const char* b3 = b2 + kstep;
            PG8_LDB(B0, 0, 0); PG8_SCHED; PG8_LDA(At, 0, 0); PG8_STAGE(PG8_SA(1, 1), a1 + hstepA, voffA);
            PG8_WAIT_V(6); PG8_WAIT_L(0); PG8_BAR; PG8_MMA1(0, At, B0); PG8_BAR; PG8_SCHED;
            PG8_LDA(At, 0, 1); PG8_STAGE(PG8_SB(0, 0), b2, voffB); PG8_STAGE(PG8_SA(0, 0), a2, voffA);
            PG8_WAIT_V(6); PG8_WAIT_L(0); PG8_BAR; PG8_MMA1(1, At, B0); PG8_BAR; PG8_SCHED;
            PG8_LDB(B0, 1, 0); PG8_SCHED; PG8_LDA(At, 1, 0); PG8_STAGE(PG8_SA(0, 1), a2 + hstepA, voffA);
            PG8_WAIT_V(6); PG8_WAIT_L(0); PG8_BAR; PG8_MMA1(0, At, B0); PG8_BAR; PG8_SCHED;
            PG8_LDA(At, 1, 1); PG8_STAGE(PG8_SB(1, 0), b3, voffB); PG8_STAGE(PG8_SA(1, 0), a3, voffA);
            PG8_WAIT_V(6); PG8_WAIT_L(0); PG8_BAR; PG8_MMA1(1, At, B0); PG8_BAR; PG8_SCHED;
        }
        if (wr == 0) PG8_BAR;
        E(acc, st, cur, wr, wc, fr, fq);
        if (!has_next) break;
#pragma unroll
        for (int a = 0; a < 2; ++a)
#pragma unroll
            for (int m = 0; m < 4; ++m)
#pragma unroll
                for (int n = 0; n < 2; ++n) acc[a][m][n] = (f32x4){0.f, 0.f, 0.f, 0.f};
        cur = nxt; cA = nA; cB = nB; ++ui;
        if (wr == 1) PG8_BAR;
    }
    PG8_WAIT_V(0);
    PG8_BAR;
#undef PG8_SA
#undef PG8_SB
#undef PG8_STAGE
#undef PG8_LDA
#undef PG8_LDB
#undef PG8_MMA1
#undef PG8_WAIT_V
#undef PG8_WAIT_L
#undef PG8_BAR
#undef PG8_SCHED
}
typedef f32x4 Acc1[2][4][2];
struct OneUnit { int pm; size_t tA;
    __device__ bool next(int i, Unit& u) const { if (i) return false; u.pm = pm; u.pn = 0; u.z = 0; u.offA = (size_t)pm * tA; u.offB = 0; return true; } };
struct BranchOrder1 {
    int nM, nN, G, c; size_t tA, tB, zA, zB; int paired, vc;
    __device__ bool next(int i, Unit& u) const {
        if (paired) { if (i >= 16) return false; u.z = i & 3; u.pm = vc >> 1; u.pn = 4 * (vc & 1) + (i >> 2);
            u.offA = (size_t)u.z * zA + (size_t)u.pm * tA; u.offB = (size_t)u.z * zB + (size_t)u.pn * tB; return true; }
        const int tile = (i >> 2) * G + c; if (tile >= nM * nN) return false;
        u.z = i & 3; xcd_tile_map<BR_WG>(tile, nM, nN, u.pm, u.pn);
        u.offA = (size_t)u.z * zA + (size_t)u.pm * tA; u.offB = (size_t)u.z * zB + (size_t)u.pn * tB; return true;
    }
};
struct EpiGate1 {
    static constexpr bool PERM = true;
    const bf16_t* gate; bf16_t* mb;
    __device__ __forceinline__ void operator()(const Acc1& acc, Acc1& st, const Unit& u, int wr, int wc, int fr, int fq) const {
        const int z = u.z; const int row0 = u.pm * BM + wr * 64 + fr, col = u.pn * HALF + wc * 32 + 8 * fq;
#pragma unroll
        for (int ai = 0; ai < 2; ++ai)
#pragma unroll
            for (int m = 0; m < 4; ++m) { const int row = row0 + ai * HALF + m * 16;
                f32x4 a = acc[ai][m][0], b = acc[ai][m][1];
                if (GATE8 == 2) { const v2u g8 = *(const v2u*)((const unsigned char*)gate + (size_t)row * 4096 + z * 1024 + col); const float k = 1.0f / 255.0f;
                    a[0] *= (float)(g8.x & 0xffu) * k; a[1] *= (float)((g8.x >> 8) & 0xffu) * k; a[2] *= (float)((g8.x >> 16) & 0xffu) * k; a[3] *= (float)(g8.x >> 24) * k;
                    b[0] *= (float)(g8.y & 0xffu) * k; b[1] *= (float)((g8.y >> 8) & 0xffu) * k; b[2] *= (float)((g8.y >> 16) & 0xffu) * k; b[3] *= (float)(g8.y >> 24) * k; }
                else if (GATE8 == 1) { const v2u g8 = *(const v2u*)((const unsigned char*)gate + (size_t)row * 4096 + z * 1024 + col);
                    const f32x2 g0 = __builtin_amdgcn_cvt_pk_f32_fp8((int)g8.x, false), g1 = __builtin_amdgcn_cvt_pk_f32_fp8((int)g8.x, true), g2 = __builtin_amdgcn_cvt_pk_f32_fp8((int)g8.y, false), g3 = __builtin_amdgcn_cvt_pk_f32_fp8((int)g8.y, true);
                    a[0] *= g0[0]; a[1] *= g0[1]; a[2] *= g1[0]; a[3] *= g1[1]; b[0] *= g2[0]; b[1] *= g2[1]; b[2] *= g3[0]; b[3] *= g3[1]; }
                else { const u32x4 gg = *(const u32x4*)(gate + (size_t)row * 4096 + z * 1024 + col);
                    a[0] *= bflo(gg.x); a[1] *= bfhi(gg.x); a[2] *= bflo(gg.y); a[3] *= bfhi(gg.y); b[0] *= bflo(gg.z); b[1] *= bfhi(gg.z); b[2] *= bflo(gg.w); b[3] *= bfhi(gg.w); }
                if (z == 0) { st[ai][m][0] = a; st[ai][m][1] = b; } else { st[ai][m][0] += a; st[ai][m][1] += b; }
                if (z == 3) *(u32x4*)(mb + (size_t)row * 1024 + col) = pack8(st[ai][m][0], st[ai][m][1]); }
    }
};
typedef f32x4 Acc[2][2][4][2];
#define EPI_ROWS_BEGIN const int row0 = u.pm * BM + wr * 64 + fr; _Pragma("unroll") for (int ai = 0; ai < 2; ++ai) _Pragma("unroll") for (int m = 0; m < 4; ++m) { const int row = row0 + ai * HALF + m * 16;
#define EPI_ROWS_END }

struct EpiInProj {
    static constexpr bool PERM = true;
    bf16_t *ua, *qkv, *uc, *gate; const PG8_LAS float* gl;
    __device__ __forceinline__ void operator()(const Acc& acc, const Unit& u, int wr, int wc, int fr, int fq) const {
        const int pn = u.pn;
        if (pn == 0) {
            EPI_ROWS_BEGIN
#pragma unroll
            for (int bj = 0; bj < 2; ++bj) { const int c8 = bj * HALF + wc * 32 + 8 * fq, gI = c8 >> 4, h0 = c8 & 15;
                *(u32x4*)(ua + ((size_t)(gI * 512 + (row >> 6)) * S5_LDA + (row & 63) * 16 + h0)) = pack8(acc[ai][bj][m][0], acc[ai][bj][m][1]); }
            EPI_ROWS_END
        } else if (pn == 1 || pn == 2 || pn == 6 || pn == 7) {
            const int which = (pn == 1) ? 0 : (pn == 2) ? 1 : (pn == 6) ? 2 : 3;
            const PG8_LAS float* gp = gl + which * 64;
            bf16_t* dst = qkv + (size_t)((pn < 6) ? (pn - 1) : (pn - 3)) * ((size_t)T * 256);
            f32x4 gv[2][2];
#pragma unroll
            for (int bj = 0; bj < 2; ++bj)
#pragma unroll
                for (int n = 0; n < 2; ++n) gv[bj][n] = *(const PG8_LAS f32x4*)(gp + bj * 32 + 8 * fq + 4 * n);
            EPI_ROWS_BEGIN
            float ss = 0.f;
#pragma unroll
            for (int bj = 0; bj < 2; ++bj)
#pragma unroll
                for (int n = 0; n < 2; ++n) { const f32x4 x = acc[ai][bj][m][n]; ss += (x[0] * x[0] + x[1] * x[1]) + (x[2] * x[2] + x[3] * x[3]); }
            ss += __shfl_xor(ss, 16); ss += __shfl_xor(ss, 32);
            const float rs = __builtin_amdgcn_rsqf(ss * (1.0f / 64.0f) + EPS);
#pragma unroll
            for (int bj = 0; bj < 2; ++bj)
                *(u32x4*)(dst + (size_t)row * 256 + wc * 64 + bj * 32 + 8 * fq) = pack8(acc[ai][bj][m][0] * rs * gv[bj][0], acc[ai][bj][m][1] * rs * gv[bj][1]);
            EPI_ROWS_END
        } else if (pn == 3 || pn == 8) {
            bf16_t* dst = qkv + (size_t)((pn == 3) ? 2 : 5) * ((size_t)T * 256);
            EPI_ROWS_BEGIN
#pragma unroll
            for (int bj = 0; bj < 2; ++bj) *(u32x4*)(dst + (size_t)row * 256 + bj * HALF + wc * 32 + 8 * fq) = pack8(acc[ai][bj][m][0], acc[ai][bj][m][1]);
            EPI_ROWS_END
        } else if (pn == 4 || pn == 5) {
            EPI_ROWS_BEGIN
            f32x4 o[2];
#pragma unroll
            for (int n = 0; n < 2; ++n)
#pragma unroll
                for (int e = 0; e < 4; ++e) o[n][e] = acc[ai][0][m][n][e] * sigmoidf_(acc[ai][1][m][n][e]);
            *(u32x4*)(uc + (size_t)row * 256 + (pn - 4) * 128 + wc * 32 + 8 * fq) = pack8(o[0], o[1]);
            EPI_ROWS_END
        } else {
            const int gt = pn - 9;
            EPI_ROWS_BEGIN
#pragma unroll
            for (int bj = 0; bj < 2; ++bj) { f32x4 o[2];
#pragma unroll
                for (int n = 0; n < 2; ++n)
#pragma unroll
                    for (int e = 0; e < 4; ++e) o[n][e] = sigmoidf_(acc[ai][bj][m][n][e]);
                *(u32x4*)(gate + (size_t)row * 4096 + gt * 256 + bj * HALF + wc * 32 + 8 * fq) = pack8(o[0], o[1]); }
            EPI_ROWS_END
        }
    }
};
struct EpiGateSig {
    static constexpr bool PERM = true;
    bf16_t* gate;
    __device__ __forceinline__ void operator()(const Acc& acc, const Unit& u, int wr, int wc, int fr, int fq) const {
        EPI_ROWS_BEGIN
#pragma unroll
        for (int bj = 0; bj < 2; ++bj) { f32x4 o[2];
#pragma unroll
            for (int n = 0; n < 2; ++n)
#pragma unroll
                for (int e = 0; e < 4; e += 2) { const f32x2 r = sigmoid2((f32x2){acc[ai][bj][m][n][e], acc[ai][bj][m][n][e + 1]} * (1.0f / 64.0f)) * ((GATE8 == 2) ? 255.0f : 1.0f); o[n][e] = r[0]; o[n][e + 1] = r[1]; }
            if (GATE8 == 2) { v2u w = {0u, 0u};
#pragma unroll
                for (int e = 0; e < 4; ++e) { w.x = __builtin_amdgcn_cvt_pk_u8_f32(o[0][e], e, w.x); w.y = __builtin_amdgcn_cvt_pk_u8_f32(o[1][e], e, w.y); }
                *(v2u*)((unsigned char*)gate + (size_t)row * 4096 + u.pn * BM + bj * HALF + wc * 32 + 8 * fq) = w; }
            else if (GATE8 == 1) { v2u w; w.x = pk4_fp8(o[0][0], o[0][1], o[0][2], o[0][3]); w.y = pk4_fp8(o[1][0], o[1][1], o[1][2], o[1][3]); *(v2u*)((unsigned char*)gate + (size_t)row * 4096 + u.pn * BM + bj * HALF + wc * 32 + 8 * fq) = w; }
            else *(u32x4*)(gate + (size_t)row * 4096 + u.pn * BM + bj * HALF + wc * 32 + 8 * fq) = pack8(o[0], o[1]); }
        EPI_ROWS_END
    }
};
struct EpiZ {
    static constexpr bool PERM = false;
    float* z;
    __device__ __forceinline__ void operator()(const Acc& acc, const Unit& u, int wr, int wc, int fr, int fq) const {
        EPI_ROWS_BEGIN
#pragma unroll
        for (int n = 0; n < 2; ++n) *(f32x4*)(z + ((size_t)(u.z * 512 + row)) * 128 + wc * 32 + 16 * n + 4 * fq) = acc[ai][0][m][n];
        EPI_ROWS_END
    }
};
struct EpiY {
    static constexpr bool PERM = true;
    const bf16_t* ua; const float* dskip; bf16_t* yp;
    __device__ __forceinline__ void operator()(const Acc& acc, const Unit& u, int wr, int wc, int fr, int fq) const {
        const int gI = u.z, h0 = 8 * (fq & 1);
        const f32x4 d0 = *(const f32x4*)(dskip + gI * 16 + h0), d1 = *(const f32x4*)(dskip + gI * 16 + h0 + 4);
        EPI_ROWS_BEGIN
#pragma unroll
        for (int bj = 0; bj < 2; ++bj) { const int col = u.pn * BM + bj * HALF + wc * 32 + 8 * fq;
            const u32x4 uu = *(const u32x4*)(ua + ((size_t)(gI * 512 + row)) * S5_LDA + col);
            f32x4 a = acc[ai][bj][m][0], b = acc[ai][bj][m][1];
            a[0] += d0[0] * bflo(uu.x); a[1] += d0[1] * bfhi(uu.x); a[2] += d0[2] * bflo(uu.y); a[3] += d0[3] * bfhi(uu.y);
            b[0] += d1[0] * bflo(uu.z); b[1] += d1[1] * bfhi(uu.z); b[2] += d1[2] * bflo(uu.w); b[3] += d1[3] * bfhi(uu.w);
#pragma unroll
            for (int e = 0; e < 4; ++e) { a[e] = gelu_tanh(a[e]); b[e] = gelu_tanh(b[e]); }
            *(u32x4*)(yp + ((size_t)row * 64 + (col >> 4)) * 256 + gI * 16 + h0) = pack8(a, b); }
        EPI_ROWS_END
    }
};
struct EpiGlu {
    static constexpr bool PERM = true;
    const bf16_t* yp; bf16_t* ycat;
    __device__ __forceinline__ void operator()(const Acc& acc, const Unit& u, int wr, int wc, int fr, int fq) const {
        EPI_ROWS_BEGIN
#pragma unroll
        for (int bj = 0; bj < 2; ++bj) { const int col = bj * HALF + wc * 32 + 8 * fq;
            const u32x4 yy = *(const u32x4*)(yp + (size_t)row * 256 + col);
            f32x4 a = acc[ai][bj][m][0], b = acc[ai][bj][m][1];
            a[0] = bflo(yy.x) * sigmoidf_(a[0]); a[1] = bfhi(yy.x) * sigmoidf_(a[1]); a[2] = bflo(yy.y) * sigmoidf_(a[2]); a[3] = bfhi(yy.y) * sigmoidf_(a[3]);
            b[0] = bflo(yy.z) * sigmoidf_(b[0]); b[1] = bfhi(yy.z) * sigmoidf_(b[1]); b[2] = bflo(yy.w) * sigmoidf_(b[2]); b[3] = bfhi(yy.w) * sigmoidf_(b[3]);
            *(u32x4*)(ycat + (size_t)row * 1024 + col) = pack8(a, b); }
        EPI_ROWS_END
    }
};
template <bool SC64> struct EpiResid {
    static constexpr bool PERM = true; static constexpr float sc = SC64 ? (1.0f / 64.0f) : 1.0f;
    const float* base32; const bf16_t* base16; bf16_t* out; float* ss; unsigned char* out8; int flags;
    __device__ __forceinline__ void operator()(const Acc& acc, const Unit& u, int wr, int wc, int fr, int fq) const {
        EPI_ROWS_BEGIN
        float q = 0.f;
#pragma unroll
        for (int bj = 0; bj < 2; ++bj) { const size_t off = (size_t)row * 1024 + u.pn * BM + bj * HALF + wc * 32 + 8 * fq;
            f32x4 a, b;
            if (flags & 1) { a = *(const f32x4*)(base32 + off); b = *(const f32x4*)(base32 + off + 4); }
            else { const u32x4 r = *(const u32x4*)(base16 + off); a = (f32x4){bflo(r.x), bfhi(r.x), bflo(r.y), bfhi(r.y)}; b = (f32x4){bflo(r.z), bfhi(r.z), bflo(r.w), bfhi(r.w)}; }
            const u32x4 w = pack8(a + acc[ai][bj][m][0] * sc, b + acc[ai][bj][m][1] * sc); *(u32x4*)(out + off) = w;
            if (flags & 2) { const float x0 = bflo(w.x), x1 = bfhi(w.x), x2 = bflo(w.y), x3 = bfhi(w.y), x4 = bflo(w.z), x5 = bfhi(w.z), x6 = bflo(w.w), x7 = bfhi(w.w);
                q += ((x0 * x0 + x1 * x1) + (x2 * x2 + x3 * x3)) + ((x4 * x4 + x5 * x5) + (x6 * x6 + x7 * x7));
                if (flags & 4) { v2u w8; w8.x = pk4_fp8(x0, x1, x2, x3); w8.y = pk4_fp8(x4, x5, x6, x7); *(v2u*)(out8 + off) = w8; } } }
        if (flags & 2) { q += __shfl_xor(q, 16); q += __shfl_xor(q, 32); if (fq == 0) ss[(size_t)row * 16 + u.pn * 4 + wc] = q; }
        EPI_ROWS_END
    }
};
template <bool H8> struct EpiSwiGlu {
    static constexpr bool PERM = true;
    bf16_t* h; float sc; const float* ss; int use_ss;
    __device__ __forceinline__ void operator()(const Acc& acc, const Unit& u, int wr, int wc, int fr, int fq) const {
        EPI_ROWS_BEGIN
        float rsc = sc;
        if (use_ss) { const f32x4 s0 = *(const f32x4*)(ss + (size_t)row * 16), s1 = *(const f32x4*)(ss + (size_t)row * 16 + 4), s2 = *(const f32x4*)(ss + (size_t)row * 16 + 8), s3 = *(const f32x4*)(ss + (size_t)row * 16 + 12);
            const f32x4 t = (s0 + s1) + (s2 + s3); rsc = sc * __builtin_amdgcn_rsqf(((t[0] + t[1]) + (t[2] + t[3])) * (1.0f / D) + EPS); }
        f32x4 o[2];
#pragma unroll
        for (int n = 0; n < 2; ++n)
#pragma unroll
            for (int e = 0; e < 4; e += 2) { const f32x2 a = (f32x2){acc[ai][0][m][n][e], acc[ai][0][m][n][e + 1]} * rsc, b = (f32x2){acc[ai][1][m][n][e], acc[ai][1][m][n][e + 1]} * rsc;
                const f32x2 r = (a * b) * sigmoid2(a); o[n][e] = r[0]; o[n][e + 1] = r[1]; }
        if constexpr (H8) { v2u w; w.x = pk4_fp8(o[0][0], o[0][1], o[0][2], o[0][3]); w.y = pk4_fp8(o[1][0], o[1][1], o[1][2], o[1][3]); *(v2u*)((unsigned char*)h + (size_t)row * FF + u.pn * 128 + wc * 32 + 8 * fq) = w; }
        else *(u32x4*)(h + (size_t)row * FF + u.pn * 128 + wc * 32 + 8 * fq) = pack8(o[0], o[1]);
        EPI_ROWS_END
    }
};
struct EpiStore {
    static constexpr bool PERM = true;
    bf16_t* o; float sc;
    __device__ __forceinline__ void operator()(const Acc& acc, const Unit& u, int wr, int wc, int fr, int fq) const {
        EPI_ROWS_BEGIN
#pragma unroll
        for (int bj = 0; bj < 2; ++bj) *(u32x4*)(o + (size_t)row * 1024 + u.pn * BM + bj * HALF + wc * 32 + 8 * fq) = pack8(acc[ai][bj][m][0] * sc, acc[ai][bj][m][1] * sc);
        EPI_ROWS_END
    }
};
}

#define XB_TMO      128
#define XB_XCNT(j)  (256  + 64 * (j))
#define XB_XSUB(j)  (1280 + 64 * (j))
#define XB_XGEN(j)  (2304 + 64 * (j))
#define XB_TOP      3328
#define XB_TOPGEN   3392
#define XCD_BAR_WORDS 3456
#define XB_SPIN_CAP (1u << 18)
__device__ __forceinline__ unsigned xb_ld(unsigned* p)              { return __hip_atomic_load(p, __ATOMIC_RELAXED, __HIP_MEMORY_SCOPE_AGENT); }
__device__ __forceinline__ unsigned xb_add(unsigned* p, unsigned v) { return __hip_atomic_fetch_add(p, v, __ATOMIC_RELAXED, __HIP_MEMORY_SCOPE_AGENT); }
__device__ __forceinline__ unsigned xb_xcc_id() { return (unsigned)__builtin_amdgcn_s_getreg((3 << 11) | 20) & 0xFu; }
#define XB_SPIN(cond, bar) do { unsigned _sp = 0; while (cond) { __builtin_amdgcn_s_sleep(1); \
    if ((++_sp & 255u) == 0u) { if (xb_ld(&(bar)[XB_TMO])) break; if (_sp > XB_SPIN_CAP) { atomicAdd(&(bar)[XB_TMO], 1u); break; } } } } while (0)
struct XcdBarrier { unsigned* bar; unsigned x; volatile LAS unsigned* st; };
__device__ __forceinline__ XcdBarrier xcd_barrier_post(unsigned* bar, volatile LAS unsigned* st) {
    XcdBarrier b; b.bar = bar; b.x = xb_xcc_id(); b.st = st;
    if (threadIdx.x == 0) (void)xb_add(&bar[XB_XCNT(b.x)], 1u);
    return b;
}
__device__ __forceinline__ void xcd_barrier_complete(unsigned* bar, unsigned x, unsigned& nloc, unsigned& nx) {
    const unsigned G = gridDim.x * gridDim.y * gridDim.z;
    unsigned sum, cnt, mine, sp = 0u;
    for (;;) {
        sum = 0u; cnt = 0u; mine = 0u;
#pragma unroll
        for (unsigned j = 0; j < 16; ++j) { const unsigned c = xb_ld(&bar[XB_XCNT(j)]); sum += c; cnt += (c > 0u) ? 1u : 0u; mine = (j == x) ? c : mine; }
        if (sum == G) break;
        __builtin_amdgcn_s_sleep(1);
        if ((++sp & 255u) == 0u) { if (xb_ld(&bar[XB_TMO])) break; if (sp > XB_SPIN_CAP) { atomicAdd(&bar[XB_TMO], 1u); break; } }
    }
    nloc = mine > 0u ? mine : 1u; nx = cnt > 0u ? cnt : 1u;
}
__device__ __forceinline__ void xcd_barrier(const XcdBarrier& b) {
    asm volatile("s_waitcnt vmcnt(0)" ::: "memory");
    __syncthreads();
    if (threadIdx.x == 0) {
        unsigned* bar = b.bar;
        __builtin_amdgcn_s_waitcnt(0);
        unsigned nloc = b.st[0], nx = b.st[1];
        if (nloc == 0u) { xcd_barrier_complete(bar, b.x, nloc, nx); b.st[0] = nloc; b.st[1] = nx; }
        const unsigned old = xb_add(&bar[XB_XSUB(b.x)], 1u);
        const unsigned gen = old / nloc;
        if (old + 1u == (gen + 1u) * nloc) {
            __builtin_amdgcn_fence(__ATOMIC_RELEASE, "agent");
            asm volatile("s_waitcnt vmcnt(0)" ::: "memory");
            const unsigned og = xb_add(&bar[XB_TOP], 1u);
            const unsigned tg = og / nx;
            if (og + 1u == (tg + 1u) * nx) xb_add(&bar[XB_TOPGEN], 1u);
            else XB_SPIN(xb_ld(&bar[XB_TOPGEN]) == tg, bar);
            __builtin_amdgcn_fence(__ATOMIC_ACQUIRE, "agent");
            xb_add(&bar[XB_XGEN(b.x)], 1u);
            asm volatile("s_waitcnt vmcnt(0)" ::: "memory");
        } else {
            XB_SPIN(xb_ld(&bar[XB_XGEN(b.x)]) == gen, bar);
            __builtin_amdgcn_fence(__ATOMIC_ACQUIRE, "agent");
            asm volatile("s_waitcnt vmcnt(0)" ::: "memory");
        }
    }
    __syncthreads();
}

struct Args { const float* in[32]; float* out; unsigned char* ws; int gp_lo, gp_hi; };
enum { I_X = 0, I_GMIX, I_WIN, I_BFORGET, I_FQG, I_FKG, I_SQG, I_SKG, I_LRE, I_LIM, I_LDT, I_BRE, I_BIM, I_CRE, I_CIM, I_S5D, I_WGLU, I_CONVW, I_CONVB, I_LNG, I_LNB,
       I_WBR, I_WOUT, I_GFFN, I_W1, I_W3, I_W2, I_RW, I_RB, I_MW1, I_MW3, I_MW2 };
constexpr int NPH = 12, GP_FINAL = DEPTH * NPH, GP_TOTAL = GP_FINAL + 1;

struct Frame { LAS unsigned char* lds; int tid, lane, wave, vcu, G, gw, NGW; const Args* a; unsigned char* ws; };

__device__ __forceinline__ void transpose_item(const float* W, int ldw, bf16* WT, int ldt, int k0, int src_col0, int dst_row0, LAS float* scr, int lane, const float* ks = nullptr) {
    f32x4 ld[8];
#pragma unroll
    for (int i = 0; i < 8; ++i) ld[i] = *(const f32x4*)(W + (size_t)(k0 + 8 * i + (lane >> 3)) * ldw + src_col0 + 4 * (lane & 7));
#pragma unroll
    for (int i = 0; i < 8; ++i) { LAS float* d = scr + (8 * i + (lane >> 3)) * 33 + 4 * (lane & 7); const float s = ks ? ks[k0 + 8 * i + (lane >> 3)] : 1.0f; d[0] = ld[i][0] * s; d[1] = ld[i][1] * s; d[2] = ld[i][2] * s; d[3] = ld[i][3] * s; }
    LDS_WAIT(); asm volatile("" ::: "memory");
    const int c = lane & 7;
#pragma unroll
    for (int j = 0; j < 4; ++j) { const int n = (lane >> 3) + 8 * j; const LAS float* s = scr + (8 * c) * 33 + n;
        v4u o; o.x = pk2(s[0 * 33], s[1 * 33]); o.y = pk2(s[2 * 33], s[3 * 33]); o.z = pk2(s[4 * 33], s[5 * 33]); o.w = pk2(s[6 * 33], s[7 * 33]);
        *(GAS v4u*)(WT + (size_t)(dst_row0 + n) * ldt + k0 + 8 * c) = o; }
    LDS_WAIT(); asm volatile("" ::: "memory");
}
__device__ __forceinline__ void transpose_item_f8(const float* W, int ldw, unsigned char* WT, int ldt, int k0, int src_col0, int dst_row0, LAS float* scr, int lane, float sc, const float* ks = nullptr) {
    f32x4 ld[8];
#pragma unroll
    for (int i = 0; i < 8; ++i) ld[i] = *(const f32x4*)(W + (size_t)(k0 + 8 * i + (lane >> 3)) * ldw + src_col0 + 4 * (lane & 7));
#pragma unroll
    for (int i = 0; i < 8; ++i) { LAS float* d = scr + (8 * i + (lane >> 3)) * 33 + 4 * (lane & 7); const float s = ks ? sc * ks[k0 + 8 * i + (lane >> 3)] : sc; d[0] = ld[i][0] * s; d[1] = ld[i][1] * s; d[2] = ld[i][2] * s; d[3] = ld[i][3] * s; }
    LDS_WAIT(); asm volatile("" ::: "memory");
    const int c = lane & 7;
#pragma unroll
    for (int j = 0; j < 4; ++j) { const int n = (lane >> 3) + 8 * j; const LAS float* s = scr + (8 * c) * 33 + n;
        v2u o; o.x = pk4_fp8(s[0 * 33], s[1 * 33], s[2 * 33], s[3 * 33]); o.y = pk4_fp8(s[4 * 33], s[5 * 33], s[6 * 33], s[7 * 33]);
        *(GAS v2u*)(WT + (size_t)(dst_row0 + n) * ldt + k0 + 8 * c) = o; }
    LDS_WAIT(); asm volatile("" ::: "memory");
}
__device__ __forceinline__ int win_src_col(int blk) {
    const int tile = blk >> 3, j = blk & 7, bj = j >> 2, hh = j & 3;
    if (tile == 0) return 32 * j;
    if (tile == 1 || tile == 2) return 256 + 256 * (tile - 1) + 64 * hh + 32 * bj;
    if (tile == 3) return 768 + 32 * j;
    if (tile == 4 || tile == 5) return (j < 4) ? (1028 + 128 * (tile - 4) + 32 * j) : (1284 + 128 * (tile - 4) + 32 * (j - 4));
    if (tile == 6 || tile == 7) return 1540 + 256 * (tile - 6) + 64 * hh + 32 * bj;
    if (tile == 8) return 2052 + 32 * j;
    return 2308 + 256 * (tile - 9) + 32 * j;
}
constexpr int CONV_NIN = 200 * 16, CONV_NBR = 4 * 32 * 4, CONV_NOUT = 32 * 16, CONV_NGLU = 8 * 4, CONV_NUP1 = 176 * 16, CONV_NDN1 = 32 * 44;
constexpr int CONV_NMIX = CONV_NIN + CONV_NBR + CONV_NOUT + CONV_NGLU, CONV_CHUNK = 64;
__device__ __forceinline__ int conv_ffn_items(int layer) { return (CONV_NUP1 + CONV_NDN1) * ((layer & 1) ? NE : 1); }
__device__ __forceinline__ void convert_item(Frame& F, int layer, int it, LAS float* scr) {
    const Args& A = *F.a; unsigned char* ws = F.ws;
    const bool moe = (layer & 1) != 0; const int j2 = layer >> 1, ne = moe ? NE : 1;
    const int n_up = CONV_NUP1 * ne;
    int r = it;
    if (r < CONV_NIN) { const int blk = r >> 4, kb = r & 15;
        if (F8_GATES && blk >= 72) transpose_item_f8(A.in[I_WIN] + (size_t)layer * D * DP, DP, (unsigned char*)(ws + WS_WIN8), D, 64 * kb, win_src_col(blk), 32 * (blk - 72), scr, F.lane, 64.0f);
        else transpose_item(A.in[I_WIN] + (size_t)layer * D * DP, DP, (bf16*)(ws + WS_WIN), D, 64 * kb, win_src_col(blk), 32 * blk, scr, F.lane);
        return; } r -= CONV_NIN;
    if (r < CONV_NBR) { const int z = r >> 7, q = r & 127, blk = q >> 2, kb = q & 3;
        transpose_item(A.in[I_WBR] + ((size_t)layer * 4 + z) * 256 * D, D, (bf16*)(ws + WS_WBR) + (size_t)z * D * 256, 256, 64 * kb, 32 * blk, 32 * blk, scr, F.lane); return; } r -= CONV_NBR;
    if (r < CONV_NOUT) { const int blk = r >> 4, kb = r & 15; transpose_item(A.in[I_WOUT] + (size_t)layer * D * D, D, (bf16*)(ws + WS_WOUT), D, 64 * kb, 32 * blk, 32 * blk, scr, F.lane); return; } r -= CONV_NOUT;
    if (r < CONV_NGLU) { const int blk = r >> 2, kb = r & 3; transpose_item(A.in[I_WGLU] + (size_t)layer * 256 * 256, 256, (bf16*)(ws + WS_WGLU), 256, 64 * kb, 32 * blk, 32 * blk, scr, F.lane); return; } r -= CONV_NGLU;
    if (r < n_up) { const int e = r / CONV_NUP1, q = r % CONV_NUP1, blk = q >> 4, kb = q & 15, tile = blk >> 3, jj = blk & 7;
        const float* w1 = moe ? A.in[I_MW1] + ((size_t)j2 * NE + e) * D * FF : A.in[I_W1] + (size_t)j2 * D * FF;
        const float* w3 = moe ? A.in[I_MW3] + ((size_t)j2 * NE + e) * D * FF : A.in[I_W3] + (size_t)j2 * D * FF;
        const float* ks = (FUSE_DENSE_NORM && !moe) ? A.in[I_GFFN] + layer * D : nullptr;
        if (moe ? (F8_MOE_UP != 0) : (DENSE8(layer) != 0)) transpose_item_f8(jj < 4 ? w1 : w3, FF, (unsigned char*)(ws + WS_WUP) + (size_t)e * 5632 * D, D, 64 * kb, 128 * tile + 32 * (jj & 3), 32 * blk, scr, F.lane, 64.0f, ks);
        else transpose_item(jj < 4 ? w1 : w3, FF, (bf16*)(ws + WS_WUP) + (size_t)e * 5632 * D, D, 64 * kb, 128 * tile + 32 * (jj & 3), 32 * blk, scr, F.lane, ks);
        return; } r -= n_up;
    { const int e = r / CONV_NDN1, q = r % CONV_NDN1, blk = q / 44, kb = q % 44;
        const float* w2 = moe ? A.in[I_MW2] + ((size_t)j2 * NE + e) * FF * D : A.in[I_W2] + (size_t)j2 * FF * D;
        if (moe ? (F8_MOE_DN != 0) : (DENSE8(layer) != 0)) transpose_item_f8(w2, D, (unsigned char*)(ws + WS_WDN) + (size_t)e * D * FF, FF, 64 * kb, 32 * blk, 32 * blk, scr, F.lane, 64.0f);
        else transpose_item(w2, D, (bf16*)(ws + WS_WDN) + (size_t)e * D * FF, FF, 64 * kb, 32 * blk, 32 * blk, scr, F.lane); }
}
__device__ __forceinline__ void phase_convert(Frame& F, int layer) {
    LAS float* scr = (LAS float*)(F.lds + F.wave * 16384);
    for (int it = F.gw; it < CONV_NMIX; it += F.NGW) convert_item(F, layer, it, scr);
}
__device__ __forceinline__ void ffn_item_load(const Args& A, int layer, int r, int lane, f32x4 (&ld)[8]) {
    asm volatile("" : "+v"(r));
    const bool moe = (layer & 1) != 0; const int j2 = layer >> 1, n_up = CONV_NUP1 * (moe ? NE : 1);
    const float* w; int ldw, k0, col0;
    if (r < n_up) { const int e = r / CONV_NUP1, q = r % CONV_NUP1, blk = q >> 4, kb = q & 15, tile = blk >> 3, jj = blk & 7;
        const size_t off = moe ? ((size_t)j2 * NE + e) * D * FF : (size_t)j2 * D * FF;
        w = (moe ? (jj < 4 ? A.in[I_MW1] : A.in[I_MW3]) : (jj < 4 ? A.in[I_W1] : A.in[I_W3])) + off; ldw = FF; k0 = 64 * kb; col0 = 128 * tile + 32 * (jj & 3);
    } else { r -= n_up; const int e = r / CONV_NDN1, q = r % CONV_NDN1, blk = q / 44, kb = q % 44;
        w = moe ? A.in[I_MW2] + ((size_t)j2 * NE + e) * FF * D : A.in[I_W2] + (size_t)j2 * FF * D; ldw = D; k0 = 64 * kb; col0 = 32 * blk; }
    w += (size_t)(k0 + (lane >> 3)) * ldw + col0 + 4 * (lane & 7);
#pragma unroll
    for (int i = 0; i < 8; ++i) ld[i] = *(const f32x4*)(w + (size_t)(8 * i) * ldw);
}
__device__ __forceinline__ void ffn_item_finish(const Args& A, unsigned char* ws, int layer, int r, int lane, f32x4 (&ld)[8], LAS float* scr) {
    asm volatile("" : "+v"(r));
    const bool moe = (layer & 1) != 0; const int n_up = CONV_NUP1 * (moe ? NE : 1);
    const bool f8 = moe ? (F8_MOE_UP != 0) : (DENSE8(layer) != 0); const float sc = f8 ? 64.0f : 1.0f;
    const bool up = r < n_up; int e, k0, row0, ldt; size_t dbase;
    if (up) { e = r / CONV_NUP1; const int q = r % CONV_NUP1, blk = q >> 4, kb = q & 15; k0 = 64 * kb; row0 = 32 * blk; ldt = D; dbase = WS_WUP + (size_t)e * 5632 * D * (f8 ? 1 : 2); }
    else { r -= n_up; e = r / CONV_NDN1; const int q = r % CONV_NDN1, blk = q / 44, kb = q % 44; k0 = 64 * kb; row0 = 32 * blk; ldt = FF; dbase = WS_WDN + (size_t)e * D * FF * (f8 ? 1 : 2); }
    const bool scaled = FUSE_DENSE_NORM && !moe && up;
    const float* ks = A.in[I_GFFN] + layer * D + k0 + (lane >> 3);
#pragma unroll
    for (int i = 0; i < 8; ++i) { LAS float* d = scr + (8 * i + (lane >> 3)) * 33 + 4 * (lane & 7); const float s = scaled ? sc * ks[8 * i] : sc; d[0] = ld[i][0] * s; d[1] = ld[i][1] * s; d[2] = ld[i][2] * s; d[3] = ld[i][3] * s; }
    LDS_WAIT(); asm volatile("" ::: "memory");
    const int c = lane & 7;
    if (f8) {
#pragma unroll
        for (int j = 0; j < 4; ++j) { const int n = (lane >> 3) + 8 * j; const LAS float* s = scr + (8 * c) * 33 + n;
            v2u o; o.x = pk4_fp8(s[0 * 33], s[1 * 33], s[2 * 33], s[3 * 33]); o.y = pk4_fp8(s[4 * 33], s[5 * 33], s[6 * 33], s[7 * 33]);
            *(GAS v2u*)(ws + dbase + (size_t)(row0 + n) * ldt + k0 + 8 * c) = o; }
    } else {
#pragma unroll
        for (int j = 0; j < 4; ++j) { const int n = (lane >> 3) + 8 * j; const LAS float* s = scr + (8 * c) * 33 + n;
            v4u o; o.x = pk2(s[0 * 33], s[1 * 33]); o.y = pk2(s[2 * 33], s[3 * 33]); o.z = pk2(s[4 * 33], s[5 * 33]); o.w = pk2(s[6 * 33], s[7 * 33]);
            *(GAS v4u*)((bf16*)(ws + dbase) + (size_t)(row0 + n) * ldt + k0 + 8 * c) = o; }
    }
    LDS_WAIT(); asm volatile("" ::: "memory");
}
__device__ __forceinline__ void convert_ffn_chunk(Frame& F, int layer, int chunk) {
    LAS float* scr = (LAS float*)(F.lds + F.wave * 16384); const int nf = conv_ffn_items(layer), base = chunk * CONV_CHUNK + F.wave;
    const Args& A = *F.a; unsigned char* ws = F.ws; const int lane = F.lane;
    f32x4 la[8], lb[8];
    ffn_item_load(A, layer, min(base, nf - 1), lane, la);
#pragma unroll 1
    for (int jj = 0; jj < CONV_CHUNK / NWAVES; jj += 2) {
        const int i0 = base + NWAVES * jj, i1 = i0 + NWAVES, i2 = i1 + NWAVES;
        ffn_item_load(A, layer, min(i1, nf - 1), lane, lb);
        if (i0 < nf) ffn_item_finish(A, ws, layer, i0, lane, la, scr);
        if (jj + 2 < CONV_CHUNK / NWAVES) ffn_item_load(A, layer, min(i2, nf - 1), lane, la);
        if (i1 < nf) ffn_item_finish(A, ws, layer, i1, lane, lb, scr);
    }
}
struct S5P { float lr, li, dt, kr, ki; };
__device__ __forceinline__ S5P s5_params(const Args& A, int layer, int g, int p) {
    S5P q; q.lr = A.in[I_LRE][(layer * 16 + g) * 64 + p]; q.li = A.in[I_LIM][(layer * 16 + g) * 64 + p]; q.dt = expf(A.in[I_LDT][layer * 16 + g]);
    const float mag = expf(q.lr * q.dt), abr = mag * cosf(q.li * q.dt), abi = mag * sinf(q.li * q.dt);
    const float nr = abr - 1.0f, ni = abi, den = q.lr * q.lr + q.li * q.li;
    q.kr = (nr * q.lr + ni * q.li) / den; q.ki = (ni * q.lr - nr * q.li) / den; return q;
}
__device__ __forceinline__ void s5_pow(const S5P& q, float n, float& pr, float& pi) { const float m = expf(n * q.lr * q.dt), a = n * q.li * q.dt; pr = m * cosf(a); pi = m * sinf(a); }
__device__ __forceinline__ void phase_kfun(Frame& F, int layer) {
    const Args& A = *F.a; float* kf = (float*)(F.ws + WS_KFUN);
    for (int it = F.gw; it < 16 * 64; it += F.NGW) {
        const int g = it >> 6, tau = it & 63, lane = F.lane;
        const S5P q = s5_params(A, layer, g, lane); float pr, pi; s5_pow(q, (float)tau, pr, pi);
        const float wr_ = pr * q.kr - pi * q.ki, wi_ = pr * q.ki + pi * q.kr;
        const int h = lane >> 2, hp0 = 4 * (lane & 3);
        const float* cre = A.in[I_CRE] + ((size_t)(layer * 16 + g) * 16 + h) * 64; const float* cim = A.in[I_CIM] + ((size_t)(layer * 16 + g) * 16 + h) * 64;
        const float* bre = A.in[I_BRE] + (size_t)(layer * 16 + g) * 64 * 16 + hp0; const float* bim = A.in[I_BIM] + (size_t)(layer * 16 + g) * 64 * 16 + hp0;
        f32x4 acc = {0.f, 0.f, 0.f, 0.f};
        for (int p = 0; p < 64; ++p) {
            const float wpr = __shfl(wr_, p), wpi = __shfl(wi_, p);
            const float cr = cre[p], ci = cim[p], cwr = cr * wpr - ci * wpi, cwi = cr * wpi + ci * wpr;
            const f32x4 br = *(const f32x4*)(bre + p * 16), bi = *(const f32x4*)(bim + p * 16);
            acc += cwr * br - cwi * bi;
        }
        *(f32x4*)(kf + ((size_t)(g * 64 + tau) * 16 + h) * 16 + hp0) = acc;
    }
}
__device__ __forceinline__ void moe_starts(Frame& F, int j2, int (&st)[NE + 1]) {
    const unsigned* cnt = (const unsigned*)(F.ws + WS_CTL) + CW_MOE + 64 * j2; int s = 0;
#pragma unroll
    for (int e = 0; e < NE; ++e) { st[e] = s; const int c = (int)__hip_atomic_load(cnt + e, __ATOMIC_RELAXED, __HIP_MEMORY_SCOPE_AGENT); s += (c + 255) & ~255; }
    st[NE] = s;
}
__device__ __forceinline__ void moe_combine_row(Frame& F, int row, f32x4 (&v)[4], const int (&st)[NE + 1]) {
    const unsigned* rt = (const unsigned*)(F.ws + WS_ROUTE) + (size_t)row * 8;
    const v4u rr = *(const v4u*)rt; unsigned s0 = rr.z, s1 = rr.w;
#pragma unroll
    for (int e = 0; e < NE; ++e) { if ((int)rr.x == e) s0 += (unsigned)st[e]; if ((int)rr.y == e) s1 += (unsigned)st[e]; }
    const float w0 = __builtin_bit_cast(float, rt[4]), w1 = __builtin_bit_cast(float, rt[5]);
    const bf16* yp = (const bf16*)(F.ws + WS_XNP);
#pragma unroll
    for (int j = 0; j < 4; ++j) { const v2u a = *(const v2u*)(yp + (size_t)s0 * D + 4 * F.lane + 256 * j), b = *(const v2u*)(yp + (size_t)s1 * D + 4 * F.lane + 256 * j);
        v[j][0] += w0 * bflo(a.x) + w1 * bflo(b.x); v[j][1] += w0 * bfhi(a.x) + w1 * bfhi(b.x); v[j][2] += w0 * bflo(a.y) + w1 * bflo(b.y); v[j][3] += w0 * bfhi(a.y) + w1 * bfhi(b.y); }
}
__device__ __forceinline__ void phase_rows_mixer(Frame& F, int layer) {
    const Args& A = *F.a; const int lane = F.lane;
    const float* xin = A.in[I_X]; bf16* xb = (bf16*)(F.ws + WS_XB); const bool first = (layer == 0), comb = (layer > 0) && (((layer - 1) & 1) != 0);
    f32x4 gv[4]; f32x4 wf[4][4];
#pragma unroll
    for (int j = 0; j < 4; ++j) { gv[j] = *(const f32x4*)(A.in[I_GMIX] + layer * D + 4 * lane + 256 * j);
#pragma unroll
        for (int e = 0; e < 4; ++e) wf[j][e] = *(const f32x4*)(A.in[I_WIN] + (size_t)layer * D * DP + (size_t)(4 * lane + 256 * j + e) * DP + 1024); }
    const f32x4 bf = *(const f32x4*)(A.in[I_BFORGET] + layer * 4);
    bf16* xn = (bf16*)(F.ws + WS_XN); float* lf = (float*)(F.ws + WS_LF); unsigned char* xn8 = F.ws + WS_XN8;
    int st[NE + 1];
#pragma unroll
    for (int e = 0; e <= NE; ++e) st[e] = 0;
    if (comb) moe_starts(F, (layer - 1) >> 1, st);
    for (int row = F.gw; row < T; row += F.NGW) {
        f32x4 v[4]; float ss = 0.f;
        if (first) {
#pragma unroll
            for (int j = 0; j < 4; ++j) v[j] = *(const f32x4*)(xin + (size_t)row * D + 4 * lane + 256 * j);
        } else {
#pragma unroll
            for (int j = 0; j < 4; ++j) { const v2u r = *(const v2u*)(xb + (size_t)row * D + 4 * lane + 256 * j); v[j] = (f32x4){bflo(r.x), bfhi(r.x), bflo(r.y), bfhi(r.y)}; }
        }
        if (comb) { moe_combine_row(F, row, v, st);
#pragma unroll
            for (int j = 0; j < 4; ++j) { v2u o; o.x = pk2(v[j][0], v[j][1]); o.y = pk2(v[j][2], v[j][3]); *(v2u*)(xb + (size_t)row * D + 4 * lane + 256 * j) = o;
                v[j] = (f32x4){bflo(o.x), bfhi(o.x), bflo(o.y), bfhi(o.y)}; } }
#pragma unroll
        for (int j = 0; j < 4; ++j) ss += (v[j][0] * v[j][0] + v[j][1] * v[j][1]) + (v[j][2] * v[j][2] + v[j][3] * v[j][3]);
        const float rs = 1.0f / sqrtf(wave_sum(ss) * (1.0f / D) + EPS);
        f32x4 fl = {0.f, 0.f, 0.f, 0.f};
#pragma unroll
        for (int j = 0; j < 4; ++j) { const f32x4 h = v[j] * rs * gv[j];
            v2u o; o.x = pk2(h[0], h[1]); o.y = pk2(h[2], h[3]); *(v2u*)(xn + (size_t)row * D + 4 * lane + 256 * j) = o;
            if (F8_GATES) *(unsigned*)(xn8 + (size_t)row * D + 4 * lane + 256 * j) = pk4_fp8(h[0], h[1], h[2], h[3]);
#pragma unroll
            for (int e = 0; e < 4; ++e) fl += h[e] * wf[j][e]; }
#pragma unroll
        for (int e = 0; e < 4; ++e) fl[e] = wave_sum(fl[e]);
        if (lane == 0) { f32x4 o;
#pragma unroll
            for (int e = 0; e < 4; ++e) { const float xx = fl[e] + bf[e]; o[e] = (fminf(xx, 0.f) - log1pf(expf(-fabsf(xx)))) * LOG2E; }
            *(f32x4*)(lf + (size_t)row * 4) = o; }
    }
}
__device__ __forceinline__ void phase_s5_tables(Frame& F, int layer) {
    const Args& A = *F.a; const int lane = F.lane;
    bf16* wz = (bf16*)(F.ws + WS_WZ); bf16* wy = (bf16*)(F.ws + WS_WY); const float* kf = (const float*)(F.ws + WS_KFUN);
    for (int it = F.gw; it < 16 * 256; it += F.NGW) {
        const int g = it >> 8, rowz = it & 255; bf16* dst = wz + ((size_t)(g * 256 + rowz)) * 1024 + lane * 16;
        v4u o0 = {0u, 0u, 0u, 0u}, o1 = {0u, 0u, 0u, 0u};
        if (rowz < 128) { const int p = rowz >> 1, ri = rowz & 1; const S5P q = s5_params(A, layer, g, p); float pr, pi; s5_pow(q, (float)(63 - lane), pr, pi);
            const float wr_ = pr * q.kr - pi * q.ki, wi_ = pr * q.ki + pi * q.kr;
            const float* bre = A.in[I_BRE] + ((size_t)(layer * 16 + g) * 64 + p) * 16; const float* bim = A.in[I_BIM] + ((size_t)(layer * 16 + g) * 64 + p) * 16;
            float val[16];
#pragma unroll
            for (int h = 0; h < 16; ++h) { const float br = bre[h], bi = bim[h]; val[h] = ri == 0 ? (wr_ * br - wi_ * bi) : (wr_ * bi + wi_ * br); }
            o0 = (v4u){pk2(val[0], val[1]), pk2(val[2], val[3]), pk2(val[4], val[5]), pk2(val[6], val[7])};
            o1 = (v4u){pk2(val[8], val[9]), pk2(val[10], val[11]), pk2(val[12], val[13]), pk2(val[14], val[15])}; }
        *(v4u*)dst = o0; *(v4u*)(dst + 8) = o1;
    }
    for (int it = F.gw; it < 16 * 1024; it += F.NGW) {
        const int g = it >> 10, n = it & 1023, t = n >> 4, h = n & 15; bf16* dst = wy + ((size_t)(g * 1024 + n)) * S5_LDA;
        v4u o0 = {0u, 0u, 0u, 0u}, o1 = {0u, 0u, 0u, 0u};
        if (lane <= t) { const float* src = kf + ((size_t)(g * 64 + (t - lane)) * 16 + h) * 16;
            const f32x4 a = *(const f32x4*)src, b = *(const f32x4*)(src + 4), c = *(const f32x4*)(src + 8), d = *(const f32x4*)(src + 12);
            o0 = (v4u){pk2(a[0], a[1]), pk2(a[2], a[3]), pk2(b[0], b[1]), pk2(b[2], b[3])}; o1 = (v4u){pk2(c[0], c[1]), pk2(c[2], c[3]), pk2(d[0], d[1]), pk2(d[2], d[3])}; }
        *(v4u*)(dst + lane * 16) = o0; *(v4u*)(dst + lane * 16 + 8) = o1;
        const S5P q = s5_params(A, layer, g, lane); float pr, pi; s5_pow(q, (float)(t + 1), pr, pi);
        const float cr = A.in[I_CRE][((size_t)(layer * 16 + g) * 16 + h) * 64 + lane], ci = A.in[I_CIM][((size_t)(layer * 16 + g) * 16 + h) * 64 + lane];
        *(unsigned*)(dst + 1024 + 2 * lane) = pk2(cr * pr - ci * pi, -(cr * pi + ci * pr));
    }
}
__device__ __forceinline__ void phase_cumsum(Frame& F) {
    const int first = (gridDim.x >= 160) ? 128 : 0;
    if ((int)blockIdx.x < first || (int)blockIdx.x >= first + 32) return;
    const int bh = (int)blockIdx.x - first, b = bh >> 2, h = bh & 3, tid = F.tid;
    const float* lf = (const float*)(F.ws + WS_LF); float* cum = (float*)(F.ws + WS_CUM);
    LAS float* wtot = (LAS float*)(F.lds);
    float v[8]; float run = 0.f;
#pragma unroll
    for (int i = 0; i < 8; ++i) { run += lf[((size_t)b * SEQ + tid * 8 + i) * 4 + h]; v[i] = run; }
    float incl = run;
#pragma unroll
    for (int o = 1; o < 64; o <<= 1) { const float n = __shfl_up(incl, o); if (F.lane >= o) incl += n; }
    if (F.lane == 63) wtot[F.wave] = incl;
    __syncthreads();
    float base = incl - run;
    for (int w = 0; w < F.wave; ++w) base += wtot[w];
#pragma unroll
    for (int i = 0; i < 8; ++i) cum[(size_t)bh * SEQ + tid * 8 + i] = base + v[i];
    __syncthreads();
}
__device__ __forceinline__ void phase_conv(Frame& F, int layer) {
    const Args& A = *F.a; const int lane = F.lane;
    LAS f32x4* wl = (LAS f32x4*)F.lds;
    { int ly = layer; asm volatile("" : "+v"(ly));
      const float* cw = A.in[I_CONVW] + (size_t)ly * 31 * 256;
      for (int i = F.tid; i < 31 * 64; i += NWAVES * 64) wl[i] = *(const f32x4*)(cw + (size_t)i * 4); }
    __syncthreads();
    const f32x4 cb = *(const f32x4*)(A.in[I_CONVB] + layer * 256 + 4 * lane), lg = *(const f32x4*)(A.in[I_LNG] + layer * 256 + 4 * lane), lb = *(const f32x4*)(A.in[I_LNB] + layer * 256 + 4 * lane);
    const bf16* uc = (const bf16*)(F.ws + WS_UC); bf16* ycat = (bf16*)(F.ws + WS_YCAT);
    for (int run = F.gw; run < T / 8; run += F.NGW) {
        const int t0 = run * 8, tl0 = t0 & (SEQ - 1);
        f32x4 acc[8];
#pragma unroll
        for (int i = 0; i < 8; ++i) acc[i] = cb;
#pragma unroll
        for (int r = 0; r < 38; ++r) {
            v2u raw = {0u, 0u};
            if (tl0 - 30 + r >= 0) raw = *(const v2u*)(uc + (size_t)(t0 - 30 + r) * 256 + 4 * lane);
            const f32x4 x = {bflo(raw.x), bfhi(raw.x), bflo(raw.y), bfhi(raw.y)};
#pragma unroll
            for (int i = 0; i < 8; ++i) { const int j = r - i; if (j >= 0 && j < 31) acc[i] += wl[j * 64 + lane] * x; }
        }
#pragma unroll
        for (int i = 0; i < 8; ++i) {
            const f32x4 a = acc[i];
            const float mean = wave_sum((a[0] + a[1]) + (a[2] + a[3])) * (1.0f / 256.0f);
            const f32x4 dlt = a - mean;
            const float var = wave_sum((dlt[0] * dlt[0] + dlt[1] * dlt[1]) + (dlt[2] * dlt[2] + dlt[3] * dlt[3])) * (1.0f / 256.0f);
            const float rs = 1.0f / sqrtf(var + EPS);
            f32x4 y = dlt * rs * lg + lb;
#pragma unroll
            for (int e = 0; e < 4; ++e) y[e] = y[e] * sigmoidf_(y[e]);
            v2u o; o.x = pk2(y[0], y[1]); o.y = pk2(y[2], y[3]);
            *(v2u*)(ycat + (size_t)(t0 + i) * 1024 + 512 + 4 * lane) = o;
        }
    }
    __syncthreads();
}

typedef float f32x16 __attribute__((ext_vector_type(16)));
typedef short s16x4 __attribute__((ext_vector_type(4)));
constexpr int AW_BLKS = 11, AW_KEYS = 32 * AW_BLKS, AW_K = 0, AW_V = AW_KEYS * 128, AW_C = 2 * AW_KEYS * 128, AW_FLAG = AW_C + AW_KEYS * 4;
constexpr float SB_DEAD = -64.0f;
__device__ __forceinline__ s16x4 tr_read(const LAS unsigned char* p) { return __builtin_bit_cast(s16x4, __builtin_amdgcn_ds_read_tr16_b64_v4i16((LAS s16x4*)p)); }

template <int MODE>
__device__ __forceinline__ void attn_unit(Frame& F, int bh, int qb, const bf16* Q, const bf16* K, const bf16* V, const float* CUM, bf16* Y, float z2max) {
    const int tid = F.tid, lane = F.lane, w = F.wave, l31 = lane & 31, hh = lane >> 5;
    const int b = bh >> 2, h = bh & 3, qblk = qb * 8 + w, qw0 = 32 * qblk, qrow = qw0 + l31;
    const size_t rowbase = (size_t)b * SEQ;
    LAS unsigned char* lds = F.lds;
    LAS unsigned* flags = (LAS unsigned*)(lds + AW_FLAG);
    if (tid < 3) flags[tid] = 0u;
    bf16x8 qf[4];
#pragma unroll
    for (int s = 0; s < 4; ++s) qf[s] = *(const bf16x8*)(Q + (rowbase + qrow) * 256 + h * 64 + 16 * s + 8 * hh);
    f32x16 ot[2];
#pragma unroll
    for (int r = 0; r < 16; ++r) { ot[0][r] = 0.f; ot[1][r] = 0.f; }
    float m_run = -INFINITY, l_run = 0.f, carry = 0.f;
    const int ti = lane & 15, tq = ti >> 2, tp = ti & 3, tg = (lane >> 4) & 1;
    int kofs[4], vofs[2];
#pragma unroll
    for (int s = 0; s < 4; ++s) kofs[s] = AW_K + l31 * 128 + (((2 * s + hh) ^ (l31 & 7)) << 4);
#pragma unroll
    for (int db = 0; db < 2; ++db) vofs[db] = AW_V + (4 * hh + tq) * 128 + (((4 * db + 2 * tg + (tp >> 1)) ^ (4 * hh + tq)) << 4) + 8 * (tp & 1);
    const int srow = lane >> 3, sch = ((lane & 7) ^ srow) * 8;
    int kbw = qblk; bool done = false; int it = 0;
    for (int whi = qb * 8 + 7; whi >= 0; whi -= AW_BLKS, ++it) {
        const int wlo = whi - (AW_BLKS - 1), key0 = 32 * wlo;
        for (int g = w; g < 2 * AW_KEYS / 8; g += NWAVES) {
            const int gg = g < AW_KEYS / 8 ? g : g - AW_KEYS / 8; const int key = max(key0 + 8 * gg + srow, 0);
            const bf16* src = (g < AW_KEYS / 8 ? K : V) + (rowbase + key) * 256 + h * 64 + sch;
            __builtin_amdgcn_global_load_lds((const unsigned*)src, (LAS unsigned*)(lds + (g < AW_KEYS / 8 ? AW_K : AW_V) + gg * 1024), 16, 0, 0);
        }
        if (MODE == 0 && tid < AW_KEYS) *(LAS float*)(lds + AW_C + tid * 4) = -CUM[(size_t)bh * SEQ + max(key0 + tid, 0)];
        asm volatile("s_waitcnt vmcnt(0)" ::: "memory");
        __syncthreads();
        if (!done) {
            const int lo = max(wlo, 0);
            for (; kbw >= lo; --kbw) {
                const int kv0 = 32 * kbw, rb = (kbw - wlo) * 32;
                if (MODE == 0) { const float clast = *(const LAS float*)(lds + AW_C + (rb + 31) * 4); if (__all((z2max + clast - m_run) < SB_DEAD)) { done = true; break; } }
                else if (__all(carry < SB_DEAD)) { done = true; break; }
                f32x16 p;
                if (MODE == 0) {
#pragma unroll
                    for (int c = 0; c < 4; ++c) { const f32x4 ck = *(const LAS f32x4*)(lds + AW_C + (rb + 8 * c + 4 * hh) * 4); p[4 * c] = ck[0]; p[4 * c + 1] = ck[1]; p[4 * c + 2] = ck[2]; p[4 * c + 3] = ck[3]; }
                } else {
#pragma unroll
                    for (int r = 0; r < 16; ++r) p[r] = 0.f;
                }
#pragma unroll
                for (int s = 0; s < 4; ++s) { const bf16x8 kf = *(const LAS bf16x8*)(lds + rb * 128 + kofs[s]); p = __builtin_amdgcn_mfma_f32_32x32x16_bf16(kf, qf[s], p, 0, 0, 0); }
                const bool diag = (kbw == qblk);
                if (MODE == 0) {
                    if (diag) {
#pragma unroll
                        for (int r = 0; r < 16; ++r) { const int kvg = kv0 + (r & 3) + 8 * (r >> 2) + 4 * hh; if (kvg > qrow) p[r] = -INFINITY; }
                    }
                    float mt = p[0];
#pragma unroll
                    for (int r = 1; r < 16; ++r) mt = fmaxf(mt, p[r]);
                    mt = fmaxf(mt, __shfl_xor(mt, 32));
                    const float mn = fmaxf(m_run, mt), alpha = fast_exp2(m_run - mn); m_run = mn;
                    float rs = 0.f;
#pragma unroll
                    for (int r = 0; r < 16; ++r) { p[r] = fast_exp2(p[r] - mn); rs += p[r]; }
                    l_run = l_run * alpha + rs;
                    if (__any(alpha != 1.0f)) {
#pragma unroll
                        for (int r = 0; r < 16; ++r) { ot[0][r] *= alpha; ot[1][r] *= alpha; } }
                } else {
                    f32x16 lk;
#pragma unroll
                    for (int r = 0; r < 16; ++r) { const float z = p[r], e = fast_exp2(-fabsf(z)), lg = __builtin_amdgcn_logf(1.0f + e);
                        float lb = fminf(z, 0.f) - lg, k_ = -(fmaxf(z, 0.f) + lg);
                        if (diag) { const int kvg = kv0 + (r & 3) + 8 * (r >> 2) + 4 * hh; if (kvg >= qrow) { k_ = 0.f; lb = -INFINITY; } }
                        p[r] = lb; lk[r] = k_; }
                    float T4[4], To[4], PS[4];
#pragma unroll
                    for (int c = 0; c < 4; ++c) { T4[c] = (lk[4 * c] + lk[4 * c + 1]) + (lk[4 * c + 2] + lk[4 * c + 3]); To[c] = __shfl_xor(T4[c], 32); }
                    float run = 0.f;
#pragma unroll
                    for (int c = 3; c >= 0; --c) { PS[c] = run; run += T4[c] + To[c]; }
#pragma unroll
                    for (int c = 0; c < 4; ++c) { const float base = carry + PS[c] + (hh == 0 ? To[c] : 0.f);
                        const float s3 = lk[4 * c + 3], s2 = s3 + lk[4 * c + 2], s1 = s2 + lk[4 * c + 1];
                        p[4 * c + 3] = fast_exp2(p[4 * c + 3] + base); p[4 * c + 2] = fast_exp2(p[4 * c + 2] + base + s3);
                        p[4 * c + 1] = fast_exp2(p[4 * c + 1] + base + s2); p[4 * c] = fast_exp2(p[4 * c] + base + s1); }
                    carry += run;
                }
                bf16x8 pb[2];
#pragma unroll
                for (int c2 = 0; c2 < 2; ++c2) { v4u wv; wv.x = pg8::cvt_pk_bf16(p[8 * c2], p[8 * c2 + 1]); wv.y = pg8::cvt_pk_bf16(p[8 * c2 + 2], p[8 * c2 + 3]);
                    wv.z = pg8::cvt_pk_bf16(p[8 * c2 + 4], p[8 * c2 + 5]); wv.w = pg8::cvt_pk_bf16(p[8 * c2 + 6], p[8 * c2 + 7]); pb[c2] = __builtin_bit_cast(bf16x8, wv); }
#pragma unroll
                for (int db = 0; db < 2; ++db)
#pragma unroll
                    for (int c2 = 0; c2 < 2; ++c2) { const LAS unsigned char* vp = lds + (rb + 16 * c2) * 128 + vofs[db];
                        const s16x4 lo4 = tr_read(vp), hi4 = tr_read(vp + 8 * 128);
                        const bf16x8 va = {lo4[0], lo4[1], lo4[2], lo4[3], hi4[0], hi4[1], hi4[2], hi4[3]};
                        ot[db] = __builtin_amdgcn_mfma_f32_32x32x16_bf16(va, pb[c2], ot[db], 0, 0, 0); }
            }
            if (kbw < 0) done = true;
        }
        { const int sl = it % 3, sn = (it + 1) % 3;
            if (!done && lane == 0) flags[sl] = 1u;
            if (tid == 0) flags[sn] = 0u;
            __syncthreads();
            if (flags[sl] == 0u) break; }
    }
    float inv = 1.0f;
    if (MODE == 0) { const float lt = l_run + __shfl_xor(l_run, 32); inv = 1.0f / lt; }
    bf16* yrow = Y + (rowbase + qrow) * 1024 + h * 64;
#pragma unroll
    for (int db = 0; db < 2; ++db)
#pragma unroll
        for (int c = 0; c < 4; ++c) { v2u o; o.x = pg8::cvt_pk_bf16(ot[db][4 * c] * inv, ot[db][4 * c + 1] * inv); o.y = pg8::cvt_pk_bf16(ot[db][4 * c + 2] * inv, ot[db][4 * c + 3] * inv);
            *(v2u*)(yrow + 32 * db + 8 * c + 4 * hh) = o; }
}
__device__ __forceinline__ int q_pop(Frame& F, unsigned* ctr) {
    LAS int* slot = (LAS int*)(F.lds + QSLOT_OFF);
    __syncthreads();
    if (F.tid == 0) *slot = (int)__hip_atomic_fetch_add(ctr, 1u, __ATOMIC_RELAXED, __HIP_MEMORY_SCOPE_AGENT);
    __syncthreads();
    return *slot;
}
__device__ __forceinline__ void phase_attn_sb(Frame& F, int layer, int rep) {
    const bf16* qkv = (const bf16*)(F.ws + WS_QKV); const size_t sz = (size_t)T * 256; bf16* ycat = (bf16*)(F.ws + WS_YCAT);
    unsigned* ctr = (unsigned*)(F.ws + WS_CTL) + CW_Q + 128 * layer + 16 * rep;
    for (;;) { const int un = q_pop(F, ctr); if (un >= 512) break;
        attn_unit<1>(F, un & 31, 15 - (un >> 5), qkv + 3 * sz, qkv + 4 * sz, qkv + 5 * sz, nullptr, ycat + 768, 0.f); }
}
__device__ __forceinline__ void phase_attn_fox(Frame& F, int layer, int rep) {
    const bf16* qkv = (const bf16*)(F.ws + WS_QKV); const size_t sz = (size_t)T * 256; const float* cum = (const float*)(F.ws + WS_CUM); bf16* ycat = (bf16*)(F.ws + WS_YCAT);
    unsigned* ctr = (unsigned*)(F.ws + WS_CTL) + CW_Q + 128 * layer + 64 + 16 * rep;
    const float gq = fabsf(F.a->in[I_FQG][layer * 64 + F.lane]), gk = fabsf(F.a->in[I_FKG][layer * 64 + F.lane]);
    float mq = gq, mk = gk;
#pragma unroll
    for (int o = 1; o < 64; o <<= 1) { mq = fmaxf(mq, __shfl_xor(mq, o)); mk = fmaxf(mk, __shfl_xor(mk, o)); }
    const float z2max = 8.0f * mq * mk * LOG2E * 1.02f + 0.25f;
    const int nchunk = (conv_ffn_items(layer) + CONV_CHUNK - 1) / CONV_CHUNK;
    const int total = 512 + nchunk;
    for (;;) { const int t = q_pop(F, ctr); if (t >= total) break;
        const int na0 = (int)(((long)t * 512) / total), na1 = (int)(((long)(t + 1) * 512) / total);
        if (na1 > na0) attn_unit<0>(F, na0 & 31, 15 - (na0 >> 5), qkv, qkv + sz, qkv + 2 * sz, cum, ycat + 256, z2max);
        else convert_ffn_chunk(F, layer, t - na0); }
}
__device__ __forceinline__ void phase_s5_scan_unit(Frame& F, int layer, int g, int pm) {
    __builtin_amdgcn_fence(__ATOMIC_ACQUIRE, "agent");
    if (F.tid < 256) {
        const int b = 4 * pm + (F.tid >> 6), p = F.tid & 63;
        const S5P q = s5_params(*F.a, layer, g, p); float ar, ai; s5_pow(q, 64.0f, ar, ai);
        const float* z = (const float*)(F.ws + WS_Z); bf16* ua = (bf16*)(F.ws + WS_UA);
        float sr = 0.f, si = 0.f;
        for (int n0 = 0; n0 < 64; n0 += 16) {
            f32x2 zz[16];
#pragma unroll
            for (int j = 0; j < 16; ++j) zz[j] = *(const f32x2*)(z + ((size_t)g * 512 + b * 64 + n0 + j) * 128 + 2 * p);
#pragma unroll
            for (int j = 0; j < 16; ++j) { const size_t ch = (size_t)g * 512 + b * 64 + n0 + j;
                *(unsigned*)(ua + ch * S5_LDA + 1024 + 2 * p) = pk2(sr, si);
                const float nr = ar * sr - ai * si + zz[j][0], ni = ar * si + ai * sr + zz[j][1]; sr = nr; si = ni; }
        }
    }
    __syncthreads();
}
__device__ __forceinline__ void phase_rows_ffn(Frame& F, int layer) {
    const Args& A = *F.a; const int lane = F.lane; const int j2 = layer >> 1;
    f32x4 gv[4];
#pragma unroll
    for (int j = 0; j < 4; ++j) gv[j] = *(const f32x4*)(A.in[I_GFFN] + layer * D + 4 * lane + 256 * j);
    const bf16* xb = (const bf16*)(F.ws + WS_XB); unsigned char* seg = F.ws + WS_XNP; unsigned* route = (unsigned*)(F.ws + WS_ROUTE); unsigned* cnt = (unsigned*)(F.ws + WS_CTL) + CW_MOE + 64 * j2;
    unsigned my_e0 = 0, my_e1 = 0, my_r0 = 0, my_r1 = 0; float my_w0 = 0.f, my_w1 = 0.f, my_rs = 0.f; unsigned long long lc = 0ull; int nrow = 0;
    for (int row = F.gw; row < T; row += F.NGW, ++nrow) {
        f32x4 v[4]; float ss = 0.f;
#pragma unroll
        for (int j = 0; j < 4; ++j) { const v2u r = *(const v2u*)(xb + (size_t)row * D + 4 * lane + 256 * j); v[j] = (f32x4){bflo(r.x), bfhi(r.x), bflo(r.y), bfhi(r.y)};
            ss += (v[j][0] * v[j][0] + v[j][1] * v[j][1]) + (v[j][2] * v[j][2] + v[j][3] * v[j][3]); }
        const float rs = 1.0f / sqrtf(wave_sum(ss) * (1.0f / D) + EPS);
        float lg[8];
#pragma unroll
        for (int e = 0; e < 8; ++e) lg[e] = 0.f;
#pragma unroll
        for (int j = 0; j < 4; ++j) { const f32x4 h = v[j] * rs * gv[j];
#pragma unroll
            for (int e4 = 0; e4 < 4; ++e4) { const float* wr = A.in[I_RW] + ((size_t)j2 * D + 4 * lane + 256 * j + e4) * NE; const f32x4 a = *(const f32x4*)wr, b = *(const f32x4*)(wr + 4);
                lg[0] += h[e4] * a[0]; lg[1] += h[e4] * a[1]; lg[2] += h[e4] * a[2]; lg[3] += h[e4] * a[3]; lg[4] += h[e4] * b[0]; lg[5] += h[e4] * b[1]; lg[6] += h[e4] * b[2]; lg[7] += h[e4] * b[3]; } }
#pragma unroll
        for (int e = 0; e < 8; ++e) lg[e] = wave_sum(lg[e]) + A.in[I_RB][j2 * NE + e];
        int e0 = 0; float v0 = lg[0];
#pragma unroll
        for (int e = 1; e < 8; ++e) if (lg[e] > v0) { v0 = lg[e]; e0 = e; }
        int e1 = -1; float v1 = -INFINITY;
#pragma unroll
        for (int e = 0; e < 8; ++e) if (e != e0 && lg[e] > v1) { v1 = lg[e]; e1 = e; }
        const float w1 = 1.0f / (1.0f + expf(v0 - v1)), w0 = 1.0f - w1;
        const unsigned r0 = (unsigned)(lc >> (8 * e0)) & 0xffu; lc += 1ull << (8 * e0);
        const unsigned r1 = (unsigned)(lc >> (8 * e1)) & 0xffu; lc += 1ull << (8 * e1);
        if (lane == nrow) { my_e0 = e0; my_e1 = e1; my_r0 = r0; my_r1 = r1; my_w0 = w0; my_w1 = w1; my_rs = rs; }
    }
    unsigned basev = 0;
    if (lane < 8) { const unsigned c = (unsigned)(lc >> (8 * lane)) & 0xffu; basev = c ? __hip_atomic_fetch_add(cnt + lane, c, __ATOMIC_RELAXED, __HIP_MEMORY_SCOPE_AGENT) : 0u; }
    const unsigned my_p0 = __shfl(basev, (int)my_e0) + my_r0, my_p1 = __shfl(basev, (int)my_e1) + my_r1;
    if (lane < nrow) { const int row = F.gw + lane * F.NGW; unsigned* rt = route + (size_t)row * 8;
        *(v4u*)rt = (v4u){my_e0, my_e1, my_p0, my_p1}; *(v4u*)(rt + 4) = (v4u){__builtin_bit_cast(unsigned, my_w0), __builtin_bit_cast(unsigned, my_w1), 0u, 0u}; }
    for (int i = 0; i < nrow; ++i) {
        const int row = F.gw + i * F.NGW; const float rs = __shfl(my_rs, i);
        const size_t d0 = ((size_t)__shfl((int)my_e0, i) * T + (size_t)__shfl((int)my_p0, i)) * D, d1 = ((size_t)__shfl((int)my_e1, i) * T + (size_t)__shfl((int)my_p1, i)) * D;
#pragma unroll
        for (int j = 0; j < 4; ++j) { const v2u r = *(const v2u*)(xb + (size_t)row * D + 4 * lane + 256 * j);
            const f32x4 h = (f32x4){bflo(r.x), bfhi(r.x), bflo(r.y), bfhi(r.y)} * rs * gv[j]; const unsigned w = pk4_fp8(h[0], h[1], h[2], h[3]);
            *(unsigned*)(seg + d0 + 4 * lane + 256 * j) = w; *(unsigned*)(seg + d1 + 4 * lane + 256 * j) = w; }
    }
}
__device__ __forceinline__ void phase_final_combine(Frame& F) {
    const Args& A = *F.a; int st[NE + 1]; moe_starts(F, (DEPTH - 1) >> 1, st);
    for (int row = F.gw; row < T; row += F.NGW) {
        f32x4 v[4];
#pragma unroll
        for (int j = 0; j < 4; ++j) { const v2u r = *(const v2u*)((const bf16*)(F.ws + WS_XB) + (size_t)row * D + 4 * F.lane + 256 * j); v[j] = (f32x4){bflo(r.x), bfhi(r.x), bflo(r.y), bfhi(r.y)}; }
        moe_combine_row(F, row, v, st);
#pragma unroll
        for (int j = 0; j < 4; ++j) *(f32x4*)(A.out + (size_t)row * D + 4 * F.lane + 256 * j) = v[j];
    }
}

__global__ void __launch_bounds__(NWAVES * 64, 2) mk_fwd(Args args) {
    extern __shared__ __attribute__((aligned(16))) unsigned char lds_raw[];
    Frame F; F.lds = (LAS unsigned char*)lds_raw; F.tid = threadIdx.x; F.lane = F.tid & 63; F.wave = __builtin_amdgcn_readfirstlane(F.tid >> 6);
    F.G = gridDim.x; { const int bx = blockIdx.x; F.vcu = (F.G % 8 == 0) ? (bx % 8) * (F.G / 8) + bx / 8 : bx; }
    F.gw = F.vcu * NWAVES + F.wave; F.NGW = F.G * NWAVES; F.a = &args; F.ws = args.ws;
    volatile LAS unsigned* MISC = (volatile LAS unsigned*)(F.lds + MISC_OFF);
    for (int u = F.tid; u < (LDS_BYTES - RING_BYTES) / 4; u += NWAVES * 64) ((LAS unsigned*)(F.lds + RING_BYTES))[u] = 0u;
    __syncthreads();
    unsigned* ctl = (unsigned*)(args.ws + WS_CTL);
    const bool multi = (args.gp_hi - args.gp_lo) > 1;
    XcdBarrier bar; bar.bar = ctl + CW_BAR; bar.x = 0; bar.st = nullptr;
    if (multi) bar = xcd_barrier_post(ctl + CW_BAR, MISC + 8);
    unsigned char* ws = args.ws;
    LAS unsigned char* ring = F.lds;

    const int gp_lo = args.gp_lo, gp_hi = args.gp_hi;
#define IN(p) (gp_lo <= layer * NPH + (p) && layer * NPH + (p) < gp_hi)
#define SEAM(p) do { if (IN(p) && layer * NPH + (p) + 1 < gp_hi) xcd_barrier(bar); } while (0)
#ifndef PH_MASK
#define PH_MASK 0xffff
#endif
#define ON(p) (((PH_MASK) >> (p)) & 1)
#ifndef PROBE_PH
#define PROBE_PH -1
#endif
#ifndef PROBE_N
#define PROBE_N 1
#endif
#ifndef PROBE_LAYERS
#define PROBE_LAYERS 15
#endif
#define REPS(p) ((((p) == PROBE_PH) && ((PROBE_LAYERS >> layer) & 1)) ? 1 + PROBE_N : 1)
#define SUBREPS(p) for (int r2_ = 0; r2_ < REPS(p); ++r2_)
#define ENTER() do { ws = args.ws; asm volatile("" : "+s"(ws)); F.ws = ws; int t_ = threadIdx.x; asm volatile("" : "+v"(t_)); F.tid = t_; F.lane = t_ & 63; F.wave = __builtin_amdgcn_readfirstlane(t_ >> 6); F.gw = F.vcu * NWAVES + F.wave; } while (0)
    for (int layer = gp_lo / NPH; layer < DEPTH && layer * NPH < gp_hi; ++layer) {
        const bool moe = (layer & 1) != 0;
#if ON(0)
        if (IN(0)) for (int rep_ = 0; rep_ < REPS(0); ++rep_) { ENTER(); for (int r2_ = 0; r2_ < ((PROBE_PH == 100) ? 1 + PROBE_N : 1); ++r2_) { phase_convert(F, layer); phase_kfun(F, layer); } phase_rows_mixer(F, layer); }
        SEAM(0);
#endif
#if ON(1)
        if (IN(1)) for (int rep_ = 0; rep_ < REPS(1); ++rep_) { ENTER();
            phase_s5_tables(F, layer); phase_cumsum(F);
#if F8_GATES
            { pg8::Gemm g8{(const bf16*)(ws + WS_XN8), (const bf16*)(ws + WS_WIN8), D / 2, D / 2, D / 2}; pg8::StaticOrder S8; S8.init(T, 4096, F.G, (int)blockIdx.x, D / 2, D / 2);
              pg8::EpiGateSig E8; E8.gate = (bf16*)(ws + WS_GATE);
              pg8::gemm_phase<pg8::EpiGateSig, pg8::StaticOrder, true, true>(ring, g8, S8, E8); }
#endif
            pg8::Gemm g{(const bf16*)(ws + WS_XN), (const bf16*)(ws + WS_WIN), D, D, D}; pg8::StaticOrder S; S.init(T, F8_GATES ? 2304 : NPROJ, F.G, (int)blockIdx.x, D, D);
            pg8::EpiInProj E; E.ua = (bf16*)(ws + WS_UA); E.qkv = (bf16*)(ws + WS_QKV); E.uc = (bf16*)(ws + WS_UC); E.gate = (bf16*)(ws + WS_GATE);
            { LAS float* gl = (LAS float*)(F.lds + GAIN_OFF);
              if (F.tid < 256) { const int w = F.tid >> 6, d = F.tid & 63; const float* src = (w == 0) ? args.in[I_FQG] : (w == 1) ? args.in[I_FKG] : (w == 2) ? args.in[I_SQG] : args.in[I_SKG];
                  gl[F.tid] = src[layer * 64 + d] * ((w == 0 || w == 2) ? QSCALE : 1.0f); }
              __syncthreads(); E.gl = gl; }
            pg8::gemm_phase<pg8::EpiInProj, pg8::StaticOrder, true>(ring, g, S, E);
        }
        SEAM(1);
#endif
#if ON(2)
        if (IN(2)) for (int rep_ = 0; rep_ < REPS(2); ++rep_) { ENTER();
            { pg8::Gemm g{(const bf16*)(ws + WS_UA), (const bf16*)(ws + WS_WZ), 1024, S5_LDA, 1024};
              pg8::BatchOrder S; S.nM = 2; S.nN = 1; S.nZ = 16; S.G = F.G; S.c = (int)blockIdx.x; S.tA = (size_t)256 * S5_LDA * 2; S.tB = 0; S.zA = (size_t)512 * S5_LDA * 2; S.zB = (size_t)256 * 1024 * 2;
              pg8::EpiZ E; E.z = (float*)(ws + WS_Z);
              SUBREPS(106) { pg8::gemm_phase<pg8::EpiZ, pg8::BatchOrder, false>(ring, g, S, E);
              if ((int)blockIdx.x < 32) phase_s5_scan_unit(F, layer, (int)blockIdx.x >> 1, (int)blockIdx.x & 1); } }
            SUBREPS(103) phase_conv(F, layer);
            SUBREPS(102) phase_attn_sb(F, layer, rep_ + r2_);
        }
        SEAM(2);
#endif
#if ON(4)
        if (IN(4)) for (int rep_ = 0; rep_ < REPS(4); ++rep_) { ENTER();
            { pg8::Gemm g{(const bf16*)(ws + WS_UA), (const bf16*)(ws + WS_WY), S5_LDA, S5_LDA, S5_LDA};
              pg8::BatchOrder S; S.nM = 2; S.nN = 4; S.nZ = 16; S.G = F.G; S.c = (int)blockIdx.x; S.tA = (size_t)256 * S5_LDA * 2; S.tB = (size_t)256 * S5_LDA * 2; S.zA = (size_t)512 * S5_LDA * 2; S.zB = (size_t)1024 * S5_LDA * 2;
              pg8::EpiY E; E.ua = (const bf16*)(ws + WS_UA); E.dskip = args.in[I_S5D] + layer * 256; E.yp = (bf16*)(ws + WS_YP);
              SUBREPS(105) pg8::gemm_phase<pg8::EpiY, pg8::BatchOrder, false>(ring, g, S, E); }
            SUBREPS(104) phase_attn_fox(F, layer, rep_ + r2_);
        }
        SEAM(4);
#endif
#if ON(5)
        if (IN(5) && F.G != 256) for (int rep_ = 0; rep_ < REPS(5); ++rep_) { ENTER();
            pg8::Gemm g{(const bf16*)(ws + WS_YP), (const bf16*)(ws + WS_WGLU), 256, 256, 256};
            pg8::BatchOrder S; S.nM = T / 256; S.nN = 1; S.nZ = 1; S.G = F.G; S.c = (int)blockIdx.x; S.tA = (size_t)256 * 256 * 2; S.tB = 0; S.zA = 0; S.zB = 0;
            pg8::EpiGlu E; E.yp = (const bf16*)(ws + WS_YP); E.ycat = (bf16*)(ws + WS_YCAT);
            pg8::gemm_phase<pg8::EpiGlu, pg8::BatchOrder, false>(ring, g, S, E);
        }
        if (F.G != 256) SEAM(5);
#endif
#if ON(6)
        if (IN(6)) for (int rep_ = 0; rep_ < REPS(6); ++rep_) { ENTER();
            const int paired = (F.G == 256) ? 1 : 0;
            if (paired) {
                pg8::Gemm g{(const bf16*)(ws + WS_YP), (const bf16*)(ws + WS_WGLU), 256, 256, 256};
                pg8::OneUnit S; S.pm = F.vcu >> 1; S.tA = (size_t)256 * 256 * 2;
                pg8::EpiGlu E; E.yp = (const bf16*)(ws + WS_YP); E.ycat = (bf16*)(ws + WS_YCAT);
                pg8::gemm_phase<pg8::EpiGlu, pg8::OneUnit, false>(ring, g, S, E);
            }
            pg8::Gemm g{(const bf16*)(ws + WS_YCAT), (const bf16*)(ws + WS_WBR), 256, 1024, 256};
            pg8::BranchOrder1 S; S.nM = T / 256; S.nN = 8; S.G = F.G; S.c = (int)blockIdx.x; S.tA = (size_t)256 * 1024 * 2; S.tB = (size_t)128 * 256 * 2; S.zA = 256 * 2; S.zB = (size_t)1024 * 256 * 2; S.paired = paired; S.vc = F.vcu;
            pg8::EpiGate1 E; E.gate = (const bf16*)(ws + WS_GATE); E.mb = (bf16*)(ws + WS_XN);
            pg8::gemm_phase_n1<pg8::EpiGate1, pg8::BranchOrder1>(ring, g, S, E);
        }
        SEAM(6);
#endif
#if ON(7)
        if (IN(7)) for (int rep_ = 0; rep_ < REPS(7); ++rep_) { ENTER();
            pg8::Gemm g{(const bf16*)(ws + WS_XN), (const bf16*)(ws + WS_WOUT), D, D, D}; pg8::StaticOrder S; S.init(T, D, F.G, (int)blockIdx.x, D, D);
            pg8::EpiResid<false> E; E.base32 = args.in[I_X]; E.base16 = (const bf16*)(ws + WS_XB); E.out = (bf16*)(ws + WS_XB); E.ss = (float*)(ws + WS_SSP); E.out8 = ws + WS_XN8;
            E.flags = ((layer == 0) ? 1 : 0) | ((FUSE_DENSE_NORM && !moe) ? 2 : 0) | ((FUSE_DENSE_NORM && !moe && DENSE8(layer)) ? 4 : 0);
            pg8::gemm_phase<pg8::EpiResid<false>, pg8::StaticOrder, true>(ring, g, S, E);
        }
        SEAM(7);
#endif
#if ON(8)
        if (IN(8)) for (int rep_ = 0; rep_ < REPS(8); ++rep_) { ENTER(); if (moe || !FUSE_DENSE_NORM) phase_rows_ffn(F, layer); }
        if (moe || !FUSE_DENSE_NORM) SEAM(8);
#endif
#if ON(10)
        if (IN(10)) for (int rep_ = 0; rep_ < REPS(10); ++rep_) { ENTER();
            if (!moe) {
                if (DENSE8(layer)) {
                    constexpr int DQ = D / 2;
                    pg8::Gemm g{(const bf16*)(ws + (FUSE_DENSE_NORM ? WS_XN8 : WS_XN)), (const bf16*)(ws + WS_WUP), DQ, DQ, DQ}; pg8::StaticOrder S; S.init(T, 2 * FF, F.G, (int)blockIdx.x, DQ, DQ);
                    pg8::EpiSwiGlu<true> E; E.h = (bf16*)(ws + WS_HH); E.sc = 1.0f / 64.0f; E.ss = (const float*)(ws + WS_SSP); E.use_ss = FUSE_DENSE_NORM;
                    pg8::gemm_phase<pg8::EpiSwiGlu<true>, pg8::StaticOrder, true, true>(ring, g, S, E);
                } else {
                    pg8::Gemm g{(const bf16*)(ws + (FUSE_DENSE_NORM ? WS_XB : WS_XN)), (const bf16*)(ws + WS_WUP), D, D, D}; pg8::StaticOrder S; S.init(T, 2 * FF, F.G, (int)blockIdx.x, D, D);
                    pg8::EpiSwiGlu<false> E; E.h = (bf16*)(ws + WS_HH); E.sc = 1.0f; E.ss = (const float*)(ws + WS_SSP); E.use_ss = FUSE_DENSE_NORM;
                    pg8::gemm_phase<pg8::EpiSwiGlu<false>, pg8::StaticOrder, true, false>(ring, g, S, E);
                }
            } else {
                constexpr bool U8 = F8_MOE_UP != 0, H8 = F8_MOE_DN != 0; constexpr int DQ = U8 ? D / 2 : D;
                pg8::Gemm g{(const bf16*)(ws + WS_XNP), (const bf16*)(ws + WS_WUP), DQ, DQ, DQ};
                pg8::GroupOrder S; S.nN = 22; S.G = F.G; S.c = (int)blockIdx.x; S.tA = (size_t)256 * DQ * 2; S.tB = (size_t)256 * DQ * 2; S.zB = (size_t)5632 * DQ * 2; S.zA = (size_t)T * DQ * 2;
                int st[NE + 1]; moe_starts(F, layer >> 1, st);
#pragma unroll
                for (int e = 0; e <= NE; ++e) S.ts[e] = __builtin_amdgcn_readfirstlane(st[e] >> 8);
                pg8::EpiSwiGlu<H8> E; E.h = (bf16*)(ws + WS_HP); E.sc = U8 ? (1.0f / 64.0f) : 1.0f; E.ss = (const float*)(ws + WS_SSP); E.use_ss = 0;
                pg8::gemm_phase<pg8::EpiSwiGlu<H8>, pg8::GroupOrder, true, U8>(ring, g, S, E);
            }
        }
        SEAM(10);
#endif
#if ON(11)
        if (IN(11)) for (int rep_ = 0; rep_ < REPS(11); ++rep_) { ENTER();
            if (!moe) {
                if (DENSE8(layer)) {
                    constexpr int FQ = FF / 2;
                    pg8::Gemm g{(const bf16*)(ws + WS_HH), (const bf16*)(ws + WS_WDN), FQ, FQ, FQ}; pg8::StaticOrder S; S.init(T, D, F.G, (int)blockIdx.x, FQ, FQ);
                    pg8::EpiResid<true> E; E.base32 = args.in[I_X]; E.base16 = (const bf16*)(ws + WS_XB); E.out = (bf16*)(ws + WS_XB); E.ss = (float*)(ws + WS_SSP); E.out8 = ws + WS_XN8; E.flags = 0;
                    pg8::gemm_phase<pg8::EpiResid<true>, pg8::StaticOrder, true, true>(ring, g, S, E);
                } else {
                    pg8::Gemm g{(const bf16*)(ws + WS_HH), (const bf16*)(ws + WS_WDN), FF, FF, FF}; pg8::StaticOrder S; S.init(T, D, F.G, (int)blockIdx.x, FF, FF);
                    pg8::EpiResid<false> E; E.base32 = args.in[I_X]; E.base16 = (const bf16*)(ws + WS_XB); E.out = (bf16*)(ws + WS_XB); E.ss = (float*)(ws + WS_SSP); E.out8 = ws + WS_XN8; E.flags = 0;
                    pg8::gemm_phase<pg8::EpiResid<false>, pg8::StaticOrder, true, false>(ring, g, S, E);
                }
            } else {
                constexpr bool F8 = F8_MOE_DN != 0; constexpr int FQ = F8 ? FF / 2 : FF;
                pg8::Gemm g{(const bf16*)(ws + WS_HP), (const bf16*)(ws + WS_WDN), FQ, FQ, FQ};
                pg8::GroupOrder S; S.nN = 4; S.G = F.G; S.c = (int)blockIdx.x; S.tA = (size_t)256 * FQ * 2; S.tB = (size_t)256 * FQ * 2; S.zB = (size_t)D * FQ * 2; S.zA = 0;
                int st[NE + 1]; moe_starts(F, layer >> 1, st);
#pragma unroll
                for (int e = 0; e <= NE; ++e) S.ts[e] = __builtin_amdgcn_readfirstlane(st[e] >> 8);
                pg8::EpiStore E; E.o = (bf16*)(ws + WS_XNP); E.sc = F8 ? (1.0f / 64.0f) : 1.0f;
                pg8::gemm_phase<pg8::EpiStore, pg8::GroupOrder, true, F8>(ring, g, S, E);
            }
        }
        SEAM(11);
#endif
    }
#if ON(12)
    if (gp_lo <= GP_FINAL && GP_FINAL < gp_hi) phase_final_combine(F);
#endif
}

extern "C" void kernel_launch(void* const* d_in, const int* in_sizes, int n_in, void* d_out, int out_size, void* d_ws, size_t ws_size, hipStream_t stream) {
    static int grid = 0;
    if (grid == 0) {
        if (n_in != 32 || in_sizes[0] != T * D || out_size != T * D || ws_size < WS_END) { fprintf(stderr, "kernel_launch: unexpected shapes / workspace (n_in %d, ws %zu < %zu)\n", n_in, ws_size, (size_t)WS_END); grid = -1; return; }
        int dev = 0, cus = 0, per_cu = 0;
        if (hipGetDevice(&dev) != hipSuccess || hipDeviceGetAttribute(&cus, hipDeviceAttributeMultiprocessorCount, dev) != hipSuccess) { grid = -1; return; }
        if (hipFuncSetAttribute((const void*)mk_fwd, hipFuncAttributeMaxDynamicSharedMemorySize, LDS_BYTES) != hipSuccess) { grid = -1; return; }
        if (hipOccupancyMaxActiveBlocksPerMultiprocessor(&per_cu, (const void*)mk_fwd, NWAVES * 64, LDS_BYTES) != hipSuccess || per_cu < 1) fprintf(stderr, "kernel_launch: occupancy query says %d\n", per_cu);
        (void)hipGetLastError();
        grid = cus;
    }
    if (grid < 0) return;
    if (hipMemsetAsync((char*)d_ws + WS_CTL, 0, CTL_ZERO_BYTES, stream) != hipSuccess) return;
    Args a{};
    for (int i = 0; i < 32; ++i) a.in[i] = (const float*)d_in[i];
    a.out = (float*)d_out; a.ws = (unsigned char*)d_ws;
    a.gp_lo = 0; a.gp_hi = GP_TOTAL;
    hipLaunchKernelGGL(mk_fwd, dim3(grid), dim3(NWAVES * 64), LDS_BYTES, stream, a);
}
```

```cpp
#include <hip/hip_runtime.h>
#include <cstdio>
#include <cstdint>

#ifndef F8_DENSE_MASK
#define F8_DENSE_MASK 4
#endif
#define DENSE8(layer) (((F8_DENSE_MASK) >> (layer)) & 1)
#ifndef F8_MOE_UP
#define F8_MOE_UP 1
#endif
#ifndef FUSE_DENSE_NORM
#define FUSE_DENSE_NORM 1
#endif
#ifndef GATE8
#define GATE8 2
#endif
#ifndef BR_WG
#define BR_WG 4
#endif
#ifndef F8_GATES
#define F8_GATES 1
#endif
#ifndef F8_MOE_DN
#define F8_MOE_DN 1
#endif

#define GAS __attribute__((address_space(1)))
#define LAS __attribute__((address_space(3)))
typedef unsigned short bf16;
typedef unsigned v4u __attribute__((ext_vector_type(4)));
typedef unsigned v2u __attribute__((ext_vector_type(2)));
typedef float f32x4 __attribute__((ext_vector_type(4)));
typedef float f32x2 __attribute__((ext_vector_type(2)));
typedef short bf16x8 __attribute__((ext_vector_type(8)));

constexpr int NB = 8, SEQ = 4096, D = 1024, DEPTH = 4, T = NB * SEQ;
constexpr int DP = 6404, NPROJ = 6400, FF = 2816, NE = 8;
constexpr float EPS = 1e-6f, LOG2E = 1.4426950408889634f;
constexpr float QSCALE = 0.125f * LOG2E;
constexpr int MOE_ROWS = 2 * T + NE * 256;
constexpr int S5_LDA = 1152;

constexpr size_t MiB = 1u << 20;
constexpr size_t WS_CTL = 0, CTL_ZERO_BYTES = 1 * MiB;
constexpr size_t WS_WIN = 1 * MiB;
constexpr size_t WS_WIN8 = WS_WIN + (size_t)2304 * D * 2;
constexpr size_t WS_WBR = WS_WIN + (size_t)NPROJ * D * 2;
constexpr size_t WS_WOUT = WS_WBR + 2 * MiB;
constexpr size_t WS_WGLU = WS_WOUT + 2 * MiB;
constexpr size_t WS_WZ = WS_WGLU + 128 * 1024;
constexpr size_t WS_WY = WS_WZ + 8 * MiB;
constexpr size_t WS_WUP = WS_WY + 36 * MiB;
constexpr size_t WS_WDN = WS_WUP + 88 * MiB;
constexpr size_t WS_KFUN = WS_WDN + 44 * MiB;
constexpr size_t WS_ROUTE = WS_KFUN + 1 * MiB;
constexpr size_t WS_LF = WS_ROUTE + 1 * MiB;
constexpr size_t WS_CUM = WS_LF + 512 * 1024;
constexpr size_t WS_XN = 198 * MiB;
static_assert(WS_CUM + 512 * 1024 <= WS_XN, "ws map");
constexpr size_t WS_R = WS_XN + 64 * MiB;
constexpr size_t WS_GATE = WS_R;
constexpr size_t WS_QKV = WS_GATE + 256 * MiB;
constexpr size_t WS_UC = WS_QKV + 96 * MiB;
constexpr size_t WS_UA = WS_UC + 16 * MiB;
constexpr size_t WS_Z = WS_UA + 18 * MiB;
constexpr size_t WS_YP = WS_Z + 4 * MiB;
constexpr size_t WS_YCAT = WS_YP + 16 * MiB;
constexpr size_t WS_MIX_END = WS_YCAT + 64 * MiB;
constexpr size_t WS_XN8 = WS_YCAT;
constexpr size_t WS_HH = WS_R;
constexpr size_t WS_XNP = WS_R;
constexpr size_t WS_HP = WS_XNP + (size_t)NE * T * D;
constexpr size_t WS_FFN_END = WS_HP + (size_t)MOE_ROWS * FF;
static_assert(F8_MOE_UP && F8_MOE_DN, "the MoE path stores its rows and hidden activations as e4m3 bytes");
constexpr size_t WS_XB = ((WS_MIX_END > WS_FFN_END ? WS_MIX_END : WS_FFN_END) + MiB - 1) / MiB * MiB;
constexpr size_t WS_SSP = WS_XB + 64 * MiB;
constexpr size_t WS_END = WS_SSP + 2 * MiB;
static_assert(WS_END <= 856 * MiB, "ws budget");
constexpr int CW_BAR = 4096;
constexpr int CW_Q = 20480;
constexpr int CW_MOE = 16384;

constexpr int RING_BYTES = 131072, MISC_OFF = RING_BYTES + 320, GAIN_OFF = RING_BYTES + 1024, QSLOT_OFF = RING_BYTES + 64, LDS_BYTES = 147456;
constexpr int NWAVES = 8;

__device__ __forceinline__ unsigned f2bf(float f) { unsigned u = __builtin_bit_cast(unsigned, f); return (u + 0x7fffu + ((u >> 16) & 1u)) >> 16; }
__device__ __forceinline__ unsigned pk2(float lo, float hi) { return f2bf(lo) | (f2bf(hi) << 16); }
__device__ __forceinline__ float bflo(unsigned u) { return __builtin_bit_cast(float, u << 16); }
__device__ __forceinline__ float bfhi(unsigned u) { return __builtin_bit_cast(float, u & 0xffff0000u); }
__device__ __forceinline__ float bf2f(bf16 v) { return __builtin_bit_cast(float, (unsigned)v << 16); }
__device__ __forceinline__ float wave_sum(float v) {
#pragma unroll
    for (int o = 1; o < 64; o <<= 1) v += __shfl_xor(v, o);
    return v;
}
__device__ __forceinline__ float fast_exp2(float x) { return __builtin_amdgcn_exp2f(x); }
__device__ __forceinline__ float fast_rcp(float x) { return __builtin_amdgcn_rcpf(x); }
__device__ __forceinline__ float sigmoidf_(float x) { return fast_rcp(1.0f + fast_exp2(-x * LOG2E)); }
__device__ __forceinline__ f32x2 sigmoid2(f32x2 x) { const f32x2 a = x * (-LOG2E); f32x2 t = {fast_exp2(a[0]), fast_exp2(a[1])}; t = t + 1.0f; return (f32x2){fast_rcp(t[0]), fast_rcp(t[1])}; }
__device__ __forceinline__ float gelu_tanh(float y) { const float u = 0.7978845608028654f * (y + 0.044715f * y * y * y); return y * sigmoidf_(2.0f * u); }
__device__ __forceinline__ unsigned pk4_fp8(float a, float b, float c, float d) { unsigned w = 0u; w = (unsigned)__builtin_amdgcn_cvt_pk_fp8_f32(a, b, (int)w, false); w = (unsigned)__builtin_amdgcn_cvt_pk_fp8_f32(c, d, (int)w, true); return w; }
#define LDS_WAIT() asm volatile("s_waitcnt lgkmcnt(0)" ::: "memory")
#define VM_WAIT() asm volatile("s_waitcnt vmcnt(0)" ::: "memory")

namespace pg8 {
#define PG8_LAS __attribute__((address_space(3)))
typedef unsigned short bf16_t;
typedef unsigned u32x4 __attribute__((ext_vector_type(4)));
typedef int v4i __attribute__((ext_vector_type(4)));
typedef int v8i __attribute__((ext_vector_type(8)));
constexpr int BM = 256, BK = 64, HALF = 128, HTB = HALF * BK * 2, STAGE_BYTES = 8 * HTB, NXCD = 8, WGM = 8;
__host__ __device__ __forceinline__ int lds_byte(int r, int c) { const int st = (r >> 4) * 2 + (c >> 5), rr = r & 15, cc = c & 31, ob = rr * 64 + cc * 2; return st * 1024 + (ob ^ (((ob >> 9) & 1) << 5)); }
__host__ __device__ __forceinline__ void stage_rc(int b, int& R, int& C) { const int st = b / 1024, sb = b % 1024, swz = sb ^ (((sb >> 9) & 1) << 5); R = (st >> 1) * 16 + swz / 64; C = (st & 1) * 32 + (swz % 64) / 2; }
__host__ __device__ __forceinline__ int perm32(int rho) { const int n = rho >> 4, i = rho & 15; return 8 * (i >> 2) + 4 * n + (i & 3); }

struct Unit { int pm, pn, z; size_t offA, offB; };
struct Gemm { const bf16_t* A; const bf16_t* Bt; int K, lda, ldb; };

template <int WG = WGM> __device__ __forceinline__ void xcd_tile_map(int L, int nM, int nN, int& pm, int& pn) {
    const int nwg = nM * nN; int wgid = L; { const int q = nwg / NXCD, r = nwg % NXCD, xcd = wgid % NXCD, off = wgid / NXCD; wgid = (xcd < r ? xcd * (q + 1) : r * (q + 1) + (xcd - r) * q) + off; }
    const int nig = WG * nN, gid = wgid / nig, fm = gid * WG, gsz = (nM - fm) < WG ? (nM - fm) : WG;
    pm = fm + ((wgid % nig) % gsz); pn = (wgid % nig) / gsz;
}
struct StaticOrder {
    int nM, nN, nwg, G, c, full; size_t tA, tB;
    __device__ void init(int M, int N, int G_, int c_, int lda, int ldb) { nM = M / BM; nN = N / BM; nwg = nM * nN; G = G_; c = c_; full = 1 << 20; tA = (size_t)BM * lda * 2; tB = (size_t)BM * ldb * 2; }
    __device__ bool next(int i, Unit& u) const {
        long L = (long)i * G + c;
        if (i >= full) { const int h = G >> 1; if (c < h) return false; L = (long)full * G + (long)(i - full) * h + (c - h); }
        if (L >= nwg) return false;
        int wgid = (int)L; { const int q = nwg / NXCD, r = nwg % NXCD, xcd = wgid % NXCD, off = wgid / NXCD; wgid = (xcd < r ? xcd * (q + 1) : r * (q + 1) + (xcd - r) * q) + off; }
        const int nig = WGM * nN, gid = wgid / nig, fm = gid * WGM, gsz = (nM - fm) < WGM ? (nM - fm) : WGM;
        u.pm = fm + ((wgid % nig) % gsz); u.pn = (wgid % nig) / gsz; u.z = 0; u.offA = (size_t)u.pm * tA; u.offB = (size_t)u.pn * tB; return true;
    }
};
struct BatchOrder {
    int nM, nN, nZ, G, c; size_t tA, tB, zA, zB;
    __device__ bool next(int i, Unit& u) const {
        const int L = i * G + c; if (L >= nM * nN * nZ) return false;
        u.z = L / (nM * nN); const int r = L % (nM * nN); u.pm = r / nN; u.pn = r % nN;
        u.offA = (size_t)u.z * zA + (size_t)u.pm * tA; u.offB = (size_t)u.z * zB + (size_t)u.pn * tB; return true;
    }
};
struct GroupOrder {
    int nN, G, c; int ts[NE + 1]; size_t tA, tB, zB, zA;
    __device__ bool next(int i, Unit& u) const {
        const int L = i * G + c; if (L >= ts[NE] * nN) return false;
        xcd_tile_map(L, ts[NE], nN, u.pm, u.pn); int e = 0, tse = 0;
#pragma unroll
        for (int k = 1; k < NE; ++k) if (u.pm >= ts[k]) { e = k; tse = ts[k]; }
        u.z = e; u.offA = zA ? (size_t)e * zA + (size_t)(u.pm - tse) * tA : (size_t)u.pm * tA; u.offB = (size_t)e * zB + (size_t)u.pn * tB; return true;
    }
};

typedef __bf16 bf16x2_t __attribute__((ext_vector_type(2)));
__device__ __forceinline__ unsigned cvt_pk_bf16(float lo, float hi) { const f32x2 v = {lo, hi}; const bf16x2_t b = __builtin_convertvector(v, bf16x2_t); return __builtin_bit_cast(unsigned, b); }

__device__ __forceinline__ u32x4 pack8(const f32x4 a, const f32x4 b) { u32x4 w; w.x = cvt_pk_bf16(a[0], a[1]); w.y = cvt_pk_bf16(a[2], a[3]); w.z = cvt_pk_bf16(b[0], b[1]); w.w = cvt_pk_bf16(b[2], b[3]); return w; }
template <class Epi, class Sched, bool ALIGN_EPI, bool FP8 = false>
__device__ __forceinline__ void gemm_phase(PG8_LAS unsigned char* lds, const Gemm g, const Sched& S, const Epi& E) {
    int tid = threadIdx.x; asm volatile("" : "+v"(tid));
    const int wid = __builtin_amdgcn_readfirstlane(tid >> 6), lane = tid & 63, wr = wid >> 2, wc = wid & 3, fr = lane & 15, fq = lane >> 4;
    int K = g.K; asm volatile("" : "+s"(K));
    const int nt = K / BK;
    unsigned voffA[2], voffB[2];
#pragma unroll
    for (int i = 0; i < 2; ++i) { int R, C; stage_rc(tid * 16 + i * 8192, R, C); const int Rb = Epi::PERM ? ((R & ~31) + perm32(R & 31)) : R;
        voffA[i] = (unsigned)(R * g.lda + C) * 2u; voffB[i] = (unsigned)(Rb * g.ldb + C) * 2u; }
    const size_t kstep = (size_t)(BK * 2);
    const size_t hstepA = (size_t)HALF * g.lda * 2, hstepB = (size_t)HALF * g.ldb * 2;
    const unsigned ldsw = (unsigned)wid * 1024u;
    const int aoff = lds_byte(wr * 64 + fr, fq * 8), boff = lds_byte(wc * 32 + fr, fq * 8);
#define PG8_SA(b, h) (((b) * 2 + (h)) * HTB)
#define PG8_SB(b, h) ((4 + (b) * 2 + (h)) * HTB)
#define PG8_STAGE(bufoff, gbase, voff) do { _Pragma("unroll") for (int _i = 0; _i < 2; ++_i) \
        __builtin_amdgcn_global_load_lds((const unsigned*)((const char*)(gbase) + (voff)[_i]), (PG8_LAS unsigned*)(lds + (bufoff) + ldsw + _i * 8192), 16, 0, 0); } while (0)
#define PG8_LDA(dst, b, h) do { _Pragma("unroll") for (int m = 0; m < 4; ++m) { if constexpr (FP8) dst##8[m] = __builtin_shufflevector(*(const PG8_LAS v4i*)(lds + PG8_SA(b, h) + aoff + m * 2048), *(const PG8_LAS v4i*)(lds + PG8_SA(b, h) + aoff + m * 2048 + 1024), 0, 1, 2, 3, 4, 5, 6, 7); \
        else { _Pragma("unroll") for (int k = 0; k < 2; ++k) dst[m][k] = *(const PG8_LAS bf16x8*)(lds + PG8_SA(b, h) + aoff + m * 2048 + k * 1024); } } } while (0)
#define PG8_LDB(dst, b, h) do { _Pragma("unroll") for (int n = 0; n < 2; ++n) { if constexpr (FP8) dst##8[n] = __builtin_shufflevector(*(const PG8_LAS v4i*)(lds + PG8_SB(b, h) + boff + n * 2048), *(const PG8_LAS v4i*)(lds + PG8_SB(b, h) + boff + n * 2048 + 1024), 0, 1, 2, 3, 4, 5, 6, 7); \
        else { _Pragma("unroll") for (int k = 0; k < 2; ++k) dst[n][k] = *(const PG8_LAS bf16x8*)(lds + PG8_SB(b, h) + boff + n * 2048 + k * 1024); } } } while (0)
#define PG8_MMA(ai, bj, At, Bt) do { __builtin_amdgcn_s_setprio(1); _Pragma("unroll") for (int m = 0; m < 4; ++m) _Pragma("unroll") for (int n = 0; n < 2; ++n) { \
        if constexpr (FP8) asm volatile("v_mfma_f32_16x16x128_f8f6f4 %0, %1, %2, %0" : "+v"(acc[ai][bj][m][n]) : "v"(Bt##8[n]), "v"(At##8[m])); \
        else { _Pragma("unroll") for (int k = 0; k < 2; ++k) acc[ai][bj][m][n] = __builtin_amdgcn_mfma_f32_16x16x32_bf16(Bt[n][k], At[m][k], acc[ai][bj][m][n], 0, 0, 0); } } \
        __builtin_amdgcn_s_setprio(0); } while (0)
#define PG8_WAIT_V(n) asm volatile("s_waitcnt vmcnt(" #n ")" ::: "memory")
#define PG8_WAIT_L(n) asm volatile("s_waitcnt lgkmcnt(" #n ")" ::: "memory")
#define PG8_BAR __builtin_amdgcn_s_barrier()
#define PG8_SCHED __builtin_amdgcn_sched_barrier(0)
    Unit cur, nxt; int ui = 0;
    if (!S.next(0, cur)) return;
    f32x4 acc[2][2][4][2];
#pragma unroll
    for (int a = 0; a < 2; ++a)
#pragma unroll
        for (int b = 0; b < 2; ++b)
#pragma unroll
            for (int m = 0; m < 4; ++m)
#pragma unroll
                for (int n = 0; n < 2; ++n) acc[a][b][m][n] = (f32x4){0.f, 0.f, 0.f, 0.f};
    bf16x8 At[4][2], B0[2][2], B1[2][2]; v8i At8[4], B08[2], B18[2];
    const char* cA = (const char*)g.A + cur.offA; const char* cB = (const char*)g.Bt + cur.offB;
    PG8_STAGE(PG8_SB(0, 0), cB, voffB); PG8_STAGE(PG8_SB(0, 1), cB + hstepB, voffB); PG8_STAGE(PG8_SA(0, 0), cA, voffA); PG8_STAGE(PG8_SA(0, 1), cA + hstepA, voffA);
    if (wr == 1) PG8_BAR;
    PG8_WAIT_V(2); PG8_BAR;
    PG8_STAGE(PG8_SB(1, 0), cB + kstep, voffB); PG8_STAGE(PG8_SA(1, 0), cA + kstep, voffA); PG8_STAGE(PG8_SB(1, 1), cB + hstepB + kstep, voffB);
    PG8_WAIT_V(6); PG8_BAR;
    for (;;) {
        const bool has_next = S.next(ui + 1, nxt);
        const char* nA = has_next ? (const char*)g.A + nxt.offA : cA; const char* nB = has_next ? (const char*)g.Bt + nxt.offB : cB;
        for (int t = 0; t < nt; t += 2) {
            const bool last = (t == nt - 2);
            const char* a1 = cA + (size_t)(t + 1) * kstep;
            const char* a2 = last ? nA : cA + (size_t)(t + 2) * kstep; const char* b2 = last ? nB : cB + (size_t)(t + 2) * kstep;
            const char* a3 = a2 + kstep; const char* b3 = b2 + kstep;
            PG8_LDB(B0, 0, 0); PG8_LDB(B1, 0, 1); PG8_SCHED; PG8_LDA(At, 0, 0); PG8_STAGE(PG8_SA(1, 1), a1 + hstepA, voffA);
            PG8_WAIT_V(8); PG8_WAIT_L(0); PG8_BAR; PG8_MMA(0, 0, At, B0); PG8_MMA(0, 1, At, B1); PG8_BAR; PG8_SCHED;
            PG8_LDA(At, 0, 1); PG8_STAGE(PG8_SB(0, 0), b2, voffB); PG8_STAGE(PG8_SB(0, 1), b2 + hstepB, voffB); PG8_STAGE(PG8_SA(0, 0), a2, voffA);
            PG8_WAIT_V(8); PG8_WAIT_L(0); PG8_BAR; PG8_MMA(1, 0, At, B0); PG8_MMA(1, 1, At, B1); PG8_BAR; PG8_SCHED;
            PG8_LDB(B0, 1, 0); PG8_LDB(B1, 1, 1); PG8_SCHED; PG8_LDA(At, 1, 0); PG8_STAGE(PG8_SA(0, 1), a2 + hstepA, voffA);
            PG8_WAIT_V(8); PG8_WAIT_L(0); PG8_BAR; PG8_MMA(0, 0, At, B0); PG8_MMA(0, 1, At, B1); PG8_BAR; PG8_SCHED;
            PG8_LDA(At, 1, 1); PG8_STAGE(PG8_SB(1, 0), b3, voffB); PG8_STAGE(PG8_SB(1, 1), b3 + hstepB, voffB); PG8_STAGE(PG8_SA(1, 0), a3, voffA);
            PG8_WAIT_V(8); PG8_WAIT_L(0); PG8_BAR; PG8_MMA(1, 0, At, B0); PG8_MMA(1, 1, At, B1); PG8_BAR; PG8_SCHED;
        }
        if constexpr (ALIGN_EPI) { if (wr == 0) PG8_BAR; }
        if constexpr (FP8) asm volatile("s_nop 15\n\ts_nop 15" ::: "memory");
        E(acc, cur, wr, wc, fr, fq);
        if (!has_next) break;
#pragma unroll
        for (int a = 0; a < 2; ++a)
#pragma unroll
            for (int b = 0; b < 2; ++b)
#pragma unroll
                for (int m = 0; m < 4; ++m)
#pragma unroll
                    for (int n = 0; n < 2; ++n) acc[a][b][m][n] = (f32x4){0.f, 0.f, 0.f, 0.f};
        cur = nxt; cA = nA; cB = nB; ++ui;
        if constexpr (ALIGN_EPI) { if (wr == 1) PG8_BAR; }
    }
    PG8_WAIT_V(0);
    if constexpr (!ALIGN_EPI) { if (wr == 0) PG8_BAR; }
    PG8_BAR;
#undef PG8_SA
#undef PG8_SB
#undef PG8_STAGE
#undef PG8_LDA
#undef PG8_LDB
#undef PG8_MMA
#undef PG8_WAIT_V
#undef PG8_WAIT_L
#undef PG8_BAR
#undef PG8_SCHED
}


template <class Epi, class Sched>
__device__ __forceinline__ void gemm_phase_n1(PG8_LAS unsigned char* lds, const Gemm g, const Sched& S, const Epi& E) {
    int tid = threadIdx.x; asm volatile("" : "+v"(tid));
    const int wid = __builtin_amdgcn_readfirstlane(tid >> 6), lane = tid & 63, wr = wid >> 2, wc = wid & 3, fr = lane & 15, fq = lane >> 4;
    int K = g.K; asm volatile("" : "+s"(K));
    const int nt = K / BK;
    unsigned voffA[2], voffB[2];
#pragma unroll
    for (int i = 0; i < 2; ++i) { int R, C; stage_rc(tid * 16 + i * 8192, R, C); const int Rb = Epi::PERM ? ((R & ~31) + perm32(R & 31)) : R;
        voffA[i] = (unsigned)(R * g.lda + C) * 2u; voffB[i] = (unsigned)(Rb * g.ldb + C) * 2u; }
    const size_t kstep = (size_t)(BK * 2);
    const size_t hstepA = (size_t)HALF * g.lda * 2;
    const unsigned ldsw = (unsigned)wid * 1024u;
    const int aoff = lds_byte(wr * 64 + fr, fq * 8), boff = lds_byte(wc * 32 + fr, fq * 8);
#define PG8_SA(b, h) (((b) * 2 + (h)) * HTB)
#define PG8_SB(b, h) ((4 + (b) * 2 + (h)) * HTB)
#define PG8_STAGE(bufoff, gbase, voff) do { _Pragma("unroll") for (int _i = 0; _i < 2; ++_i) \
        __builtin_amdgcn_global_load_lds((const unsigned*)((const char*)(gbase) + (voff)[_i]), (PG8_LAS unsigned*)(lds + (bufoff) + ldsw + _i * 8192), 16, 0, 0); } while (0)
#define PG8_LDA(dst, b, h) do { _Pragma("unroll") for (int m = 0; m < 4; ++m) _Pragma("unroll") for (int k = 0; k < 2; ++k) dst[m][k] = *(const PG8_LAS bf16x8*)(lds + PG8_SA(b, h) + aoff + m * 2048 + k * 1024); } while (0)
#define PG8_LDB(dst, b, h) do { _Pragma("unroll") for (int n = 0; n < 2; ++n) _Pragma("unroll") for (int k = 0; k < 2; ++k) dst[n][k] = *(const PG8_LAS bf16x8*)(lds + PG8_SB(b, h) + boff + n * 2048 + k * 1024); } while (0)
#define PG8_MMA1(ai, At, Bt) do { __builtin_amdgcn_s_setprio(1); _Pragma("unroll") for (int m = 0; m < 4; ++m) _Pragma("unroll") for (int n = 0; n < 2; ++n) _Pragma("unroll") for (int k = 0; k < 2; ++k) \
        acc[ai][m][n] = __builtin_amdgcn_mfma_f32_16x16x32_bf16(Bt[n][k], At[m][k], acc[ai][m][n], 0, 0, 0); __builtin_amdgcn_s_setprio(0); } while (0)
#define PG8_WAIT_V(n) asm volatile("s_waitcnt vmcnt(" #n ")" ::: "memory")
#define PG8_WAIT_L(n) asm volatile("s_waitcnt lgkmcnt(" #n ")" ::: "memory")
#define PG8_BAR __builtin_amdgcn_s_barrier()
#define PG8_SCHED __builtin_amdgcn_sched_barrier(0)
    Unit cur, nxt; int ui = 0;
    if (!S.next(0, cur)) return;
    f32x4 acc[2][4][2], st[2][4][2];
#pragma unroll
    for (int a = 0; a < 2; ++a)
#pragma unroll
        for (int m = 0; m < 4; ++m)
#pragma unroll
            for (int n = 0; n < 2; ++n) { acc[a][m][n] = (f32x4){0.f, 0.f, 0.f, 0.f}; st[a][m][n] = (f32x4){0.f, 0.f, 0.f, 0.f}; }
    bf16x8 At[4][2], B0[2][2];
    const char* cA = (const char*)g.A + cur.offA; const char* cB = (const char*)g.Bt + cur.offB;
    PG8_STAGE(PG8_SB(0, 0), cB, voffB); PG8_STAGE(PG8_SA(0, 0), cA, voffA); PG8_STAGE(PG8_SA(0, 1), cA + hstepA, voffA);
    if (wr == 1) PG8_BAR;
    PG8_WAIT_V(2); PG8_BAR;
    PG8_STAGE(PG8_SB(1, 0), cB + kstep, voffB); PG8_STAGE(PG8_SA(1, 0), cA + kstep, voffA);
    PG8_WAIT_V(4); PG8_BAR;
    for (;;) {
        const bool has_next = S.next(ui + 1, nxt);
        const char* nA = has_next ? (const char*)g.A + nxt.offA : cA; const char* nB = has_next ? (const char*)g.Bt + nxt.offB : cB;
        for (int t = 0; t < nt; t += 2) {
            const bool last = (t == nt - 2);
            const char* a1 = cA + (size_t)(t + 1) * kstep;
            const char* a2 = last ? nA : cA + (size_t)(t + 2) * kstep; const char* b2 = last ? nB : cB + (size_t)(t + 2) * kstep;
            const char* a3 = a2 + kstep; const char* b3 = b2 + kstep;
            PG8_LDB(B0, 0, 0); PG8_SCHED; PG8_LDA(At, 0, 0); PG8_STAGE(PG8_SA(1, 1), a1 + hstepA, voffA);
            PG8_WAIT_V(6); PG8_WAIT_L(0); PG8_BAR; PG8_MMA1(0, At, B0); PG8_BAR; PG8_SCHED;
            PG8_LDA(At, 0, 1); PG8_STAGE(PG8_SB(0, 0), b2, voffB); PG8_STAGE(PG8_SA(0, 0), a2, voffA);
            PG8_WAIT_V(6); PG8_WAIT_L(0); PG8_BAR; PG8_MMA1(1, At, B0); PG8_BAR; PG8_SCHED;
            PG8_LDB(B0, 1, 0); PG8_SCHED; PG8_LDA(At, 1, 0); PG8_STAGE(PG8_SA(0, 1), a2 + hstepA, voffA);
            PG8_WAIT_V(6); PG8_WAIT_L(0); PG8_BAR; PG8_MMA1(0, At, B0); PG8_BAR; PG8_SCHED;
            PG8_LDA(At, 1, 1); PG8_STAGE(PG8_SB(1, 0), b3, voffB); PG8_STAGE(PG8_SA(1, 0), a3, voffA);
            PG8_WAIT_V(6); PG8_WAIT_L(0); PG8_BAR; PG8_MMA1(1, At, B0); PG8_BAR; PG8_SCHED;
        }
        if (wr == 0) PG8_BAR;
        E(acc, st, cur, wr, wc, fr, fq);
        if (!has_next) break;
#pragma unroll
        for (int a = 0; a < 2; ++a)
#pragma unroll
            for (int m = 0; m < 4; ++m)
#pragma unroll
                for (int n = 0; n < 2; ++n) acc[a][m][n] = (f32x4){0.f, 0.f, 0.f, 0.f};
        cur = nxt; cA = nA; cB = nB; ++ui;
        if (wr == 1) PG8_BAR;
    }
    PG8_WAIT_V(0);
    PG8_BAR;
#undef PG8_SA
#undef PG8_SB
#undef PG8_STAGE
#undef PG8_LDA
#undef PG8_LDB
#undef PG8_MMA1
#undef PG8_WAIT_V
#undef PG8_WAIT_L
#undef PG8_BAR
#undef PG8_SCHED
}
typedef f32x4 Acc1[2][4][2];
struct OneUnit { int pm; size_t tA;
    __device__ bool next(int i, Unit& u) const { if (i) return false; u.pm = pm; u.pn = 0; u.z = 0; u.offA = (size_t)pm * tA; u.offB = 0; return true; } };
struct BranchOrder1 {
    int nM, nN, G, c; size_t tA, tB, zA, zB; int paired, vc;
    __device__ bool next(int i, Unit& u) const {
        if (paired) { if (i >= 16) return false; u.z = i & 3; u.pm = vc >> 1; u.pn = 4 * (vc & 1) + (i >> 2);
            u.offA = (size_t)u.z * zA + (size_t)u.pm * tA; u.offB = (size_t)u.z * zB + (size_t)u.pn * tB; return true; }
        const int tile = (i >> 2) * G + c; if (tile >= nM * nN) return false;
        u.z = i & 3; xcd_tile_map<BR_WG>(tile, nM, nN, u.pm, u.pn);
        u.offA = (size_t)u.z * zA + (size_t)u.pm * tA; u.offB = (size_t)u.z * zB + (size_t)u.pn * tB; return true;
    }
};
struct EpiGate1 {
    static constexpr bool PERM = true;
    const bf16_t* gate; bf16_t* mb;
    __device__ __forceinline__ void operator()(const Acc1& acc, Acc1& st, const Unit& u, int wr, int wc, int fr, int fq) const {
        const int z = u.z; const int row0 = u.pm * BM + wr * 64 + fr, col = u.pn * HALF + wc * 32 + 8 * fq;
#pragma unroll
        for (int ai = 0; ai < 2; ++ai)
#pragma unroll
            for (int m = 0; m < 4; ++m) { const int row = row0 + ai * HALF + m * 16;
                f32x4 a = acc[ai][m][0], b = acc[ai][m][1];
                if (GATE8 == 2) { const v2u g8 = *(const v2u*)((const unsigned char*)gate + (size_t)row * 4096 + z * 1024 + col); const float k = 1.0f / 255.0f;
                    a[0] *= (float)(g8.x & 0xffu) * k; a[1] *= (float)((g8.x >> 8) & 0xffu) * k; a[2] *= (float)((g8.x >> 16) & 0xffu) * k; a[3] *= (float)(g8.x >> 24) * k;
                    b[0] *= (float)(g8.y & 0xffu) * k; b[1] *= (float)((g8.y >> 8) & 0xffu) * k; b[2] *= (float)((g8.y >> 16) & 0xffu) * k; b[3] *= (float)(g8.y >> 24) * k; }
                else if (GATE8 == 1) { const v2u g8 = *(const v2u*)((const unsigned char*)gate + (size_t)row * 4096 + z * 1024 + col);
                    const f32x2 g0 = __builtin_amdgcn_cvt_pk_f32_fp8((int)g8.x, false), g1 = __builtin_amdgcn_cvt_pk_f32_fp8((int)g8.x, true), g2 = __builtin_amdgcn_cvt_pk_f32_fp8((int)g8.y, false), g3 = __builtin_amdgcn_cvt_pk_f32_fp8((int)g8.y, true);
                    a[0] *= g0[0]; a[1] *= g0[1]; a[2] *= g1[0]; a[3] *= g1[1]; b[0] *= g2[0]; b[1] *= g2[1]; b[2] *= g3[0]; b[3] *= g3[1]; }
                else { const u32x4 gg = *(const u32x4*)(gate + (size_t)row * 4096 + z * 1024 + col);
                    a[0] *= bflo(gg.x); a[1] *= bfhi(gg.x); a[2] *= bflo(gg.y); a[3] *= bfhi(gg.y); b[0] *= bflo(gg.z); b[1] *= bfhi(gg.z); b[2] *= bflo(gg.w); b[3] *= bfhi(gg.w); }
                if (z == 0) { st[ai][m][0] = a; st[ai][m][1] = b; } else { st[ai][m][0] += a; st[ai][m][1] += b; }
                if (z == 3) *(u32x4*)(mb + (size_t)row * 1024 + col) = pack8(st[ai][m][0], st[ai][m][1]); }
    }
};
typedef f32x4 Acc[2][2][4][2];
#define EPI_ROWS_BEGIN const int row0 = u.pm * BM + wr * 64 + fr; _Pragma("unroll") for (int ai = 0; ai < 2; ++ai) _Pragma("unroll") for (int m = 0; m < 4; ++m) { const int row = row0 + ai * HALF + m * 16;
#define EPI_ROWS_END }

struct EpiInProj {
    static constexpr bool PERM = true;
    bf16_t *ua, *qkv, *uc, *gate; const PG8_LAS float* gl;
    __device__ __forceinline__ void operator()(const Acc& acc, const Unit& u, int wr, int wc, int fr, int fq) const {
        const int pn = u.pn;
        if (pn == 0) {
            EPI_ROWS_BEGIN
#pragma unroll
            for (int bj = 0; bj < 2; ++bj) { const int c8 = bj * HALF + wc * 32 + 8 * fq, gI = c8 >> 4, h0 = c8 & 15;
                *(u32x4*)(ua + ((size_t)(gI * 512 + (row >> 6)) * S5_LDA + (row & 63) * 16 + h0)) = pack8(acc[ai][bj][m][0], acc[ai][bj][m][1]); }
            EPI_ROWS_END
        } else if (pn == 1 || pn == 2 || pn == 6 || pn == 7) {
            const int which = (pn == 1) ? 0 : (pn == 2) ? 1 : (pn == 6) ? 2 : 3;
            const PG8_LAS float* gp = gl + which * 64;
            bf16_t* dst = qkv + (size_t)((pn < 6) ? (pn - 1) : (pn - 3)) * ((size_t)T * 256);
            f32x4 gv[2][2];
#pragma unroll
            for (int bj = 0; bj < 2; ++bj)
#pragma unroll
                for (int n = 0; n < 2; ++n) gv[bj][n] = *(const PG8_LAS f32x4*)(gp + bj * 32 + 8 * fq + 4 * n);
            EPI_ROWS_BEGIN
            float ss = 0.f;
#pragma unroll
            for (int bj = 0; bj < 2; ++bj)
#pragma unroll
                for (int n = 0; n < 2; ++n) { const f32x4 x = acc[ai][bj][m][n]; ss += (x[0] * x[0] + x[1] * x[1]) + (x[2] * x[2] + x[3] * x[3]); }
            ss += __shfl_xor(ss, 16); ss += __shfl_xor(ss, 32);
            const float rs = __builtin_amdgcn_rsqf(ss * (1.0f / 64.0f) + EPS);
#pragma unroll
            for (int bj = 0; bj < 2; ++bj)
                *(u32x4*)(dst + (size_t)row * 256 + wc * 64 + bj * 32 + 8 * fq) = pack8(acc[ai][bj][m][0] * rs * gv[bj][0], acc[ai][bj][m][1] * rs * gv[bj][1]);
            EPI_ROWS_END
        } else if (pn == 3 || pn == 8) {
            bf16_t* dst = qkv + (size_t)((pn == 3) ? 2 : 5) * ((size_t)T * 256);
            EPI_ROWS_BEGIN
#pragma unroll
            for (int bj = 0; bj < 2; ++bj) *(u32x4*)(dst + (size_t)row * 256 + bj * HALF + wc * 32 + 8 * fq) = pack8(acc[ai][bj][m][0], acc[ai][bj][m][1]);
            EPI_ROWS_END
        } else if (pn == 4 || pn == 5) {
            EPI_ROWS_BEGIN
            f32x4 o[2];
#pragma unroll
            for (int n = 0; n < 2; ++n)
#pragma unroll
                for (int e = 0; e < 4; ++e) o[n][e] = acc[ai][0][m][n][e] * sigmoidf_(acc[ai][1][m][n][e]);
            *(u32x4*)(uc + (size_t)row * 256 + (pn - 4) * 128 + wc * 32 + 8 * fq) = pack8(o[0], o[1]);
            EPI_ROWS_END
        } else {
            const int gt = pn - 9;
            EPI_ROWS_BEGIN
#pragma unroll
            for (int bj = 0; bj < 2; ++bj) { f32x4 o[2];
#pragma unroll
                for (int n = 0; n < 2; ++n)
#pragma unroll
                    for (int e = 0; e < 4; ++e) o[n][e] = sigmoidf_(acc[ai][bj][m][n][e]);
                *(u32x4*)(gate + (size_t)row * 4096 + gt * 256 + bj * HALF + wc * 32 + 8 * fq) = pack8(o[0], o[1]); }
            EPI_ROWS_END
        }
    }
};
struct EpiGateSig {
    static constexpr bool PERM = true;
    bf16_t* gate;
    __device__ __forceinline__ void operator()(const Acc& acc, const Unit& u, int wr, int wc, int fr, int fq) const {
        EPI_ROWS_BEGIN
#pragma unroll
        for (int bj = 0; bj < 2; ++bj) { f32x4 o[2];
#pragma unroll
            for (int n = 0; n < 2; ++n)
#pragma unroll
                for (int e = 0; e < 4; e += 2) { const f32x2 r = sigmoid2((f32x2){acc[ai][bj][m][n][e], acc[ai][bj][m][n][e + 1]} * (1.0f / 64.0f)) * ((GATE8 == 2) ? 255.0f : 1.0f); o[n][e] = r[0]; o[n][e + 1] = r[1]; }
            if (GATE8 == 2) { v2u w = {0u, 0u};
#pragma unroll
                for (int e = 0; e < 4; ++e) { w.x = __builtin_amdgcn_cvt_pk_u8_f32(o[0][e], e, w.x); w.y = __builtin_amdgcn_cvt_pk_u8_f32(o[1][e], e, w.y); }
                *(v2u*)((unsigned char*)gate + (size_t)row * 4096 + u.pn * BM + bj * HALF + wc * 32 + 8 * fq) = w; }
            else if (GATE8 == 1) { v2u w; w.x = pk4_fp8(o[0][0], o[0][1], o[0][2], o[0][3]); w.y = pk4_fp8(o[1][0], o[1][1], o[1][2], o[1][3]); *(v2u*)((unsigned char*)gate + (size_t)row * 4096 + u.pn * BM + bj * HALF + wc * 32 + 8 * fq) = w; }
            else *(u32x4*)(gate + (size_t)row * 4096 + u.pn * BM + bj * HALF + wc * 32 + 8 * fq) = pack8(o[0], o[1]); }
        EPI_ROWS_END
    }
};
struct EpiZ {
    static constexpr bool PERM = false;
    float* z;
    __device__ __forceinline__ void operator()(const Acc& acc, const Unit& u, int wr, int wc, int fr, int fq) const {
        EPI_ROWS_BEGIN
#pragma unroll
        for (int n = 0; n < 2; ++n) *(f32x4*)(z + ((size_t)(u.z * 512 + row)) * 128 + wc * 32 + 16 * n + 4 * fq) = acc[ai][0][m][n];
        EPI_ROWS_END
    }
};
struct EpiY {
    static constexpr bool PERM = true;
    const bf16_t* ua; const float* dskip; bf16_t* yp;
    __device__ __forceinline__ void operator()(const Acc& acc, const Unit& u, int wr, int wc, int fr, int fq) const {
        const int gI = u.z, h0 = 8 * (fq & 1);
        const f32x4 d0 = *(const f32x4*)(dskip + gI * 16 + h0), d1 = *(const f32x4*)(dskip + gI * 16 + h0 + 4);
        EPI_ROWS_BEGIN
#pragma unroll
        for (int bj = 0; bj < 2; ++bj) { const int col = u.pn * BM + bj * HALF + wc * 32 + 8 * fq;
            const u32x4 uu = *(const u32x4*)(ua + ((size_t)(gI * 512 + row)) * S5_LDA + col);
            f32x4 a = acc[ai][bj][m][0], b = acc[ai][bj][m][1];
            a[0] += d0[0] * bflo(uu.x); a[1] += d0[1] * bfhi(uu.x); a[2] += d0[2] * bflo(uu.y); a[3] += d0[3] * bfhi(uu.y);
            b[0] += d1[0] * bflo(uu.z); b[1] += d1[1] * bfhi(uu.z); b[2] += d1[2] * bflo(uu.w); b[3] += d1[3] * bfhi(uu.w);
#pragma unroll
            for (int e = 0; e < 4; ++e) { a[e] = gelu_tanh(a[e]); b[e] = gelu_tanh(b[e]); }
            *(u32x4*)(yp + ((size_t)row * 64 + (col >> 4)) * 256 + gI * 16 + h0) = pack8(a, b); }
        EPI_ROWS_END
    }
};
struct EpiGlu {
    static constexpr bool PERM = true;
    const bf16_t* yp; bf16_t* ycat;
    __device__ __forceinline__ void operator()(const Acc& acc, const Unit& u, int wr, int wc, int fr, int fq) const {
        EPI_ROWS_BEGIN
#pragma unroll
        for (int bj = 0; bj < 2; ++bj) { const int col = bj * HALF + wc * 32 + 8 * fq;
            const u32x4 yy = *(const u32x4*)(yp + (size_t)row * 256 + col);
            f32x4 a = acc[ai][bj][m][0], b = acc[ai][bj][m][1];
            a[0] = bflo(yy.x) * sigmoidf_(a[0]); a[1] = bfhi(yy.x) * sigmoidf_(a[1]); a[2] = bflo(yy.y) * sigmoidf_(a[2]); a[3] = bfhi(yy.y) * sigmoidf_(a[3]);
            b[0] = bflo(yy.z) * sigmoidf_(b[0]); b[1] = bfhi(yy.z) * sigmoidf_(b[1]); b[2] = bflo(yy.w) * sigmoidf_(b[2]); b[3] = bfhi(yy.w) * sigmoidf_(b[3]);
            *(u32x4*)(ycat + (size_t)row * 1024 + col) = pack8(a, b); }
        EPI_ROWS_END
    }
};
template <bool SC64> struct EpiResid {
    static constexpr bool PERM = true; static constexpr float sc = SC64 ? (1.0f / 64.0f) : 1.0f;
    const float* base32; const bf16_t* base16; bf16_t* out; float* ss; unsigned char* out8; int flags;
    __device__ __forceinline__ void operator()(const Acc& acc, const Unit& u, int wr, int wc, int fr, int fq) const {
        EPI_ROWS_BEGIN
        float q = 0.f;
#pragma unroll
        for (int bj = 0; bj < 2; ++bj) { const size_t off = (size_t)row * 1024 + u.pn * BM + bj * HALF + wc * 32 + 8 * fq;
            f32x4 a, b;
            if (flags & 1) { a = *(const f32x4*)(base32 + off); b = *(const f32x4*)(base32 + off + 4); }
            else { const u32x4 r = *(const u32x4*)(base16 + off); a = (f32x4){bflo(r.x), bfhi(r.x), bflo(r.y), bfhi(r.y)}; b = (f32x4){bflo(r.z), bfhi(r.z), bflo(r.w), bfhi(r.w)}; }
            const u32x4 w = pack8(a + acc[ai][bj][m][0] * sc, b + acc[ai][bj][m][1] * sc); *(u32x4*)(out + off) = w;
            if (flags & 2) { const float x0 = bflo(w.x), x1 = bfhi(w.x), x2 = bflo(w.y), x3 = bfhi(w.y), x4 = bflo(w.z), x5 = bfhi(w.z), x6 = bflo(w.w), x7 = bfhi(w.w);
                q += ((x0 * x0 + x1 * x1) + (x2 * x2 + x3 * x3)) + ((x4 * x4 + x5 * x5) + (x6 * x6 + x7 * x7));
                if (flags & 4) { v2u w8; w8.x = pk4_fp8(x0, x1, x2, x3); w8.y = pk4_fp8(x4, x5, x6, x7); *(v2u*)(out8 + off) = w8; } } }
        if (flags & 2) { q += __shfl_xor(q, 16); q += __shfl_xor(q, 32); if (fq == 0) ss[(size_t)row * 16 + u.pn * 4 + wc] = q; }
        EPI_ROWS_END
    }
};
template <bool H8> struct EpiSwiGlu {
    static constexpr bool PERM = true;
    bf16_t* h; float sc; const float* ss; int use_ss;
    __device__ __forceinline__ void operator()(const Acc& acc, const Unit& u, int wr, int wc, int fr, int fq) const {
        EPI_ROWS_BEGIN
        float rsc = sc;
        if (use_ss) { const f32x4 s0 = *(const f32x4*)(ss + (size_t)row * 16), s1 = *(const f32x4*)(ss + (size_t)row * 16 + 4), s2 = *(const f32x4*)(ss + (size_t)row * 16 + 8), s3 = *(const f32x4*)(ss + (size_t)row * 16 + 12);
            const f32x4 t = (s0 + s1) + (s2 + s3); rsc = sc * __builtin_amdgcn_rsqf(((t[0] + t[1]) + (t[2] + t[3])) * (1.0f / D) + EPS); }
        f32x4 o[2];
#pragma unroll
        for (int n = 0; n < 2; ++n)
#pragma unroll
            for (int e = 0; e < 4; e += 2) { const f32x2 a = (f32x2){acc[ai][0][m][n][e], acc[ai][0][m][n][e + 1]} * rsc, b = (f32x2){acc[ai][1][m][n][e], acc[ai][1][m][n][e + 1]} * rsc;
                const f32x2 r = (a * b) * sigmoid2(a); o[n][e] = r[0]; o[n][e + 1] = r[1]; }
        if constexpr (H8) { v2u w; w.x = pk4_fp8(o[0][0], o[0][1], o[0][2], o[0][3]); w.y = pk4_fp8(o[1][0], o[1][1], o[1][2], o[1][3]); *(v2u*)((unsigned char*)h + (size_t)row * FF + u.pn * 128 + wc * 32 + 8 * fq) = w; }
        else *(u32x4*)(h + (size_t)row * FF + u.pn * 128 + wc * 32 + 8 * fq) = pack8(o[0], o[1]);
        EPI_ROWS_END
    }
};
struct EpiStore {
    static constexpr bool PERM = true;
    bf16_t* o; float sc;
    __device__ __forceinline__ void operator()(const Acc& acc, const Unit& u, int wr, int wc, int fr, int fq) const {
        EPI_ROWS_BEGIN
#pragma unroll
        for (int bj = 0; bj < 2; ++bj) *(u32x4*)(o + (size_t)row * 1024 + u.pn * BM + bj * HALF + wc * 32 + 8 * fq) = pack8(acc[ai][bj][m][0] * sc, acc[ai][bj][m][1] * sc);
        EPI_ROWS_END
    }
};
}

#define XB_TMO      128
#define XB_XCNT(j)  (256  + 64 * (j))
#define XB_XSUB(j)  (1280 + 64 * (j))
#define XB_XGEN(j)  (2304 + 64 * (j))
#define XB_TOP      3328
#define XB_TOPGEN   3392
#define XCD_BAR_WORDS 3456
#define XB_SPIN_CAP (1u << 18)
__device__ __forceinline__ unsigned xb_ld(unsigned* p)              { return __hip_atomic_load(p, __ATOMIC_RELAXED, __HIP_MEMORY_SCOPE_AGENT); }
__device__ __forceinline__ unsigned xb_add(unsigned* p, unsigned v) { return __hip_atomic_fetch_add(p, v, __ATOMIC_RELAXED, __HIP_MEMORY_SCOPE_AGENT); }
__device__ __forceinline__ unsigned xb_xcc_id() { return (unsigned)__builtin_amdgcn_s_getreg((3 << 11) | 20) & 0xFu; }
#define XB_SPIN(cond, bar) do { unsigned _sp = 0; while (cond) { __builtin_amdgcn_s_sleep(1); \
    if ((++_sp & 255u) == 0u) { if (xb_ld(&(bar)[XB_TMO])) break; if (_sp > XB_SPIN_CAP) { atomicAdd(&(bar)[XB_TMO], 1u); break; } } } } while (0)
struct XcdBarrier { unsigned* bar; unsigned x; volatile LAS unsigned* st; };
__device__ __forceinline__ XcdBarrier xcd_barrier_post(unsigned* bar, volatile LAS unsigned* st) {
    XcdBarrier b; b.bar = bar; b.x = xb_xcc_id(); b.st = st;
    if (threadIdx.x == 0) (void)xb_add(&bar[XB_XCNT(b.x)], 1u);
    return b;
}
__device__ __forceinline__ void xcd_barrier_complete(unsigned* bar, unsigned x, unsigned& nloc, unsigned& nx) {
    const unsigned G = gridDim.x * gridDim.y * gridDim.z;
    unsigned sum, cnt, mine, sp = 0u;
    for (;;) {
        sum = 0u; cnt = 0u; mine = 0u;
#pragma unroll
        for (unsigned j = 0; j < 16; ++j) { const unsigned c = xb_ld(&bar[XB_XCNT(j)]); sum += c; cnt += (c > 0u) ? 1u : 0u; }
        mine = xb_ld(&bar[XB_XCNT(x)]);
        if (sum == G) break;
        __builtin_amdgcn_s_sleep(1);
        if ((++sp & 255u) == 0u) { if (xb_ld(&bar[XB_TMO])) break; if (sp > XB_SPIN_CAP) { atomicAdd(&bar[XB_TMO], 1u); break; } }
    }
    nloc = mine > 0u ? mine : 1u; nx = cnt > 0u ? cnt : 1u;
}
__device__ __forceinline__ void xcd_barrier(const XcdBarrier& b) {
    asm volatile("s_waitcnt vmcnt(0)" ::: "memory");
    __syncthreads();
    if (threadIdx.x == 0) {
        unsigned* bar = b.bar; unsigned bx = b.x; asm volatile("" : "+s"(bx));
        __builtin_amdgcn_s_waitcnt(0);
        unsigned nloc = b.st[0], nx = b.st[1];
        if (nloc == 0u) { xcd_barrier_complete(bar, bx, nloc, nx); b.st[0] = nloc; b.st[1] = nx; }
        const unsigned old = xb_add(&bar[XB_XSUB(bx)], 1u);
        const unsigned gen = old / nloc;
        if (old + 1u == (gen + 1u) * nloc) {
            __builtin_amdgcn_fence(__ATOMIC_RELEASE, "agent");
            asm volatile("s_waitcnt vmcnt(0)" ::: "memory");
            const unsigned og = xb_add(&bar[XB_TOP], 1u);
            const unsigned tg = og / nx;
            if (og + 1u == (tg + 1u) * nx) xb_add(&bar[XB_TOPGEN], 1u);
            else XB_SPIN(xb_ld(&bar[XB_TOPGEN]) == tg, bar);
            __builtin_amdgcn_fence(__ATOMIC_ACQUIRE, "agent");
            xb_add(&bar[XB_XGEN(bx)], 1u);
            asm volatile("s_waitcnt vmcnt(0)" ::: "memory");
        } else {
            XB_SPIN(xb_ld(&bar[XB_XGEN(bx)]) == gen, bar);
            __builtin_amdgcn_fence(__ATOMIC_ACQUIRE, "agent");
            asm volatile("s_waitcnt vmcnt(0)" ::: "memory");
        }
    }
    __syncthreads();
}

struct Args { const float* in[32]; float* out; unsigned char* ws; int gp_lo, gp_hi; };
enum { I_X = 0, I_GMIX, I_WIN, I_BFORGET, I_FQG, I_FKG, I_SQG, I_SKG, I_LRE, I_LIM, I_LDT, I_BRE, I_BIM, I_CRE, I_CIM, I_S5D, I_WGLU, I_CONVW, I_CONVB, I_LNG, I_LNB,
       I_WBR, I_WOUT, I_GFFN, I_W1, I_W3, I_W2, I_RW, I_RB, I_MW1, I_MW3, I_MW2 };
constexpr int NPH = 12, GP_FINAL = DEPTH * NPH, GP_TOTAL = GP_FINAL + 1;

struct Frame { LAS unsigned char* lds; int tid, lane, wave, vcu, G, gw, NGW; const Args* a; unsigned char* ws; };

__device__ __forceinline__ void transpose_item(const float* W, int ldw, bf16* WT, int ldt, int k0, int src_col0, int dst_row0, LAS float* scr, int lane, const float* ks = nullptr) {
    f32x4 ld[8];
#pragma unroll
    for (int i = 0; i < 8; ++i) ld[i] = *(const f32x4*)(W + (size_t)(k0 + 8 * i + (lane >> 3)) * ldw + src_col0 + 4 * (lane & 7));
#pragma unroll
    for (int i = 0; i < 8; ++i) { LAS float* d = scr + (8 * i + (lane >> 3)) * 33 + 4 * (lane & 7); const float s = ks ? ks[k0 + 8 * i + (lane >> 3)] : 1.0f; d[0] = ld[i][0] * s; d[1] = ld[i][1] * s; d[2] = ld[i][2] * s; d[3] = ld[i][3] * s; }
    LDS_WAIT(); asm volatile("" ::: "memory");
    const int c = lane & 7;
#pragma unroll
    for (int j = 0; j < 4; ++j) { const int n = (lane >> 3) + 8 * j; const LAS float* s = scr + (8 * c) * 33 + n;
        v4u o; o.x = pk2(s[0 * 33], s[1 * 33]); o.y = pk2(s[2 * 33], s[3 * 33]); o.z = pk2(s[4 * 33], s[5 * 33]); o.w = pk2(s[6 * 33], s[7 * 33]);
        *(GAS v4u*)(WT + (size_t)(dst_row0 + n) * ldt + k0 + 8 * c) = o; }
    LDS_WAIT(); asm volatile("" ::: "memory");
}
__device__ __forceinline__ void transpose_item_f8(const float* W, int ldw, unsigned char* WT, int ldt, int k0, int src_col0, int dst_row0, LAS float* scr, int lane, float sc, const float* ks = nullptr) {
    f32x4 ld[8];
#pragma unroll
    for (int i = 0; i < 8; ++i) ld[i] = *(const f32x4*)(W + (size_t)(k0 + 8 * i + (lane >> 3)) * ldw + src_col0 + 4 * (lane & 7));
#pragma unroll
    for (int i = 0; i < 8; ++i) { LAS float* d = scr + (8 * i + (lane >> 3)) * 33 + 4 * (lane & 7); const float s = ks ? sc * ks[k0 + 8 * i + (lane >> 3)] : sc; d[0] = ld[i][0] * s; d[1] = ld[i][1] * s; d[2] = ld[i][2] * s; d[3] = ld[i][3] * s; }
    LDS_WAIT(); asm volatile("" ::: "memory");
    const int c = lane & 7;
#pragma unroll
    for (int j = 0; j < 4; ++j) { const int n = (lane >> 3) + 8 * j; const LAS float* s = scr + (8 * c) * 33 + n;
        v2u o; o.x = pk4_fp8(s[0 * 33], s[1 * 33], s[2 * 33], s[3 * 33]); o.y = pk4_fp8(s[4 * 33], s[5 * 33], s[6 * 33], s[7 * 33]);
        *(GAS v2u*)(WT + (size_t)(dst_row0 + n) * ldt + k0 + 8 * c) = o; }
    LDS_WAIT(); asm volatile("" ::: "memory");
}
__device__ __forceinline__ int win_src_col(int blk) {
    const int tile = blk >> 3, j = blk & 7, bj = j >> 2, hh = j & 3;
    if (tile == 0) return 32 * j;
    if (tile == 1 || tile == 2) return 256 + 256 * (tile - 1) + 64 * hh + 32 * bj;
    if (tile == 3) return 768 + 32 * j;
    if (tile == 4 || tile == 5) return (j < 4) ? (1028 + 128 * (tile - 4) + 32 * j) : (1284 + 128 * (tile - 4) + 32 * (j - 4));
    if (tile == 6 || tile == 7) return 1540 + 256 * (tile - 6) + 64 * hh + 32 * bj;
    if (tile == 8) return 2052 + 32 * j;
    return 2308 + 256 * (tile - 9) + 32 * j;
}
constexpr int CONV_NIN = 200 * 16, CONV_NBR = 4 * 32 * 4, CONV_NOUT = 32 * 16, CONV_NGLU = 8 * 4, CONV_NUP1 = 176 * 16, CONV_NDN1 = 32 * 44;
constexpr int CONV_NMIX = CONV_NIN + CONV_NBR + CONV_NOUT + CONV_NGLU, CONV_CHUNK = 64;
__device__ __forceinline__ int conv_ffn_items(int layer) { return (CONV_NUP1 + CONV_NDN1) * ((layer & 1) ? NE : 1); }
__device__ __forceinline__ void convert_item(Frame& F, int layer, int it, LAS float* scr) {
    const Args& A = *F.a; unsigned char* ws = F.ws;
    const bool moe = (layer & 1) != 0; const int j2 = layer >> 1, ne = moe ? NE : 1;
    const int n_up = CONV_NUP1 * ne;
    int r = it;
    if (r < CONV_NIN) { const int blk = r >> 4, kb = r & 15;
        if (F8_GATES && blk >= 72) transpose_item_f8(A.in[I_WIN] + (size_t)layer * D * DP, DP, (unsigned char*)(ws + WS_WIN8), D, 64 * kb, win_src_col(blk), 32 * (blk - 72), scr, F.lane, 64.0f);
        else transpose_item(A.in[I_WIN] + (size_t)layer * D * DP, DP, (bf16*)(ws + WS_WIN), D, 64 * kb, win_src_col(blk), 32 * blk, scr, F.lane);
        return; } r -= CONV_NIN;
    if (r < CONV_NBR) { const int z = r >> 7, q = r & 127, blk = q >> 2, kb = q & 3;
        transpose_item(A.in[I_WBR] + ((size_t)layer * 4 + z) * 256 * D, D, (bf16*)(ws + WS_WBR) + (size_t)z * D * 256, 256, 64 * kb, 32 * blk, 32 * blk, scr, F.lane); return; } r -= CONV_NBR;
    if (r < CONV_NOUT) { const int blk = r >> 4, kb = r & 15; transpose_item(A.in[I_WOUT] + (size_t)layer * D * D, D, (bf16*)(ws + WS_WOUT), D, 64 * kb, 32 * blk, 32 * blk, scr, F.lane); return; } r -= CONV_NOUT;
    if (r < CONV_NGLU) { const int blk = r >> 2, kb = r & 3; transpose_item(A.in[I_WGLU] + (size_t)layer * 256 * 256, 256, (bf16*)(ws + WS_WGLU), 256, 64 * kb, 32 * blk, 32 * blk, scr, F.lane); return; } r -= CONV_NGLU;
    if (r < n_up) { const int e = r / CONV_NUP1, q = r % CONV_NUP1, blk = q >> 4, kb = q & 15, tile = blk >> 3, jj = blk & 7;
        const float* w1 = moe ? A.in[I_MW1] + ((size_t)j2 * NE + e) * D * FF : A.in[I_W1] + (size_t)j2 * D * FF;
        const float* w3 = moe ? A.in[I_MW3] + ((size_t)j2 * NE + e) * D * FF : A.in[I_W3] + (size_t)j2 * D * FF;
        const float* ks = (FUSE_DENSE_NORM && !moe) ? A.in[I_GFFN] + layer * D : nullptr;
        if (moe ? (F8_MOE_UP != 0) : (DENSE8(layer) != 0)) transpose_item_f8(jj < 4 ? w1 : w3, FF, (unsigned char*)(ws + WS_WUP) + (size_t)e * 5632 * D, D, 64 * kb, 128 * tile + 32 * (jj & 3), 32 * blk, scr, F.lane, 64.0f, ks);
        else transpose_item(jj < 4 ? w1 : w3, FF, (bf16*)(ws + WS_WUP) + (size_t)e * 5632 * D, D, 64 * kb, 128 * tile + 32 * (jj & 3), 32 * blk, scr, F.lane, ks);
        return; } r -= n_up;
    { const int e = r / CONV_NDN1, q = r % CONV_NDN1, blk = q / 44, kb = q % 44;
        const float* w2 = moe ? A.in[I_MW2] + ((size_t)j2 * NE + e) * FF * D : A.in[I_W2] + (size_t)j2 * FF * D;
        if (moe ? (F8_MOE_DN != 0) : (DENSE8(layer) != 0)) transpose_item_f8(w2, D, (unsigned char*)(ws + WS_WDN) + (size_t)e * D * FF, FF, 64 * kb, 32 * blk, 32 * blk, scr, F.lane, 64.0f);
        else transpose_item(w2, D, (bf16*)(ws + WS_WDN) + (size_t)e * D * FF, FF, 64 * kb, 32 * blk, 32 * blk, scr, F.lane); }
}
__device__ __forceinline__ void phase_convert(Frame& F, int layer) {
    LAS float* scr = (LAS float*)(F.lds + F.wave * 16384);
    for (int it = F.gw; it < CONV_NMIX; it += F.NGW) convert_item(F, layer, it, scr);
}
__device__ __forceinline__ void ffn_item_load(const Args& A, int layer, int r, int lane, f32x4 (&ld)[8]) {
    asm volatile("" : "+v"(r));
    const bool moe = (layer & 1) != 0; const int j2 = layer >> 1, n_up = CONV_NUP1 * (moe ? NE : 1);
    const float* w; int ldw, k0, col0;
    if (r < n_up) { const int e = r / CONV_NUP1, q = r % CONV_NUP1, blk = q >> 4, kb = q & 15, tile = blk >> 3, jj = blk & 7;
        const size_t off = moe ? ((size_t)j2 * NE + e) * D * FF : (size_t)j2 * D * FF;
        w = (moe ? (jj < 4 ? A.in[I_MW1] : A.in[I_MW3]) : (jj < 4 ? A.in[I_W1] : A.in[I_W3])) + off; ldw = FF; k0 = 64 * kb; col0 = 128 * tile + 32 * (jj & 3);
    } else { r -= n_up; const int e = r / CONV_NDN1, q = r % CONV_NDN1, blk = q / 44, kb = q % 44;
        w = moe ? A.in[I_MW2] + ((size_t)j2 * NE + e) * FF * D : A.in[I_W2] + (size_t)j2 * FF * D; ldw = D; k0 = 64 * kb; col0 = 32 * blk; }
    w += (size_t)(k0 + (lane >> 3)) * ldw + col0 + 4 * (lane & 7);
#pragma unroll
    for (int i = 0; i < 8; ++i) ld[i] = *(const f32x4*)(w + (size_t)(8 * i) * ldw);
}
__device__ __forceinline__ void ffn_item_finish(const Args& A, unsigned char* ws, int layer, int r, int lane, f32x4 (&ld)[8], LAS float* scr) {
    asm volatile("" : "+v"(r));
    const bool moe = (layer & 1) != 0; const int n_up = CONV_NUP1 * (moe ? NE : 1);
    const bool f8 = moe ? (F8_MOE_UP != 0) : (DENSE8(layer) != 0); const float sc = f8 ? 64.0f : 1.0f;
    const bool up = r < n_up; int e, k0, row0, ldt; size_t dbase;
    if (up) { e = r / CONV_NUP1; const int q = r % CONV_NUP1, blk = q >> 4, kb = q & 15; k0 = 64 * kb; row0 = 32 * blk; ldt = D; dbase = WS_WUP + (size_t)e * 5632 * D * (f8 ? 1 : 2); }
    else { r -= n_up; e = r / CONV_NDN1; const int q = r % CONV_NDN1, blk = q / 44, kb = q % 44; k0 = 64 * kb; row0 = 32 * blk; ldt = FF; dbase = WS_WDN + (size_t)e * D * FF * (f8 ? 1 : 2); }
    const bool scaled = FUSE_DENSE_NORM && !moe && up;
    const float* ks = A.in[I_GFFN] + layer * D + k0 + (lane >> 3);
#pragma unroll
    for (int i = 0; i < 8; ++i) { LAS float* d = scr + (8 * i + (lane >> 3)) * 33 + 4 * (lane & 7); const float s = scaled ? sc * ks[8 * i] : sc; d[0] = ld[i][0] * s; d[1] = ld[i][1] * s; d[2] = ld[i][2] * s; d[3] = ld[i][3] * s; }
    LDS_WAIT(); asm volatile("" ::: "memory");
    const int c = lane & 7;
    if (f8) {
#pragma unroll
        for (int j = 0; j < 4; ++j) { const int n = (lane >> 3) + 8 * j; const LAS float* s = scr + (8 * c) * 33 + n;
            v2u o; o.x = pk4_fp8(s[0 * 33], s[1 * 33], s[2 * 33], s[3 * 33]); o.y = pk4_fp8(s[4 * 33], s[5 * 33], s[6 * 33], s[7 * 33]);
            *(GAS v2u*)(ws + dbase + (size_t)(row0 + n) * ldt + k0 + 8 * c) = o; }
    } else {
#pragma unroll
        for (int j = 0; j < 4; ++j) { const int n = (lane >> 3) + 8 * j; const LAS float* s = scr + (8 * c) * 33 + n;
            v4u o; o.x = pk2(s[0 * 33], s[1 * 33]); o.y = pk2(s[2 * 33], s[3 * 33]); o.z = pk2(s[4 * 33], s[5 * 33]); o.w = pk2(s[6 * 33], s[7 * 33]);
            *(GAS v4u*)((bf16*)(ws + dbase) + (size_t)(row0 + n) * ldt + k0 + 8 * c) = o; }
    }
    LDS_WAIT(); asm volatile("" ::: "memory");
}
__device__ __forceinline__ void convert_ffn_chunk(Frame& F, int layer, int chunk) {
    LAS float* scr = (LAS float*)(F.lds + F.wave * 16384); const int nf = conv_ffn_items(layer), base = chunk * CONV_CHUNK + F.wave;
    const Args& A = *F.a; unsigned char* ws = F.ws; const int lane = F.lane;
    f32x4 la[8], lb[8];
    ffn_item_load(A, layer, min(base, nf - 1), lane, la);
#pragma unroll 1
    for (int jj = 0; jj < CONV_CHUNK / NWAVES; jj += 2) {
        const int i0 = base + NWAVES * jj, i1 = i0 + NWAVES, i2 = i1 + NWAVES;
        ffn_item_load(A, layer, min(i1, nf - 1), lane, lb);
        if (i0 < nf) ffn_item_finish(A, ws, layer, i0, lane, la, scr);
        if (jj + 2 < CONV_CHUNK / NWAVES) ffn_item_load(A, layer, min(i2, nf - 1), lane, la);
        if (i1 < nf) ffn_item_finish(A, ws, layer, i1, lane, lb, scr);
    }
}
struct S5P { float lr, li, dt, kr, ki; };
__device__ __forceinline__ S5P s5_params(const Args& A, int layer, int g, int p) {
    S5P q; q.lr = A.in[I_LRE][(layer * 16 + g) * 64 + p]; q.li = A.in[I_LIM][(layer * 16 + g) * 64 + p]; q.dt = expf(A.in[I_LDT][layer * 16 + g]);
    const float mag = expf(q.lr * q.dt), abr = mag * cosf(q.li * q.dt), abi = mag * sinf(q.li * q.dt);
    const float nr = abr - 1.0f, ni = abi, den = q.lr * q.lr + q.li * q.li;
    q.kr = (nr * q.lr + ni * q.li) / den; q.ki = (ni * q.lr - nr * q.li) / den; return q;
}
__device__ __forceinline__ void s5_pow(const S5P& q, float n, float& pr, float& pi) { const float m = expf(n * q.lr * q.dt), a = n * q.li * q.dt; pr = m * cosf(a); pi = m * sinf(a); }
__device__ __forceinline__ void phase_kfun(Frame& F, int layer) {
    const Args& A = *F.a; float* kf = (float*)(F.ws + WS_KFUN);
    for (int it = F.gw; it < 16 * 64; it += F.NGW) {
        const int g = it >> 6, tau = it & 63, lane = F.lane;
        const S5P q = s5_params(A, layer, g, lane); float pr, pi; s5_pow(q, (float)tau, pr, pi);
        const float wr_ = pr * q.kr - pi * q.ki, wi_ = pr * q.ki + pi * q.kr;
        const int h = lane >> 2, hp0 = 4 * (lane & 3);
        const float* cre = A.in[I_CRE] + ((size_t)(layer * 16 + g) * 16 + h) * 64; const float* cim = A.in[I_CIM] + ((size_t)(layer * 16 + g) * 16 + h) * 64;
        const float* bre = A.in[I_BRE] + (size_t)(layer * 16 + g) * 64 * 16 + hp0; const float* bim = A.in[I_BIM] + (size_t)(layer * 16 + g) * 64 * 16 + hp0;
        f32x4 acc = {0.f, 0.f, 0.f, 0.f};
        for (int p = 0; p < 64; ++p) {
            const float wpr = __shfl(wr_, p), wpi = __shfl(wi_, p);
            const float cr = cre[p], ci = cim[p], cwr = cr * wpr - ci * wpi, cwi = cr * wpi + ci * wpr;
            const f32x4 br = *(const f32x4*)(bre + p * 16), bi = *(const f32x4*)(bim + p * 16);
            acc += cwr * br - cwi * bi;
        }
        *(f32x4*)(kf + ((size_t)(g * 64 + tau) * 16 + h) * 16 + hp0) = acc;
    }
}
__device__ __forceinline__ void moe_starts(Frame& F, int j2, int (&st)[NE + 1]) {
    const unsigned* cnt = (const unsigned*)(F.ws + WS_CTL) + CW_MOE + 64 * j2; int s = 0;
#pragma unroll
    for (int e = 0; e < NE; ++e) { st[e] = s; const int c = (int)__hip_atomic_load(cnt + e, __ATOMIC_RELAXED, __HIP_MEMORY_SCOPE_AGENT); s += (c + 255) & ~255; }
    st[NE] = s;
}
__device__ __forceinline__ void moe_combine_row(Frame& F, int row, f32x4 (&v)[4], const int (&st)[NE + 1]) {
    const unsigned* rt = (const unsigned*)(F.ws + WS_ROUTE) + (size_t)row * 8;
    const v4u rr = *(const v4u*)rt; unsigned s0 = rr.z, s1 = rr.w;
#pragma unroll
    for (int e = 0; e < NE; ++e) { if ((int)rr.x == e) s0 += (unsigned)st[e]; if ((int)rr.y == e) s1 += (unsigned)st[e]; }
    const float w0 = __builtin_bit_cast(float, rt[4]), w1 = __builtin_bit_cast(float, rt[5]);
    const bf16* yp = (const bf16*)(F.ws + WS_XNP);
#pragma unroll
    for (int j = 0; j < 4; ++j) { const v2u a = *(const v2u*)(yp + (size_t)s0 * D + 4 * F.lane + 256 * j), b = *(const v2u*)(yp + (size_t)s1 * D + 4 * F.lane + 256 * j);
        v[j][0] += w0 * bflo(a.x) + w1 * bflo(b.x); v[j][1] += w0 * bfhi(a.x) + w1 * bfhi(b.x); v[j][2] += w0 * bflo(a.y) + w1 * bflo(b.y); v[j][3] += w0 * bfhi(a.y) + w1 * bfhi(b.y); }
}
__device__ __forceinline__ void phase_rows_mixer(Frame& F, int layer) {
    const Args& A = *F.a; const int lane = F.lane;
    const float* xin = A.in[I_X]; bf16* xb = (bf16*)(F.ws + WS_XB); const bool first = (layer == 0), comb = (layer > 0) && (((layer - 1) & 1) != 0);
    f32x4 gv[4]; f32x4 wf[4][4];
#pragma unroll
    for (int j = 0; j < 4; ++j) { gv[j] = *(const f32x4*)(A.in[I_GMIX] + layer * D + 4 * lane + 256 * j);
#pragma unroll
        for (int e = 0; e < 4; ++e) wf[j][e] = *(const f32x4*)(A.in[I_WIN] + (size_t)layer * D * DP + (size_t)(4 * lane + 256 * j + e) * DP + 1024); }
    const f32x4 bf = *(const f32x4*)(A.in[I_BFORGET] + layer * 4);
    bf16* xn = (bf16*)(F.ws + WS_XN); float* lf = (float*)(F.ws + WS_LF); unsigned char* xn8 = F.ws + WS_XN8;
    int st[NE + 1];
#pragma unroll
    for (int e = 0; e <= NE; ++e) st[e] = 0;
    if (comb) moe_starts(F, (layer - 1) >> 1, st);
    for (int row = F.gw; row < T; row += F.NGW) {
        f32x4 v[4]; float ss = 0.f;
        if (first) {
#pragma unroll
            for (int j = 0; j < 4; ++j) v[j] = *(const f32x4*)(xin + (size_t)row * D + 4 * lane + 256 * j);
        } else {
#pragma unroll
            for (int j = 0; j < 4; ++j) { const v2u r = *(const v2u*)(xb + (size_t)row * D + 4 * lane + 256 * j); v[j] = (f32x4){bflo(r.x), bfhi(r.x), bflo(r.y), bfhi(r.y)}; }
        }
        if (comb) { moe_combine_row(F, row, v, st);
#pragma unroll
            for (int j = 0; j < 4; ++j) { v2u o; o.x = pk2(v[j][0], v[j][1]); o.y = pk2(v[j][2], v[j][3]); *(v2u*)(xb + (size_t)row * D + 4 * lane + 256 * j) = o;
                v[j] = (f32x4){bflo(o.x), bfhi(o.x), bflo(o.y), bfhi(o.y)}; } }
#pragma unroll
        for (int j = 0; j < 4; ++j) ss += (v[j][0] * v[j][0] + v[j][1] * v[j][1]) + (v[j][2] * v[j][2] + v[j][3] * v[j][3]);
        const float rs = 1.0f / sqrtf(wave_sum(ss) * (1.0f / D) + EPS);
        f32x4 fl = {0.f, 0.f, 0.f, 0.f};
#pragma unroll
        for (int j = 0; j < 4; ++j) { const f32x4 h = v[j] * rs * gv[j];
            v2u o; o.x = pk2(h[0], h[1]); o.y = pk2(h[2], h[3]); *(v2u*)(xn + (size_t)row * D + 4 * lane + 256 * j) = o;
            if (F8_GATES) *(unsigned*)(xn8 + (size_t)row * D + 4 * lane + 256 * j) = pk4_fp8(h[0], h[1], h[2], h[3]);
#pragma unroll
            for (int e = 0; e < 4; ++e) fl += h[e] * wf[j][e]; }
#pragma unroll
        for (int e = 0; e < 4; ++e) fl[e] = wave_sum(fl[e]);
        if (lane == 0) { f32x4 o;
#pragma unroll
            for (int e = 0; e < 4; ++e) { const float xx = fl[e] + bf[e]; o[e] = (fminf(xx, 0.f) - log1pf(expf(-fabsf(xx)))) * LOG2E; }
            *(f32x4*)(lf + (size_t)row * 4) = o; }
    }
}
__device__ __forceinline__ void phase_s5_tables(Frame& F, int layer) {
    const Args& A = *F.a; const int lane = F.lane;
    bf16* wz = (bf16*)(F.ws + WS_WZ); bf16* wy = (bf16*)(F.ws + WS_WY); const float* kf = (const float*)(F.ws + WS_KFUN);
    for (int it = F.gw; it < 16 * 256; it += F.NGW) {
        const int g = it >> 8, rowz = it & 255; bf16* dst = wz + ((size_t)(g * 256 + rowz)) * 1024 + lane * 16;
        v4u o0 = {0u, 0u, 0u, 0u}, o1 = {0u, 0u, 0u, 0u};
        if (rowz < 128) { const int p = rowz >> 1, ri = rowz & 1; const S5P q = s5_params(A, layer, g, p); float pr, pi; s5_pow(q, (float)(63 - lane), pr, pi);
            const float wr_ = pr * q.kr - pi * q.ki, wi_ = pr * q.ki + pi * q.kr;
            const float* bre = A.in[I_BRE] + ((size_t)(layer * 16 + g) * 64 + p) * 16; const float* bim = A.in[I_BIM] + ((size_t)(layer * 16 + g) * 64 + p) * 16;
            float val[16];
#pragma unroll
            for (int h = 0; h < 16; ++h) { const float br = bre[h], bi = bim[h]; val[h] = ri == 0 ? (wr_ * br - wi_ * bi) : (wr_ * bi + wi_ * br); }
            o0 = (v4u){pk2(val[0], val[1]), pk2(val[2], val[3]), pk2(val[4], val[5]), pk2(val[6], val[7])};
            o1 = (v4u){pk2(val[8], val[9]), pk2(val[10], val[11]), pk2(val[12], val[13]), pk2(val[14], val[15])}; }
        *(v4u*)dst = o0; *(v4u*)(dst + 8) = o1;
    }
    for (int it = F.gw; it < 16 * 1024; it += F.NGW) {
        const int g = it >> 10, n = it & 1023, t = n >> 4, h = n & 15; bf16* dst = wy + ((size_t)(g * 1024 + n)) * S5_LDA;
        v4u o0 = {0u, 0u, 0u, 0u}, o1 = {0u, 0u, 0u, 0u};
        if (lane <= t) { const float* src = kf + ((size_t)(g * 64 + (t - lane)) * 16 + h) * 16;
            const f32x4 a = *(const f32x4*)src, b = *(const f32x4*)(src + 4), c = *(const f32x4*)(src + 8), d = *(const f32x4*)(src + 12);
            o0 = (v4u){pk2(a[0], a[1]), pk2(a[2], a[3]), pk2(b[0], b[1]), pk2(b[2], b[3])}; o1 = (v4u){pk2(c[0], c[1]), pk2(c[2], c[3]), pk2(d[0], d[1]), pk2(d[2], d[3])}; }
        *(v4u*)(dst + lane * 16) = o0; *(v4u*)(dst + lane * 16 + 8) = o1;
        const S5P q = s5_params(A, layer, g, lane); float pr, pi; s5_pow(q, (float)(t + 1), pr, pi);
        const float cr = A.in[I_CRE][((size_t)(layer * 16 + g) * 16 + h) * 64 + lane], ci = A.in[I_CIM][((size_t)(layer * 16 + g) * 16 + h) * 64 + lane];
        *(unsigned*)(dst + 1024 + 2 * lane) = pk2(cr * pr - ci * pi, -(cr * pi + ci * pr));
    }
}
__device__ __forceinline__ void phase_cumsum(Frame& F) {
    const int first = (gridDim.x >= 160) ? 128 : 0;
    if ((int)blockIdx.x < first || (int)blockIdx.x >= first + 32) return;
    const int bh = (int)blockIdx.x - first, b = bh >> 2, h = bh & 3, tid = F.tid;
    const float* lf = (const float*)(F.ws + WS_LF); float* cum = (float*)(F.ws + WS_CUM);
    LAS float* wtot = (LAS float*)(F.lds);
    float v[8]; float run = 0.f;
#pragma unroll
    for (int i = 0; i < 8; ++i) { run += lf[((size_t)b * SEQ + tid * 8 + i) * 4 + h]; v[i] = run; }
    float incl = run;
#pragma unroll
    for (int o = 1; o < 64; o <<= 1) { const float n = __shfl_up(incl, o); if (F.lane >= o) incl += n; }
    if (F.lane == 63) wtot[F.wave] = incl;
    __syncthreads();
    float base = incl - run;
    for (int w = 0; w < F.wave; ++w) base += wtot[w];
#pragma unroll
    for (int i = 0; i < 8; ++i) cum[(size_t)bh * SEQ + tid * 8 + i] = base + v[i];
    __syncthreads();
}
__device__ __forceinline__ void phase_conv(Frame& F, int layer) {
    const Args& A = *F.a; const int lane = F.lane;
    LAS f32x4* wl = (LAS f32x4*)F.lds;
    { int ly = layer; asm volatile("" : "+v"(ly));
      const float* cw = A.in[I_CONVW] + (size_t)ly * 31 * 256;
      for (int i = F.tid; i < 31 * 64; i += NWAVES * 64) wl[i] = *(const f32x4*)(cw + (size_t)i * 4); }
    __syncthreads();
    const f32x4 cb = *(const f32x4*)(A.in[I_CONVB] + layer * 256 + 4 * lane), lg = *(const f32x4*)(A.in[I_LNG] + layer * 256 + 4 * lane), lb = *(const f32x4*)(A.in[I_LNB] + layer * 256 + 4 * lane);
    const bf16* uc = (const bf16*)(F.ws + WS_UC); bf16* ycat = (bf16*)(F.ws + WS_YCAT);
    for (int run = F.gw; run < T / 8; run += F.NGW) {
        const int t0 = run * 8, tl0 = t0 & (SEQ - 1);
        f32x4 acc[8];
#pragma unroll
        for (int i = 0; i < 8; ++i) acc[i] = cb;
#pragma unroll
        for (int r = 0; r < 38; ++r) {
            v2u raw = {0u, 0u};
            if (tl0 - 30 + r >= 0) raw = *(const v2u*)(uc + (size_t)(t0 - 30 + r) * 256 + 4 * lane);
            const f32x4 x = {bflo(raw.x), bfhi(raw.x), bflo(raw.y), bfhi(raw.y)};
#pragma unroll
            for (int i = 0; i < 8; ++i) { const int j = r - i; if (j >= 0 && j < 31) acc[i] += wl[j * 64 + lane] * x; }
        }
#pragma unroll
        for (int i = 0; i < 8; ++i) {
            const f32x4 a = acc[i];
            const float mean = wave_sum((a[0] + a[1]) + (a[2] + a[3])) * (1.0f / 256.0f);
            const f32x4 dlt = a - mean;
            const float var = wave_sum((dlt[0] * dlt[0] + dlt[1] * dlt[1]) + (dlt[2] * dlt[2] + dlt[3] * dlt[3])) * (1.0f / 256.0f);
            const float rs = 1.0f / sqrtf(var + EPS);
            f32x4 y = dlt * rs * lg + lb;
#pragma unroll
            for (int e = 0; e < 4; ++e) y[e] = y[e] * sigmoidf_(y[e]);
            v2u o; o.x = pk2(y[0], y[1]); o.y = pk2(y[2], y[3]);
            *(v2u*)(ycat + (size_t)(t0 + i) * 1024 + 512 + 4 * lane) = o;
        }
    }
    __syncthreads();
}

typedef float f32x16 __attribute__((ext_vector_type(16)));
typedef short s16x4 __attribute__((ext_vector_type(4)));
constexpr int AW_BLKS = 11, AW_KEYS = 32 * AW_BLKS, AW_K = 0, AW_V = AW_KEYS * 128, AW_C = 2 * AW_KEYS * 128, AW_FLAG = AW_C + AW_KEYS * 4;
constexpr float SB_DEAD = -64.0f;
__device__ __forceinline__ s16x4 tr_read(const LAS unsigned char* p) { return __builtin_bit_cast(s16x4, __builtin_amdgcn_ds_read_tr16_b64_v4i16((LAS s16x4*)p)); }

template <int MODE>
__device__ __forceinline__ void attn_unit(Frame& F, int bh, int qb, const bf16* Q, const bf16* K, const bf16* V, const float* CUM, bf16* Y, float z2max) {
    const int tid = F.tid, lane = F.lane, w = F.wave, l31 = lane & 31, hh = lane >> 5;
    const int b = bh >> 2, h = bh & 3, qblk = qb * 8 + w, qw0 = 32 * qblk, qrow = qw0 + l31;
    const size_t rowbase = (size_t)b * SEQ;
    LAS unsigned char* lds = F.lds;
    LAS unsigned* flags = (LAS unsigned*)(lds + AW_FLAG);
    if (tid < 3) flags[tid] = 0u;
    bf16x8 qf[4];
#pragma unroll
    for (int s = 0; s < 4; ++s) qf[s] = *(const bf16x8*)(Q + (rowbase + qrow) * 256 + h * 64 + 16 * s + 8 * hh);
    f32x16 ot[2];
#pragma unroll
    for (int r = 0; r < 16; ++r) { ot[0][r] = 0.f; ot[1][r] = 0.f; }
    float m_run = -INFINITY, l_run = 0.f, carry = 0.f;
    const int ti = lane & 15, tq = ti >> 2, tp = ti & 3, tg = (lane >> 4) & 1;
    int kofs[4], vofs[2];
#pragma unroll
    for (int s = 0; s < 4; ++s) kofs[s] = AW_K + l31 * 128 + (((2 * s + hh) ^ (l31 & 7)) << 4);
#pragma unroll
    for (int db = 0; db < 2; ++db) vofs[db] = AW_V + (4 * hh + tq) * 128 + (((4 * db + 2 * tg + (tp >> 1)) ^ (4 * hh + tq)) << 4) + 8 * (tp & 1);
    const int srow = lane >> 3, sch = ((lane & 7) ^ srow) * 8;
    int kbw = qblk; bool done = false; int it = 0;
    for (int whi = qb * 8 + 7; whi >= 0; whi -= AW_BLKS, ++it) {
        const int wlo = whi - (AW_BLKS - 1), key0 = 32 * wlo;
        for (int g = w; g < 2 * AW_KEYS / 8; g += NWAVES) {
            const int gg = g < AW_KEYS / 8 ? g : g - AW_KEYS / 8; const int key = max(key0 + 8 * gg + srow, 0);
            const bf16* src = (g < AW_KEYS / 8 ? K : V) + (rowbase + key) * 256 + h * 64 + sch;
            __builtin_amdgcn_global_load_lds((const unsigned*)src, (LAS unsigned*)(lds + (g < AW_KEYS / 8 ? AW_K : AW_V) + gg * 1024), 16, 0, 0);
        }
        if (MODE == 0 && tid < AW_KEYS) *(LAS float*)(lds + AW_C + tid * 4) = -CUM[(size_t)bh * SEQ + max(key0 + tid, 0)];
        asm volatile("s_waitcnt vmcnt(0)" ::: "memory");
        __syncthreads();
        if (!done) {
            const int lo = max(wlo, 0);
            for (; kbw >= lo; --kbw) {
                const int kv0 = 32 * kbw, rb = (kbw - wlo) * 32;
                if (MODE == 0) { const float clast = *(const LAS float*)(lds + AW_C + (rb + 31) * 4); if (__all((z2max + clast - m_run) < SB_DEAD)) { done = true; break; } }
                else if (__all(carry < SB_DEAD)) { done = true; break; }
                f32x16 p;
                if (MODE == 0) {
#pragma unroll
                    for (int c = 0; c < 4; ++c) { const f32x4 ck = *(const LAS f32x4*)(lds + AW_C + (rb + 8 * c + 4 * hh) * 4); p[4 * c] = ck[0]; p[4 * c + 1] = ck[1]; p[4 * c + 2] = ck[2]; p[4 * c + 3] = ck[3]; }
                } else {
#pragma unroll
                    for (int r = 0; r < 16; ++r) p[r] = 0.f;
                }
#pragma unroll
                for (int s = 0; s < 4; ++s) { const bf16x8 kf = *(const LAS bf16x8*)(lds + rb * 128 + kofs[s]); p = __builtin_amdgcn_mfma_f32_32x32x16_bf16(kf, qf[s], p, 0, 0, 0); }
                const bool diag = (kbw == qblk);
                if (MODE == 0) {
                    if (diag) {
#pragma unroll
                        for (int r = 0; r < 16; ++r) { const int kvg = kv0 + (r & 3) + 8 * (r >> 2) + 4 * hh; if (kvg > qrow) p[r] = -INFINITY; }
                    }
                    float mt = p[0];
#pragma unroll
                    for (int r = 1; r < 16; ++r) mt = fmaxf(mt, p[r]);
                    mt = fmaxf(mt, __shfl_xor(mt, 32));
                    const float mn = fmaxf(m_run, mt), alpha = fast_exp2(m_run - mn); m_run = mn;
                    float rs = 0.f;
#pragma unroll
                    for (int r = 0; r < 16; ++r) { p[r] = fast_exp2(p[r] - mn); rs += p[r]; }
                    l_run = l_run * alpha + rs;
                    if (__any(alpha != 1.0f)) {
#pragma unroll
                        for (int r = 0; r < 16; ++r) { ot[0][r] *= alpha; ot[1][r] *= alpha; } }
                } else {
                    f32x16 lk;
#pragma unroll
                    for (int r = 0; r < 16; ++r) { const float z = p[r], e = fast_exp2(-fabsf(z)), lg = __builtin_amdgcn_logf(1.0f + e);
                        float lb = fminf(z, 0.f) - lg, k_ = -(fmaxf(z, 0.f) + lg);
                        if (diag) { const int kvg = kv0 + (r & 3) + 8 * (r >> 2) + 4 * hh; if (kvg >= qrow) { k_ = 0.f; lb = -INFINITY; } }
                        p[r] = lb; lk[r] = k_; }
                    float T4[4], To[4], PS[4];
#pragma unroll
                    for (int c = 0; c < 4; ++c) { T4[c] = (lk[4 * c] + lk[4 * c + 1]) + (lk[4 * c + 2] + lk[4 * c + 3]); To[c] = __shfl_xor(T4[c], 32); }
                    float run = 0.f;
#pragma unroll
                    for (int c = 3; c >= 0; --c) { PS[c] = run; run += T4[c] + To[c]; }
#pragma unroll
                    for (int c = 0; c < 4; ++c) { const float base = carry + PS[c] + (hh == 0 ? To[c] : 0.f);
                        const float s3 = lk[4 * c + 3], s2 = s3 + lk[4 * c + 2], s1 = s2 + lk[4 * c + 1];
                        p[4 * c + 3] = fast_exp2(p[4 * c + 3] + base); p[4 * c + 2] = fast_exp2(p[4 * c + 2] + base + s3);
                        p[4 * c + 1] = fast_exp2(p[4 * c + 1] + base + s2); p[4 * c] = fast_exp2(p[4 * c] + base + s1); }
                    carry += run;
                }
                bf16x8 pb[2];
#pragma unroll
                for (int c2 = 0; c2 < 2; ++c2) { v4u wv; wv.x = pg8::cvt_pk_bf16(p[8 * c2], p[8 * c2 + 1]); wv.y = pg8::cvt_pk_bf16(p[8 * c2 + 2], p[8 * c2 + 3]);
                    wv.z = pg8::cvt_pk_bf16(p[8 * c2 + 4], p[8 * c2 + 5]); wv.w = pg8::cvt_pk_bf16(p[8 * c2 + 6], p[8 * c2 + 7]); pb[c2] = __builtin_bit_cast(bf16x8, wv); }
#pragma unroll
                for (int db = 0; db < 2; ++db)
#pragma unroll
                    for (int c2 = 0; c2 < 2; ++c2) { const LAS unsigned char* vp = lds + (rb + 16 * c2) * 128 + vofs[db];
                        const s16x4 lo4 = tr_read(vp), hi4 = tr_read(vp + 8 * 128);
                        const bf16x8 va = {lo4[0], lo4[1], lo4[2], lo4[3], hi4[0], hi4[1], hi4[2], hi4[3]};
                        ot[db] = __builtin_amdgcn_mfma_f32_32x32x16_bf16(va, pb[c2], ot[db], 0, 0, 0); }
            }
            if (kbw < 0) done = true;
        }
        { const int sl = it % 3, sn = (it + 1) % 3;
            if (!done && lane == 0) flags[sl] = 1u;
            if (tid == 0) flags[sn] = 0u;
            __syncthreads();
            if (flags[sl] == 0u) break; }
    }
    float inv = 1.0f;
    if (MODE == 0) { const float lt = l_run + __shfl_xor(l_run, 32); inv = 1.0f / lt; }
    bf16* yrow = Y + (rowbase + qrow) * 1024 + h * 64;
#pragma unroll
    for (int db = 0; db < 2; ++db)
#pragma unroll
        for (int c = 0; c < 4; ++c) { v2u o; o.x = pg8::cvt_pk_bf16(ot[db][4 * c] * inv, ot[db][4 * c + 1] * inv); o.y = pg8::cvt_pk_bf16(ot[db][4 * c + 2] * inv, ot[db][4 * c + 3] * inv);
            *(v2u*)(yrow + 32 * db + 8 * c + 4 * hh) = o; }
}
__device__ __forceinline__ int q_pop(Frame& F, unsigned* ctr) {
    LAS int* slot = (LAS int*)(F.lds + QSLOT_OFF);
    __syncthreads();
    if (F.tid == 0) *slot = (int)__hip_atomic_fetch_add(ctr, 1u, __ATOMIC_RELAXED, __HIP_MEMORY_SCOPE_AGENT);
    __syncthreads();
    return *slot;
}
__device__ __forceinline__ void phase_attn_sb(Frame& F, int layer, int rep) {
    const bf16* qkv = (const bf16*)(F.ws + WS_QKV); const size_t sz = (size_t)T * 256; bf16* ycat = (bf16*)(F.ws + WS_YCAT);
    unsigned* ctr = (unsigned*)(F.ws + WS_CTL) + CW_Q + 128 * layer + 16 * rep;
    for (;;) { const int un = q_pop(F, ctr); if (un >= 512) break;
        attn_unit<1>(F, un & 31, 15 - (un >> 5), qkv + 3 * sz, qkv + 4 * sz, qkv + 5 * sz, nullptr, ycat + 768, 0.f); }
}
__device__ __forceinline__ void phase_attn_fox(Frame& F, int layer, int rep) {
    const bf16* qkv = (const bf16*)(F.ws + WS_QKV); const size_t sz = (size_t)T * 256; const float* cum = (const float*)(F.ws + WS_CUM); bf16* ycat = (bf16*)(F.ws + WS_YCAT);
    unsigned* ctr = (unsigned*)(F.ws + WS_CTL) + CW_Q + 128 * layer + 64 + 16 * rep;
    const float gq = fabsf(F.a->in[I_FQG][layer * 64 + F.lane]), gk = fabsf(F.a->in[I_FKG][layer * 64 + F.lane]);
    float mq = gq, mk = gk;
#pragma unroll
    for (int o = 1; o < 64; o <<= 1) { mq = fmaxf(mq, __shfl_xor(mq, o)); mk = fmaxf(mk, __shfl_xor(mk, o)); }
    const float z2max = 8.0f * mq * mk * LOG2E * 1.02f + 0.25f;
    const int nchunk = (conv_ffn_items(layer) + CONV_CHUNK - 1) / CONV_CHUNK;
    const int total = 512 + nchunk;
    for (;;) { const int t = q_pop(F, ctr); if (t >= total) break;
        const int na0 = (int)(((long)t * 512) / total), na1 = (int)(((long)(t + 1) * 512) / total);
        if (na1 > na0) attn_unit<0>(F, na0 & 31, 15 - (na0 >> 5), qkv, qkv + sz, qkv + 2 * sz, cum, ycat + 256, z2max);
        else convert_ffn_chunk(F, layer, t - na0); }
}
__device__ __forceinline__ void phase_s5_scan_unit(Frame& F, int layer, int g, int pm) {
    __builtin_amdgcn_fence(__ATOMIC_ACQUIRE, "agent");
    if (F.tid < 256) {
        const int b = 4 * pm + (F.tid >> 6), p = F.tid & 63;
        const S5P q = s5_params(*F.a, layer, g, p); float ar, ai; s5_pow(q, 64.0f, ar, ai);
        const float* z = (const float*)(F.ws + WS_Z); bf16* ua = (bf16*)(F.ws + WS_UA);
        float sr = 0.f, si = 0.f;
        for (int n0 = 0; n0 < 64; n0 += 16) {
            f32x2 zz[16];
#pragma unroll
            for (int j = 0; j < 16; ++j) zz[j] = *(const f32x2*)(z + ((size_t)g * 512 + b * 64 + n0 + j) * 128 + 2 * p);
#pragma unroll
            for (int j = 0; j < 16; ++j) { const size_t ch = (size_t)g * 512 + b * 64 + n0 + j;
                *(unsigned*)(ua + ch * S5_LDA + 1024 + 2 * p) = pk2(sr, si);
                const float nr = ar * sr - ai * si + zz[j][0], ni = ar * si + ai * sr + zz[j][1]; sr = nr; si = ni; }
        }
    }
    __syncthreads();
}
__device__ __forceinline__ void phase_rows_ffn(Frame& F, int layer) {
    const Args& A = *F.a; const int lane = F.lane; const int j2 = layer >> 1;
    f32x4 gv[4];
#pragma unroll
    for (int j = 0; j < 4; ++j) gv[j] = *(const f32x4*)(A.in[I_GFFN] + layer * D + 4 * lane + 256 * j);
    const bf16* xb = (const bf16*)(F.ws + WS_XB); unsigned char* seg = F.ws + WS_XNP; unsigned* route = (unsigned*)(F.ws + WS_ROUTE); unsigned* cnt = (unsigned*)(F.ws + WS_CTL) + CW_MOE + 64 * j2;
    unsigned my_e0 = 0, my_e1 = 0, my_r0 = 0, my_r1 = 0; float my_w0 = 0.f, my_w1 = 0.f, my_rs = 0.f; unsigned long long lc = 0ull; int nrow = 0;
    for (int row = F.gw; row < T; row += F.NGW, ++nrow) {
        f32x4 v[4]; float ss = 0.f;
#pragma unroll
        for (int j = 0; j < 4; ++j) { const v2u r = *(const v2u*)(xb + (size_t)row * D + 4 * lane + 256 * j); v[j] = (f32x4){bflo(r.x), bfhi(r.x), bflo(r.y), bfhi(r.y)};
            ss += (v[j][0] * v[j][0] + v[j][1] * v[j][1]) + (v[j][2] * v[j][2] + v[j][3] * v[j][3]); }
        const float rs = 1.0f / sqrtf(wave_sum(ss) * (1.0f / D) + EPS);
        float lg[8];
#pragma unroll
        for (int e = 0; e < 8; ++e) lg[e] = 0.f;
#pragma unroll
        for (int j = 0; j < 4; ++j) { const f32x4 h = v[j] * rs * gv[j];
#pragma unroll
            for (int e4 = 0; e4 < 4; ++e4) { const float* wr = A.in[I_RW] + ((size_t)j2 * D + 4 * lane + 256 * j + e4) * NE; const f32x4 a = *(const f32x4*)wr, b = *(const f32x4*)(wr + 4);
                lg[0] += h[e4] * a[0]; lg[1] += h[e4] * a[1]; lg[2] += h[e4] * a[2]; lg[3] += h[e4] * a[3]; lg[4] += h[e4] * b[0]; lg[5] += h[e4] * b[1]; lg[6] += h[e4] * b[2]; lg[7] += h[e4] * b[3]; } }
#pragma unroll
        for (int e = 0; e < 8; ++e) lg[e] = wave_sum(lg[e]) + A.in[I_RB][j2 * NE + e];
        int e0 = 0; float v0 = lg[0];
#pragma unroll
        for (int e = 1; e < 8; ++e) if (lg[e] > v0) { v0 = lg[e]; e0 = e; }
        int e1 = -1; float v1 = -INFINITY;
#pragma unroll
        for (int e = 0; e < 8; ++e) if (e != e0 && lg[e] > v1) { v1 = lg[e]; e1 = e; }
        const float w1 = 1.0f / (1.0f + expf(v0 - v1)), w0 = 1.0f - w1;
        const unsigned r0 = (unsigned)(lc >> (8 * e0)) & 0xffu; lc += 1ull << (8 * e0);
        const unsigned r1 = (unsigned)(lc >> (8 * e1)) & 0xffu; lc += 1ull << (8 * e1);
        if (lane == nrow) { my_e0 = e0; my_e1 = e1; my_r0 = r0; my_r1 = r1; my_w0 = w0; my_w1 = w1; my_rs = rs; }
    }
    unsigned basev = 0;
    if (lane < 8) { const unsigned c = (unsigned)(lc >> (8 * lane)) & 0xffu; basev = c ? __hip_atomic_fetch_add(cnt + lane, c, __ATOMIC_RELAXED, __HIP_MEMORY_SCOPE_AGENT) : 0u; }
    const unsigned my_p0 = __shfl(basev, (int)my_e0) + my_r0, my_p1 = __shfl(basev, (int)my_e1) + my_r1;
    if (lane < nrow) { const int row = F.gw + lane * F.NGW; unsigned* rt = route + (size_t)row * 8;
        *(v4u*)rt = (v4u){my_e0, my_e1, my_p0, my_p1}; *(v4u*)(rt + 4) = (v4u){__builtin_bit_cast(unsigned, my_w0), __builtin_bit_cast(unsigned, my_w1), 0u, 0u}; }
    for (int i = 0; i < nrow; ++i) {
        const int row = F.gw + i * F.NGW; const float rs = __shfl(my_rs, i);
        const size_t d0 = ((size_t)__shfl((int)my_e0, i) * T + (size_t)__shfl((int)my_p0, i)) * D, d1 = ((size_t)__shfl((int)my_e1, i) * T + (size_t)__shfl((int)my_p1, i)) * D;
#pragma unroll
        for (int j = 0; j < 4; ++j) { const v2u r = *(const v2u*)(xb + (size_t)row * D + 4 * lane + 256 * j);
            const f32x4 h = (f32x4){bflo(r.x), bfhi(r.x), bflo(r.y), bfhi(r.y)} * rs * gv[j]; const unsigned w = pk4_fp8(h[0], h[1], h[2], h[3]);
            *(unsigned*)(seg + d0 + 4 * lane + 256 * j) = w; *(unsigned*)(seg + d1 + 4 * lane + 256 * j) = w; }
    }
}
__device__ __forceinline__ void phase_final_combine(Frame& F) {
    const Args& A = *F.a; int st[NE + 1]; moe_starts(F, (DEPTH - 1) >> 1, st);
    for (int row = F.gw; row < T; row += F.NGW) {
        f32x4 v[4];
#pragma unroll
        for (int j = 0; j < 4; ++j) { const v2u r = *(const v2u*)((const bf16*)(F.ws + WS_XB) + (size_t)row * D + 4 * F.lane + 256 * j); v[j] = (f32x4){bflo(r.x), bfhi(r.x), bflo(r.y), bfhi(r.y)}; }
        moe_combine_row(F, row, v, st);
#pragma unroll
        for (int j = 0; j < 4; ++j) *(f32x4*)(A.out + (size_t)row * D + 4 * F.lane + 256 * j) = v[j];
    }
}

__global__ void __launch_bounds__(NWAVES * 64, 2) mk_fwd(Args args) {
    extern __shared__ __attribute__((aligned(16))) unsigned char lds_raw[];
    Frame F; F.lds = (LAS unsigned char*)lds_raw; F.tid = threadIdx.x; F.lane = F.tid & 63; F.wave = __builtin_amdgcn_readfirstlane(F.tid >> 6);
    F.G = gridDim.x; { const int bx = blockIdx.x; F.vcu = (F.G % 8 == 0) ? (bx % 8) * (F.G / 8) + bx / 8 : bx; }
    F.gw = F.vcu * NWAVES + F.wave; F.NGW = F.G * NWAVES; F.a = &args; F.ws = args.ws;
    volatile LAS unsigned* MISC = (volatile LAS unsigned*)(F.lds + MISC_OFF);
    for (int u = F.tid; u < (LDS_BYTES - RING_BYTES) / 4; u += NWAVES * 64) ((LAS unsigned*)(F.lds + RING_BYTES))[u] = 0u;
    __syncthreads();
    unsigned* ctl = (unsigned*)(args.ws + WS_CTL);
    const bool multi = (args.gp_hi - args.gp_lo) > 1;
    XcdBarrier bar; bar.bar = ctl + CW_BAR; bar.x = 0; bar.st = nullptr;
    if (multi) bar = xcd_barrier_post(ctl + CW_BAR, MISC + 8);
    unsigned char* ws = args.ws;
    LAS unsigned char* ring = F.lds;

    const int gp_lo = args.gp_lo, gp_hi = args.gp_hi;
#define IN(p) (gp_lo <= layer * NPH + (p) && layer * NPH + (p) < gp_hi)
#define SEAM(p) do { if (IN(p) && layer * NPH + (p) + 1 < gp_hi) xcd_barrier(bar); } while (0)
#ifndef PH_MASK
#define PH_MASK 0xffff
#endif
#define ON(p) (((PH_MASK) >> (p)) & 1)
#ifndef PROBE_PH
#define PROBE_PH -1
#endif
#ifndef PROBE_N
#define PROBE_N 1
#endif
#ifndef PROBE_LAYERS
#define PROBE_LAYERS 15
#endif
#define REPS(p) ((((p) == PROBE_PH) && ((PROBE_LAYERS >> layer) & 1)) ? 1 + PROBE_N : 1)
#define SUBREPS(p) for (int r2_ = 0; r2_ < REPS(p); ++r2_)
#define ENTER() do { LAYER_REFRESH(); ws = args.ws; asm volatile("" : "+s"(ws)); F.ws = ws; int t_ = threadIdx.x; asm volatile("" : "+v"(t_)); F.tid = t_; F.lane = t_ & 63; F.wave = __builtin_amdgcn_readfirstlane(t_ >> 6); F.gw = F.vcu * NWAVES + F.wave; } while (0)
#define LAYER_REFRESH() do { int l_ = layer_iv; asm volatile("" : "+v"(l_)); layer = __builtin_amdgcn_readfirstlane(l_); } while (0)
    for (int layer_iv = gp_lo / NPH; layer_iv < DEPTH && layer_iv * NPH < gp_hi; ++layer_iv) {
        int layer; LAYER_REFRESH();
        const bool moe = (layer & 1) != 0;
#if ON(0)
        if (IN(0)) for (int rep_ = 0; rep_ < REPS(0); ++rep_) { ENTER(); for (int r2_ = 0; r2_ < ((PROBE_PH == 100) ? 1 + PROBE_N : 1); ++r2_) { phase_convert(F, layer); phase_kfun(F, layer); } phase_rows_mixer(F, layer); }
        SEAM(0);
#endif
#if ON(1)
        if (IN(1)) for (int rep_ = 0; rep_ < REPS(1); ++rep_) { ENTER();
            phase_s5_tables(F, layer); phase_cumsum(F);
#if F8_GATES
            { pg8::Gemm g8{(const bf16*)(ws + WS_XN8), (const bf16*)(ws + WS_WIN8), D / 2, D / 2, D / 2}; pg8::StaticOrder S8; S8.init(T, 4096, F.G, (int)blockIdx.x, D / 2, D / 2);
              if (F.G == 256) S8.full = 7;
              pg8::EpiGateSig E8; E8.gate = (bf16*)(ws + WS_GATE);
              pg8::gemm_phase<pg8::EpiGateSig, pg8::StaticOrder, true, true>(ring, g8, S8, E8); }
#endif
            pg8::Gemm g{(const bf16*)(ws + WS_XN), (const bf16*)(ws + WS_WIN), D, D, D}; pg8::StaticOrder S; S.init(T, F8_GATES ? 2304 : NPROJ, F.G, (int)blockIdx.x, D, D);
            pg8::EpiInProj E; E.ua = (bf16*)(ws + WS_UA); E.qkv = (bf16*)(ws + WS_QKV); E.uc = (bf16*)(ws + WS_UC); E.gate = (bf16*)(ws + WS_GATE);
            { LAS float* gl = (LAS float*)(F.lds + GAIN_OFF);
              if (F.tid < 256) { const int w = F.tid >> 6, d = F.tid & 63; const float* src = (w == 0) ? args.in[I_FQG] : (w == 1) ? args.in[I_FKG] : (w == 2) ? args.in[I_SQG] : args.in[I_SKG];
                  gl[F.tid] = src[layer * 64 + d] * ((w == 0 || w == 2) ? QSCALE : 1.0f); }
              __syncthreads(); E.gl = gl; }
            pg8::gemm_phase<pg8::EpiInProj, pg8::StaticOrder, true>(ring, g, S, E);
        }
        SEAM(1);
#endif
#if ON(2)
        if (IN(2)) for (int rep_ = 0; rep_ < REPS(2); ++rep_) { ENTER();
            { pg8::Gemm g{(const bf16*)(ws + WS_UA), (const bf16*)(ws + WS_WZ), 1024, S5_LDA, 1024};
              pg8::BatchOrder S; S.nM = 2; S.nN = 1; S.nZ = 16; S.G = F.G; S.c = (int)blockIdx.x; S.tA = (size_t)256 * S5_LDA * 2; S.tB = 0; S.zA = (size_t)512 * S5_LDA * 2; S.zB = (size_t)256 * 1024 * 2;
              pg8::EpiZ E; E.z = (float*)(ws + WS_Z);
              SUBREPS(106) { pg8::gemm_phase<pg8::EpiZ, pg8::BatchOrder, false>(ring, g, S, E);
              if ((int)blockIdx.x < 32) phase_s5_scan_unit(F, layer, (int)blockIdx.x >> 1, (int)blockIdx.x & 1); } }
            SUBREPS(103) phase_conv(F, layer);
            SUBREPS(102) phase_attn_sb(F, layer, rep_ + r2_);
        }
        SEAM(2);
#endif
#if ON(4)
        if (IN(4)) for (int rep_ = 0; rep_ < REPS(4); ++rep_) { ENTER();
            { pg8::Gemm g{(const bf16*)(ws + WS_UA), (const bf16*)(ws + WS_WY), S5_LDA, S5_LDA, S5_LDA};
              pg8::BatchOrder S; S.nM = 2; S.nN = 4; S.nZ = 16; S.G = F.G; S.c = (int)blockIdx.x; S.tA = (size_t)256 * S5_LDA * 2; S.tB = (size_t)256 * S5_LDA * 2; S.zA = (size_t)512 * S5_LDA * 2; S.zB = (size_t)1024 * S5_LDA * 2;
              pg8::EpiY E; E.ua = (const bf16*)(ws + WS_UA); E.dskip = args.in[I_S5D] + layer * 256; E.yp = (bf16*)(ws + WS_YP);
              SUBREPS(105) pg8::gemm_phase<pg8::EpiY, pg8::BatchOrder, false>(ring, g, S, E); }
            SUBREPS(104) phase_attn_fox(F, layer, rep_ + r2_);
        }
        SEAM(4);
#endif
#if ON(5)
        if (IN(5) && F.G != 256) for (int rep_ = 0; rep_ < REPS(5); ++rep_) { ENTER();
            pg8::Gemm g{(const bf16*)(ws + WS_YP), (const bf16*)(ws + WS_WGLU), 256, 256, 256};
            pg8::BatchOrder S; S.nM = T / 256; S.nN = 1; S.nZ = 1; S.G = F.G; S.c = (int)blockIdx.x; S.tA = (size_t)256 * 256 * 2; S.tB = 0; S.zA = 0; S.zB = 0;
            pg8::EpiGlu E; E.yp = (const bf16*)(ws + WS_YP); E.ycat = (bf16*)(ws + WS_YCAT);
            pg8::gemm_phase<pg8::EpiGlu, pg8::BatchOrder, false>(ring, g, S, E);
        }
        if (F.G != 256) SEAM(5);
#endif
#if ON(6)
        if (IN(6)) for (int rep_ = 0; rep_ < REPS(6); ++rep_) { ENTER();
            const int paired = (F.G == 256) ? 1 : 0;
            if (paired) {
                pg8::Gemm g{(const bf16*)(ws + WS_YP), (const bf16*)(ws + WS_WGLU), 256, 256, 256};
                pg8::OneUnit S; S.pm = F.vcu >> 1; S.tA = (size_t)256 * 256 * 2;
                pg8::EpiGlu E; E.yp = (const bf16*)(ws + WS_YP); E.ycat = (bf16*)(ws + WS_YCAT);
                pg8::gemm_phase<pg8::EpiGlu, pg8::OneUnit, false>(ring, g, S, E);
            }
            pg8::Gemm g{(const bf16*)(ws + WS_YCAT), (const bf16*)(ws + WS_WBR), 256, 1024, 256};
            pg8::BranchOrder1 S; S.nM = T / 256; S.nN = 8; S.G = F.G; S.c = (int)blockIdx.x; S.tA = (size_t)256 * 1024 * 2; S.tB = (size_t)128 * 256 * 2; S.zA = 256 * 2; S.zB = (size_t)1024 * 256 * 2; S.paired = paired; S.vc = F.vcu;
            pg8::EpiGate1 E; E.gate = (const bf16*)(ws + WS_GATE); E.mb = (bf16*)(ws + WS_XN);
            pg8::gemm_phase_n1<pg8::EpiGate1, pg8::BranchOrder1>(ring, g, S, E);
        }
        SEAM(6);
#endif
#if ON(7)
        if (IN(7)) for (int rep_ = 0; rep_ < REPS(7); ++rep_) { ENTER();
            pg8::Gemm g{(const bf16*)(ws + WS_XN), (const bf16*)(ws + WS_WOUT), D, D, D}; pg8::StaticOrder S; S.init(T, D, F.G, (int)blockIdx.x, D, D);
            pg8::EpiResid<false> E; E.base32 = args.in[I_X]; E.base16 = (const bf16*)(ws + WS_XB); E.out = (bf16*)(ws + WS_XB); E.ss = (float*)(ws + WS_SSP); E.out8 = ws + WS_XN8;
            E.flags = ((layer == 0) ? 1 : 0) | ((FUSE_DENSE_NORM && !moe) ? 2 : 0) | ((FUSE_DENSE_NORM && !moe && DENSE8(layer)) ? 4 : 0);
            pg8::gemm_phase<pg8::EpiResid<false>, pg8::StaticOrder, true>(ring, g, S, E);
        }
        SEAM(7);
#endif
#if ON(8)
        if (IN(8)) for (int rep_ = 0; rep_ < REPS(8); ++rep_) { ENTER(); if (moe || !FUSE_DENSE_NORM) phase_rows_ffn(F, layer); }
        if (moe || !FUSE_DENSE_NORM) SEAM(8);
#endif
#if ON(10)
        if (IN(10)) for (int rep_ = 0; rep_ < REPS(10); ++rep_) { ENTER();
            if (!moe) {
                if (DENSE8(layer)) {
                    constexpr int DQ = D / 2;
                    pg8::Gemm g{(const bf16*)(ws + (FUSE_DENSE_NORM ? WS_XN8 : WS_XN)), (const bf16*)(ws + WS_WUP), DQ, DQ, DQ}; pg8::StaticOrder S; S.init(T, 2 * FF, F.G, (int)blockIdx.x, DQ, DQ);
                    pg8::EpiSwiGlu<true> E; E.h = (bf16*)(ws + WS_HH); E.sc = 1.0f / 64.0f; E.ss = (const float*)(ws + WS_SSP); E.use_ss = FUSE_DENSE_NORM;
                    pg8::gemm_phase<pg8::EpiSwiGlu<true>, pg8::StaticOrder, true, true>(ring, g, S, E);
                } else {
                    pg8::Gemm g{(const bf16*)(ws + (FUSE_DENSE_NORM ? WS_XB : WS_XN)), (const bf16*)(ws + WS_WUP), D, D, D}; pg8::StaticOrder S; S.init(T, 2 * FF, F.G, (int)blockIdx.x, D, D);
                    pg8::EpiSwiGlu<false> E; E.h = (bf16*)(ws + WS_HH); E.sc = 1.0f; E.ss = (const float*)(ws + WS_SSP); E.use_ss = FUSE_DENSE_NORM;
                    pg8::gemm_phase<pg8::EpiSwiGlu<false>, pg8::StaticOrder, true, false>(ring, g, S, E);
                }
            } else {
                constexpr bool U8 = F8_MOE_UP != 0, H8 = F8_MOE_DN != 0; constexpr int DQ = U8 ? D / 2 : D;
                pg8::Gemm g{(const bf16*)(ws + WS_XNP), (const bf16*)(ws + WS_WUP), DQ, DQ, DQ};
                pg8::GroupOrder S; S.nN = 22; S.G = F.G; S.c = (int)blockIdx.x; S.tA = (size_t)256 * DQ * 2; S.tB = (size_t)256 * DQ * 2; S.zB = (size_t)5632 * DQ * 2; S.zA = (size_t)T * DQ * 2;
                int st[NE + 1]; moe_starts(F, layer >> 1, st);
#pragma unroll
                for (int e = 0; e <= NE; ++e) S.ts[e] = __builtin_amdgcn_readfirstlane(st[e] >> 8);
                pg8::EpiSwiGlu<H8> E; E.h = (bf16*)(ws + WS_HP); E.sc = U8 ? (1.0f / 64.0f) : 1.0f; E.ss = (const float*)(ws + WS_SSP); E.use_ss = 0;
                pg8::gemm_phase<pg8::EpiSwiGlu<H8>, pg8::GroupOrder, true, U8>(ring, g, S, E);
            }
        }
        SEAM(10);
#endif
#if ON(11)
        if (IN(11)) for (int rep_ = 0; rep_ < REPS(11); ++rep_) { ENTER();
            if (!moe) {
                if (DENSE8(layer)) {
                    constexpr int FQ = FF / 2;
                    pg8::Gemm g{(const bf16*)(ws + WS_HH), (const bf16*)(ws + WS_WDN), FQ, FQ, FQ}; pg8::StaticOrder S; S.init(T, D, F.G, (int)blockIdx.x, FQ, FQ);
                    pg8::EpiResid<true> E; E.base32 = args.in[I_X]; E.base16 = (const bf16*)(ws + WS_XB); E.out = (bf16*)(ws + WS_XB); E.ss = (float*)(ws + WS_SSP); E.out8 = ws + WS_XN8; E.flags = 0;
                    pg8::gemm_phase<pg8::EpiResid<true>, pg8::StaticOrder, true, true>(ring, g, S, E);
                } else {
                    pg8::Gemm g{(const bf16*)(ws + WS_HH), (const bf16*)(ws + WS_WDN), FF, FF, FF}; pg8::StaticOrder S; S.init(T, D, F.G, (int)blockIdx.x, FF, FF);
                    pg8::EpiResid<false> E; E.base32 = args.in[I_X]; E.base16 = (const bf16*)(ws + WS_XB); E.out = (bf16*)(ws + WS_XB); E.ss = (float*)(ws + WS_SSP); E.out8 = ws + WS_XN8; E.flags = 0;
                    pg8::gemm_phase<pg8::EpiResid<false>, pg8::StaticOrder, true, false>(ring, g, S, E);
                }
            } else {
                constexpr bool F8 = F8_MOE_DN != 0; constexpr int FQ = F8 ? FF / 2 : FF;
                pg8::Gemm g{(const bf16*)(ws + WS_HP), (const bf16*)(ws + WS_WDN), FQ, FQ, FQ};
                pg8::GroupOrder S; S.nN = 4; S.G = F.G; S.c = (int)blockIdx.x; S.tA = (size_t)256 * FQ * 2; S.tB = (size_t)256 * FQ * 2; S.zB = (size_t)D * FQ * 2; S.zA = 0;
                int st[NE + 1]; moe_starts(F, layer >> 1, st);
#pragma unroll
                for (int e = 0; e <= NE; ++e) S.ts[e] = __builtin_amdgcn_readfirstlane(st[e] >> 8);
                pg8::EpiStore E; E.o = (bf16*)(ws + WS_XNP); E.sc = F8 ? (1.0f / 64.0f) : 1.0f;
                pg8::gemm_phase<pg8::EpiStore, pg8::GroupOrder, true, F8>(ring, g, S, E);
            }
        }
        SEAM(11);
#endif
    }
#if ON(12)
    if (gp_lo <= GP_FINAL && GP_FINAL < gp_hi) phase_final_combine(F);
#endif
}

extern "C" void kernel_launch(void* const* d_in, const int* in_sizes, int n_in, void* d_out, int out_size, void* d_ws, size_t ws_size, hipStream_t stream) {
    static int grid = 0;
    if (grid == 0) {
        if (n_in != 32 || in_sizes[0] != T * D || out_size != T * D || ws_size < WS_END) { fprintf(stderr, "kernel_launch: unexpected shapes / workspace (n_in %d, ws %zu < %zu)\n", n_in, ws_size, (size_t)WS_END); grid = -1; return; }
        int dev = 0, cus = 0, per_cu = 0;
        if (hipGetDevice(&dev) != hipSuccess || hipDeviceGetAttribute(&cus, hipDeviceAttributeMultiprocessorCount, dev) != hipSuccess) { grid = -1; return; }
        if (hipFuncSetAttribute((const void*)mk_fwd, hipFuncAttributeMaxDynamicSharedMemorySize, LDS_BYTES) != hipSuccess) { grid = -1; return; }
        if (hipOccupancyMaxActiveBlocksPerMultiprocessor(&per_cu, (const void*)mk_fwd, NWAVES * 64, LDS_BYTES) != hipSuccess || per_cu < 1) fprintf(stderr, "kernel_launch: occupancy query says %d\n", per_cu);
        (void)hipGetLastError();
        grid = cus;
    }
    if (grid < 0) return;
    if (hipMemsetAsync((char*)d_ws + WS_CTL, 0, CTL_ZERO_BYTES, stream) != hipSuccess) return;
    Args a{};
    for (int i = 0; i < 32; ++i) a.in[i] = (const float*)d_in[i];
    a.out = (float*)d_out; a.ws = (unsigned char*)d_ws;
    a.gp_lo = 0; a.gp_hi = GP_TOTAL;
    hipLaunchKernelGGL(mk_fwd, dim3(grid), dim3(NWAVES * 64), LDS_BYTES, stream, a);
}
```

```cpp
#include <hip/hip_runtime.h>
#include <cstdio>
#include <cstdint>

#ifndef F8_DENSE_MASK
#define F8_DENSE_MASK 4
#endif
#define DENSE8(layer) (((F8_DENSE_MASK) >> (layer)) & 1)
#ifndef F8_MOE_UP
#define F8_MOE_UP 1
#endif
#ifndef FUSE_DENSE_NORM
#define FUSE_DENSE_NORM 1
#endif
#ifndef GATE8
#define GATE8 2
#endif
#ifndef BR_WG
#define BR_WG 4
#endif
#ifndef F8_GATES
#define F8_GATES 1
#endif
#ifndef F8_MOE_DN
#define F8_MOE_DN 1
#endif

#define GAS __attribute__((address_space(1)))
#define LAS __attribute__((address_space(3)))
typedef unsigned short bf16;
typedef unsigned v4u __attribute__((ext_vector_type(4)));
typedef unsigned v2u __attribute__((ext_vector_type(2)));
typedef float f32x4 __attribute__((ext_vector_type(4)));
typedef float f32x2 __attribute__((ext_vector_type(2)));
typedef short bf16x8 __attribute__((ext_vector_type(8)));

constexpr int NB = 8, SEQ = 4096, D = 1024, DEPTH = 4, T = NB * SEQ;
constexpr int DP = 6404, NPROJ = 6400, FF = 2816, NE = 8;
constexpr float EPS = 1e-6f, LOG2E = 1.4426950408889634f;
constexpr float QSCALE = 0.125f * LOG2E;
constexpr int MOE_ROWS = 2 * T + NE * 256;
constexpr int S5_LDA = 1152;

constexpr size_t MiB = 1u << 20;
constexpr size_t WS_CTL = 0, CTL_ZERO_BYTES = 1 * MiB;
constexpr size_t WS_WIN = 1 * MiB;
constexpr size_t WS_WIN8 = WS_WIN + (size_t)2304 * D * 2;
constexpr size_t WS_WBR = WS_WIN + (size_t)NPROJ * D * 2;
constexpr size_t WS_WOUT = WS_WBR + 2 * MiB;
constexpr size_t WS_WGLU = WS_WOUT + 2 * MiB;
constexpr size_t WS_WZ = WS_WGLU + 128 * 1024;
constexpr size_t WS_WY = WS_WZ + 8 * MiB;
constexpr size_t WS_WUP = WS_WY + 36 * MiB;
constexpr size_t WS_WDN = WS_WUP + 88 * MiB;
constexpr size_t WS_KFUN = WS_WDN + 44 * MiB;
constexpr size_t WS_ROUTE = WS_KFUN + 1 * MiB;
constexpr size_t WS_LF = WS_ROUTE + 1 * MiB;
constexpr size_t WS_CUM = WS_LF + 512 * 1024;
constexpr size_t WS_XN = 198 * MiB;
static_assert(WS_CUM + 512 * 1024 <= WS_XN, "ws map");
constexpr size_t WS_R = WS_XN + 64 * MiB;
constexpr size_t WS_GATE = WS_R;
constexpr size_t WS_QKV = WS_GATE + 256 * MiB;
constexpr size_t WS_UC = WS_QKV + 96 * MiB;
constexpr size_t WS_UA = WS_UC + 16 * MiB;
constexpr size_t WS_Z = WS_UA + 18 * MiB;
constexpr size_t WS_YP = WS_Z + 4 * MiB;
constexpr size_t WS_YCAT = WS_YP + 16 * MiB;
constexpr size_t WS_MIX_END = WS_YCAT + 64 * MiB;
constexpr size_t WS_XN8 = WS_YCAT;
constexpr size_t WS_HH = WS_R;
constexpr size_t WS_XNP = WS_R;
constexpr size_t WS_HP = WS_XNP + (size_t)NE * T * D;
constexpr size_t WS_FFN_END = WS_HP + (size_t)MOE_ROWS * FF;
static_assert(F8_MOE_UP && F8_MOE_DN, "the MoE path stores its rows and hidden activations as e4m3 bytes");
constexpr size_t WS_XB = ((WS_MIX_END > WS_FFN_END ? WS_MIX_END : WS_FFN_END) + MiB - 1) / MiB * MiB;
constexpr size_t WS_SSP = WS_XB + 64 * MiB;
constexpr size_t WS_END = WS_SSP + 2 * MiB;
static_assert(WS_END <= 856 * MiB, "ws budget");
constexpr int CW_BAR = 4096;
constexpr int CW_Q = 20480;
constexpr int CW_MOE = 16384;

constexpr int RING_BYTES = 131072, MISC_OFF = RING_BYTES + 320, GAIN_OFF = RING_BYTES + 1024, QSLOT_OFF = RING_BYTES + 64, LDS_BYTES = 147456;
constexpr int NWAVES = 8;

__device__ __forceinline__ unsigned f2bf(float f) { unsigned u = __builtin_bit_cast(unsigned, f); return (u + 0x7fffu + ((u >> 16) & 1u)) >> 16; }
__device__ __forceinline__ unsigned pk2(float lo, float hi) { return f2bf(lo) | (f2bf(hi) << 16); }
__device__ __forceinline__ float bflo(unsigned u) { return __builtin_bit_cast(float, u << 16); }
__device__ __forceinline__ float bfhi(unsigned u) { return __builtin_bit_cast(float, u & 0xffff0000u); }
__device__ __forceinline__ float bf2f(bf16 v) { return __builtin_bit_cast(float, (unsigned)v << 16); }
__device__ __forceinline__ float wave_sum(float v) {
#pragma unroll
    for (int o = 1; o < 64; o <<= 1) v += __shfl_xor(v, o);
    return v;
}
__device__ __forceinline__ float fast_exp2(float x) { return __builtin_amdgcn_exp2f(x); }
__device__ __forceinline__ float fast_rcp(float x) { return __builtin_amdgcn_rcpf(x); }
__device__ __forceinline__ float sigmoidf_(float x) { return fast_rcp(1.0f + fast_exp2(-x * LOG2E)); }
__device__ __forceinline__ f32x2 sigmoid2(f32x2 x) { const f32x2 a = x * (-LOG2E); f32x2 t = {fast_exp2(a[0]), fast_exp2(a[1])}; t = t + 1.0f; return (f32x2){fast_rcp(t[0]), fast_rcp(t[1])}; }
__device__ __forceinline__ float gelu_tanh(float y) { const float u = 0.7978845608028654f * (y + 0.044715f * y * y * y); return y * sigmoidf_(2.0f * u); }
__device__ __forceinline__ unsigned pk4_fp8(float a, float b, float c, float d) { unsigned w = 0u; w = (unsigned)__builtin_amdgcn_cvt_pk_fp8_f32(a, b, (int)w, false); w = (unsigned)__builtin_amdgcn_cvt_pk_fp8_f32(c, d, (int)w, true); return w; }
#define LDS_WAIT() asm volatile("s_waitcnt lgkmcnt(0)" ::: "memory")
#define VM_WAIT() asm volatile("s_waitcnt vmcnt(0)" ::: "memory")

namespace pg8 {
#define PG8_LAS __attribute__((address_space(3)))
typedef unsigned short bf16_t;
typedef unsigned u32x4 __attribute__((ext_vector_type(4)));
typedef int v4i __attribute__((ext_vector_type(4)));
typedef int v8i __attribute__((ext_vector_type(8)));
constexpr int BM = 256, BK = 64, HALF = 128, HTB = HALF * BK * 2, STAGE_BYTES = 8 * HTB, NXCD = 8, WGM = 8;
__host__ __device__ __forceinline__ int lds_byte(int r, int c) { const int st = (r >> 4) * 2 + (c >> 5), rr = r & 15, cc = c & 31, ob = rr * 64 + cc * 2; return st * 1024 + (ob ^ (((ob >> 9) & 1) << 5)); }
__host__ __device__ __forceinline__ void stage_rc(int b, int& R, int& C) { const int st = b / 1024, sb = b % 1024, swz = sb ^ (((sb >> 9) & 1) << 5); R = (st >> 1) * 16 + swz / 64; C = (st & 1) * 32 + (swz % 64) / 2; }
__host__ __device__ __forceinline__ int perm32(int rho) { const int n = rho >> 4, i = rho & 15; return 8 * (i >> 2) + 4 * n + (i & 3); }

struct Unit { int pm, pn, z; size_t offA, offB; };
struct Gemm { const bf16_t* A; const bf16_t* Bt; int K, lda, ldb; };

template <int WG = WGM> __device__ __forceinline__ void xcd_tile_map(int L, int nM, int nN, int& pm, int& pn) {
    const int nwg = nM * nN; int wgid = L; { const int q = nwg / NXCD, r = nwg % NXCD, xcd = wgid % NXCD, off = wgid / NXCD; wgid = (xcd < r ? xcd * (q + 1) : r * (q + 1) + (xcd - r) * q) + off; }
    const int nig = WG * nN, gid = wgid / nig, fm = gid * WG, gsz = (nM - fm) < WG ? (nM - fm) : WG;
    pm = fm + ((wgid % nig) % gsz); pn = (wgid % nig) / gsz;
}
struct StaticOrder {
    int nM, nN, nwg, G, c, full; size_t tA, tB;
    __device__ void init(int M, int N, int G_, int c_, int lda, int ldb) { nM = M / BM; nN = N / BM; nwg = nM * nN; G = G_; c = c_; full = 1 << 20; tA = (size_t)BM * lda * 2; tB = (size_t)BM * ldb * 2; }
    __device__ bool next(int i, Unit& u) const {
        long L = (long)i * G + c;
        if (i >= full) { const int h = G >> 1; if (c < h) return false; L = (long)full * G + (long)(i - full) * h + (c - h); }
        if (L >= nwg) return false;
        int wgid = (int)L; { const int q = nwg / NXCD, r = nwg % NXCD, xcd = wgid % NXCD, off = wgid / NXCD; wgid = (xcd < r ? xcd * (q + 1) : r * (q + 1) + (xcd - r) * q) + off; }
        const int nig = WGM * nN, gid = wgid / nig, fm = gid * WGM, gsz = (nM - fm) < WGM ? (nM - fm) : WGM;
        u.pm = fm + ((wgid % nig) % gsz); u.pn = (wgid % nig) / gsz; u.z = 0; u.offA = (size_t)u.pm * tA; u.offB = (size_t)u.pn * tB; return true;
    }
};
struct BatchOrder {
    int nM, nN, nZ, G, c; size_t tA, tB, zA, zB;
    __device__ bool next(int i, Unit& u) const {
        const int L = i * G + c; if (L >= nM * nN * nZ) return false;
        u.z = L / (nM * nN); const int r = L % (nM * nN); u.pm = r / nN; u.pn = r % nN;
        u.offA = (size_t)u.z * zA + (size_t)u.pm * tA; u.offB = (size_t)u.z * zB + (size_t)u.pn * tB; return true;
    }
};
struct GroupOrder {
    int nN, G, c; int ts[NE + 1]; size_t tA, tB, zB, zA;
    __device__ bool next(int i, Unit& u) const {
        const int L = i * G + c; if (L >= ts[NE] * nN) return false;
        xcd_tile_map(L, ts[NE], nN, u.pm, u.pn); int e = 0, tse = 0;
#pragma unroll
        for (int k = 1; k < NE; ++k) if (u.pm >= ts[k]) { e = k; tse = ts[k]; }
        u.z = e; u.offA = zA ? (size_t)e * zA + (size_t)(u.pm - tse) * tA : (size_t)u.pm * tA; u.offB = (size_t)e * zB + (size_t)u.pn * tB; return true;
    }
};

typedef __bf16 bf16x2_t __attribute__((ext_vector_type(2)));
__device__ __forceinline__ unsigned cvt_pk_bf16(float lo, float hi) { const f32x2 v = {lo, hi}; const bf16x2_t b = __builtin_convertvector(v, bf16x2_t); return __builtin_bit_cast(unsigned, b); }

__device__ __forceinline__ u32x4 pack8(const f32x4 a, const f32x4 b) { u32x4 w; w.x = cvt_pk_bf16(a[0], a[1]); w.y = cvt_pk_bf16(a[2], a[3]); w.z = cvt_pk_bf16(b[0], b[1]); w.w = cvt_pk_bf16(b[2], b[3]); return w; }
template <class Epi, class Sched, bool ALIGN_EPI, bool FP8 = false>
__device__ __forceinline__ void gemm_phase(PG8_LAS unsigned char* lds, const Gemm g, const Sched& S, const Epi& E) {
    int tid = threadIdx.x; asm volatile("" : "+v"(tid));
    const int wid = __builtin_amdgcn_readfirstlane(tid >> 6), lane = tid & 63, wr = wid >> 2, wc = wid & 3, fr = lane & 15, fq = lane >> 4;
    int K = g.K; asm volatile("" : "+s"(K));
    const int nt = K / BK;
    unsigned voffA[2], voffB[2];
#pragma unroll
    for (int i = 0; i < 2; ++i) { int R, C; stage_rc(tid * 16 + i * 8192, R, C); const int Rb = Epi::PERM ? ((R & ~31) + perm32(R & 31)) : R;
        voffA[i] = (unsigned)(R * g.lda + C) * 2u; voffB[i] = (unsigned)(Rb * g.ldb + C) * 2u; }
    const size_t kstep = (size_t)(BK * 2);
    const size_t hstepA = (size_t)HALF * g.lda * 2, hstepB = (size_t)HALF * g.ldb * 2;
    const unsigned ldsw = (unsigned)wid * 1024u;
    const int aoff = lds_byte(wr * 64 + fr, fq * 8), boff = lds_byte(wc * 32 + fr, fq * 8);
#define PG8_SA(b, h) (((b) * 2 + (h)) * HTB)
#define PG8_SB(b, h) ((4 + (b) * 2 + (h)) * HTB)
#define PG8_STAGE(bufoff, gbase, voff) do { _Pragma("unroll") for (int _i = 0; _i < 2; ++_i) \
        __builtin_amdgcn_global_load_lds((const unsigned*)((const char*)(gbase) + (voff)[_i]), (PG8_LAS unsigned*)(lds + (bufoff) + ldsw + _i * 8192), 16, 0, 0); } while (0)
#define PG8_LDA(dst, b, h) do { _Pragma("unroll") for (int m = 0; m < 4; ++m) { if constexpr (FP8) dst##8[m] = __builtin_shufflevector(*(const PG8_LAS v4i*)(lds + PG8_SA(b, h) + aoff + m * 2048), *(const PG8_LAS v4i*)(lds + PG8_SA(b, h) + aoff + m * 2048 + 1024), 0, 1, 2, 3, 4, 5, 6, 7); \
        else { _Pragma("unroll") for (int k = 0; k < 2; ++k) dst[m][k] = *(const PG8_LAS bf16x8*)(lds + PG8_SA(b, h) + aoff + m * 2048 + k * 1024); } } } while (0)
#define PG8_LDB(dst, b, h) do { _Pragma("unroll") for (int n = 0; n < 2; ++n) { if constexpr (FP8) dst##8[n] = __builtin_shufflevector(*(const PG8_LAS v4i*)(lds + PG8_SB(b, h) + boff + n * 2048), *(const PG8_LAS v4i*)(lds + PG8_SB(b, h) + boff + n * 2048 + 1024), 0, 1, 2, 3, 4, 5, 6, 7); \
        else { _Pragma("unroll") for (int k = 0; k < 2; ++k) dst[n][k] = *(const PG8_LAS bf16x8*)(lds + PG8_SB(b, h) + boff + n * 2048 + k * 1024); } } } while (0)
#define PG8_MMA(ai, bj, At, Bt) do { __builtin_amdgcn_s_setprio(1); _Pragma("unroll") for (int m = 0; m < 4; ++m) _Pragma("unroll") for (int n = 0; n < 2; ++n) { \
        if constexpr (FP8) asm volatile("v_mfma_f32_16x16x128_f8f6f4 %0, %1, %2, %0" : "+v"(acc[ai][bj][m][n]) : "v"(Bt##8[n]), "v"(At##8[m])); \
        else { _Pragma("unroll") for (int k = 0; k < 2; ++k) acc[ai][bj][m][n] = __builtin_amdgcn_mfma_f32_16x16x32_bf16(Bt[n][k], At[m][k], acc[ai][bj][m][n], 0, 0, 0); } } \
        __builtin_amdgcn_s_setprio(0); } while (0)
#define PG8_WAIT_V(n) asm volatile("s_waitcnt vmcnt(" #n ")" ::: "memory")
#define PG8_WAIT_L(n) asm volatile("s_waitcnt lgkmcnt(" #n ")" ::: "memory")
#define PG8_BAR __builtin_amdgcn_s_barrier()
#define PG8_SCHED __builtin_amdgcn_sched_barrier(0)
    Unit cur, nxt; int ui = 0;
    if (!S.next(0, cur)) return;
    f32x4 acc[2][2][4][2];
#pragma unroll
    for (int a = 0; a < 2; ++a)
#pragma unroll
        for (int b = 0; b < 2; ++b)
#pragma unroll
            for (int m = 0; m < 4; ++m)
#pragma unroll
                for (int n = 0; n < 2; ++n) acc[a][b][m][n] = (f32x4){0.f, 0.f, 0.f, 0.f};
    bf16x8 At[4][2], B0[2][2], B1[2][2]; v8i At8[4], B08[2], B18[2];
    const char* cA = (const char*)g.A + cur.offA; const char* cB = (const char*)g.Bt + cur.offB;
    PG8_STAGE(PG8_SB(0, 0), cB, voffB); PG8_STAGE(PG8_SB(0, 1), cB + hstepB, voffB); PG8_STAGE(PG8_SA(0, 0), cA, voffA); PG8_STAGE(PG8_SA(0, 1), cA + hstepA, voffA);
    if (wr == 1) PG8_BAR;
    PG8_WAIT_V(2); PG8_BAR;
    PG8_STAGE(PG8_SB(1, 0), cB + kstep, voffB); PG8_STAGE(PG8_SA(1, 0), cA + kstep, voffA); PG8_STAGE(PG8_SB(1, 1), cB + hstepB + kstep, voffB);
    PG8_WAIT_V(6); PG8_BAR;
    for (;;) {
        const bool has_next = S.next(ui + 1, nxt);
        const char* nA = has_next ? (const char*)g.A + nxt.offA : cA; const char* nB = has_next ? (const char*)g.Bt + nxt.offB : cB;
        for (int t = 0; t < nt; t += 2) {
            const bool last = (t == nt - 2);
            const char* a1 = cA + (size_t)(t + 1) * kstep;
            const char* a2 = last ? nA : cA + (size_t)(t + 2) * kstep; const char* b2 = last ? nB : cB + (size_t)(t + 2) * kstep;
            const char* a3 = a2 + kstep; const char* b3 = b2 + kstep;
            PG8_LDB(B0, 0, 0); PG8_LDB(B1, 0, 1); PG8_SCHED; PG8_LDA(At, 0, 0); PG8_STAGE(PG8_SA(1, 1), a1 + hstepA, voffA);
            PG8_WAIT_V(8); PG8_WAIT_L(0); PG8_BAR; PG8_MMA(0, 0, At, B0); PG8_MMA(0, 1, At, B1); PG8_BAR; PG8_SCHED;
            PG8_LDA(At, 0, 1); PG8_STAGE(PG8_SB(0, 0), b2, voffB); PG8_STAGE(PG8_SB(0, 1), b2 + hstepB, voffB); PG8_STAGE(PG8_SA(0, 0), a2, voffA);
            PG8_WAIT_V(8); PG8_WAIT_L(0); PG8_BAR; PG8_MMA(1, 0, At, B0); PG8_MMA(1, 1, At, B1); PG8_BAR; PG8_SCHED;
            PG8_LDB(B0, 1, 0); PG8_LDB(B1, 1, 1); PG8_SCHED; PG8_LDA(At, 1, 0); PG8_STAGE(PG8_SA(0, 1), a2 + hstepA, voffA);
            PG8_WAIT_V(8); PG8_WAIT_L(0); PG8_BAR; PG8_MMA(0, 0, At, B0); PG8_MMA(0, 1, At, B1); PG8_BAR; PG8_SCHED;
            PG8_LDA(At, 1, 1); PG8_STAGE(PG8_SB(1, 0), b3, voffB); PG8_STAGE(PG8_SB(1, 1), b3 + hstepB, voffB); PG8_STAGE(PG8_SA(1, 0), a3, voffA);
            PG8_WAIT_V(8); PG8_WAIT_L(0); PG8_BAR; PG8_MMA(1, 0, At, B0); PG8_MMA(1, 1, At, B1); PG8_BAR; PG8_SCHED;
        }
        if constexpr (ALIGN_EPI) { if (wr == 0) PG8_BAR; }
        if constexpr (FP8) asm volatile("s_nop 15\n\ts_nop 15" ::: "memory");
        E(acc, cur, wr, wc, fr, fq);
        if (!has_next) break;
#pragma unroll
        for (int a = 0; a < 2; ++a)
#pragma unroll
            for (int b = 0; b < 2; ++b)
#pragma unroll
                for (int m = 0; m < 4; ++m)
#pragma unroll
                    for (int n = 0; n < 2; ++n) acc[a][b][m][n] = (f32x4){0.f, 0.f, 0.f, 0.f};
        cur = nxt; cA = nA; cB = nB; ++ui;
        if constexpr (ALIGN_EPI) { if (wr == 1) PG8_BAR; }
    }
    PG8_WAIT_V(0);
    if constexpr (!ALIGN_EPI) { if (wr == 0) PG8_BAR; }
    PG8_BAR;
#undef PG8_SA
#undef PG8_SB
#undef PG8_STAGE
#undef PG8_LDA
#undef PG8_LDB
#undef PG8_MMA
#undef PG8_WAIT_V
#undef PG8_WAIT_L
#undef PG8_BAR
#undef PG8_SCHED
}


template <class Epi, class Sched>
__device__ __forceinline__ void gemm_phase_n1(PG8_LAS unsigned char* lds, const Gemm g, const Sched& S, const Epi& E) {
    int tid = threadIdx.x; asm volatile("" : "+v"(tid));
    const int wid = __builtin_amdgcn_readfirstlane(tid >> 6), lane = tid & 63, wr = wid >> 2, wc = wid & 3, fr = lane & 15, fq = lane >> 4;
    int K = g.K; asm volatile("" : "+s"(K));
    const int nt = K / BK;
    unsigned voffA[2], voffB[2];
#pragma unroll
    for (int i = 0; i < 2; ++i) { int R, C; stage_rc(tid * 16 + i * 8192, R, C); const int Rb = Epi::PERM ? ((R & ~31) + perm32(R & 31)) : R;
        voffA[i] = (unsigned)(R * g.lda + C) * 2u; voffB[i] = (unsigned)(Rb * g.ldb + C) * 2u; }
    const size_t kstep = (size_t)(BK * 2);
    const size_t hstepA = (size_t)HALF * g.lda * 2;
    const unsigned ldsw = (unsigned)wid * 1024u;
    const int aoff = lds_byte(wr * 64 + fr, fq * 8), boff = lds_byte(wc * 32 + fr, fq * 8);
#define PG8_SA(b, h) (((b) * 2 + (h)) * HTB)
#define PG8_SB(b, h) ((4 + (b) * 2 + (h)) * HTB)
#define PG8_STAGE(bufoff, gbase, voff) do { _Pragma("unroll") for (int _i = 0; _i < 2; ++_i) \
        __builtin_amdgcn_global_load_lds((const unsigned*)((const char*)(gbase) + (voff)[_i]), (PG8_LAS unsigned*)(lds + (bufoff) + ldsw + _i * 8192), 16, 0, 0); } while (0)
#define PG8_LDA(dst, b, h) do { _Pragma("unroll") for (int m = 0; m < 4; ++m) _Pragma("unroll") for (int k = 0; k < 2; ++k) dst[m][k] = *(const PG8_LAS bf16x8*)(lds + PG8_SA(b, h) + aoff + m * 2048 + k * 1024); } while (0)
#define PG8_LDB(dst, b, h) do { _Pragma("unroll") for (int n = 0; n < 2; ++n) _Pragma("unroll") for (int k = 0; k < 2; ++k) dst[n][k] = *(const PG8_LAS bf16x8*)(lds + PG8_SB(b, h) + boff + n * 2048 + k * 1024); } while (0)
#define PG8_MMA1(ai, At, Bt) do { __builtin_amdgcn_s_setprio(1); _Pragma("unroll") for (int m = 0; m < 4; ++m) _Pragma("unroll") for (int n = 0; n < 2; ++n) _Pragma("unroll") for (int k = 0; k < 2; ++k) \
        acc[ai][m][n] = __builtin_amdgcn_mfma_f32_16x16x32_bf16(Bt[n][k], At[m][k], acc[ai][m][n], 0, 0, 0); __builtin_amdgcn_s_setprio(0); } while (0)
#define PG8_WAIT_V(n) asm volatile("s_waitcnt vmcnt(" #n ")" ::: "memory")
#define PG8_WAIT_L(n) asm volatile("s_waitcnt lgkmcnt(" #n ")" ::: "memory")
#define PG8_BAR __builtin_amdgcn_s_barrier()
#define PG8_SCHED __builtin_amdgcn_sched_barrier(0)
    Unit cur, nxt; int ui = 0;
    if (!S.next(0, cur)) return;
    f32x4 acc[2][4][2], st[2][4][2];
#pragma unroll
    for (int a = 0; a < 2; ++a)
#pragma unroll
        for (int m = 0; m < 4; ++m)
#pragma unroll
            for (int n = 0; n < 2; ++n) { acc[a][m][n] = (f32x4){0.f, 0.f, 0.f, 0.f}; st[a][m][n] = (f32x4){0.f, 0.f, 0.f, 0.f}; }
    bf16x8 At[4][2], B0[2][2];
    const char* cA = (const char*)g.A + cur.offA; const char* cB = (const char*)g.Bt + cur.offB;
    PG8_STAGE(PG8_SB(0, 0), cB, voffB); PG8_STAGE(PG8_SA(0, 0), cA, voffA); PG8_STAGE(PG8_SA(0, 1), cA + hstepA, voffA);
    if (wr == 1) PG8_BAR;
    PG8_WAIT_V(2); PG8_BAR;
    PG8_STAGE(PG8_SB(1, 0), cB + kstep, voffB); PG8_STAGE(PG8_SA(1, 0), cA + kstep, voffA);
    PG8_WAIT_V(4); PG8_BAR;
    for (;;) {
        const bool has_next = S.next(ui + 1, nxt);
        const char* nA = has_next ? (const char*)g.A + nxt.offA : cA; const char* nB = has_next ? (const char*)g.Bt + nxt.offB : cB;
        for (int t = 0; t < nt; t += 2) {
            const bool last = (t == nt - 2);
            const char* a1 = cA + (size_t)(t + 1) * kstep;
            const char* a2 = last ? nA : cA + (size_t)(t + 2) * kstep; const char* b2 = last ? nB : cB + (size_t)(t + 2) * kstep;
            const char* a3 = a2 + kstep; const char* b3 = b2 + kstep;
            PG8_LDB(B0, 0, 0); PG8_SCHED; PG8_LDA(At, 0, 0); PG8_STAGE(PG8_SA(1, 1), a1 + hstepA, voffA);
            PG8_WAIT_V(6); PG8_WAIT_L(0); PG8_BAR; PG8_MMA1(0, At, B0); PG8_BAR; PG8_SCHED;
            PG8_LDA(At, 0, 1); PG8_STAGE(PG8_SB(0, 0), b2, voffB); PG8_STAGE(PG8_SA(0, 0), a2, voffA);
            PG8_WAIT_V(6); PG8_WAIT_L(0); PG8_BAR; PG8_MMA1(1, At, B0); PG8_BAR; PG8_SCHED;
            PG8_LDB(B0, 1, 0); PG8_SCHED; PG8_LDA(At, 1, 0); PG8_STAGE(PG8_SA(0, 1), a2 + hstepA, voffA);
            PG8_WAIT_V(6); PG8_WAIT_L(0); PG8_BAR; PG8_MMA1(0, At, B0); PG8_BAR; PG8_SCHED;
            PG8_LDA(At, 1, 1); PG8_STAGE(PG8_SB(1, 0), b3, voffB); PG8_STAGE(PG8_SA(1, 0), a3, voffA);
            PG8_WAIT_V(6); PG8_WAIT_L(0); PG8_BAR; PG8_MMA1(1, At, B0); PG8_BAR; PG8_SCHED;
        }
        if (wr == 0) PG8_BAR;
        E(acc, st, cur, wr, wc, fr, fq);
        if (!has_next) break;
#pragma unroll
        for (int a = 0; a < 2; ++a)
#pragma unroll
            for (int m = 0; m < 4; ++m)
#pragma unroll
                for (int n = 0; n < 2; ++n) acc[a][m][n] = (f32x4){0.f, 0.f, 0.f, 0.f};
        cur = nxt; cA = nA; cB = nB; ++ui;
        if (wr == 1) PG8_BAR;
    }
    PG8_WAIT_V(0);
    PG8_BAR;
#undef PG8_SA
#undef PG8_SB
#undef PG8_STAGE
#undef PG8_LDA
#undef PG8_LDB
#undef PG8_MMA1
#undef PG8_WAIT_V
#undef PG8_WAIT_L
#undef PG8_BAR
#undef PG8_SCHED
}
typedef f32x4 Acc1[2][4][2];
struct OneUnit { int pm; size_t tA;
    __device__ bool next(int i, Unit& u) const { if (i) return false; u.pm = pm; u.pn = 0; u.z = 0; u.offA = (size_t)pm * tA; u.offB = 0; return true; } };
struct BranchOrder1 {
    int nM, nN, G, c; size_t tA, tB, zA, zB; int paired, vc;
    __device__ bool next(int i, Unit& u) const {
        if (paired) { if (i >= 16) return false; u.z = i & 3; u.pm = vc >> 1; u.pn = 4 * (vc & 1) + (i >> 2);
            u.offA = (size_t)u.z * zA + (size_t)u.pm * tA; u.offB = (size_t)u.z * zB + (size_t)u.pn * tB; return true; }
        const int tile = (i >> 2) * G + c; if (tile >= nM * nN) return false;
        u.z = i & 3; xcd_tile_map<BR_WG>(tile, nM, nN, u.pm, u.pn);
        u.offA = (size_t)u.z * zA + (size_t)u.pm * tA; u.offB = (size_t)u.z * zB + (size_t)u.pn * tB; return true;
    }
};
struct EpiGate1 {
    static constexpr bool PERM = true;
    const bf16_t* gate; bf16_t* mb;
    __device__ __forceinline__ void operator()(const Acc1& acc, Acc1& st, const Unit& u, int wr, int wc, int fr, int fq) const {
        const int z = u.z; const int row0 = u.pm * BM + wr * 64 + fr, col = u.pn * HALF + wc * 32 + 8 * fq;
#pragma unroll
        for (int ai = 0; ai < 2; ++ai)
#pragma unroll
            for (int m = 0; m < 4; ++m) { const int row = row0 + ai * HALF + m * 16;
                f32x4 a = acc[ai][m][0], b = acc[ai][m][1];
                if (GATE8 == 2) { const v2u g8 = *(const v2u*)((const unsigned char*)gate + (size_t)row * 4096 + z * 1024 + col); const float k = 1.0f / 255.0f;
                    a[0] *= (float)(g8.x & 0xffu) * k; a[1] *= (float)((g8.x >> 8) & 0xffu) * k; a[2] *= (float)((g8.x >> 16) & 0xffu) * k; a[3] *= (float)(g8.x >> 24) * k;
                    b[0] *= (float)(g8.y & 0xffu) * k; b[1] *= (float)((g8.y >> 8) & 0xffu) * k; b[2] *= (float)((g8.y >> 16) & 0xffu) * k; b[3] *= (float)(g8.y >> 24) * k; }
                else if (GATE8 == 1) { const v2u g8 = *(const v2u*)((const unsigned char*)gate + (size_t)row * 4096 + z * 1024 + col);
                    const f32x2 g0 = __builtin_amdgcn_cvt_pk_f32_fp8((int)g8.x, false), g1 = __builtin_amdgcn_cvt_pk_f32_fp8((int)g8.x, true), g2 = __builtin_amdgcn_cvt_pk_f32_fp8((int)g8.y, false), g3 = __builtin_amdgcn_cvt_pk_f32_fp8((int)g8.y, true);
                    a[0] *= g0[0]; a[1] *= g0[1]; a[2] *= g1[0]; a[3] *= g1[1]; b[0] *= g2[0]; b[1] *= g2[1]; b[2] *= g3[0]; b[3] *= g3[1]; }
                else { const u32x4 gg = *(const u32x4*)(gate + (size_t)row * 4096 + z * 1024 + col);
                    a[0] *= bflo(gg.x); a[1] *= bfhi(gg.x); a[2] *= bflo(gg.y); a[3] *= bfhi(gg.y); b[0] *= bflo(gg.z); b[1] *= bfhi(gg.z); b[2] *= bflo(gg.w); b[3] *= bfhi(gg.w); }
                if (z == 0) { st[ai][m][0] = a; st[ai][m][1] = b; } else { st[ai][m][0] += a; st[ai][m][1] += b; }
                if (z == 3) *(u32x4*)(mb + (size_t)row * 1024 + col) = pack8(st[ai][m][0], st[ai][m][1]); }
    }
};
typedef f32x4 Acc[2][2][4][2];
#define EPI_ROWS_BEGIN const int row0 = u.pm * BM + wr * 64 + fr; _Pragma("unroll") for (int ai = 0; ai < 2; ++ai) _Pragma("unroll") for (int m = 0; m < 4; ++m) { const int row = row0 + ai * HALF + m * 16;
#define EPI_ROWS_END }

struct EpiInProj {
    static constexpr bool PERM = true;
    bf16_t *ua, *qkv, *uc, *gate; const PG8_LAS float* gl;
    __device__ __forceinline__ void operator()(const Acc& acc, const Unit& u, int wr, int wc, int fr, int fq) const {
        const int pn = u.pn;
        if (pn == 0) {
            EPI_ROWS_BEGIN
#pragma unroll
            for (int bj = 0; bj < 2; ++bj) { const int c8 = bj * HALF + wc * 32 + 8 * fq, gI = c8 >> 4, h0 = c8 & 15;
                *(u32x4*)(ua + ((size_t)(gI * 512 + (row >> 6)) * S5_LDA + (row & 63) * 16 + h0)) = pack8(acc[ai][bj][m][0], acc[ai][bj][m][1]); }
            EPI_ROWS_END
        } else if (pn == 1 || pn == 2 || pn == 6 || pn == 7) {
            const int which = (pn == 1) ? 0 : (pn == 2) ? 1 : (pn == 6) ? 2 : 3;
            const PG8_LAS float* gp = gl + which * 64;
            bf16_t* dst = qkv + (size_t)((pn < 6) ? (pn - 1) : (pn - 3)) * ((size_t)T * 256);
            f32x4 gv[2][2];
#pragma unroll
            for (int bj = 0; bj < 2; ++bj)
#pragma unroll
                for (int n = 0; n < 2; ++n) gv[bj][n] = *(const PG8_LAS f32x4*)(gp + bj * 32 + 8 * fq + 4 * n);
            EPI_ROWS_BEGIN
            float ss = 0.f;
#pragma unroll
            for (int bj = 0; bj < 2; ++bj)
#pragma unroll
                for (int n = 0; n < 2; ++n) { const f32x4 x = acc[ai][bj][m][n]; ss += (x[0] * x[0] + x[1] * x[1]) + (x[2] * x[2] + x[3] * x[3]); }
            ss += __shfl_xor(ss, 16); ss += __shfl_xor(ss, 32);
            const float rs = __builtin_amdgcn_rsqf(ss * (1.0f / 64.0f) + EPS);
#pragma unroll
            for (int bj = 0; bj < 2; ++bj)
                *(u32x4*)(dst + (size_t)row * 256 + wc * 64 + bj * 32 + 8 * fq) = pack8(acc[ai][bj][m][0] * rs * gv[bj][0], acc[ai][bj][m][1] * rs * gv[bj][1]);
            EPI_ROWS_END
        } else if (pn == 3 || pn == 8) {
            bf16_t* dst = qkv + (size_t)((pn == 3) ? 2 : 5) * ((size_t)T * 256);
            EPI_ROWS_BEGIN
#pragma unroll
            for (int bj = 0; bj < 2; ++bj) *(u32x4*)(dst + (size_t)row * 256 + bj * HALF + wc * 32 + 8 * fq) = pack8(acc[ai][bj][m][0], acc[ai][bj][m][1]);
            EPI_ROWS_END
        } else if (pn == 4 || pn == 5) {
            EPI_ROWS_BEGIN
            f32x4 o[2];
#pragma unroll
            for (int n = 0; n < 2; ++n)
#pragma unroll
                for (int e = 0; e < 4; ++e) o[n][e] = acc[ai][0][m][n][e] * sigmoidf_(acc[ai][1][m][n][e]);
            *(u32x4*)(uc + (size_t)row * 256 + (pn - 4) * 128 + wc * 32 + 8 * fq) = pack8(o[0], o[1]);
            EPI_ROWS_END
        } else {
            const int gt = pn - 9;
            EPI_ROWS_BEGIN
#pragma unroll
            for (int bj = 0; bj < 2; ++bj) { f32x4 o[2];
#pragma unroll
                for (int n = 0; n < 2; ++n)
#pragma unroll
                    for (int e = 0; e < 4; ++e) o[n][e] = sigmoidf_(acc[ai][bj][m][n][e]);
                *(u32x4*)(gate + (size_t)row * 4096 + gt * 256 + bj * HALF + wc * 32 + 8 * fq) = pack8(o[0], o[1]); }
            EPI_ROWS_END
        }
    }
};
struct EpiGateSig {
    static constexpr bool PERM = true;
    bf16_t* gate;
    __device__ __forceinline__ void operator()(const Acc& acc, const Unit& u, int wr, int wc, int fr, int fq) const {
        EPI_ROWS_BEGIN
#pragma unroll
        for (int bj = 0; bj < 2; ++bj) { f32x4 o[2];
#pragma unroll
            for (int n = 0; n < 2; ++n)
#pragma unroll
                for (int e = 0; e < 4; e += 2) { const f32x2 r = sigmoid2((f32x2){acc[ai][bj][m][n][e], acc[ai][bj][m][n][e + 1]} * (1.0f / 64.0f)) * ((GATE8 == 2) ? 255.0f : 1.0f); o[n][e] = r[0]; o[n][e + 1] = r[1]; }
            if (GATE8 == 2) { v2u w = {0u, 0u};
#pragma unroll
                for (int e = 0; e < 4; ++e) { w.x = __builtin_amdgcn_cvt_pk_u8_f32(o[0][e], e, w.x); w.y = __builtin_amdgcn_cvt_pk_u8_f32(o[1][e], e, w.y); }
                *(v2u*)((unsigned char*)gate + (size_t)row * 4096 + u.pn * BM + bj * HALF + wc * 32 + 8 * fq) = w; }
            else if (GATE8 == 1) { v2u w; w.x = pk4_fp8(o[0][0], o[0][1], o[0][2], o[0][3]); w.y = pk4_fp8(o[1][0], o[1][1], o[1][2], o[1][3]); *(v2u*)((unsigned char*)gate + (size_t)row * 4096 + u.pn * BM + bj * HALF + wc * 32 + 8 * fq) = w; }
            else *(u32x4*)(gate + (size_t)row * 4096 + u.pn * BM + bj * HALF + wc * 32 + 8 * fq) = pack8(o[0], o[1]); }
        EPI_ROWS_END
    }
};
struct EpiZ {
    static constexpr bool PERM = false;
    float* z;
    __device__ __forceinline__ void operator()(const Acc& acc, const Unit& u, int wr, int wc, int fr, int fq) const {
        EPI_ROWS_BEGIN
#pragma unroll
        for (int n = 0; n < 2; ++n) *(f32x4*)(z + ((size_t)(u.z * 512 + row)) * 128 + wc * 32 + 16 * n + 4 * fq) = acc[ai][0][m][n];
        EPI_ROWS_END
    }
};
struct EpiY {
    static constexpr bool PERM = true;
    const bf16_t* ua; const float* dskip; bf16_t* yp;
    __device__ __forceinline__ void operator()(const Acc& acc, const Unit& u, int wr, int wc, int fr, int fq) const {
        const int gI = u.z, h0 = 8 * (fq & 1);
        const f32x4 d0 = *(const f32x4*)(dskip + gI * 16 + h0), d1 = *(const f32x4*)(dskip + gI * 16 + h0 + 4);
        EPI_ROWS_BEGIN
#pragma unroll
        for (int bj = 0; bj < 2; ++bj) { const int col = u.pn * BM + bj * HALF + wc * 32 + 8 * fq;
            const u32x4 uu = *(const u32x4*)(ua + ((size_t)(gI * 512 + row)) * S5_LDA + col);
            f32x4 a = acc[ai][bj][m][0], b = acc[ai][bj][m][1];
            a[0] += d0[0] * bflo(uu.x); a[1] += d0[1] * bfhi(uu.x); a[2] += d0[2] * bflo(uu.y); a[3] += d0[3] * bfhi(uu.y);
            b[0] += d1[0] * bflo(uu.z); b[1] += d1[1] * bfhi(uu.z); b[2] += d1[2] * bflo(uu.w); b[3] += d1[3] * bfhi(uu.w);
#pragma unroll
            for (int e = 0; e < 4; ++e) { a[e] = gelu_tanh(a[e]); b[e] = gelu_tanh(b[e]); }
            *(u32x4*)(yp + ((size_t)row * 64 + (col >> 4)) * 256 + gI * 16 + h0) = pack8(a, b); }
        EPI_ROWS_END
    }
};
struct EpiGlu {
    static constexpr bool PERM = true;
    const bf16_t* yp; bf16_t* ycat;
    __device__ __forceinline__ void operator()(const Acc& acc, const Unit& u, int wr, int wc, int fr, int fq) const {
        EPI_ROWS_BEGIN
#pragma unroll
        for (int bj = 0; bj < 2; ++bj) { const int col = bj * HALF + wc * 32 + 8 * fq;
            const u32x4 yy = *(const u32x4*)(yp + (size_t)row * 256 + col);
            f32x4 a = acc[ai][bj][m][0], b = acc[ai][bj][m][1];
            a[0] = bflo(yy.x) * sigmoidf_(a[0]); a[1] = bfhi(yy.x) * sigmoidf_(a[1]); a[2] = bflo(yy.y) * sigmoidf_(a[2]); a[3] = bfhi(yy.y) * sigmoidf_(a[3]);
            b[0] = bflo(yy.z) * sigmoidf_(b[0]); b[1] = bfhi(yy.z) * sigmoidf_(b[1]); b[2] = bflo(yy.w) * sigmoidf_(b[2]); b[3] = bfhi(yy.w) * sigmoidf_(b[3]);
            *(u32x4*)(ycat + (size_t)row * 1024 + col) = pack8(a, b); }
        EPI_ROWS_END
    }
};
template <bool SC64> struct EpiResid {
    static constexpr bool PERM = true; static constexpr float sc = SC64 ? (1.0f / 64.0f) : 1.0f;
    const float* base32; const bf16_t* base16; bf16_t* out; float* ss; unsigned char* out8; int flags;
    __device__ __forceinline__ void operator()(const Acc& acc, const Unit& u, int wr, int wc, int fr, int fq) const {
        EPI_ROWS_BEGIN
        float q = 0.f;
#pragma unroll
        for (int bj = 0; bj < 2; ++bj) { const size_t off = (size_t)row * 1024 + u.pn * BM + bj * HALF + wc * 32 + 8 * fq;
            f32x4 a, b;
            if (flags & 1) { a = *(const f32x4*)(base32 + off); b = *(const f32x4*)(base32 + off + 4); }
            else { const u32x4 r = *(const u32x4*)(base16 + off); a = (f32x4){bflo(r.x), bfhi(r.x), bflo(r.y), bfhi(r.y)}; b = (f32x4){bflo(r.z), bfhi(r.z), bflo(r.w), bfhi(r.w)}; }
            const u32x4 w = pack8(a + acc[ai][bj][m][0] * sc, b + acc[ai][bj][m][1] * sc); *(u32x4*)(out + off) = w;
            if (flags & 2) { const float x0 = bflo(w.x), x1 = bfhi(w.x), x2 = bflo(w.y), x3 = bfhi(w.y), x4 = bflo(w.z), x5 = bfhi(w.z), x6 = bflo(w.w), x7 = bfhi(w.w);
                q += ((x0 * x0 + x1 * x1) + (x2 * x2 + x3 * x3)) + ((x4 * x4 + x5 * x5) + (x6 * x6 + x7 * x7));
                if (flags & 4) { v2u w8; w8.x = pk4_fp8(x0, x1, x2, x3); w8.y = pk4_fp8(x4, x5, x6, x7); *(v2u*)(out8 + off) = w8; } } }
        if (flags & 2) { q += __shfl_xor(q, 16); q += __shfl_xor(q, 32); if (fq == 0) ss[(size_t)row * 16 + u.pn * 4 + wc] = q; }
        EPI_ROWS_END
    }
};
template <bool H8> struct EpiSwiGlu {
    static constexpr bool PERM = true;
    bf16_t* h; float sc; const float* ss; int use_ss;
    __device__ __forceinline__ void operator()(const Acc& acc, const Unit& u, int wr, int wc, int fr, int fq) const {
        EPI_ROWS_BEGIN
        float rsc = sc;
        if (use_ss) { const f32x4 s0 = *(const f32x4*)(ss + (size_t)row * 16), s1 = *(const f32x4*)(ss + (size_t)row * 16 + 4), s2 = *(const f32x4*)(ss + (size_t)row * 16 + 8), s3 = *(const f32x4*)(ss + (size_t)row * 16 + 12);
            const f32x4 t = (s0 + s1) + (s2 + s3); rsc = sc * __builtin_amdgcn_rsqf(((t[0] + t[1]) + (t[2] + t[3])) * (1.0f / D) + EPS); }
        f32x4 o[2];
#pragma unroll
        for (int n = 0; n < 2; ++n)
#pragma unroll
            for (int e = 0; e < 4; e += 2) { const f32x2 a = (f32x2){acc[ai][0][m][n][e], acc[ai][0][m][n][e + 1]} * rsc, b = (f32x2){acc[ai][1][m][n][e], acc[ai][1][m][n][e + 1]} * rsc;
                const f32x2 r = (a * b) * sigmoid2(a); o[n][e] = r[0]; o[n][e + 1] = r[1]; }
        if constexpr (H8) { v2u w; w.x = pk4_fp8(o[0][0], o[0][1], o[0][2], o[0][3]); w.y = pk4_fp8(o[1][0], o[1][1], o[1][2], o[1][3]); *(v2u*)((unsigned char*)h + (size_t)row * FF + u.pn * 128 + wc * 32 + 8 * fq) = w; }
        else *(u32x4*)(h + (size_t)row * FF + u.pn * 128 + wc * 32 + 8 * fq) = pack8(o[0], o[1]);
        EPI_ROWS_END
    }
};
struct EpiStore {
    static constexpr bool PERM = true;
    bf16_t* o; float sc;
    __device__ __forceinline__ void operator()(const Acc& acc, const Unit& u, int wr, int wc, int fr, int fq) const {
        EPI_ROWS_BEGIN
#pragma unroll
        for (int bj = 0; bj < 2; ++bj) *(u32x4*)(o + (size_t)row * 1024 + u.pn * BM + bj * HALF + wc * 32 + 8 * fq) = pack8(acc[ai][bj][m][0] * sc, acc[ai][bj][m][1] * sc);
        EPI_ROWS_END
    }
};
}

#define XB_TMO      128
#define XB_XCNT(j)  (256  + 64 * (j))
#define XB_XSUB(j)  (1280 + 64 * (j))
#define XB_XGEN(j)  (2304 + 64 * (j))
#define XB_TOP      3328
#define XB_TOPGEN   3392
#define XCD_BAR_WORDS 3456
#define XB_SPIN_CAP (1u << 18)
__device__ __forceinline__ unsigned xb_ld(unsigned* p)              { return __hip_atomic_load(p, __ATOMIC_RELAXED, __HIP_MEMORY_SCOPE_AGENT); }
__device__ __forceinline__ unsigned xb_add(unsigned* p, unsigned v) { return __hip_atomic_fetch_add(p, v, __ATOMIC_RELAXED, __HIP_MEMORY_SCOPE_AGENT); }
__device__ __forceinline__ unsigned xb_xcc_id() { return (unsigned)__builtin_amdgcn_s_getreg((3 << 11) | 20) & 0xFu; }
#define XB_SPIN(cond, bar) do { unsigned _sp = 0; while (cond) { __builtin_amdgcn_s_sleep(1); \
    if ((++_sp & 255u) == 0u) { if (xb_ld(&(bar)[XB_TMO])) break; if (_sp > XB_SPIN_CAP) { atomicAdd(&(bar)[XB_TMO], 1u); break; } } } } while (0)
struct XcdBarrier { unsigned* bar; unsigned x; volatile LAS unsigned* st; };
__device__ __forceinline__ XcdBarrier xcd_barrier_post(unsigned* bar, volatile LAS unsigned* st) {
    XcdBarrier b; b.bar = bar; b.x = xb_xcc_id(); b.st = st;
    if (threadIdx.x == 0) (void)xb_add(&bar[XB_XCNT(b.x)], 1u);
    return b;
}
__device__ __forceinline__ void xcd_barrier_complete(unsigned* bar, unsigned x, unsigned& nloc, unsigned& nx) {
    const unsigned G = gridDim.x * gridDim.y * gridDim.z;
    unsigned sum, cnt, mine, sp = 0u;
    for (;;) {
        sum = 0u; cnt = 0u; mine = 0u;
#pragma unroll
        for (unsigned j = 0; j < 16; ++j) { const unsigned c = xb_ld(&bar[XB_XCNT(j)]); sum += c; cnt += (c > 0u) ? 1u : 0u; }
        mine = xb_ld(&bar[XB_XCNT(x)]);
        if (sum == G) break;
        __builtin_amdgcn_s_sleep(1);
        if ((++sp & 255u) == 0u) { if (xb_ld(&bar[XB_TMO])) break; if (sp > XB_SPIN_CAP) { atomicAdd(&bar[XB_TMO], 1u); break; } }
    }
    nloc = mine > 0u ? mine : 1u; nx = cnt > 0u ? cnt : 1u;
}
__device__ __forceinline__ void xcd_barrier(const XcdBarrier& b) {
    asm volatile("s_waitcnt vmcnt(0)" ::: "memory");
    __syncthreads();
    if (threadIdx.x == 0) {
        unsigned* bar = b.bar; unsigned bx = b.x; asm volatile("" : "+s"(bx));
        __builtin_amdgcn_s_waitcnt(0);
        unsigned nloc = b.st[0], nx = b.st[1];
        if (nloc == 0u) { xcd_barrier_complete(bar, bx, nloc, nx); b.st[0] = nloc; b.st[1] = nx; }
        const unsigned old = xb_add(&bar[XB_XSUB(bx)], 1u);
        const unsigned gen = old / nloc;
        if (old + 1u == (gen + 1u) * nloc) {
            __builtin_amdgcn_fence(__ATOMIC_RELEASE, "agent");
            asm volatile("s_waitcnt vmcnt(0)" ::: "memory");
            const unsigned og = xb_add(&bar[XB_TOP], 1u);
            const unsigned tg = og / nx;
            if (og + 1u == (tg + 1u) * nx) xb_add(&bar[XB_TOPGEN], 1u);
            else XB_SPIN(xb_ld(&bar[XB_TOPGEN]) == tg, bar);
            __builtin_amdgcn_fence(__ATOMIC_ACQUIRE, "agent");
            xb_add(&bar[XB_XGEN(bx)], 1u);
            asm volatile("s_waitcnt vmcnt(0)" ::: "memory");
        } else {
            XB_SPIN(xb_ld(&bar[XB_XGEN(bx)]) == gen, bar);
            __builtin_amdgcn_fence(__ATOMIC_ACQUIRE, "agent");
            asm volatile("s_waitcnt vmcnt(0)" ::: "memory");
        }
    }
    __syncthreads();
}

struct Args { const float* in[32]; float* out; unsigned char* ws; int gp_lo, gp_hi; };
enum { I_X = 0, I_GMIX, I_WIN, I_BFORGET, I_FQG, I_FKG, I_SQG, I_SKG, I_LRE, I_LIM, I_LDT, I_BRE, I_BIM, I_CRE, I_CIM, I_S5D, I_WGLU, I_CONVW, I_CONVB, I_LNG, I_LNB,
       I_WBR, I_WOUT, I_GFFN, I_W1, I_W3, I_W2, I_RW, I_RB, I_MW1, I_MW3, I_MW2 };
constexpr int NPH = 12, GP_FINAL = DEPTH * NPH, GP_TOTAL = GP_FINAL + 1;

struct Frame { LAS unsigned char* lds; int tid, lane, wave, vcu, G, gw, NGW; const Args* a; unsigned char* ws; };

__device__ __forceinline__ void transpose_item(const float* W, int ldw, bf16* WT, int ldt, int k0, int src_col0, int dst_row0, LAS float* scr, int lane, const float* ks = nullptr) {
    f32x4 ld[8];
#pragma unroll
    for (int i = 0; i < 8; ++i) ld[i] = *(const f32x4*)(W + (size_t)(k0 + 8 * i + (lane >> 3)) * ldw + src_col0 + 4 * (lane & 7));
#pragma unroll
    for (int i = 0; i < 8; ++i) { LAS float* d = scr + (8 * i + (lane >> 3)) * 33 + 4 * (lane & 7); const float s = ks ? ks[k0 + 8 * i + (lane >> 3)] : 1.0f; d[0] = ld[i][0] * s; d[1] = ld[i][1] * s; d[2] = ld[i][2] * s; d[3] = ld[i][3] * s; }
    LDS_WAIT(); asm volatile("" ::: "memory");
    const int c = lane & 7;
#pragma unroll
    for (int j = 0; j < 4; ++j) { const int n = (lane >> 3) + 8 * j; const LAS float* s = scr + (8 * c) * 33 + n;
        v4u o; o.x = pk2(s[0 * 33], s[1 * 33]); o.y = pk2(s[2 * 33], s[3 * 33]); o.z = pk2(s[4 * 33], s[5 * 33]); o.w = pk2(s[6 * 33], s[7 * 33]);
        *(GAS v4u*)(WT + (size_t)(dst_row0 + n) * ldt + k0 + 8 * c) = o; }
    LDS_WAIT(); asm volatile("" ::: "memory");
}
__device__ __forceinline__ void transpose_item_f8(const float* W, int ldw, unsigned char* WT, int ldt, int k0, int src_col0, int dst_row0, LAS float* scr, int lane, float sc, const float* ks = nullptr) {
    f32x4 ld[8];
#pragma unroll
    for (int i = 0; i < 8; ++i) ld[i] = *(const f32x4*)(W + (size_t)(k0 + 8 * i + (lane >> 3)) * ldw + src_col0 + 4 * (lane & 7));
#pragma unroll
    for (int i = 0; i < 8; ++i) { LAS float* d = scr + (8 * i + (lane >> 3)) * 33 + 4 * (lane & 7); const float s = ks ? sc * ks[k0 + 8 * i + (lane >> 3)] : sc; d[0] = ld[i][0] * s; d[1] = ld[i][1] * s; d[2] = ld[i][2] * s; d[3] = ld[i][3] * s; }
    LDS_WAIT(); asm volatile("" ::: "memory");
    const int c = lane & 7;
#pragma unroll
    for (int j = 0; j < 4; ++j) { const int n = (lane >> 3) + 8 * j; const LAS float* s = scr + (8 * c) * 33 + n;
        v2u o; o.x = pk4_fp8(s[0 * 33], s[1 * 33], s[2 * 33], s[3 * 33]); o.y = pk4_fp8(s[4 * 33], s[5 * 33], s[6 * 33], s[7 * 33]);
        *(GAS v2u*)(WT + (size_t)(dst_row0 + n) * ldt + k0 + 8 * c) = o; }
    LDS_WAIT(); asm volatile("" ::: "memory");
}
__device__ __forceinline__ int win_src_col(int blk) {
    const int tile = blk >> 3, j = blk & 7, bj = j >> 2, hh = j & 3;
    if (tile == 0) return 32 * j;
    if (tile == 1 || tile == 2) return 256 + 256 * (tile - 1) + 64 * hh + 32 * bj;
    if (tile == 3) return 768 + 32 * j;
    if (tile == 4 || tile == 5) return (j < 4) ? (1028 + 128 * (tile - 4) + 32 * j) : (1284 + 128 * (tile - 4) + 32 * (j - 4));
    if (tile == 6 || tile == 7) return 1540 + 256 * (tile - 6) + 64 * hh + 32 * bj;
    if (tile == 8) return 2052 + 32 * j;
    return 2308 + 256 * (tile - 9) + 32 * j;
}
constexpr int CONV_NIN = 200 * 16, CONV_NBR = 4 * 32 * 4, CONV_NOUT = 32 * 16, CONV_NGLU = 8 * 4, CONV_NUP1 = 176 * 16, CONV_NDN1 = 32 * 44;
constexpr int CONV_NMIX = CONV_NIN + CONV_NBR + CONV_NOUT + CONV_NGLU, CONV_CHUNK = 64;
__device__ __forceinline__ int conv_ffn_items(int layer) { return (CONV_NUP1 + CONV_NDN1) * ((layer & 1) ? NE : 1); }
__device__ __forceinline__ void mix_item_load(const Args& A, int layer, int r, int lane, f32x4 (&ld)[8]) {
    asm volatile("" : "+v"(r));
    const float* w; int ldw, k0, col0;
    if (r < CONV_NIN) { const int blk = r >> 4, kb = r & 15; w = A.in[I_WIN] + (size_t)layer * D * DP; ldw = DP; k0 = 64 * kb; col0 = win_src_col(blk); }
    else if (r < CONV_NIN + CONV_NBR) { r -= CONV_NIN; const int z = r >> 7, q = r & 127, blk = q >> 2, kb = q & 3; w = A.in[I_WBR] + ((size_t)layer * 4 + z) * 256 * D; ldw = D; k0 = 64 * kb; col0 = 32 * blk; }
    else if (r < CONV_NIN + CONV_NBR + CONV_NOUT) { r -= CONV_NIN + CONV_NBR; const int blk = r >> 4, kb = r & 15; w = A.in[I_WOUT] + (size_t)layer * D * D; ldw = D; k0 = 64 * kb; col0 = 32 * blk; }
    else { r -= CONV_NIN + CONV_NBR + CONV_NOUT; const int blk = r >> 2, kb = r & 3; w = A.in[I_WGLU] + (size_t)layer * 256 * 256; ldw = 256; k0 = 64 * kb; col0 = 32 * blk; }
    w += (size_t)(k0 + (lane >> 3)) * ldw + col0 + 4 * (lane & 7);
#pragma unroll
    for (int i = 0; i < 8; ++i) ld[i] = *(const f32x4*)(w + (size_t)(8 * i) * ldw);
}
__device__ __forceinline__ void mix_item_finish(unsigned char* ws, int r, int lane, f32x4 (&ld)[8], LAS float* scr) {
    asm volatile("" : "+v"(r));
    size_t dbase; int ldt, k0, row0; bool f8 = false;
    if (r < CONV_NIN) { const int blk = r >> 4, kb = r & 15; k0 = 64 * kb; ldt = D;
        if (F8_GATES && blk >= 72) { f8 = true; dbase = WS_WIN8; row0 = 32 * (blk - 72); } else { dbase = WS_WIN; row0 = 32 * blk; } }
    else if (r < CONV_NIN + CONV_NBR) { r -= CONV_NIN; const int z = r >> 7, q = r & 127, blk = q >> 2, kb = q & 3; dbase = WS_WBR + (size_t)z * D * 256 * 2; ldt = 256; k0 = 64 * kb; row0 = 32 * blk; }
    else if (r < CONV_NIN + CONV_NBR + CONV_NOUT) { r -= CONV_NIN + CONV_NBR; const int blk = r >> 4, kb = r & 15; dbase = WS_WOUT; ldt = D; k0 = 64 * kb; row0 = 32 * blk; }
    else { r -= CONV_NIN + CONV_NBR + CONV_NOUT; const int blk = r >> 2, kb = r & 3; dbase = WS_WGLU; ldt = 256; k0 = 64 * kb; row0 = 32 * blk; }
    const float sc = f8 ? 64.0f : 1.0f;
#pragma unroll
    for (int i = 0; i < 8; ++i) { LAS float* d = scr + (8 * i + (lane >> 3)) * 33 + 4 * (lane & 7); d[0] = ld[i][0] * sc; d[1] = ld[i][1] * sc; d[2] = ld[i][2] * sc; d[3] = ld[i][3] * sc; }
    LDS_WAIT(); asm volatile("" ::: "memory");
    const int c = lane & 7;
    if (f8) {
#pragma unroll
        for (int j = 0; j < 4; ++j) { const int n = (lane >> 3) + 8 * j; const LAS float* s = scr + (8 * c) * 33 + n;
            v2u o; o.x = pk4_fp8(s[0 * 33], s[1 * 33], s[2 * 33], s[3 * 33]); o.y = pk4_fp8(s[4 * 33], s[5 * 33], s[6 * 33], s[7 * 33]);
            *(GAS v2u*)(ws + dbase + (size_t)(row0 + n) * ldt + k0 + 8 * c) = o; }
    } else {
#pragma unroll
        for (int j = 0; j < 4; ++j) { const int n = (lane >> 3) + 8 * j; const LAS float* s = scr + (8 * c) * 33 + n;
            v4u o; o.x = pk2(s[0 * 33], s[1 * 33]); o.y = pk2(s[2 * 33], s[3 * 33]); o.z = pk2(s[4 * 33], s[5 * 33]); o.w = pk2(s[6 * 33], s[7 * 33]);
            *(GAS v4u*)((bf16*)(ws + dbase) + (size_t)(row0 + n) * ldt + k0 + 8 * c) = o; }
    }
    LDS_WAIT(); asm volatile("" ::: "memory");
}
__device__ __forceinline__ void phase_convert(Frame& F, int layer) {
    LAS float* scr = (LAS float*)(F.lds + F.wave * 16384); const Args& A = *F.a; unsigned char* ws = F.ws; const int lane = F.lane;
    f32x4 la[8], lb[8];
    int it = F.gw;
    if (it < CONV_NMIX) mix_item_load(A, layer, it, lane, la);
#pragma unroll 1
    for (; it < CONV_NMIX; it += 2 * F.NGW) {
        const int i1 = it + F.NGW, i2 = i1 + F.NGW;
        if (i1 < CONV_NMIX) mix_item_load(A, layer, i1, lane, lb);
        mix_item_finish(ws, it, lane, la, scr);
        if (i2 < CONV_NMIX) mix_item_load(A, layer, i2, lane, la);
        if (i1 < CONV_NMIX) mix_item_finish(ws, i1, lane, lb, scr);
    }
}
__device__ __forceinline__ void ffn_item_load(const Args& A, int layer, int r, int lane, f32x4 (&ld)[8]) {
    asm volatile("" : "+v"(r));
    const bool moe = (layer & 1) != 0; const int j2 = layer >> 1, n_up = CONV_NUP1 * (moe ? NE : 1);
    const float* w; int ldw, k0, col0;
    if (r < n_up) { const int e = r / CONV_NUP1, q = r % CONV_NUP1, blk = q >> 4, kb = q & 15, tile = blk >> 3, jj = blk & 7;
        const size_t off = moe ? ((size_t)j2 * NE + e) * D * FF : (size_t)j2 * D * FF;
        w = (moe ? (jj < 4 ? A.in[I_MW1] : A.in[I_MW3]) : (jj < 4 ? A.in[I_W1] : A.in[I_W3])) + off; ldw = FF; k0 = 64 * kb; col0 = 128 * tile + 32 * (jj & 3);
    } else { r -= n_up; const int e = r / CONV_NDN1, q = r % CONV_NDN1, blk = q / 44, kb = q % 44;
        w = moe ? A.in[I_MW2] + ((size_t)j2 * NE + e) * FF * D : A.in[I_W2] + (size_t)j2 * FF * D; ldw = D; k0 = 64 * kb; col0 = 32 * blk; }
    w += (size_t)(k0 + (lane >> 3)) * ldw + col0 + 4 * (lane & 7);
#pragma unroll
    for (int i = 0; i < 8; ++i) ld[i] = *(const f32x4*)(w + (size_t)(8 * i) * ldw);
}
__device__ __forceinline__ void ffn_item_finish(const Args& A, unsigned char* ws, int layer, int r, int lane, f32x4 (&ld)[8], LAS float* scr) {
    asm volatile("" : "+v"(r));
    const bool moe = (layer & 1) != 0; const int n_up = CONV_NUP1 * (moe ? NE : 1);
    const bool f8 = moe ? (F8_MOE_UP != 0) : (DENSE8(layer) != 0); const float sc = f8 ? 64.0f : 1.0f;
    const bool up = r < n_up; int e, k0, row0, ldt; size_t dbase;
    if (up) { e = r / CONV_NUP1; const int q = r % CONV_NUP1, blk = q >> 4, kb = q & 15; k0 = 64 * kb; row0 = 32 * blk; ldt = D; dbase = WS_WUP + (size_t)e * 5632 * D * (f8 ? 1 : 2); }
    else { r -= n_up; e = r / CONV_NDN1; const int q = r % CONV_NDN1, blk = q / 44, kb = q % 44; k0 = 64 * kb; row0 = 32 * blk; ldt = FF; dbase = WS_WDN + (size_t)e * D * FF * (f8 ? 1 : 2); }
    const bool scaled = FUSE_DENSE_NORM && !moe && up;
    const float* ks = A.in[I_GFFN] + layer * D + k0 + (lane >> 3);
#pragma unroll
    for (int i = 0; i < 8; ++i) { LAS float* d = scr + (8 * i + (lane >> 3)) * 33 + 4 * (lane & 7); const float s = scaled ? sc * ks[8 * i] : sc; d[0] = ld[i][0] * s; d[1] = ld[i][1] * s; d[2] = ld[i][2] * s; d[3] = ld[i][3] * s; }
    LDS_WAIT(); asm volatile("" ::: "memory");
    const int c = lane & 7;
    if (f8) {
#pragma unroll
        for (int j = 0; j < 4; ++j) { const int n = (lane >> 3) + 8 * j; const LAS float* s = scr + (8 * c) * 33 + n;
            v2u o; o.x = pk4_fp8(s[0 * 33], s[1 * 33], s[2 * 33], s[3 * 33]); o.y = pk4_fp8(s[4 * 33], s[5 * 33], s[6 * 33], s[7 * 33]);
            *(GAS v2u*)(ws + dbase + (size_t)(row0 + n) * ldt + k0 + 8 * c) = o; }
    } else {
#pragma unroll
        for (int j = 0; j < 4; ++j) { const int n = (lane >> 3) + 8 * j; const LAS float* s = scr + (8 * c) * 33 + n;
            v4u o; o.x = pk2(s[0 * 33], s[1 * 33]); o.y = pk2(s[2 * 33], s[3 * 33]); o.z = pk2(s[4 * 33], s[5 * 33]); o.w = pk2(s[6 * 33], s[7 * 33]);
            *(GAS v4u*)((bf16*)(ws + dbase) + (size_t)(row0 + n) * ldt + k0 + 8 * c) = o; }
    }
    LDS_WAIT(); asm volatile("" ::: "memory");
}
__device__ __forceinline__ void convert_ffn_chunk(Frame& F, int layer, int chunk) {
    LAS float* scr = (LAS float*)(F.lds + F.wave * 16384); const int nf = conv_ffn_items(layer), base = chunk * CONV_CHUNK + F.wave;
    const Args& A = *F.a; unsigned char* ws = F.ws; const int lane = F.lane;
    f32x4 la[8], lb[8];
    ffn_item_load(A, layer, min(base, nf - 1), lane, la);
#pragma unroll 1
    for (int jj = 0; jj < CONV_CHUNK / NWAVES; jj += 2) {
        const int i0 = base + NWAVES * jj, i1 = i0 + NWAVES, i2 = i1 + NWAVES;
        ffn_item_load(A, layer, min(i1, nf - 1), lane, lb);
        if (i0 < nf) ffn_item_finish(A, ws, layer, i0, lane, la, scr);
        if (jj + 2 < CONV_CHUNK / NWAVES) ffn_item_load(A, layer, min(i2, nf - 1), lane, la);
        if (i1 < nf) ffn_item_finish(A, ws, layer, i1, lane, lb, scr);
    }
}
struct S5P { float lr, li, dt, kr, ki; };
__device__ __forceinline__ S5P s5_params(const Args& A, int layer, int g, int p) {
    S5P q; q.lr = A.in[I_LRE][(layer * 16 + g) * 64 + p]; q.li = A.in[I_LIM][(layer * 16 + g) * 64 + p]; q.dt = expf(A.in[I_LDT][layer * 16 + g]);
    const float mag = expf(q.lr * q.dt), abr = mag * cosf(q.li * q.dt), abi = mag * sinf(q.li * q.dt);
    const float nr = abr - 1.0f, ni = abi, den = q.lr * q.lr + q.li * q.li;
    q.kr = (nr * q.lr + ni * q.li) / den; q.ki = (ni * q.lr - nr * q.li) / den; return q;
}
__device__ __forceinline__ void s5_pow(const S5P& q, float n, float& pr, float& pi) { const float m = expf(n * q.lr * q.dt), a = n * q.li * q.dt; pr = m * cosf(a); pi = m * sinf(a); }
__device__ __forceinline__ void phase_kfun(Frame& F, int layer) {
    const Args& A = *F.a; float* kf = (float*)(F.ws + WS_KFUN);
    for (int it = F.gw; it < 16 * 64; it += F.NGW) {
        const int g = it >> 6, tau = it & 63, lane = F.lane;
        const S5P q = s5_params(A, layer, g, lane); float pr, pi; s5_pow(q, (float)tau, pr, pi);
        const float wr_ = pr * q.kr - pi * q.ki, wi_ = pr * q.ki + pi * q.kr;
        const int h = lane >> 2, hp0 = 4 * (lane & 3);
        const float* cre = A.in[I_CRE] + ((size_t)(layer * 16 + g) * 16 + h) * 64; const float* cim = A.in[I_CIM] + ((size_t)(layer * 16 + g) * 16 + h) * 64;
        const float* bre = A.in[I_BRE] + (size_t)(layer * 16 + g) * 64 * 16 + hp0; const float* bim = A.in[I_BIM] + (size_t)(layer * 16 + g) * 64 * 16 + hp0;
        f32x4 acc = {0.f, 0.f, 0.f, 0.f};
        for (int p = 0; p < 64; ++p) {
            const float wpr = __shfl(wr_, p), wpi = __shfl(wi_, p);
            const float cr = cre[p], ci = cim[p], cwr = cr * wpr - ci * wpi, cwi = cr * wpi + ci * wpr;
            const f32x4 br = *(const f32x4*)(bre + p * 16), bi = *(const f32x4*)(bim + p * 16);
            acc += cwr * br - cwi * bi;
        }
        *(f32x4*)(kf + ((size_t)(g * 64 + tau) * 16 + h) * 16 + hp0) = acc;
    }
}
__device__ __forceinline__ void moe_starts(Frame& F, int j2, int (&st)[NE + 1]) {
    const unsigned* cnt = (const unsigned*)(F.ws + WS_CTL) + CW_MOE + 64 * j2; int s = 0;
#pragma unroll
    for (int e = 0; e < NE; ++e) { st[e] = s; const int c = (int)__hip_atomic_load(cnt + e, __ATOMIC_RELAXED, __HIP_MEMORY_SCOPE_AGENT); s += (c + 255) & ~255; }
    st[NE] = s;
}
__device__ __forceinline__ void moe_combine_row(Frame& F, int row, f32x4 (&v)[4], const int (&st)[NE + 1]) {
    const unsigned* rt = (const unsigned*)(F.ws + WS_ROUTE) + (size_t)row * 8;
    const v4u rr = *(const v4u*)rt; unsigned s0 = rr.z, s1 = rr.w;
#pragma unroll
    for (int e = 0; e < NE; ++e) { if ((int)rr.x == e) s0 += (unsigned)st[e]; if ((int)rr.y == e) s1 += (unsigned)st[e]; }
    const float w0 = __builtin_bit_cast(float, rt[4]), w1 = __builtin_bit_cast(float, rt[5]);
    const bf16* yp = (const bf16*)(F.ws + WS_XNP);
#pragma unroll
    for (int j = 0; j < 4; ++j) { const v2u a = *(const v2u*)(yp + (size_t)s0 * D + 4 * F.lane + 256 * j), b = *(const v2u*)(yp + (size_t)s1 * D + 4 * F.lane + 256 * j);
        v[j][0] += w0 * bflo(a.x) + w1 * bflo(b.x); v[j][1] += w0 * bfhi(a.x) + w1 * bfhi(b.x); v[j][2] += w0 * bflo(a.y) + w1 * bflo(b.y); v[j][3] += w0 * bfhi(a.y) + w1 * bfhi(b.y); }
}
__device__ __forceinline__ void phase_rows_mixer(Frame& F, int layer) {
    const Args& A = *F.a; const int lane = F.lane;
    const float* xin = A.in[I_X]; bf16* xb = (bf16*)(F.ws + WS_XB); const bool first = (layer == 0), comb = (layer > 0) && (((layer - 1) & 1) != 0);
    f32x4 gv[4]; f32x4 wf[4][4];
#pragma unroll
    for (int j = 0; j < 4; ++j) { gv[j] = *(const f32x4*)(A.in[I_GMIX] + layer * D + 4 * lane + 256 * j);
#pragma unroll
        for (int e = 0; e < 4; ++e) wf[j][e] = *(const f32x4*)(A.in[I_WIN] + (size_t)layer * D * DP + (size_t)(4 * lane + 256 * j + e) * DP + 1024); }
    const f32x4 bf = *(const f32x4*)(A.in[I_BFORGET] + layer * 4);
    bf16* xn = (bf16*)(F.ws + WS_XN); float* lf = (float*)(F.ws + WS_LF); unsigned char* xn8 = F.ws + WS_XN8;
    int st[NE + 1];
#pragma unroll
    for (int e = 0; e <= NE; ++e) st[e] = 0;
    if (comb) moe_starts(F, (layer - 1) >> 1, st);
    for (int row = F.gw; row < T; row += F.NGW) {
        f32x4 v[4]; float ss = 0.f;
        if (first) {
#pragma unroll
            for (int j = 0; j < 4; ++j) v[j] = *(const f32x4*)(xin + (size_t)row * D + 4 * lane + 256 * j);
        } else {
#pragma unroll
            for (int j = 0; j < 4; ++j) { const v2u r = *(const v2u*)(xb + (size_t)row * D + 4 * lane + 256 * j); v[j] = (f32x4){bflo(r.x), bfhi(r.x), bflo(r.y), bfhi(r.y)}; }
        }
        if (comb) { moe_combine_row(F, row, v, st);
#pragma unroll
            for (int j = 0; j < 4; ++j) { v2u o; o.x = pk2(v[j][0], v[j][1]); o.y = pk2(v[j][2], v[j][3]); *(v2u*)(xb + (size_t)row * D + 4 * lane + 256 * j) = o;
                v[j] = (f32x4){bflo(o.x), bfhi(o.x), bflo(o.y), bfhi(o.y)}; } }
#pragma unroll
        for (int j = 0; j < 4; ++j) ss += (v[j][0] * v[j][0] + v[j][1] * v[j][1]) + (v[j][2] * v[j][2] + v[j][3] * v[j][3]);
        const float rs = 1.0f / sqrtf(wave_sum(ss) * (1.0f / D) + EPS);
        f32x4 fl = {0.f, 0.f, 0.f, 0.f};
#pragma unroll
        for (int j = 0; j < 4; ++j) { const f32x4 h = v[j] * rs * gv[j];
            v2u o; o.x = pk2(h[0], h[1]); o.y = pk2(h[2], h[3]); *(v2u*)(xn + (size_t)row * D + 4 * lane + 256 * j) = o;
            if (F8_GATES) *(unsigned*)(xn8 + (size_t)row * D + 4 * lane + 256 * j) = pk4_fp8(h[0], h[1], h[2], h[3]);
#pragma unroll
            for (int e = 0; e < 4; ++e) fl += h[e] * wf[j][e]; }
#pragma unroll
        for (int e = 0; e < 4; ++e) fl[e] = wave_sum(fl[e]);
        if (lane == 0) { f32x4 o;
#pragma unroll
            for (int e = 0; e < 4; ++e) { const float xx = fl[e] + bf[e]; o[e] = (fminf(xx, 0.f) - log1pf(expf(-fabsf(xx)))) * LOG2E; }
            *(f32x4*)(lf + (size_t)row * 4) = o; }
    }
}
__device__ __forceinline__ void phase_s5_tables(Frame& F, int layer) {
    const Args& A = *F.a; const int lane = F.lane;
    bf16* wz = (bf16*)(F.ws + WS_WZ); bf16* wy = (bf16*)(F.ws + WS_WY); const float* kf = (const float*)(F.ws + WS_KFUN);
    for (int it = F.gw; it < 16 * 256; it += F.NGW) {
        const int g = it >> 8, rowz = it & 255; bf16* dst = wz + ((size_t)(g * 256 + rowz)) * 1024 + lane * 16;
        v4u o0 = {0u, 0u, 0u, 0u}, o1 = {0u, 0u, 0u, 0u};
        if (rowz < 128) { const int p = rowz >> 1, ri = rowz & 1; const S5P q = s5_params(A, layer, g, p); float pr, pi; s5_pow(q, (float)(63 - lane), pr, pi);
            const float wr_ = pr * q.kr - pi * q.ki, wi_ = pr * q.ki + pi * q.kr;
            const float* bre = A.in[I_BRE] + ((size_t)(layer * 16 + g) * 64 + p) * 16; const float* bim = A.in[I_BIM] + ((size_t)(layer * 16 + g) * 64 + p) * 16;
            float val[16];
#pragma unroll
            for (int h = 0; h < 16; ++h) { const float br = bre[h], bi = bim[h]; val[h] = ri == 0 ? (wr_ * br - wi_ * bi) : (wr_ * bi + wi_ * br); }
            o0 = (v4u){pk2(val[0], val[1]), pk2(val[2], val[3]), pk2(val[4], val[5]), pk2(val[6], val[7])};
            o1 = (v4u){pk2(val[8], val[9]), pk2(val[10], val[11]), pk2(val[12], val[13]), pk2(val[14], val[15])}; }
        *(v4u*)dst = o0; *(v4u*)(dst + 8) = o1;
    }
    for (int it = F.gw; it < 16 * 1024; it += F.NGW) {
        const int g = it >> 10, n = it & 1023, t = n >> 4, h = n & 15; bf16* dst = wy + ((size_t)(g * 1024 + n)) * S5_LDA;
        v4u o0 = {0u, 0u, 0u, 0u}, o1 = {0u, 0u, 0u, 0u};
        if (lane <= t) { const float* src = kf + ((size_t)(g * 64 + (t - lane)) * 16 + h) * 16;
            const f32x4 a = *(const f32x4*)src, b = *(const f32x4*)(src + 4), c = *(const f32x4*)(src + 8), d = *(const f32x4*)(src + 12);
            o0 = (v4u){pk2(a[0], a[1]), pk2(a[2], a[3]), pk2(b[0], b[1]), pk2(b[2], b[3])}; o1 = (v4u){pk2(c[0], c[1]), pk2(c[2], c[3]), pk2(d[0], d[1]), pk2(d[2], d[3])}; }
        *(v4u*)(dst + lane * 16) = o0; *(v4u*)(dst + lane * 16 + 8) = o1;
        const S5P q = s5_params(A, layer, g, lane); float pr, pi; s5_pow(q, (float)(t + 1), pr, pi);
        const float cr = A.in[I_CRE][((size_t)(layer * 16 + g) * 16 + h) * 64 + lane], ci = A.in[I_CIM][((size_t)(layer * 16 + g) * 16 + h) * 64 + lane];
        *(unsigned*)(dst + 1024 + 2 * lane) = pk2(cr * pr - ci * pi, -(cr * pi + ci * pr));
    }
}
__device__ __forceinline__ void phase_cumsum(Frame& F) {
    const int first = (gridDim.x >= 160) ? 128 : 0;
    if ((int)blockIdx.x < first || (int)blockIdx.x >= first + 32) return;
    const int bh = (int)blockIdx.x - first, b = bh >> 2, h = bh & 3, tid = F.tid;
    const float* lf = (const float*)(F.ws + WS_LF); float* cum = (float*)(F.ws + WS_CUM);
    LAS float* wtot = (LAS float*)(F.lds);
    float v[8]; float run = 0.f;
#pragma unroll
    for (int i = 0; i < 8; ++i) { run += lf[((size_t)b * SEQ + tid * 8 + i) * 4 + h]; v[i] = run; }
    float incl = run;
#pragma unroll
    for (int o = 1; o < 64; o <<= 1) { const float n = __shfl_up(incl, o); if (F.lane >= o) incl += n; }
    if (F.lane == 63) wtot[F.wave] = incl;
    __syncthreads();
    float base = incl - run;
    for (int w = 0; w < F.wave; ++w) base += wtot[w];
#pragma unroll
    for (int i = 0; i < 8; ++i) cum[(size_t)bh * SEQ + tid * 8 + i] = base + v[i];
    __syncthreads();
}
__device__ __forceinline__ void phase_conv(Frame& F, int layer) {
    const Args& A = *F.a; const int lane = F.lane;
    LAS f32x4* wl = (LAS f32x4*)F.lds;
    { int ly = layer; asm volatile("" : "+v"(ly));
      const float* cw = A.in[I_CONVW] + (size_t)ly * 31 * 256;
      for (int i = F.tid; i < 31 * 64; i += NWAVES * 64) wl[i] = *(const f32x4*)(cw + (size_t)i * 4); }
    __syncthreads();
    const f32x4 cb = *(const f32x4*)(A.in[I_CONVB] + layer * 256 + 4 * lane), lg = *(const f32x4*)(A.in[I_LNG] + layer * 256 + 4 * lane), lb = *(const f32x4*)(A.in[I_LNB] + layer * 256 + 4 * lane);
    const bf16* uc = (const bf16*)(F.ws + WS_UC); bf16* ycat = (bf16*)(F.ws + WS_YCAT);
    for (int run = F.gw; run < T / 8; run += F.NGW) {
        const int t0 = run * 8, tl0 = t0 & (SEQ - 1);
        f32x4 acc[8];
#pragma unroll
        for (int i = 0; i < 8; ++i) acc[i] = cb;
#pragma unroll
        for (int r = 0; r < 38; ++r) {
            v2u raw = {0u, 0u};
            if (tl0 - 30 + r >= 0) raw = *(const v2u*)(uc + (size_t)(t0 - 30 + r) * 256 + 4 * lane);
            const f32x4 x = {bflo(raw.x), bfhi(raw.x), bflo(raw.y), bfhi(raw.y)};
#pragma unroll
            for (int i = 0; i < 8; ++i) { const int j = r - i; if (j >= 0 && j < 31) acc[i] += wl[j * 64 + lane] * x; }
        }
#pragma unroll
        for (int i = 0; i < 8; ++i) {
            const f32x4 a = acc[i];
            const float mean = wave_sum((a[0] + a[1]) + (a[2] + a[3])) * (1.0f / 256.0f);
            const f32x4 dlt = a - mean;
            const float var = wave_sum((dlt[0] * dlt[0] + dlt[1] * dlt[1]) + (dlt[2] * dlt[2] + dlt[3] * dlt[3])) * (1.0f / 256.0f);
            const float rs = 1.0f / sqrtf(var + EPS);
            f32x4 y = dlt * rs * lg + lb;
#pragma unroll
            for (int e = 0; e < 4; ++e) y[e] = y[e] * sigmoidf_(y[e]);
            v2u o; o.x = pk2(y[0], y[1]); o.y = pk2(y[2], y[3]);
            *(v2u*)(ycat + (size_t)(t0 + i) * 1024 + 512 + 4 * lane) = o;
        }
    }
    __syncthreads();
}

typedef float f32x16 __attribute__((ext_vector_type(16)));
typedef short s16x4 __attribute__((ext_vector_type(4)));
constexpr int AW_BLKS = 11, AW_KEYS = 32 * AW_BLKS, AW_K = 0, AW_V = AW_KEYS * 128, AW_C = 2 * AW_KEYS * 128, AW_FLAG = AW_C + AW_KEYS * 4;
constexpr float SB_DEAD = -64.0f;
__device__ __forceinline__ s16x4 tr_read(const LAS unsigned char* p) { return __builtin_bit_cast(s16x4, __builtin_amdgcn_ds_read_tr16_b64_v4i16((LAS s16x4*)p)); }

template <int MODE>
__device__ __forceinline__ void attn_unit(Frame& F, int bh, int qb, const bf16* Q, const bf16* K, const bf16* V, const float* CUM, bf16* Y, float z2max) {
    const int tid = F.tid, lane = F.lane, w = F.wave, l31 = lane & 31, hh = lane >> 5;
    const int b = bh >> 2, h = bh & 3, qblk = qb * 8 + w, qw0 = 32 * qblk, qrow = qw0 + l31;
    const size_t rowbase = (size_t)b * SEQ;
    LAS unsigned char* lds = F.lds;
    LAS unsigned* flags = (LAS unsigned*)(lds + AW_FLAG);
    if (tid < 3) flags[tid] = 0u;
    bf16x8 qf[4];
#pragma unroll
    for (int s = 0; s < 4; ++s) qf[s] = *(const bf16x8*)(Q + (rowbase + qrow) * 256 + h * 64 + 16 * s + 8 * hh);
    f32x16 ot[2];
#pragma unroll
    for (int r = 0; r < 16; ++r) { ot[0][r] = 0.f; ot[1][r] = 0.f; }
    float m_run = -INFINITY, l_run = 0.f, carry = 0.f;
    const int ti = lane & 15, tq = ti >> 2, tp = ti & 3, tg = (lane >> 4) & 1;
    int kofs[4], vofs[2];
#pragma unroll
    for (int s = 0; s < 4; ++s) kofs[s] = AW_K + l31 * 128 + (((2 * s + hh) ^ (l31 & 7)) << 4);
#pragma unroll
    for (int db = 0; db < 2; ++db) vofs[db] = AW_V + (4 * hh + tq) * 128 + (((4 * db + 2 * tg + (tp >> 1)) ^ (4 * hh + tq)) << 4) + 8 * (tp & 1);
    const int srow = lane >> 3, sch = ((lane & 7) ^ srow) * 8;
    int kbw = qblk; bool done = false; int it = 0;
    for (int whi = qb * 8 + 7; whi >= 0; whi -= AW_BLKS, ++it) {
        const int wlo = whi - (AW_BLKS - 1), key0 = 32 * wlo;
        for (int g = w; g < 2 * AW_KEYS / 8; g += NWAVES) {
            const int gg = g < AW_KEYS / 8 ? g : g - AW_KEYS / 8; const int key = max(key0 + 8 * gg + srow, 0);
            const bf16* src = (g < AW_KEYS / 8 ? K : V) + (rowbase + key) * 256 + h * 64 + sch;
            __builtin_amdgcn_global_load_lds((const unsigned*)src, (LAS unsigned*)(lds + (g < AW_KEYS / 8 ? AW_K : AW_V) + gg * 1024), 16, 0, 0);
        }
        if (MODE == 0 && tid < AW_KEYS) *(LAS float*)(lds + AW_C + tid * 4) = -CUM[(size_t)bh * SEQ + max(key0 + tid, 0)];
        asm volatile("s_waitcnt vmcnt(0)" ::: "memory");
        __syncthreads();
        if (!done) {
            const int lo = max(wlo, 0);
            for (; kbw >= lo; --kbw) {
                const int kv0 = 32 * kbw, rb = (kbw - wlo) * 32;
                if (MODE == 0) { const float clast = *(const LAS float*)(lds + AW_C + (rb + 31) * 4); if (__all((z2max + clast - m_run) < SB_DEAD)) { done = true; break; } }
                else if (__all(carry < SB_DEAD)) { done = true; break; }
                f32x16 p;
                if (MODE == 0) {
#pragma unroll
                    for (int c = 0; c < 4; ++c) { const f32x4 ck = *(const LAS f32x4*)(lds + AW_C + (rb + 8 * c + 4 * hh) * 4); p[4 * c] = ck[0]; p[4 * c + 1] = ck[1]; p[4 * c + 2] = ck[2]; p[4 * c + 3] = ck[3]; }
                } else {
#pragma unroll
                    for (int r = 0; r < 16; ++r) p[r] = 0.f;
                }
#pragma unroll
                for (int s = 0; s < 4; ++s) { const bf16x8 kf = *(const LAS bf16x8*)(lds + rb * 128 + kofs[s]); p = __builtin_amdgcn_mfma_f32_32x32x16_bf16(kf, qf[s], p, 0, 0, 0); }
                const bool diag = (kbw == qblk);
                if (MODE == 0) {
                    if (diag) {
#pragma unroll
                        for (int r = 0; r < 16; ++r) { const int kvg = kv0 + (r & 3) + 8 * (r >> 2) + 4 * hh; if (kvg > qrow) p[r] = -INFINITY; }
                    }
                    float mt = p[0];
#pragma unroll
                    for (int r = 1; r < 16; ++r) mt = fmaxf(mt, p[r]);
                    mt = fmaxf(mt, __shfl_xor(mt, 32));
                    const float mn = fmaxf(m_run, mt), alpha = fast_exp2(m_run - mn); m_run = mn;
                    float rs = 0.f;
#pragma unroll
                    for (int r = 0; r < 16; ++r) { p[r] = fast_exp2(p[r] - mn); rs += p[r]; }
                    l_run = l_run * alpha + rs;
                    if (__any(alpha != 1.0f)) {
#pragma unroll
                        for (int r = 0; r < 16; ++r) { ot[0][r] *= alpha; ot[1][r] *= alpha; } }
                } else {
                    f32x16 lk;
#pragma unroll
                    for (int r = 0; r < 16; ++r) { const float z = p[r], e = fast_exp2(-fabsf(z)), lg = __builtin_amdgcn_logf(1.0f + e);
                        float lb = fminf(z, 0.f) - lg, k_ = -(fmaxf(z, 0.f) + lg);
                        if (diag) { const int kvg = kv0 + (r & 3) + 8 * (r >> 2) + 4 * hh; if (kvg >= qrow) { k_ = 0.f; lb = -INFINITY; } }
                        p[r] = lb; lk[r] = k_; }
                    float T4[4], To[4], PS[4];
#pragma unroll
                    for (int c = 0; c < 4; ++c) { T4[c] = (lk[4 * c] + lk[4 * c + 1]) + (lk[4 * c + 2] + lk[4 * c + 3]); To[c] = __shfl_xor(T4[c], 32); }
                    float run = 0.f;
#pragma unroll
                    for (int c = 3; c >= 0; --c) { PS[c] = run; run += T4[c] + To[c]; }
#pragma unroll
                    for (int c = 0; c < 4; ++c) { const float base = carry + PS[c] + (hh == 0 ? To[c] : 0.f);
                        const float s3 = lk[4 * c + 3], s2 = s3 + lk[4 * c + 2], s1 = s2 + lk[4 * c + 1];
                        p[4 * c + 3] = fast_exp2(p[4 * c + 3] + base); p[4 * c + 2] = fast_exp2(p[4 * c + 2] + base + s3);
                        p[4 * c + 1] = fast_exp2(p[4 * c + 1] + base + s2); p[4 * c] = fast_exp2(p[4 * c] + base + s1); }
                    carry += run;
                }
                bf16x8 pb[2];
#pragma unroll
                for (int c2 = 0; c2 < 2; ++c2) { v4u wv; wv.x = pg8::cvt_pk_bf16(p[8 * c2], p[8 * c2 + 1]); wv.y = pg8::cvt_pk_bf16(p[8 * c2 + 2], p[8 * c2 + 3]);
                    wv.z = pg8::cvt_pk_bf16(p[8 * c2 + 4], p[8 * c2 + 5]); wv.w = pg8::cvt_pk_bf16(p[8 * c2 + 6], p[8 * c2 + 7]); pb[c2] = __builtin_bit_cast(bf16x8, wv); }
#pragma unroll
                for (int db = 0; db < 2; ++db)
#pragma unroll
                    for (int c2 = 0; c2 < 2; ++c2) { const LAS unsigned char* vp = lds + (rb + 16 * c2) * 128 + vofs[db];
                        const s16x4 lo4 = tr_read(vp), hi4 = tr_read(vp + 8 * 128);
                        const bf16x8 va = {lo4[0], lo4[1], lo4[2], lo4[3], hi4[0], hi4[1], hi4[2], hi4[3]};
                        ot[db] = __builtin_amdgcn_mfma_f32_32x32x16_bf16(va, pb[c2], ot[db], 0, 0, 0); }
            }
            if (kbw < 0) done = true;
        }
        { const int sl = it % 3, sn = (it + 1) % 3;
            if (!done && lane == 0) flags[sl] = 1u;
            if (tid == 0) flags[sn] = 0u;
            __syncthreads();
            if (flags[sl] == 0u) break; }
    }
    float inv = 1.0f;
    if (MODE == 0) { const float lt = l_run + __shfl_xor(l_run, 32); inv = 1.0f / lt; }
    bf16* yrow = Y + (rowbase + qrow) * 1024 + h * 64;
#pragma unroll
    for (int db = 0; db < 2; ++db)
#pragma unroll
        for (int c = 0; c < 4; ++c) { v2u o; o.x = pg8::cvt_pk_bf16(ot[db][4 * c] * inv, ot[db][4 * c + 1] * inv); o.y = pg8::cvt_pk_bf16(ot[db][4 * c + 2] * inv, ot[db][4 * c + 3] * inv);
            *(v2u*)(yrow + 32 * db + 8 * c + 4 * hh) = o; }
}
__device__ __forceinline__ int q_pop(Frame& F, unsigned* ctr) {
    LAS int* slot = (LAS int*)(F.lds + QSLOT_OFF);
    __syncthreads();
    if (F.tid == 0) *slot = (int)__hip_atomic_fetch_add(ctr, 1u, __ATOMIC_RELAXED, __HIP_MEMORY_SCOPE_AGENT);
    __syncthreads();
    return *slot;
}
__device__ __forceinline__ void phase_attn_sb(Frame& F, int layer, int rep) {
    const bf16* qkv = (const bf16*)(F.ws + WS_QKV); const size_t sz = (size_t)T * 256; bf16* ycat = (bf16*)(F.ws + WS_YCAT);
    unsigned* ctr = (unsigned*)(F.ws + WS_CTL) + CW_Q + 128 * layer + 16 * rep;
    for (;;) { const int un = q_pop(F, ctr); if (un >= 512) break;
        attn_unit<1>(F, un & 31, 15 - (un >> 5), qkv + 3 * sz, qkv + 4 * sz, qkv + 5 * sz, nullptr, ycat + 768, 0.f); }
}
__device__ __forceinline__ void phase_attn_fox(Frame& F, int layer, int rep) {
    const bf16* qkv = (const bf16*)(F.ws + WS_QKV); const size_t sz = (size_t)T * 256; const float* cum = (const float*)(F.ws + WS_CUM); bf16* ycat = (bf16*)(F.ws + WS_YCAT);
    unsigned* ctr = (unsigned*)(F.ws + WS_CTL) + CW_Q + 128 * layer + 64 + 16 * rep;
    const float gq = fabsf(F.a->in[I_FQG][layer * 64 + F.lane]), gk = fabsf(F.a->in[I_FKG][layer * 64 + F.lane]);
    float mq = gq, mk = gk;
#pragma unroll
    for (int o = 1; o < 64; o <<= 1) { mq = fmaxf(mq, __shfl_xor(mq, o)); mk = fmaxf(mk, __shfl_xor(mk, o)); }
    const float z2max = 8.0f * mq * mk * LOG2E * 1.02f + 0.25f;
    const int nchunk = (conv_ffn_items(layer) + CONV_CHUNK - 1) / CONV_CHUNK;
    const int total = 512 + nchunk;
    for (;;) { const int t = q_pop(F, ctr); if (t >= total) break;
        const int na0 = (int)(((long)t * 512) / total), na1 = (int)(((long)(t + 1) * 512) / total);
        if (na1 > na0) attn_unit<0>(F, na0 & 31, 15 - (na0 >> 5), qkv, qkv + sz, qkv + 2 * sz, cum, ycat + 256, z2max);
        else convert_ffn_chunk(F, layer, t - na0); }
}
__device__ __forceinline__ void phase_s5_scan_unit(Frame& F, int layer, int g, int pm) {
    __builtin_amdgcn_fence(__ATOMIC_ACQUIRE, "agent");
    if (F.tid < 256) {
        const int b = 4 * pm + (F.tid >> 6), p = F.tid & 63;
        const S5P q = s5_params(*F.a, layer, g, p); float ar, ai; s5_pow(q, 64.0f, ar, ai);
        const float* z = (const float*)(F.ws + WS_Z); bf16* ua = (bf16*)(F.ws + WS_UA);
        float sr = 0.f, si = 0.f;
        for (int n0 = 0; n0 < 64; n0 += 16) {
            f32x2 zz[16];
#pragma unroll
            for (int j = 0; j < 16; ++j) zz[j] = *(const f32x2*)(z + ((size_t)g * 512 + b * 64 + n0 + j) * 128 + 2 * p);
#pragma unroll
            for (int j = 0; j < 16; ++j) { const size_t ch = (size_t)g * 512 + b * 64 + n0 + j;
                *(unsigned*)(ua + ch * S5_LDA + 1024 + 2 * p) = pk2(sr, si);
                const float nr = ar * sr - ai * si + zz[j][0], ni = ar * si + ai * sr + zz[j][1]; sr = nr; si = ni; }
        }
    }
    __syncthreads();
}
__device__ __forceinline__ void phase_rows_ffn(Frame& F, int layer) {
    const Args& A = *F.a; const int lane = F.lane; const int j2 = layer >> 1;
    f32x4 gv[4];
#pragma unroll
    for (int j = 0; j < 4; ++j) gv[j] = *(const f32x4*)(A.in[I_GFFN] + layer * D + 4 * lane + 256 * j);
    const bf16* xb = (const bf16*)(F.ws + WS_XB); unsigned char* seg = F.ws + WS_XNP; unsigned* route = (unsigned*)(F.ws + WS_ROUTE); unsigned* cnt = (unsigned*)(F.ws + WS_CTL) + CW_MOE + 64 * j2;
    unsigned my_e0 = 0, my_e1 = 0, my_r0 = 0, my_r1 = 0; float my_w0 = 0.f, my_w1 = 0.f, my_rs = 0.f; unsigned long long lc = 0ull; int nrow = 0;
    for (int row = F.gw; row < T; row += F.NGW, ++nrow) {
        f32x4 v[4]; float ss = 0.f;
#pragma unroll
        for (int j = 0; j < 4; ++j) { const v2u r = *(const v2u*)(xb + (size_t)row * D + 4 * lane + 256 * j); v[j] = (f32x4){bflo(r.x), bfhi(r.x), bflo(r.y), bfhi(r.y)};
            ss += (v[j][0] * v[j][0] + v[j][1] * v[j][1]) + (v[j][2] * v[j][2] + v[j][3] * v[j][3]); }
        const float rs = 1.0f / sqrtf(wave_sum(ss) * (1.0f / D) + EPS);
        float lg[8];
#pragma unroll
        for (int e = 0; e < 8; ++e) lg[e] = 0.f;
#pragma unroll
        for (int j = 0; j < 4; ++j) { const f32x4 h = v[j] * rs * gv[j];
#pragma unroll
            for (int e4 = 0; e4 < 4; ++e4) { const float* wr = A.in[I_RW] + ((size_t)j2 * D + 4 * lane + 256 * j + e4) * NE; const f32x4 a = *(const f32x4*)wr, b = *(const f32x4*)(wr + 4);
                lg[0] += h[e4] * a[0]; lg[1] += h[e4] * a[1]; lg[2] += h[e4] * a[2]; lg[3] += h[e4] * a[3]; lg[4] += h[e4] * b[0]; lg[5] += h[e4] * b[1]; lg[6] += h[e4] * b[2]; lg[7] += h[e4] * b[3]; } }
#pragma unroll
        for (int e = 0; e < 8; ++e) lg[e] = wave_sum(lg[e]) + A.in[I_RB][j2 * NE + e];
        int e0 = 0; float v0 = lg[0];
#pragma unroll
        for (int e = 1; e < 8; ++e) if (lg[e] > v0) { v0 = lg[e]; e0 = e; }
        int e1 = -1; float v1 = -INFINITY;
#pragma unroll
        for (int e = 0; e < 8; ++e) if (e != e0 && lg[e] > v1) { v1 = lg[e]; e1 = e; }
        const float w1 = 1.0f / (1.0f + expf(v0 - v1)), w0 = 1.0f - w1;
        const unsigned r0 = (unsigned)(lc >> (8 * e0)) & 0xffu; lc += 1ull << (8 * e0);
        const unsigned r1 = (unsigned)(lc >> (8 * e1)) & 0xffu; lc += 1ull << (8 * e1);
        if (lane == nrow) { my_e0 = e0; my_e1 = e1; my_r0 = r0; my_r1 = r1; my_w0 = w0; my_w1 = w1; my_rs = rs; }
    }
    unsigned basev = 0;
    if (lane < 8) { const unsigned c = (unsigned)(lc >> (8 * lane)) & 0xffu; basev = c ? __hip_atomic_fetch_add(cnt + lane, c, __ATOMIC_RELAXED, __HIP_MEMORY_SCOPE_AGENT) : 0u; }
    const unsigned my_p0 = __shfl(basev, (int)my_e0) + my_r0, my_p1 = __shfl(basev, (int)my_e1) + my_r1;
    if (lane < nrow) { const int row = F.gw + lane * F.NGW; unsigned* rt = route + (size_t)row * 8;
        *(v4u*)rt = (v4u){my_e0, my_e1, my_p0, my_p1}; *(v4u*)(rt + 4) = (v4u){__builtin_bit_cast(unsigned, my_w0), __builtin_bit_cast(unsigned, my_w1), 0u, 0u}; }
    for (int i = 0; i < nrow; ++i) {
        const int row = F.gw + i * F.NGW; const float rs = __shfl(my_rs, i);
        const size_t d0 = ((size_t)__shfl((int)my_e0, i) * T + (size_t)__shfl((int)my_p0, i)) * D, d1 = ((size_t)__shfl((int)my_e1, i) * T + (size_t)__shfl((int)my_p1, i)) * D;
#pragma unroll
        for (int j = 0; j < 4; ++j) { const v2u r = *(const v2u*)(xb + (size_t)row * D + 4 * lane + 256 * j);
            const f32x4 h = (f32x4){bflo(r.x), bfhi(r.x), bflo(r.y), bfhi(r.y)} * rs * gv[j]; const unsigned w = pk4_fp8(h[0], h[1], h[2], h[3]);
            *(unsigned*)(seg + d0 + 4 * lane + 256 * j) = w; *(unsigned*)(seg + d1 + 4 * lane + 256 * j) = w; }
    }
}
__device__ __forceinline__ void phase_final_combine(Frame& F) {
    const Args& A = *F.a; int st[NE + 1]; moe_starts(F, (DEPTH - 1) >> 1, st);
    for (int row = F.gw; row < T; row += F.NGW) {
        f32x4 v[4];
#pragma unroll
        for (int j = 0; j < 4; ++j) { const v2u r = *(const v2u*)((const bf16*)(F.ws + WS_XB) + (size_t)row * D + 4 * F.lane + 256 * j); v[j] = (f32x4){bflo(r.x), bfhi(r.x), bflo(r.y), bfhi(r.y)}; }
        moe_combine_row(F, row, v, st);
#pragma unroll
        for (int j = 0; j < 4; ++j) *(f32x4*)(A.out + (size_t)row * D + 4 * F.lane + 256 * j) = v[j];
    }
}

__global__ void __launch_bounds__(NWAVES * 64, 2) mk_fwd(Args args) {
    extern __shared__ __attribute__((aligned(16))) unsigned char lds_raw[];
    Frame F; F.lds = (LAS unsigned char*)lds_raw; F.tid = threadIdx.x; F.lane = F.tid & 63; F.wave = __builtin_amdgcn_readfirstlane(F.tid >> 6);
    F.G = gridDim.x; { const int bx = blockIdx.x; F.vcu = (F.G % 8 == 0) ? (bx % 8) * (F.G / 8) + bx / 8 : bx; }
    F.gw = F.vcu * NWAVES + F.wave; F.NGW = F.G * NWAVES; F.a = &args; F.ws = args.ws;
    volatile LAS unsigned* MISC = (volatile LAS unsigned*)(F.lds + MISC_OFF);
    for (int u = F.tid; u < (LDS_BYTES - RING_BYTES) / 4; u += NWAVES * 64) ((LAS unsigned*)(F.lds + RING_BYTES))[u] = 0u;
    __syncthreads();
    unsigned* ctl = (unsigned*)(args.ws + WS_CTL);
    const bool multi = (args.gp_hi - args.gp_lo) > 1;
    XcdBarrier bar; bar.bar = ctl + CW_BAR; bar.x = 0; bar.st = nullptr;
    if (multi) bar = xcd_barrier_post(ctl + CW_BAR, MISC + 8);
    unsigned char* ws = args.ws;
    LAS unsigned char* ring = F.lds;

    const int gp_lo = args.gp_lo, gp_hi = args.gp_hi;
#define IN(p) (gp_lo <= layer * NPH + (p) && layer * NPH + (p) < gp_hi)
#define SEAM(p) do { if (IN(p) && layer * NPH + (p) + 1 < gp_hi) xcd_barrier(bar); } while (0)
#ifndef PH_MASK
#define PH_MASK 0xffff
#endif
#define ON(p) (((PH_MASK) >> (p)) & 1)
#ifndef PROBE_PH
#define PROBE_PH -1
#endif
#ifndef PROBE_N
#define PROBE_N 1
#endif
#ifndef PROBE_LAYERS
#define PROBE_LAYERS 15
#endif
#define REPS(p) ((((p) == PROBE_PH) && ((PROBE_LAYERS >> layer) & 1)) ? 1 + PROBE_N : 1)
#define SUBREPS(p) for (int r2_ = 0; r2_ < REPS(p); ++r2_)
#define ENTER() do { LAYER_REFRESH(); ws = args.ws; asm volatile("" : "+s"(ws)); F.ws = ws; int t_ = threadIdx.x; asm volatile("" : "+v"(t_)); F.tid = t_; F.lane = t_ & 63; F.wave = __builtin_amdgcn_readfirstlane(t_ >> 6); F.gw = F.vcu * NWAVES + F.wave; } while (0)
#define LAYER_REFRESH() do { int l_ = layer_iv; asm volatile("" : "+v"(l_)); layer = __builtin_amdgcn_readfirstlane(l_); } while (0)
    for (int layer_iv = gp_lo / NPH; layer_iv < DEPTH && layer_iv * NPH < gp_hi; ++layer_iv) {
        int layer; LAYER_REFRESH();
        const bool moe = (layer & 1) != 0;
#if ON(0)
        if (IN(0)) for (int rep_ = 0; rep_ < REPS(0); ++rep_) { ENTER(); for (int r2_ = 0; r2_ < ((PROBE_PH == 100) ? 1 + PROBE_N : 1); ++r2_) { phase_convert(F, layer); phase_kfun(F, layer); } phase_rows_mixer(F, layer); }
        SEAM(0);
#endif
#if ON(1)
        if (IN(1)) for (int rep_ = 0; rep_ < REPS(1); ++rep_) { ENTER();
            phase_s5_tables(F, layer); phase_cumsum(F);
#if F8_GATES
            { pg8::Gemm g8{(const bf16*)(ws + WS_XN8), (const bf16*)(ws + WS_WIN8), D / 2, D / 2, D / 2}; pg8::StaticOrder S8; S8.init(T, 4096, F.G, (int)blockIdx.x, D / 2, D / 2);
              if (F.G == 256) S8.full = 7;
              pg8::EpiGateSig E8; E8.gate = (bf16*)(ws + WS_GATE);
              pg8::gemm_phase<pg8::EpiGateSig, pg8::StaticOrder, true, true>(ring, g8, S8, E8); }
#endif
            pg8::Gemm g{(const bf16*)(ws + WS_XN), (const bf16*)(ws + WS_WIN), D, D, D}; pg8::StaticOrder S; S.init(T, F8_GATES ? 2304 : NPROJ, F.G, (int)blockIdx.x, D, D);
            pg8::EpiInProj E; E.ua = (bf16*)(ws + WS_UA); E.qkv = (bf16*)(ws + WS_QKV); E.uc = (bf16*)(ws + WS_UC); E.gate = (bf16*)(ws + WS_GATE);
            { LAS float* gl = (LAS float*)(F.lds + GAIN_OFF);
              if (F.tid < 256) { const int w = F.tid >> 6, d = F.tid & 63; const float* src = (w == 0) ? args.in[I_FQG] : (w == 1) ? args.in[I_FKG] : (w == 2) ? args.in[I_SQG] : args.in[I_SKG];
                  gl[F.tid] = src[layer * 64 + d] * ((w == 0 || w == 2) ? QSCALE : 1.0f); }
              __syncthreads(); E.gl = gl; }
            pg8::gemm_phase<pg8::EpiInProj, pg8::StaticOrder, true>(ring, g, S, E);
        }
        SEAM(1);
#endif
#if ON(2)
        if (IN(2)) for (int rep_ = 0; rep_ < REPS(2); ++rep_) { ENTER();
            { pg8::Gemm g{(const bf16*)(ws + WS_UA), (const bf16*)(ws + WS_WZ), 1024, S5_LDA, 1024};
              pg8::BatchOrder S; S.nM = 2; S.nN = 1; S.nZ = 16; S.G = F.G; S.c = (int)blockIdx.x; S.tA = (size_t)256 * S5_LDA * 2; S.tB = 0; S.zA = (size_t)512 * S5_LDA * 2; S.zB = (size_t)256 * 1024 * 2;
              pg8::EpiZ E; E.z = (float*)(ws + WS_Z);
              SUBREPS(106) { pg8::gemm_phase<pg8::EpiZ, pg8::BatchOrder, false>(ring, g, S, E);
              if ((int)blockIdx.x < 32) phase_s5_scan_unit(F, layer, (int)blockIdx.x >> 1, (int)blockIdx.x & 1); } }
            SUBREPS(103) phase_conv(F, layer);
            SUBREPS(102) phase_attn_sb(F, layer, rep_ + r2_);
        }
        SEAM(2);
#endif
#if ON(4)
        if (IN(4)) for (int rep_ = 0; rep_ < REPS(4); ++rep_) { ENTER();
            { pg8::Gemm g{(const bf16*)(ws + WS_UA), (const bf16*)(ws + WS_WY), S5_LDA, S5_LDA, S5_LDA};
              pg8::BatchOrder S; S.nM = 2; S.nN = 4; S.nZ = 16; S.G = F.G; S.c = (int)blockIdx.x; S.tA = (size_t)256 * S5_LDA * 2; S.tB = (size_t)256 * S5_LDA * 2; S.zA = (size_t)512 * S5_LDA * 2; S.zB = (size_t)1024 * S5_LDA * 2;
              pg8::EpiY E; E.ua = (const bf16*)(ws + WS_UA); E.dskip = args.in[I_S5D] + layer * 256; E.yp = (bf16*)(ws + WS_YP);
              SUBREPS(105) pg8::gemm_phase<pg8::EpiY, pg8::BatchOrder, false>(ring, g, S, E); }
            SUBREPS(104) phase_attn_fox(F, layer, rep_ + r2_);
        }
        SEAM(4);
#endif
#if ON(5)
        if (IN(5) && F.G != 256) for (int rep_ = 0; rep_ < REPS(5); ++rep_) { ENTER();
            pg8::Gemm g{(const bf16*)(ws + WS_YP), (const bf16*)(ws + WS_WGLU), 256, 256, 256};
            pg8::BatchOrder S; S.nM = T / 256; S.nN = 1; S.nZ = 1; S.G = F.G; S.c = (int)blockIdx.x; S.tA = (size_t)256 * 256 * 2; S.tB = 0; S.zA = 0; S.zB = 0;
            pg8::EpiGlu E; E.yp = (const bf16*)(ws + WS_YP); E.ycat = (bf16*)(ws + WS_YCAT);
            pg8::gemm_phase<pg8::EpiGlu, pg8::BatchOrder, false>(ring, g, S, E);
        }
        if (F.G != 256) SEAM(5);
#endif
#if ON(6)
        if (IN(6)) for (int rep_ = 0; rep_ < REPS(6); ++rep_) { ENTER();
            const int paired = (F.G == 256) ? 1 : 0;
            if (paired) {
                pg8::Gemm g{(const bf16*)(ws + WS_YP), (const bf16*)(ws + WS_WGLU), 256, 256, 256};
                pg8::OneUnit S; S.pm = F.vcu >> 1; S.tA = (size_t)256 * 256 * 2;
                pg8::EpiGlu E; E.yp = (const bf16*)(ws + WS_YP); E.ycat = (bf16*)(ws + WS_YCAT);
                pg8::gemm_phase<pg8::EpiGlu, pg8::OneUnit, false>(ring, g, S, E);
            }
            pg8::Gemm g{(const bf16*)(ws + WS_YCAT), (const bf16*)(ws + WS_WBR), 256, 1024, 256};
            pg8::BranchOrder1 S; S.nM = T / 256; S.nN = 8; S.G = F.G; S.c = (int)blockIdx.x; S.tA = (size_t)256 * 1024 * 2; S.tB = (size_t)128 * 256 * 2; S.zA = 256 * 2; S.zB = (size_t)1024 * 256 * 2; S.paired = paired; S.vc = F.vcu;
            pg8::EpiGate1 E; E.gate = (const bf16*)(ws + WS_GATE); E.mb = (bf16*)(ws + WS_XN);
            pg8::gemm_phase_n1<pg8::EpiGate1, pg8::BranchOrder1>(ring, g, S, E);
        }
        SEAM(6);
#endif
#if ON(7)
        if (IN(7)) for (int rep_ = 0; rep_ < REPS(7); ++rep_) { ENTER();
            pg8::Gemm g{(const bf16*)(ws + WS_XN), (const bf16*)(ws + WS_WOUT), D, D, D}; pg8::StaticOrder S; S.init(T, D, F.G, (int)blockIdx.x, D, D);
            pg8::EpiResid<false> E; E.base32 = args.in[I_X]; E.base16 = (const bf16*)(ws + WS_XB); E.out = (bf16*)(ws + WS_XB); E.ss = (float*)(ws + WS_SSP); E.out8 = ws + WS_XN8;
            E.flags = ((layer == 0) ? 1 : 0) | ((FUSE_DENSE_NORM && !moe) ? 2 : 0) | ((FUSE_DENSE_NORM && !moe && DENSE8(layer)) ? 4 : 0);
            pg8::gemm_phase<pg8::EpiResid<false>, pg8::StaticOrder, true>(ring, g, S, E);
        }
        SEAM(7);
#endif
#if ON(8)
        if (IN(8)) for (int rep_ = 0; rep_ < REPS(8); ++rep_) { ENTER(); if (moe || !FUSE_DENSE_NORM) phase_rows_ffn(F, layer); }
        if (moe || !FUSE_DENSE_NORM) SEAM(8);
#endif
#if ON(10)
        if (IN(10)) for (int rep_ = 0; rep_ < REPS(10); ++rep_) { ENTER();
            if (!moe) {
                if (DENSE8(layer)) {
                    constexpr int DQ = D / 2;
                    pg8::Gemm g{(const bf16*)(ws + (FUSE_DENSE_NORM ? WS_XN8 : WS_XN)), (const bf16*)(ws + WS_WUP), DQ, DQ, DQ}; pg8::StaticOrder S; S.init(T, 2 * FF, F.G, (int)blockIdx.x, DQ, DQ);
                    pg8::EpiSwiGlu<true> E; E.h = (bf16*)(ws + WS_HH); E.sc = 1.0f / 64.0f; E.ss = (const float*)(ws + WS_SSP); E.use_ss = FUSE_DENSE_NORM;
                    pg8::gemm_phase<pg8::EpiSwiGlu<true>, pg8::StaticOrder, true, true>(ring, g, S, E);
                } else {
                    pg8::Gemm g{(const bf16*)(ws + (FUSE_DENSE_NORM ? WS_XB : WS_XN)), (const bf16*)(ws + WS_WUP), D, D, D}; pg8::StaticOrder S; S.init(T, 2 * FF, F.G, (int)blockIdx.x, D, D);
                    pg8::EpiSwiGlu<false> E; E.h = (bf16*)(ws + WS_HH); E.sc = 1.0f; E.ss = (const float*)(ws + WS_SSP); E.use_ss = FUSE_DENSE_NORM;
                    pg8::gemm_phase<pg8::EpiSwiGlu<false>, pg8::StaticOrder, true, false>(ring, g, S, E);
                }
            } else {
                constexpr bool U8 = F8_MOE_UP != 0, H8 = F8_MOE_DN != 0; constexpr int DQ = U8 ? D / 2 : D;
                pg8::Gemm g{(const bf16*)(ws + WS_XNP), (const bf16*)(ws + WS_WUP), DQ, DQ, DQ};
                pg8::GroupOrder S; S.nN = 22; S.G = F.G; S.c = (int)blockIdx.x; S.tA = (size_t)256 * DQ * 2; S.tB = (size_t)256 * DQ * 2; S.zB = (size_t)5632 * DQ * 2; S.zA = (size_t)T * DQ * 2;
                int st[NE + 1]; moe_starts(F, layer >> 1, st);
#pragma unroll
                for (int e = 0; e <= NE; ++e) S.ts[e] = __builtin_amdgcn_readfirstlane(st[e] >> 8);
                pg8::EpiSwiGlu<H8> E; E.h = (bf16*)(ws + WS_HP); E.sc = U8 ? (1.0f / 64.0f) : 1.0f; E.ss = (const float*)(ws + WS_SSP); E.use_ss = 0;
                pg8::gemm_phase<pg8::EpiSwiGlu<H8>, pg8::GroupOrder, true, U8>(ring, g, S, E);
            }
        }
        SEAM(10);
#endif
#if ON(11)
        if (IN(11)) for (int rep_ = 0; rep_ < REPS(11); ++rep_) { ENTER();
            if (!moe) {
                if (DENSE8(layer)) {
                    constexpr int FQ = FF / 2;
                    pg8::Gemm g{(const bf16*)(ws + WS_HH), (const bf16*)(ws + WS_WDN), FQ, FQ, FQ}; pg8::StaticOrder S; S.init(T, D, F.G, (int)blockIdx.x, FQ, FQ);
                    pg8::EpiResid<true> E; E.base32 = args.in[I_X]; E.base16 = (const bf16*)(ws + WS_XB); E.out = (bf16*)(ws + WS_XB); E.ss = (float*)(ws + WS_SSP); E.out8 = ws + WS_XN8; E.flags = 0;
                    pg8::gemm_phase<pg8::EpiResid<true>, pg8::StaticOrder, true, true>(ring, g, S, E);
                } else {
                    pg8::Gemm g{(const bf16*)(ws + WS_HH), (const bf16*)(ws + WS_WDN), FF, FF, FF}; pg8::StaticOrder S; S.init(T, D, F.G, (int)blockIdx.x, FF, FF);
                    pg8::EpiResid<false> E; E.base32 = args.in[I_X]; E.base16 = (const bf16*)(ws + WS_XB); E.out = (bf16*)(ws + WS_XB); E.ss = (float*)(ws + WS_SSP); E.out8 = ws + WS_XN8; E.flags = 0;
                    pg8::gemm_phase<pg8::EpiResid<false>, pg8::StaticOrder, true, false>(ring, g, S, E);
                }
            } else {
                constexpr bool F8 = F8_MOE_DN != 0; constexpr int FQ = F8 ? FF / 2 : FF;
                pg8::Gemm g{(const bf16*)(ws + WS_HP), (const bf16*)(ws + WS_WDN), FQ, FQ, FQ};
                pg8::GroupOrder S; S.nN = 4; S.G = F.G; S.c = (int)blockIdx.x; S.tA = (size_t)256 * FQ * 2; S.tB = (size_t)256 * FQ * 2; S.zB = (size_t)D * FQ * 2; S.zA = 0;
                int st[NE + 1]; moe_starts(F, layer >> 1, st);
#pragma unroll
                for (int e = 0; e <= NE; ++e) S.ts[e] = __builtin_amdgcn_readfirstlane(st[e] >> 8);
                pg8::EpiStore E; E.o = (bf16*)(ws + WS_XNP); E.sc = F8 ? (1.0f / 64.0f) : 1.0f;
                pg8::gemm_phase<pg8::EpiStore, pg8::GroupOrder, true, F8>(ring, g, S, E);
            }
        }
        SEAM(11);
#endif
    }
#if ON(12)
    if (gp_lo <= GP_FINAL && GP_FINAL < gp_hi) phase_final_combine(F);
#endif
}

extern "C" void kernel_launch(void* const* d_in, const int* in_sizes, int n_in, void* d_out, int out_size, void* d_ws, size_t ws_size, hipStream_t stream) {
    static int grid = 0;
    if (grid == 0) {
        if (n_in != 32 || in_sizes[0] != T * D || out_size != T * D || ws_size < WS_END) { fprintf(stderr, "kernel_launch: unexpected shapes / workspace (n_in %d, ws %zu < %zu)\n", n_in, ws_size, (size_t)WS_END); grid = -1; return; }
        int dev = 0, cus = 0, per_cu = 0;
        if (hipGetDevice(&dev) != hipSuccess || hipDeviceGetAttribute(&cus, hipDeviceAttributeMultiprocessorCount, dev) != hipSuccess) { grid = -1; return; }
        if (hipFuncSetAttribute((const void*)mk_fwd, hipFuncAttributeMaxDynamicSharedMemorySize, LDS_BYTES) != hipSuccess) { grid = -1; return; }
        if (hipOccupancyMaxActiveBlocksPerMultiprocessor(&per_cu, (const void*)mk_fwd, NWAVES * 64, LDS_BYTES) != hipSuccess || per_cu < 1) fprintf(stderr, "kernel_launch: occupancy query says %d\n", per_cu);
        (void)hipGetLastError();
        grid = cus;
    }
    if (grid < 0) return;
    if (hipMemsetAsync((char*)d_ws + WS_CTL, 0, CTL_ZERO_BYTES, stream) != hipSuccess) return;
    Args a{};
    for (int i = 0; i < 32; ++i) a.in[i] = (const float*)d_in[i];
    a.out = (float*)d_out; a.ws = (unsigned char*)d_ws;
    a.gp_lo = 0; a.gp_hi = GP_TOTAL;
    hipLaunchKernelGGL(mk_fwd, dim3(grid), dim3(NWAVES * 64), LDS_BYTES, stream, a);
}
```

```cpp
#include <hip/hip_runtime.h>
#include <cstdio>
#include <cstdint>

#ifndef F8_DENSE_MASK
#define F8_DENSE_MASK 4
#endif
#define DENSE8(layer) (((F8_DENSE_MASK) >> (layer)) & 1)
#ifndef F8_MOE_UP
#define F8_MOE_UP 1
#endif
#ifndef FUSE_DENSE_NORM
#define FUSE_DENSE_NORM 1
#endif
#ifndef GATE8
#define GATE8 2
#endif
#ifndef BR_WG
#define BR_WG 4
#endif
#ifndef F8_GATES
#define F8_GATES 1
#endif
#ifndef F8_MOE_DN
#define F8_MOE_DN 1
#endif

#define GAS __attribute__((address_space(1)))
#define LAS __attribute__((address_space(3)))
typedef unsigned short bf16;
typedef unsigned v4u __attribute__((ext_vector_type(4)));
typedef unsigned v2u __attribute__((ext_vector_type(2)));
typedef float f32x4 __attribute__((ext_vector_type(4)));
typedef float f32x2 __attribute__((ext_vector_type(2)));
typedef short bf16x8 __attribute__((ext_vector_type(8)));

constexpr int NB = 8, SEQ = 4096, D = 1024, DEPTH = 4, T = NB * SEQ;
constexpr int DP = 6404, NPROJ = 6400, FF = 2816, NE = 8;
constexpr float EPS = 1e-6f, LOG2E = 1.4426950408889634f;
constexpr float QSCALE = 0.125f * LOG2E;
constexpr int MOE_ROWS = 2 * T + NE * 256;
constexpr int S5_LDA = 1152;

constexpr size_t MiB = 1u << 20;
constexpr size_t WS_CTL = 0, CTL_ZERO_BYTES = 1 * MiB;
constexpr size_t WS_WIN = 1 * MiB;
constexpr size_t WS_WIN8 = WS_WIN + (size_t)2304 * D * 2;
constexpr size_t WS_WBR = WS_WIN + (size_t)NPROJ * D * 2;
constexpr size_t WS_WOUT = WS_WBR + 2 * MiB;
constexpr size_t WS_WGLU = WS_WOUT + 2 * MiB;
constexpr size_t WS_WZ = WS_WGLU + 128 * 1024;
constexpr size_t WS_WY = WS_WZ + 8 * MiB;
constexpr size_t WS_WUP = WS_WY + 36 * MiB;
constexpr size_t WS_WDN = WS_WUP + 88 * MiB;
constexpr size_t WS_KFUN = WS_WDN + 44 * MiB;
constexpr size_t WS_ROUTE = WS_KFUN + 1 * MiB;
constexpr size_t WS_LF = WS_ROUTE + 1 * MiB;
constexpr size_t WS_CUM = WS_LF + 512 * 1024;
constexpr size_t WS_XN = 198 * MiB;
static_assert(WS_CUM + 512 * 1024 <= WS_XN, "ws map");
constexpr size_t WS_R = WS_XN + 64 * MiB;
constexpr size_t WS_GATE = WS_R;
constexpr size_t WS_QKV = WS_GATE + 256 * MiB;
constexpr size_t WS_UC = WS_QKV + 96 * MiB;
constexpr size_t WS_UA = WS_UC + 16 * MiB;
constexpr size_t WS_Z = WS_UA + 18 * MiB;
constexpr size_t WS_YP = WS_Z + 4 * MiB;
constexpr size_t WS_YCAT = WS_YP + 16 * MiB;
constexpr size_t WS_MIX_END = WS_YCAT + 64 * MiB;
constexpr size_t WS_XN8 = WS_YCAT;
constexpr size_t WS_HH = WS_R;
constexpr size_t WS_XNP = WS_R;
constexpr size_t WS_HP = WS_XNP + (size_t)NE * T * D;
constexpr size_t WS_FFN_END = WS_HP + (size_t)MOE_ROWS * FF;
static_assert(F8_MOE_UP && F8_MOE_DN, "the MoE path stores its rows and hidden activations as e4m3 bytes");
constexpr size_t WS_XB = ((WS_MIX_END > WS_FFN_END ? WS_MIX_END : WS_FFN_END) + MiB - 1) / MiB * MiB;
constexpr size_t WS_SSP = WS_XB + 64 * MiB;
constexpr size_t WS_END = WS_SSP + 2 * MiB;
static_assert(WS_END <= 856 * MiB, "ws budget");
constexpr int CW_BAR = 4096;
constexpr int CW_Q = 20480;
constexpr int CW_MOE = 16384;

constexpr int RING_BYTES = 131072, MISC_OFF = RING_BYTES + 320, GAIN_OFF = RING_BYTES + 1024, QSLOT_OFF = RING_BYTES + 64, LDS_BYTES = 147456;
constexpr int NWAVES = 8;

__device__ __forceinline__ unsigned f2bf(float f) { unsigned u = __builtin_bit_cast(unsigned, f); return (u + 0x7fffu + ((u >> 16) & 1u)) >> 16; }
__device__ __forceinline__ unsigned pk2(float lo, float hi) { return f2bf(lo) | (f2bf(hi) << 16); }
__device__ __forceinline__ float bflo(unsigned u) { return __builtin_bit_cast(float, u << 16); }
__device__ __forceinline__ float bfhi(unsigned u) { return __builtin_bit_cast(float, u & 0xffff0000u); }
__device__ __forceinline__ float bf2f(bf16 v) { return __builtin_bit_cast(float, (unsigned)v << 16); }
__device__ __forceinline__ float wave_sum(float v) {
#pragma unroll
    for (int o = 1; o < 64; o <<= 1) v += __shfl_xor(v, o);
    return v;
}
__device__ __forceinline__ float fast_exp2(float x) { return __builtin_amdgcn_exp2f(x); }
__device__ __forceinline__ float fast_rcp(float x) { return __builtin_amdgcn_rcpf(x); }
__device__ __forceinline__ float sigmoidf_(float x) { return fast_rcp(1.0f + fast_exp2(-x * LOG2E)); }
__device__ __forceinline__ f32x2 sigmoid2(f32x2 x) { const f32x2 a = x * (-LOG2E); f32x2 t = {fast_exp2(a[0]), fast_exp2(a[1])}; t = t + 1.0f; return (f32x2){fast_rcp(t[0]), fast_rcp(t[1])}; }
__device__ __forceinline__ float gelu_tanh(float y) { const float u = 0.7978845608028654f * (y + 0.044715f * y * y * y); return y * sigmoidf_(2.0f * u); }
__device__ __forceinline__ unsigned pk4_fp8(float a, float b, float c, float d) { unsigned w = 0u; w = (unsigned)__builtin_amdgcn_cvt_pk_fp8_f32(a, b, (int)w, false); w = (unsigned)__builtin_amdgcn_cvt_pk_fp8_f32(c, d, (int)w, true); return w; }
#define LDS_WAIT() asm volatile("s_waitcnt lgkmcnt(0)" ::: "memory")
#define VM_WAIT() asm volatile("s_waitcnt vmcnt(0)" ::: "memory")

namespace pg8 {
#define PG8_LAS __attribute__((address_space(3)))
typedef unsigned short bf16_t;
typedef unsigned u32x4 __attribute__((ext_vector_type(4)));
typedef int v4i __attribute__((ext_vector_type(4)));
typedef int v8i __attribute__((ext_vector_type(8)));
constexpr int BM = 256, BK = 64, HALF = 128, HTB = HALF * BK * 2, STAGE_BYTES = 8 * HTB, NXCD = 8, WGM = 8;
__host__ __device__ __forceinline__ int lds_byte(int r, int c) { const int st = (r >> 4) * 2 + (c >> 5), rr = r & 15, cc = c & 31, ob = rr * 64 + cc * 2; return st * 1024 + (ob ^ (((ob >> 9) & 1) << 5)); }
__host__ __device__ __forceinline__ void stage_rc(int b, int& R, int& C) { const int st = b / 1024, sb = b % 1024, swz = sb ^ (((sb >> 9) & 1) << 5); R = (st >> 1) * 16 + swz / 64; C = (st & 1) * 32 + (swz % 64) / 2; }
__host__ __device__ __forceinline__ int perm32(int rho) { const int n = rho >> 4, i = rho & 15; return 8 * (i >> 2) + 4 * n + (i & 3); }

struct Unit { int pm, pn, z; size_t offA, offB; };
struct Gemm { const bf16_t* A; const bf16_t* Bt; int K, lda, ldb; };

template <int WG = WGM> __device__ __forceinline__ void xcd_tile_map(int L, int nM, int nN, int& pm, int& pn) {
    const int nwg = nM * nN; int wgid = L; { const int q = nwg / NXCD, r = nwg % NXCD, xcd = wgid % NXCD, off = wgid / NXCD; wgid = (xcd < r ? xcd * (q + 1) : r * (q + 1) + (xcd - r) * q) + off; }
    const int nig = WG * nN, gid = wgid / nig, fm = gid * WG, gsz = (nM - fm) < WG ? (nM - fm) : WG;
    pm = fm + ((wgid % nig) % gsz); pn = (wgid % nig) / gsz;
}
struct StaticOrder {
    int nM, nN, nwg, G, c, full; size_t tA, tB;
    __device__ void init(int M, int N, int G_, int c_, int lda, int ldb) { nM = M / BM; nN = N / BM; nwg = nM * nN; G = G_; c = c_; full = 1 << 20; tA = (size_t)BM * lda * 2; tB = (size_t)BM * ldb * 2; }
    __device__ bool next(int i, Unit& u) const {
        long L = (long)i * G + c;
        if (i >= full) { const int h = G >> 1; if (c < h) return false; L = (long)full * G + (long)(i - full) * h + (c - h); }
        if (L >= nwg) return false;
        int wgid = (int)L; { const int q = nwg / NXCD, r = nwg % NXCD, xcd = wgid % NXCD, off = wgid / NXCD; wgid = (xcd < r ? xcd * (q + 1) : r * (q + 1) + (xcd - r) * q) + off; }
        const int nig = WGM * nN, gid = wgid / nig, fm = gid * WGM, gsz = (nM - fm) < WGM ? (nM - fm) : WGM;
        u.pm = fm + ((wgid % nig) % gsz); u.pn = (wgid % nig) / gsz; u.z = 0; u.offA = (size_t)u.pm * tA; u.offB = (size_t)u.pn * tB; return true;
    }
};
struct BatchOrder {
    int nM, nN, nZ, G, c; size_t tA, tB, zA, zB;
    __device__ bool next(int i, Unit& u) const {
        const int L = i * G + c; if (L >= nM * nN * nZ) return false;
        u.z = L / (nM * nN); const int r = L % (nM * nN); u.pm = r / nN; u.pn = r % nN;
        u.offA = (size_t)u.z * zA + (size_t)u.pm * tA; u.offB = (size_t)u.z * zB + (size_t)u.pn * tB; return true;
    }
};
struct GroupOrder {
    int nN, G, c; int ts[NE + 1]; size_t tA, tB, zB, zA;
    __device__ bool next(int i, Unit& u) const {
        const int L = i * G + c; if (L >= ts[NE] * nN) return false;
        xcd_tile_map(L, ts[NE], nN, u.pm, u.pn); int e = 0, tse = 0;
#pragma unroll
        for (int k = 1; k < NE; ++k) if (u.pm >= ts[k]) { e = k; tse = ts[k]; }
        u.z = e; u.offA = zA ? (size_t)e * zA + (size_t)(u.pm - tse) * tA : (size_t)u.pm * tA; u.offB = (size_t)e * zB + (size_t)u.pn * tB; return true;
    }
};

typedef __bf16 bf16x2_t __attribute__((ext_vector_type(2)));
__device__ __forceinline__ unsigned cvt_pk_bf16(float lo, float hi) { const f32x2 v = {lo, hi}; const bf16x2_t b = __builtin_convertvector(v, bf16x2_t); return __builtin_bit_cast(unsigned, b); }

__device__ __forceinline__ u32x4 pack8(const f32x4 a, const f32x4 b) { u32x4 w; w.x = cvt_pk_bf16(a[0], a[1]); w.y = cvt_pk_bf16(a[2], a[3]); w.z = cvt_pk_bf16(b[0], b[1]); w.w = cvt_pk_bf16(b[2], b[3]); return w; }
template <class Epi, class Sched, bool ALIGN_EPI, bool FP8 = false>
__device__ __forceinline__ void gemm_phase(PG8_LAS unsigned char* lds, const Gemm g, const Sched& S, const Epi& E) {
    int tid = threadIdx.x; asm volatile("" : "+v"(tid));
    const int wid = __builtin_amdgcn_readfirstlane(tid >> 6), lane = tid & 63, wr = wid >> 2, wc = wid & 3, fr = lane & 15, fq = lane >> 4;
    int K = g.K; asm volatile("" : "+s"(K));
    const int nt = K / BK;
    unsigned voffA[2], voffB[2];
#pragma unroll
    for (int i = 0; i < 2; ++i) { int R, C; stage_rc(tid * 16 + i * 8192, R, C); const int Rb = Epi::PERM ? ((R & ~31) + perm32(R & 31)) : R;
        voffA[i] = (unsigned)(R * g.lda + C) * 2u; voffB[i] = (unsigned)(Rb * g.ldb + C) * 2u; }
    const size_t kstep = (size_t)(BK * 2);
    const size_t hstepA = (size_t)HALF * g.lda * 2, hstepB = (size_t)HALF * g.ldb * 2;
    const unsigned ldsw = (unsigned)wid * 1024u;
    const int aoff = lds_byte(wr * 64 + fr, fq * 8), boff = lds_byte(wc * 32 + fr, fq * 8);
#define PG8_SA(b, h) (((b) * 2 + (h)) * HTB)
#define PG8_SB(b, h) ((4 + (b) * 2 + (h)) * HTB)
#define PG8_STAGE(bufoff, gbase, voff) do { _Pragma("unroll") for (int _i = 0; _i < 2; ++_i) \
        __builtin_amdgcn_global_load_lds((const unsigned*)((const char*)(gbase) + (voff)[_i]), (PG8_LAS unsigned*)(lds + (bufoff) + ldsw + _i * 8192), 16, 0, 0); } while (0)
#define PG8_LDA(dst, b, h) do { _Pragma("unroll") for (int m = 0; m < 4; ++m) { if constexpr (FP8) dst##8[m] = __builtin_shufflevector(*(const PG8_LAS v4i*)(lds + PG8_SA(b, h) + aoff + m * 2048), *(const PG8_LAS v4i*)(lds + PG8_SA(b, h) + aoff + m * 2048 + 1024), 0, 1, 2, 3, 4, 5, 6, 7); \
        else { _Pragma("unroll") for (int k = 0; k < 2; ++k) dst[m][k] = *(const PG8_LAS bf16x8*)(lds + PG8_SA(b, h) + aoff + m * 2048 + k * 1024); } } } while (0)
#define PG8_LDB(dst, b, h) do { _Pragma("unroll") for (int n = 0; n < 2; ++n) { if constexpr (FP8) dst##8[n] = __builtin_shufflevector(*(const PG8_LAS v4i*)(lds + PG8_SB(b, h) + boff + n * 2048), *(const PG8_LAS v4i*)(lds + PG8_SB(b, h) + boff + n * 2048 + 1024), 0, 1, 2, 3, 4, 5, 6, 7); \
        else { _Pragma("unroll") for (int k = 0; k < 2; ++k) dst[n][k] = *(const PG8_LAS bf16x8*)(lds + PG8_SB(b, h) + boff + n * 2048 + k * 1024); } } } while (0)
#define PG8_MMA(ai, bj, At, Bt) do { __builtin_amdgcn_s_setprio(1); _Pragma("unroll") for (int m = 0; m < 4; ++m) _Pragma("unroll") for (int n = 0; n < 2; ++n) { \
        if constexpr (FP8) asm volatile("v_mfma_f32_16x16x128_f8f6f4 %0, %1, %2, %0" : "+v"(acc[ai][bj][m][n]) : "v"(Bt##8[n]), "v"(At##8[m])); \
        else { _Pragma("unroll") for (int k = 0; k < 2; ++k) acc[ai][bj][m][n] = __builtin_amdgcn_mfma_f32_16x16x32_bf16(Bt[n][k], At[m][k], acc[ai][bj][m][n], 0, 0, 0); } } \
        __builtin_amdgcn_s_setprio(0); } while (0)
#define PG8_WAIT_V(n) asm volatile("s_waitcnt vmcnt(" #n ")" ::: "memory")
#define PG8_WAIT_L(n) asm volatile("s_waitcnt lgkmcnt(" #n ")" ::: "memory")
#define PG8_BAR __builtin_amdgcn_s_barrier()
#define PG8_SCHED __builtin_amdgcn_sched_barrier(0)
    Unit cur, nxt; int ui = 0;
    if (!S.next(0, cur)) return;
    f32x4 acc[2][2][4][2];
#pragma unroll
    for (int a = 0; a < 2; ++a)
#pragma unroll
        for (int b = 0; b < 2; ++b)
#pragma unroll
            for (int m = 0; m < 4; ++m)
#pragma unroll
                for (int n = 0; n < 2; ++n) acc[a][b][m][n] = (f32x4){0.f, 0.f, 0.f, 0.f};
    bf16x8 At[4][2], B0[2][2], B1[2][2]; v8i At8[4], B08[2], B18[2];
    const char* cA = (const char*)g.A + cur.offA; const char* cB = (const char*)g.Bt + cur.offB;
    PG8_STAGE(PG8_SB(0, 0), cB, voffB); PG8_STAGE(PG8_SB(0, 1), cB + hstepB, voffB); PG8_STAGE(PG8_SA(0, 0), cA, voffA); PG8_STAGE(PG8_SA(0, 1), cA + hstepA, voffA);
    if (wr == 1) PG8_BAR;
    PG8_WAIT_V(2); PG8_BAR;
    PG8_STAGE(PG8_SB(1, 0), cB + kstep, voffB); PG8_STAGE(PG8_SA(1, 0), cA + kstep, voffA); PG8_STAGE(PG8_SB(1, 1), cB + hstepB + kstep, voffB);
    PG8_WAIT_V(6); PG8_BAR;
    for (;;) {
        const bool has_next = S.next(ui + 1, nxt);
        const char* nA = has_next ? (const char*)g.A + nxt.offA : cA; const char* nB = has_next ? (const char*)g.Bt + nxt.offB : cB;
        for (int t = 0; t < nt; t += 2) {
            const bool last = (t == nt - 2);
            const char* a1 = cA + (size_t)(t + 1) * kstep;
            const char* a2 = last ? nA : cA + (size_t)(t + 2) * kstep; const char* b2 = last ? nB : cB + (size_t)(t + 2) * kstep;
            const char* a3 = a2 + kstep; const char* b3 = b2 + kstep;
            PG8_LDB(B0, 0, 0); PG8_LDB(B1, 0, 1); PG8_SCHED; PG8_LDA(At, 0, 0); PG8_STAGE(PG8_SA(1, 1), a1 + hstepA, voffA);
            PG8_WAIT_V(8); PG8_WAIT_L(0); PG8_BAR; PG8_MMA(0, 0, At, B0); PG8_MMA(0, 1, At, B1); PG8_BAR; PG8_SCHED;
            PG8_LDA(At, 0, 1); PG8_STAGE(PG8_SB(0, 0), b2, voffB); PG8_STAGE(PG8_SB(0, 1), b2 + hstepB, voffB); PG8_STAGE(PG8_SA(0, 0), a2, voffA);
            PG8_WAIT_V(8); PG8_WAIT_L(0); PG8_BAR; PG8_MMA(1, 0, At, B0); PG8_MMA(1, 1, At, B1); PG8_BAR; PG8_SCHED;
            PG8_LDB(B0, 1, 0); PG8_LDB(B1, 1, 1); PG8_SCHED; PG8_LDA(At, 1, 0); PG8_STAGE(PG8_SA(0, 1), a2 + hstepA, voffA);
            PG8_WAIT_V(8); PG8_WAIT_L(0); PG8_BAR; PG8_MMA(0, 0, At, B0); PG8_MMA(0, 1, At, B1); PG8_BAR; PG8_SCHED;
            PG8_LDA(At, 1, 1); PG8_STAGE(PG8_SB(1, 0), b3, voffB); PG8_STAGE(PG8_SB(1, 1), b3 + hstepB, voffB); PG8_STAGE(PG8_SA(1, 0), a3, voffA);
            PG8_WAIT_V(8); PG8_WAIT_L(0); PG8_BAR; PG8_MMA(1, 0, At, B0); PG8_MMA(1, 1, At, B1); PG8_BAR; PG8_SCHED;
        }
        if constexpr (ALIGN_EPI) { if (wr == 0) PG8_BAR; }
        if constexpr (FP8) asm volatile("s_nop 15\n\ts_nop 15" ::: "memory");
        E(acc, cur, wr, wc, fr, fq);
        if (!has_next) break;
#pragma unroll
        for (int a = 0; a < 2; ++a)
#pragma unroll
            for (int b = 0; b < 2; ++b)
#pragma unroll
                for (int m = 0; m < 4; ++m)
#pragma unroll
                    for (int n = 0; n < 2; ++n) acc[a][b][m][n] = (f32x4){0.f, 0.f, 0.f, 0.f};
        cur = nxt; cA = nA; cB = nB; ++ui;
        if constexpr (ALIGN_EPI) { if (wr == 1) PG8_BAR; }
    }
    PG8_WAIT_V(0);
    if constexpr (!ALIGN_EPI) { if (wr == 0) PG8_BAR; }
    PG8_BAR;
#undef PG8_SA
#undef PG8_SB
#undef PG8_STAGE
#undef PG8_LDA
#undef PG8_LDB
#undef PG8_MMA
#undef PG8_WAIT_V
#undef PG8_WAIT_L
#undef PG8_BAR
#undef PG8_SCHED
}


template <class Epi, class Sched>
__device__ __forceinline__ void gemm_phase_n1(PG8_LAS unsigned char* lds, const Gemm g, const Sched& S, const Epi& E) {
    int tid = threadIdx.x; asm volatile("" : "+v"(tid));
    const int wid = __builtin_amdgcn_readfirstlane(tid >> 6), lane = tid & 63, wr = wid >> 2, wc = wid & 3, fr = lane & 15, fq = lane >> 4;
    int K = g.K; asm volatile("" : "+s"(K));
    const int nt = K / BK;
    unsigned voffA[2], voffB[2];
#pragma unroll
    for (int i = 0; i < 2; ++i) { int R, C; stage_rc(tid * 16 + i * 8192, R, C); const int Rb = Epi::PERM ? ((R & ~31) + perm32(R & 31)) : R;
        voffA[i] = (unsigned)(R * g.lda + C) * 2u; voffB[i] = (unsigned)(Rb * g.ldb + C) * 2u; }
    const size_t kstep = (size_t)(BK * 2);
    const size_t hstepA = (size_t)HALF * g.lda * 2;
    const unsigned ldsw = (unsigned)wid * 1024u;
    const int aoff = lds_byte(wr * 64 + fr, fq * 8), boff = lds_byte(wc * 32 + fr, fq * 8);
#define PG8_SA(b, h) (((b) * 2 + (h)) * HTB)
#define PG8_SB(b, h) ((4 + (b) * 2 + (h)) * HTB)
#define PG8_STAGE(bufoff, gbase, voff) do { _Pragma("unroll") for (int _i = 0; _i < 2; ++_i) \
        __builtin_amdgcn_global_load_lds((const unsigned*)((const char*)(gbase) + (voff)[_i]), (PG8_LAS unsigned*)(lds + (bufoff) + ldsw + _i * 8192), 16, 0, 0); } while (0)
#define PG8_LDA(dst, b, h) do { _Pragma("unroll") for (int m = 0; m < 4; ++m) _Pragma("unroll") for (int k = 0; k < 2; ++k) dst[m][k] = *(const PG8_LAS bf16x8*)(lds + PG8_SA(b, h) + aoff + m * 2048 + k * 1024); } while (0)
#define PG8_LDB(dst, b, h) do { _Pragma("unroll") for (int n = 0; n < 2; ++n) _Pragma("unroll") for (int k = 0; k < 2; ++k) dst[n][k] = *(const PG8_LAS bf16x8*)(lds + PG8_SB(b, h) + boff + n * 2048 + k * 1024); } while (0)
#define PG8_MMA1(ai, At, Bt) do { __builtin_amdgcn_s_setprio(1); _Pragma("unroll") for (int m = 0; m < 4; ++m) _Pragma("unroll") for (int n = 0; n < 2; ++n) _Pragma("unroll") for (int k = 0; k < 2; ++k) \
        acc[ai][m][n] = __builtin_amdgcn_mfma_f32_16x16x32_bf16(Bt[n][k], At[m][k], acc[ai][m][n], 0, 0, 0); __builtin_amdgcn_s_setprio(0); } while (0)
#define PG8_WAIT_V(n) asm volatile("s_waitcnt vmcnt(" #n ")" ::: "memory")
#define PG8_WAIT_L(n) asm volatile("s_waitcnt lgkmcnt(" #n ")" ::: "memory")
#define PG8_BAR __builtin_amdgcn_s_barrier()
#define PG8_SCHED __builtin_amdgcn_sched_barrier(0)
    Unit cur, nxt; int ui = 0;
    if (!S.next(0, cur)) return;
    f32x4 acc[2][4][2], st[2][4][2];
#pragma unroll
    for (int a = 0; a < 2; ++a)
#pragma unroll
        for (int m = 0; m < 4; ++m)
#pragma unroll
            for (int n = 0; n < 2; ++n) { acc[a][m][n] = (f32x4){0.f, 0.f, 0.f, 0.f}; st[a][m][n] = (f32x4){0.f, 0.f, 0.f, 0.f}; }
    bf16x8 At[4][2], B0[2][2]; v2u gp[8];
    const char* cA = (const char*)g.A + cur.offA; const char* cB = (const char*)g.Bt + cur.offB;
    PG8_STAGE(PG8_SB(0, 0), cB, voffB); PG8_STAGE(PG8_SA(0, 0), cA, voffA); PG8_STAGE(PG8_SA(0, 1), cA + hstepA, voffA);
    if (wr == 1) PG8_BAR;
    PG8_WAIT_V(2); PG8_BAR;
    PG8_STAGE(PG8_SB(1, 0), cB + kstep, voffB); PG8_STAGE(PG8_SA(1, 0), cA + kstep, voffA);
    PG8_WAIT_V(4); PG8_BAR;
    for (;;) {
        const bool has_next = S.next(ui + 1, nxt);
        const char* nA = has_next ? (const char*)g.A + nxt.offA : cA; const char* nB = has_next ? (const char*)g.Bt + nxt.offB : cB;
        for (int t = 0; t < nt; t += 2) {
            const bool last = (t == nt - 2);
            const char* a1 = cA + (size_t)(t + 1) * kstep;
            const char* a2 = last ? nA : cA + (size_t)(t + 2) * kstep; const char* b2 = last ? nB : cB + (size_t)(t + 2) * kstep;
            const char* a3 = a2 + kstep; const char* b3 = b2 + kstep;
            if (t == 0) { E.prefetch(cur, wr, wc, fr, fq, gp); PG8_SCHED; }
            PG8_LDB(B0, 0, 0); PG8_SCHED; PG8_LDA(At, 0, 0); PG8_STAGE(PG8_SA(1, 1), a1 + hstepA, voffA);
            if (t == 0) PG8_WAIT_V(14); else PG8_WAIT_V(6);
            PG8_WAIT_L(0); PG8_BAR; PG8_MMA1(0, At, B0); PG8_BAR; PG8_SCHED;
            PG8_LDA(At, 0, 1); PG8_STAGE(PG8_SB(0, 0), b2, voffB); PG8_STAGE(PG8_SA(0, 0), a2, voffA);
            if (t == 0) PG8_WAIT_V(14); else PG8_WAIT_V(6);
            PG8_WAIT_L(0); PG8_BAR; PG8_MMA1(1, At, B0); PG8_BAR; PG8_SCHED;
            PG8_LDB(B0, 1, 0); PG8_SCHED; PG8_LDA(At, 1, 0); PG8_STAGE(PG8_SA(0, 1), a2 + hstepA, voffA);
            PG8_WAIT_V(6); PG8_WAIT_L(0); PG8_BAR; PG8_MMA1(0, At, B0); PG8_BAR; PG8_SCHED;
            PG8_LDA(At, 1, 1); PG8_STAGE(PG8_SB(1, 0), b3, voffB); PG8_STAGE(PG8_SA(1, 0), a3, voffA);
            PG8_WAIT_V(6); PG8_WAIT_L(0); PG8_BAR; PG8_MMA1(1, At, B0); PG8_BAR; PG8_SCHED;
        }
        if (wr == 0) PG8_BAR;
        E(acc, st, cur, wr, wc, fr, fq, gp);
        if (!has_next) break;
#pragma unroll
        for (int a = 0; a < 2; ++a)
#pragma unroll
            for (int m = 0; m < 4; ++m)
#pragma unroll
                for (int n = 0; n < 2; ++n) acc[a][m][n] = (f32x4){0.f, 0.f, 0.f, 0.f};
        cur = nxt; cA = nA; cB = nB; ++ui;
        if (wr == 1) PG8_BAR;
    }
    PG8_WAIT_V(0);
    PG8_BAR;
#undef PG8_SA
#undef PG8_SB
#undef PG8_STAGE
#undef PG8_LDA
#undef PG8_LDB
#undef PG8_MMA1
#undef PG8_WAIT_V
#undef PG8_WAIT_L
#undef PG8_BAR
#undef PG8_SCHED
}
typedef f32x4 Acc1[2][4][2];
struct OneUnit { int pm; size_t tA;
    __device__ bool next(int i, Unit& u) const { if (i) return false; u.pm = pm; u.pn = 0; u.z = 0; u.offA = (size_t)pm * tA; u.offB = 0; return true; } };
struct BranchOrder1 {
    int nM, nN, G, c; size_t tA, tB, zA, zB; int paired, vc;
    __device__ bool next(int i, Unit& u) const {
        if (paired) { if (i >= 16) return false; u.z = i & 3; u.pm = vc >> 1; u.pn = 4 * (vc & 1) + (i >> 2);
            u.offA = (size_t)u.z * zA + (size_t)u.pm * tA; u.offB = (size_t)u.z * zB + (size_t)u.pn * tB; return true; }
        const int tile = (i >> 2) * G + c; if (tile >= nM * nN) return false;
        u.z = i & 3; xcd_tile_map<BR_WG>(tile, nM, nN, u.pm, u.pn);
        u.offA = (size_t)u.z * zA + (size_t)u.pm * tA; u.offB = (size_t)u.z * zB + (size_t)u.pn * tB; return true;
    }
};
struct EpiGate1 {
    static constexpr bool PERM = true;
    const bf16_t* gate; bf16_t* mb;
    __device__ __forceinline__ void prefetch(const Unit& u, int wr, int wc, int fr, int fq, v2u (&gp)[8]) const {
        if (GATE8 != 2) return;
        const int row0 = u.pm * BM + wr * 64 + fr, col = u.pn * HALF + wc * 32 + 8 * fq;
        const unsigned char* p = (const unsigned char*)gate + (size_t)row0 * 4096 + u.z * 1024 + col;
#pragma unroll
        for (int ai = 0; ai < 2; ++ai)
#pragma unroll
            for (int m = 0; m < 4; ++m) gp[ai * 4 + m] = *(const v2u*)(p + (size_t)(ai * HALF + m * 16) * 4096);
    }
    __device__ __forceinline__ void operator()(const Acc1& acc, Acc1& st, const Unit& u, int wr, int wc, int fr, int fq, const v2u (&gp)[8]) const {
        const int z = u.z; const int row0 = u.pm * BM + wr * 64 + fr, col = u.pn * HALF + wc * 32 + 8 * fq;
#pragma unroll
        for (int ai = 0; ai < 2; ++ai)
#pragma unroll
            for (int m = 0; m < 4; ++m) { const int row = row0 + ai * HALF + m * 16;
                f32x4 a = acc[ai][m][0], b = acc[ai][m][1];
                if (GATE8 == 2) { const v2u g8 = gp[ai * 4 + m]; const float k = 1.0f / 255.0f;
                    a[0] *= (float)(g8.x & 0xffu) * k; a[1] *= (float)((g8.x >> 8) & 0xffu) * k; a[2] *= (float)((g8.x >> 16) & 0xffu) * k; a[3] *= (float)(g8.x >> 24) * k;
                    b[0] *= (float)(g8.y & 0xffu) * k; b[1] *= (float)((g8.y >> 8) & 0xffu) * k; b[2] *= (float)((g8.y >> 16) & 0xffu) * k; b[3] *= (float)(g8.y >> 24) * k; }
                else if (GATE8 == 1) { const v2u g8 = *(const v2u*)((const unsigned char*)gate + (size_t)row * 4096 + z * 1024 + col);
                    const f32x2 g0 = __builtin_amdgcn_cvt_pk_f32_fp8((int)g8.x, false), g1 = __builtin_amdgcn_cvt_pk_f32_fp8((int)g8.x, true), g2 = __builtin_amdgcn_cvt_pk_f32_fp8((int)g8.y, false), g3 = __builtin_amdgcn_cvt_pk_f32_fp8((int)g8.y, true);
                    a[0] *= g0[0]; a[1] *= g0[1]; a[2] *= g1[0]; a[3] *= g1[1]; b[0] *= g2[0]; b[1] *= g2[1]; b[2] *= g3[0]; b[3] *= g3[1]; }
                else { const u32x4 gg = *(const u32x4*)(gate + (size_t)row * 4096 + z * 1024 + col);
                    a[0] *= bflo(gg.x); a[1] *= bfhi(gg.x); a[2] *= bflo(gg.y); a[3] *= bfhi(gg.y); b[0] *= bflo(gg.z); b[1] *= bfhi(gg.z); b[2] *= bflo(gg.w); b[3] *= bfhi(gg.w); }
                if (z == 0) { st[ai][m][0] = a; st[ai][m][1] = b; } else { st[ai][m][0] += a; st[ai][m][1] += b; }
                if (z == 3) *(u32x4*)(mb + (size_t)row * 1024 + col) = pack8(st[ai][m][0], st[ai][m][1]); }
    }
};
typedef f32x4 Acc[2][2][4][2];
#define EPI_ROWS_BEGIN const int row0 = u.pm * BM + wr * 64 + fr; _Pragma("unroll") for (int ai = 0; ai < 2; ++ai) _Pragma("unroll") for (int m = 0; m < 4; ++m) { const int row = row0 + ai * HALF + m * 16;
#define EPI_ROWS_END }

struct EpiInProj {
    static constexpr bool PERM = true;
    bf16_t *ua, *qkv, *uc, *gate; const PG8_LAS float* gl;
    __device__ __forceinline__ void operator()(const Acc& acc, const Unit& u, int wr, int wc, int fr, int fq) const {
        const int pn = u.pn;
        if (pn == 0) {
            EPI_ROWS_BEGIN
#pragma unroll
            for (int bj = 0; bj < 2; ++bj) { const int c8 = bj * HALF + wc * 32 + 8 * fq, gI = c8 >> 4, h0 = c8 & 15;
                *(u32x4*)(ua + ((size_t)(gI * 512 + (row >> 6)) * S5_LDA + (row & 63) * 16 + h0)) = pack8(acc[ai][bj][m][0], acc[ai][bj][m][1]); }
            EPI_ROWS_END
        } else if (pn == 1 || pn == 2 || pn == 6 || pn == 7) {
            const int which = (pn == 1) ? 0 : (pn == 2) ? 1 : (pn == 6) ? 2 : 3;
            const PG8_LAS float* gp = gl + which * 64;
            bf16_t* dst = qkv + (size_t)((pn < 6) ? (pn - 1) : (pn - 3)) * ((size_t)T * 256);
            f32x4 gv[2][2];
#pragma unroll
            for (int bj = 0; bj < 2; ++bj)
#pragma unroll
                for (int n = 0; n < 2; ++n) gv[bj][n] = *(const PG8_LAS f32x4*)(gp + bj * 32 + 8 * fq + 4 * n);
            EPI_ROWS_BEGIN
            float ss = 0.f;
#pragma unroll
            for (int bj = 0; bj < 2; ++bj)
#pragma unroll
                for (int n = 0; n < 2; ++n) { const f32x4 x = acc[ai][bj][m][n]; ss += (x[0] * x[0] + x[1] * x[1]) + (x[2] * x[2] + x[3] * x[3]); }
            ss += __shfl_xor(ss, 16); ss += __shfl_xor(ss, 32);
            const float rs = __builtin_amdgcn_rsqf(ss * (1.0f / 64.0f) + EPS);
#pragma unroll
            for (int bj = 0; bj < 2; ++bj)
                *(u32x4*)(dst + (size_t)row * 256 + wc * 64 + bj * 32 + 8 * fq) = pack8(acc[ai][bj][m][0] * rs * gv[bj][0], acc[ai][bj][m][1] * rs * gv[bj][1]);
            EPI_ROWS_END
        } else if (pn == 3 || pn == 8) {
            bf16_t* dst = qkv + (size_t)((pn == 3) ? 2 : 5) * ((size_t)T * 256);
            EPI_ROWS_BEGIN
#pragma unroll
            for (int bj = 0; bj < 2; ++bj) *(u32x4*)(dst + (size_t)row * 256 + bj * HALF + wc * 32 + 8 * fq) = pack8(acc[ai][bj][m][0], acc[ai][bj][m][1]);
            EPI_ROWS_END
        } else if (pn == 4 || pn == 5) {
            EPI_ROWS_BEGIN
            f32x4 o[2];
#pragma unroll
            for (int n = 0; n < 2; ++n)
#pragma unroll
                for (int e = 0; e < 4; ++e) o[n][e] = acc[ai][0][m][n][e] * sigmoidf_(acc[ai][1][m][n][e]);
            *(u32x4*)(uc + (size_t)row * 256 + (pn - 4) * 128 + wc * 32 + 8 * fq) = pack8(o[0], o[1]);
            EPI_ROWS_END
        } else {
            const int gt = pn - 9;
            EPI_ROWS_BEGIN
#pragma unroll
            for (int bj = 0; bj < 2; ++bj) { f32x4 o[2];
#pragma unroll
                for (int n = 0; n < 2; ++n)
#pragma unroll
                    for (int e = 0; e < 4; ++e) o[n][e] = sigmoidf_(acc[ai][bj][m][n][e]);
                *(u32x4*)(gate + (size_t)row * 4096 + gt * 256 + bj * HALF + wc * 32 + 8 * fq) = pack8(o[0], o[1]); }
            EPI_ROWS_END
        }
    }
};
struct EpiGateSig {
    static constexpr bool PERM = true;
    bf16_t* gate;
    __device__ __forceinline__ void operator()(const Acc& acc, const Unit& u, int wr, int wc, int fr, int fq) const {
        EPI_ROWS_BEGIN
#pragma unroll
        for (int bj = 0; bj < 2; ++bj) { f32x4 o[2];
#pragma unroll
            for (int n = 0; n < 2; ++n)
#pragma unroll
                for (int e = 0; e < 4; e += 2) { const f32x2 r = sigmoid2((f32x2){acc[ai][bj][m][n][e], acc[ai][bj][m][n][e + 1]} * (1.0f / 64.0f)) * ((GATE8 == 2) ? 255.0f : 1.0f); o[n][e] = r[0]; o[n][e + 1] = r[1]; }
            if (GATE8 == 2) { v2u w = {0u, 0u};
#pragma unroll
                for (int e = 0; e < 4; ++e) { w.x = __builtin_amdgcn_cvt_pk_u8_f32(o[0][e], e, w.x); w.y = __builtin_amdgcn_cvt_pk_u8_f32(o[1][e], e, w.y); }
                *(v2u*)((unsigned char*)gate + (size_t)row * 4096 + u.pn * BM + bj * HALF + wc * 32 + 8 * fq) = w; }
            else if (GATE8 == 1) { v2u w; w.x = pk4_fp8(o[0][0], o[0][1], o[0][2], o[0][3]); w.y = pk4_fp8(o[1][0], o[1][1], o[1][2], o[1][3]); *(v2u*)((unsigned char*)gate + (size_t)row * 4096 + u.pn * BM + bj * HALF + wc * 32 + 8 * fq) = w; }
            else *(u32x4*)(gate + (size_t)row * 4096 + u.pn * BM + bj * HALF + wc * 32 + 8 * fq) = pack8(o[0], o[1]); }
        EPI_ROWS_END
    }
};
struct EpiZ {
    static constexpr bool PERM = false;
    float* z;
    __device__ __forceinline__ void operator()(const Acc& acc, const Unit& u, int wr, int wc, int fr, int fq) const {
        EPI_ROWS_BEGIN
#pragma unroll
        for (int n = 0; n < 2; ++n) *(f32x4*)(z + ((size_t)(u.z * 512 + row)) * 128 + wc * 32 + 16 * n + 4 * fq) = acc[ai][0][m][n];
        EPI_ROWS_END
    }
};
struct EpiY {
    static constexpr bool PERM = true;
    const bf16_t* ua; const float* dskip; bf16_t* yp;
    __device__ __forceinline__ void operator()(const Acc& acc, const Unit& u, int wr, int wc, int fr, int fq) const {
        const int gI = u.z, h0 = 8 * (fq & 1);
        const f32x4 d0 = *(const f32x4*)(dskip + gI * 16 + h0), d1 = *(const f32x4*)(dskip + gI * 16 + h0 + 4);
        EPI_ROWS_BEGIN
#pragma unroll
        for (int bj = 0; bj < 2; ++bj) { const int col = u.pn * BM + bj * HALF + wc * 32 + 8 * fq;
            const u32x4 uu = *(const u32x4*)(ua + ((size_t)(gI * 512 + row)) * S5_LDA + col);
            f32x4 a = acc[ai][bj][m][0], b = acc[ai][bj][m][1];
            a[0] += d0[0] * bflo(uu.x); a[1] += d0[1] * bfhi(uu.x); a[2] += d0[2] * bflo(uu.y); a[3] += d0[3] * bfhi(uu.y);
            b[0] += d1[0] * bflo(uu.z); b[1] += d1[1] * bfhi(uu.z); b[2] += d1[2] * bflo(uu.w); b[3] += d1[3] * bfhi(uu.w);
#pragma unroll
            for (int e = 0; e < 4; ++e) { a[e] = gelu_tanh(a[e]); b[e] = gelu_tanh(b[e]); }
            *(u32x4*)(yp + ((size_t)row * 64 + (col >> 4)) * 256 + gI * 16 + h0) = pack8(a, b); }
        EPI_ROWS_END
    }
};
struct EpiGlu {
    static constexpr bool PERM = true;
    const bf16_t* yp; bf16_t* ycat;
    __device__ __forceinline__ void operator()(const Acc& acc, const Unit& u, int wr, int wc, int fr, int fq) const {
        EPI_ROWS_BEGIN
#pragma unroll
        for (int bj = 0; bj < 2; ++bj) { const int col = bj * HALF + wc * 32 + 8 * fq;
            const u32x4 yy = *(const u32x4*)(yp + (size_t)row * 256 + col);
            f32x4 a = acc[ai][bj][m][0], b = acc[ai][bj][m][1];
            a[0] = bflo(yy.x) * sigmoidf_(a[0]); a[1] = bfhi(yy.x) * sigmoidf_(a[1]); a[2] = bflo(yy.y) * sigmoidf_(a[2]); a[3] = bfhi(yy.y) * sigmoidf_(a[3]);
            b[0] = bflo(yy.z) * sigmoidf_(b[0]); b[1] = bfhi(yy.z) * sigmoidf_(b[1]); b[2] = bflo(yy.w) * sigmoidf_(b[2]); b[3] = bfhi(yy.w) * sigmoidf_(b[3]);
            *(u32x4*)(ycat + (size_t)row * 1024 + col) = pack8(a, b); }
        EPI_ROWS_END
    }
};
template <bool SC64> struct EpiResid {
    static constexpr bool PERM = true; static constexpr float sc = SC64 ? (1.0f / 64.0f) : 1.0f;
    const float* base32; const bf16_t* base16; bf16_t* out; float* ss; unsigned char* out8; int flags;
    __device__ __forceinline__ void operator()(const Acc& acc, const Unit& u, int wr, int wc, int fr, int fq) const {
        EPI_ROWS_BEGIN
        float q = 0.f;
#pragma unroll
        for (int bj = 0; bj < 2; ++bj) { const size_t off = (size_t)row * 1024 + u.pn * BM + bj * HALF + wc * 32 + 8 * fq;
            f32x4 a, b;
            if (flags & 1) { a = *(const f32x4*)(base32 + off); b = *(const f32x4*)(base32 + off + 4); }
            else { const u32x4 r = *(const u32x4*)(base16 + off); a = (f32x4){bflo(r.x), bfhi(r.x), bflo(r.y), bfhi(r.y)}; b = (f32x4){bflo(r.z), bfhi(r.z), bflo(r.w), bfhi(r.w)}; }
            const u32x4 w = pack8(a + acc[ai][bj][m][0] * sc, b + acc[ai][bj][m][1] * sc); *(u32x4*)(out + off) = w;
            if (flags & 2) { const float x0 = bflo(w.x), x1 = bfhi(w.x), x2 = bflo(w.y), x3 = bfhi(w.y), x4 = bflo(w.z), x5 = bfhi(w.z), x6 = bflo(w.w), x7 = bfhi(w.w);
                q += ((x0 * x0 + x1 * x1) + (x2 * x2 + x3 * x3)) + ((x4 * x4 + x5 * x5) + (x6 * x6 + x7 * x7));
                if (flags & 4) { v2u w8; w8.x = pk4_fp8(x0, x1, x2, x3); w8.y = pk4_fp8(x4, x5, x6, x7); *(v2u*)(out8 + off) = w8; } } }
        if (flags & 2) { q += __shfl_xor(q, 16); q += __shfl_xor(q, 32); if (fq == 0) ss[(size_t)row * 16 + u.pn * 4 + wc] = q; }
        EPI_ROWS_END
    }
};
template <bool H8> struct EpiSwiGlu {
    static constexpr bool PERM = true;
    bf16_t* h; float sc; const float* ss; int use_ss;
    __device__ __forceinline__ void operator()(const Acc& acc, const Unit& u, int wr, int wc, int fr, int fq) const {
        EPI_ROWS_BEGIN
        float rsc = sc;
        if (use_ss) { const f32x4 s0 = *(const f32x4*)(ss + (size_t)row * 16), s1 = *(const f32x4*)(ss + (size_t)row * 16 + 4), s2 = *(const f32x4*)(ss + (size_t)row * 16 + 8), s3 = *(const f32x4*)(ss + (size_t)row * 16 + 12);
            const f32x4 t = (s0 + s1) + (s2 + s3); rsc = sc * __builtin_amdgcn_rsqf(((t[0] + t[1]) + (t[2] + t[3])) * (1.0f / D) + EPS); }
        f32x4 o[2];
#pragma unroll
        for (int n = 0; n < 2; ++n)
#pragma unroll
            for (int e = 0; e < 4; e += 2) { const f32x2 a = (f32x2){acc[ai][0][m][n][e], acc[ai][0][m][n][e + 1]} * rsc, b = (f32x2){acc[ai][1][m][n][e], acc[ai][1][m][n][e + 1]} * rsc;
                const f32x2 r = (a * b) * sigmoid2(a); o[n][e] = r[0]; o[n][e + 1] = r[1]; }
        if constexpr (H8) { v2u w; w.x = pk4_fp8(o[0][0], o[0][1], o[0][2], o[0][3]); w.y = pk4_fp8(o[1][0], o[1][1], o[1][2], o[1][3]); *(v2u*)((unsigned char*)h + (size_t)row * FF + u.pn * 128 + wc * 32 + 8 * fq) = w; }
        else *(u32x4*)(h + (size_t)row * FF + u.pn * 128 + wc * 32 + 8 * fq) = pack8(o[0], o[1]);
        EPI_ROWS_END
    }
};
struct EpiStore {
    static constexpr bool PERM = true;
    bf16_t* o; float sc;
    __device__ __forceinline__ void operator()(const Acc& acc, const Unit& u, int wr, int wc, int fr, int fq) const {
        EPI_ROWS_BEGIN
#pragma unroll
        for (int bj = 0; bj < 2; ++bj) *(u32x4*)(o + (size_t)row * 1024 + u.pn * BM + bj * HALF + wc * 32 + 8 * fq) = pack8(acc[ai][bj][m][0] * sc, acc[ai][bj][m][1] * sc);
        EPI_ROWS_END
    }
};
}

#define XB_TMO      128
#define XB_XCNT(j)  (256  + 64 * (j))
#define XB_XSUB(j)  (1280 + 64 * (j))
#define XB_XGEN(j)  (2304 + 64 * (j))
#define XB_TOP      3328
#define XB_TOPGEN   3392
#define XCD_BAR_WORDS 3456
#define XB_SPIN_CAP (1u << 18)
__device__ __forceinline__ unsigned xb_ld(unsigned* p)              { return __hip_atomic_load(p, __ATOMIC_RELAXED, __HIP_MEMORY_SCOPE_AGENT); }
__device__ __forceinline__ unsigned xb_add(unsigned* p, unsigned v) { return __hip_atomic_fetch_add(p, v, __ATOMIC_RELAXED, __HIP_MEMORY_SCOPE_AGENT); }
__device__ __forceinline__ unsigned xb_xcc_id() { return (unsigned)__builtin_amdgcn_s_getreg((3 << 11) | 20) & 0xFu; }
#define XB_SPIN(cond, bar) do { unsigned _sp = 0; while (cond) { __builtin_amdgcn_s_sleep(1); \
    if ((++_sp & 255u) == 0u) { if (xb_ld(&(bar)[XB_TMO])) break; if (_sp > XB_SPIN_CAP) { atomicAdd(&(bar)[XB_TMO], 1u); break; } } } } while (0)
struct XcdBarrier { unsigned* bar; unsigned x; volatile LAS unsigned* st; };
__device__ __forceinline__ XcdBarrier xcd_barrier_post(unsigned* bar, volatile LAS unsigned* st) {
    XcdBarrier b; b.bar = bar; b.x = xb_xcc_id(); b.st = st;
    if (threadIdx.x == 0) (void)xb_add(&bar[XB_XCNT(b.x)], 1u);
    return b;
}
__device__ __forceinline__ void xcd_barrier_complete(unsigned* bar, unsigned x, unsigned& nloc, unsigned& nx) {
    const unsigned G = gridDim.x * gridDim.y * gridDim.z;
    unsigned sum, cnt, mine, sp = 0u;
    for (;;) {
        sum = 0u; cnt = 0u; mine = 0u;
#pragma unroll 1
        for (unsigned j = 0; j < 16; ++j) { const unsigned c = xb_ld(&bar[XB_XCNT(j)]); sum += c; cnt += (c > 0u) ? 1u : 0u; }
        mine = xb_ld(&bar[XB_XCNT(x)]);
        if (sum == G) break;
        __builtin_amdgcn_s_sleep(1);
        if ((++sp & 255u) == 0u) { if (xb_ld(&bar[XB_TMO])) break; if (sp > XB_SPIN_CAP) { atomicAdd(&bar[XB_TMO], 1u); break; } }
    }
    nloc = mine > 0u ? mine : 1u; nx = cnt > 0u ? cnt : 1u;
}
__device__ __forceinline__ void xcd_barrier(const XcdBarrier& b) {
    asm volatile("s_waitcnt vmcnt(0)" ::: "memory");
    __syncthreads();
    if (threadIdx.x == 0) {
        unsigned* bar = b.bar; unsigned bx = b.x; asm volatile("" : "+s"(bx));
        __builtin_amdgcn_s_waitcnt(0);
        unsigned nloc = b.st[0], nx = b.st[1];
        if (nloc == 0u) { xcd_barrier_complete(bar, bx, nloc, nx); b.st[0] = nloc; b.st[1] = nx; }
        const unsigned old = xb_add(&bar[XB_XSUB(bx)], 1u);
        const unsigned gen = old / nloc;
        if (old + 1u == (gen + 1u) * nloc) {
            __builtin_amdgcn_fence(__ATOMIC_RELEASE, "agent");
            asm volatile("s_waitcnt vmcnt(0)" ::: "memory");
            const unsigned og = xb_add(&bar[XB_TOP], 1u);
            const unsigned tg = og / nx;
            if (og + 1u == (tg + 1u) * nx) xb_add(&bar[XB_TOPGEN], 1u);
            else XB_SPIN(xb_ld(&bar[XB_TOPGEN]) == tg, bar);
            __builtin_amdgcn_fence(__ATOMIC_ACQUIRE, "agent");
            xb_add(&bar[XB_XGEN(bx)], 1u);
            asm volatile("s_waitcnt vmcnt(0)" ::: "memory");
        } else {
            XB_SPIN(xb_ld(&bar[XB_XGEN(bx)]) == gen, bar);
            __builtin_amdgcn_fence(__ATOMIC_ACQUIRE, "agent");
            asm volatile("s_waitcnt vmcnt(0)" ::: "memory");
        }
    }
    __syncthreads();
}

struct Args { const float* in[32]; float* out; unsigned char* ws; int gp_lo, gp_hi; };
enum { I_X = 0, I_GMIX, I_WIN, I_BFORGET, I_FQG, I_FKG, I_SQG, I_SKG, I_LRE, I_LIM, I_LDT, I_BRE, I_BIM, I_CRE, I_CIM, I_S5D, I_WGLU, I_CONVW, I_CONVB, I_LNG, I_LNB,
       I_WBR, I_WOUT, I_GFFN, I_W1, I_W3, I_W2, I_RW, I_RB, I_MW1, I_MW3, I_MW2 };
constexpr int NPH = 12, GP_FINAL = DEPTH * NPH, GP_TOTAL = GP_FINAL + 1;

struct Frame { LAS unsigned char* lds; int tid, lane, wave, vcu, G, gw, NGW, bx; const Args* a; unsigned char* ws; };

__device__ __forceinline__ void transpose_item(const float* W, int ldw, bf16* WT, int ldt, int k0, int src_col0, int dst_row0, LAS float* scr, int lane, const float* ks = nullptr) {
    f32x4 ld[8];
#pragma unroll
    for (int i = 0; i < 8; ++i) ld[i] = *(const f32x4*)(W + (size_t)(k0 + 8 * i + (lane >> 3)) * ldw + src_col0 + 4 * (lane & 7));
#pragma unroll
    for (int i = 0; i < 8; ++i) { LAS float* d = scr + (8 * i + (lane >> 3)) * 33 + 4 * (lane & 7); const float s = ks ? ks[k0 + 8 * i + (lane >> 3)] : 1.0f; d[0] = ld[i][0] * s; d[1] = ld[i][1] * s; d[2] = ld[i][2] * s; d[3] = ld[i][3] * s; }
    LDS_WAIT(); asm volatile("" ::: "memory");
    const int c = lane & 7;
#pragma unroll
    for (int j = 0; j < 4; ++j) { const int n = (lane >> 3) + 8 * j; const LAS float* s = scr + (8 * c) * 33 + n;
        v4u o; o.x = pk2(s[0 * 33], s[1 * 33]); o.y = pk2(s[2 * 33], s[3 * 33]); o.z = pk2(s[4 * 33], s[5 * 33]); o.w = pk2(s[6 * 33], s[7 * 33]);
        *(GAS v4u*)(WT + (size_t)(dst_row0 + n) * ldt + k0 + 8 * c) = o; }
    LDS_WAIT(); asm volatile("" ::: "memory");
}
__device__ __forceinline__ void transpose_item_f8(const float* W, int ldw, unsigned char* WT, int ldt, int k0, int src_col0, int dst_row0, LAS float* scr, int lane, float sc, const float* ks = nullptr) {
    f32x4 ld[8];
#pragma unroll
    for (int i = 0; i < 8; ++i) ld[i] = *(const f32x4*)(W + (size_t)(k0 + 8 * i + (lane >> 3)) * ldw + src_col0 + 4 * (lane & 7));
#pragma unroll
    for (int i = 0; i < 8; ++i) { LAS float* d = scr + (8 * i + (lane >> 3)) * 33 + 4 * (lane & 7); const float s = ks ? sc * ks[k0 + 8 * i + (lane >> 3)] : sc; d[0] = ld[i][0] * s; d[1] = ld[i][1] * s; d[2] = ld[i][2] * s; d[3] = ld[i][3] * s; }
    LDS_WAIT(); asm volatile("" ::: "memory");
    const int c = lane & 7;
#pragma unroll
    for (int j = 0; j < 4; ++j) { const int n = (lane >> 3) + 8 * j; const LAS float* s = scr + (8 * c) * 33 + n;
        v2u o; o.x = pk4_fp8(s[0 * 33], s[1 * 33], s[2 * 33], s[3 * 33]); o.y = pk4_fp8(s[4 * 33], s[5 * 33], s[6 * 33], s[7 * 33]);
        *(GAS v2u*)(WT + (size_t)(dst_row0 + n) * ldt + k0 + 8 * c) = o; }
    LDS_WAIT(); asm volatile("" ::: "memory");
}
__device__ __forceinline__ int win_src_col(int blk) {
    const int tile = blk >> 3, j = blk & 7, bj = j >> 2, hh = j & 3;
    if (tile == 0) return 32 * j;
    if (tile == 1 || tile == 2) return 256 + 256 * (tile - 1) + 64 * hh + 32 * bj;
    if (tile == 3) return 768 + 32 * j;
    if (tile == 4 || tile == 5) return (j < 4) ? (1028 + 128 * (tile - 4) + 32 * j) : (1284 + 128 * (tile - 4) + 32 * (j - 4));
    if (tile == 6 || tile == 7) return 1540 + 256 * (tile - 6) + 64 * hh + 32 * bj;
    if (tile == 8) return 2052 + 32 * j;
    return 2308 + 256 * (tile - 9) + 32 * j;
}
constexpr int CONV_NIN = 200 * 16, CONV_NBR = 4 * 32 * 4, CONV_NOUT = 32 * 16, CONV_NGLU = 8 * 4, CONV_NUP1 = 176 * 16, CONV_NDN1 = 32 * 44;
constexpr int CONV_NMIX = CONV_NIN + CONV_NBR + CONV_NOUT + CONV_NGLU, CONV_CHUNK = 64;
__device__ __forceinline__ int conv_ffn_items(int layer) { return (CONV_NUP1 + CONV_NDN1) * ((layer & 1) ? NE : 1); }
__device__ __forceinline__ void mix_item_load(const Args& A, int layer, int r, int lane, f32x4 (&ld)[8]) {
    asm volatile("" : "+v"(r));
    const float* w; int ldw, k0, col0;
    if (r < CONV_NIN) { const int blk = r >> 4, kb = r & 15; w = A.in[I_WIN] + (size_t)layer * D * DP; ldw = DP; k0 = 64 * kb; col0 = win_src_col(blk); }
    else if (r < CONV_NIN + CONV_NBR) { r -= CONV_NIN; const int z = r >> 7, q = r & 127, blk = q >> 2, kb = q & 3; w = A.in[I_WBR] + ((size_t)layer * 4 + z) * 256 * D; ldw = D; k0 = 64 * kb; col0 = 32 * blk; }
    else if (r < CONV_NIN + CONV_NBR + CONV_NOUT) { r -= CONV_NIN + CONV_NBR; const int blk = r >> 4, kb = r & 15; w = A.in[I_WOUT] + (size_t)layer * D * D; ldw = D; k0 = 64 * kb; col0 = 32 * blk; }
    else { r -= CONV_NIN + CONV_NBR + CONV_NOUT; const int blk = r >> 2, kb = r & 3; w = A.in[I_WGLU] + (size_t)layer * 256 * 256; ldw = 256; k0 = 64 * kb; col0 = 32 * blk; }
    w += (size_t)(k0 + (lane >> 3)) * ldw + col0 + 4 * (lane & 7);
#pragma unroll
    for (int i = 0; i < 8; ++i) ld[i] = *(const f32x4*)(w + (size_t)(8 * i) * ldw);
}
__device__ __forceinline__ void mix_item_finish(unsigned char* ws, int r, int lane, f32x4 (&ld)[8], LAS float* scr) {
    asm volatile("" : "+v"(r));
    size_t dbase; int ldt, k0, row0; bool f8 = false;
    if (r < CONV_NIN) { const int blk = r >> 4, kb = r & 15; k0 = 64 * kb; ldt = D;
        if (F8_GATES && blk >= 72) { f8 = true; dbase = WS_WIN8; row0 = 32 * (blk - 72); } else { dbase = WS_WIN; row0 = 32 * blk; } }
    else if (r < CONV_NIN + CONV_NBR) { r -= CONV_NIN; const int z = r >> 7, q = r & 127, blk = q >> 2, kb = q & 3; dbase = WS_WBR + (size_t)z * D * 256 * 2; ldt = 256; k0 = 64 * kb; row0 = 32 * blk; }
    else if (r < CONV_NIN + CONV_NBR + CONV_NOUT) { r -= CONV_NIN + CONV_NBR; const int blk = r >> 4, kb = r & 15; dbase = WS_WOUT; ldt = D; k0 = 64 * kb; row0 = 32 * blk; }
    else { r -= CONV_NIN + CONV_NBR + CONV_NOUT; const int blk = r >> 2, kb = r & 3; dbase = WS_WGLU; ldt = 256; k0 = 64 * kb; row0 = 32 * blk; }
    const float sc = f8 ? 64.0f : 1.0f;
#pragma unroll
    for (int i = 0; i < 8; ++i) { LAS float* d = scr + (8 * i + (lane >> 3)) * 33 + 4 * (lane & 7); d[0] = ld[i][0] * sc; d[1] = ld[i][1] * sc; d[2] = ld[i][2] * sc; d[3] = ld[i][3] * sc; }
    LDS_WAIT(); asm volatile("" ::: "memory");
    const int c = lane & 7;
    if (f8) {
#pragma unroll
        for (int j = 0; j < 4; ++j) { const int n = (lane >> 3) + 8 * j; const LAS float* s = scr + (8 * c) * 33 + n;
            v2u o; o.x = pk4_fp8(s[0 * 33], s[1 * 33], s[2 * 33], s[3 * 33]); o.y = pk4_fp8(s[4 * 33], s[5 * 33], s[6 * 33], s[7 * 33]);
            *(GAS v2u*)(ws + dbase + (size_t)(row0 + n) * ldt + k0 + 8 * c) = o; }
    } else {
#pragma unroll
        for (int j = 0; j < 4; ++j) { const int n = (lane >> 3) + 8 * j; const LAS float* s = scr + (8 * c) * 33 + n;
            v4u o; o.x = pk2(s[0 * 33], s[1 * 33]); o.y = pk2(s[2 * 33], s[3 * 33]); o.z = pk2(s[4 * 33], s[5 * 33]); o.w = pk2(s[6 * 33], s[7 * 33]);
            *(GAS v4u*)((bf16*)(ws + dbase) + (size_t)(row0 + n) * ldt + k0 + 8 * c) = o; }
    }
    LDS_WAIT(); asm volatile("" ::: "memory");
}
__device__ __forceinline__ void phase_convert(Frame& F, int layer) {
    LAS float* scr = (LAS float*)(F.lds + F.wave * 16384); const Args& A = *F.a; unsigned char* ws = F.ws; const int lane = F.lane;
    f32x4 la[8], lb[8];
    int it = F.gw;
    if (it < CONV_NMIX) mix_item_load(A, layer, it, lane, la);
#pragma unroll 1
    for (; it < CONV_NMIX; it += 2 * F.NGW) {
        const int i1 = it + F.NGW, i2 = i1 + F.NGW;
        if (i1 < CONV_NMIX) mix_item_load(A, layer, i1, lane, lb);
        mix_item_finish(ws, it, lane, la, scr);
        if (i2 < CONV_NMIX) mix_item_load(A, layer, i2, lane, la);
        if (i1 < CONV_NMIX) mix_item_finish(ws, i1, lane, lb, scr);
    }
}
__device__ __forceinline__ void ffn_item_load(const Args& A, int layer, int r, int lane, f32x4 (&ld)[8]) {
    asm volatile("" : "+v"(r));
    const bool moe = (layer & 1) != 0; const int j2 = layer >> 1, n_up = CONV_NUP1 * (moe ? NE : 1);
    const float* w; int ldw, k0, col0;
    if (r < n_up) { const int e = r / CONV_NUP1, q = r % CONV_NUP1, blk = q >> 4, kb = q & 15, tile = blk >> 3, jj = blk & 7;
        const size_t off = moe ? ((size_t)j2 * NE + e) * D * FF : (size_t)j2 * D * FF;
        w = (moe ? (jj < 4 ? A.in[I_MW1] : A.in[I_MW3]) : (jj < 4 ? A.in[I_W1] : A.in[I_W3])) + off; ldw = FF; k0 = 64 * kb; col0 = 128 * tile + 32 * (jj & 3);
    } else { r -= n_up; const int e = r / CONV_NDN1, q = r % CONV_NDN1, blk = q / 44, kb = q % 44;
        w = moe ? A.in[I_MW2] + ((size_t)j2 * NE + e) * FF * D : A.in[I_W2] + (size_t)j2 * FF * D; ldw = D; k0 = 64 * kb; col0 = 32 * blk; }
    w += (size_t)(k0 + (lane >> 3)) * ldw + col0 + 4 * (lane & 7);
#pragma unroll
    for (int i = 0; i < 8; ++i) ld[i] = *(const f32x4*)(w + (size_t)(8 * i) * ldw);
}
__device__ __forceinline__ void ffn_item_finish(const Args& A, unsigned char* ws, int layer, int r, int lane, f32x4 (&ld)[8], LAS float* scr) {
    asm volatile("" : "+v"(r));
    const bool moe = (layer & 1) != 0; const int n_up = CONV_NUP1 * (moe ? NE : 1);
    const bool f8 = moe ? (F8_MOE_UP != 0) : (DENSE8(layer) != 0); const float sc = f8 ? 64.0f : 1.0f;
    const bool up = r < n_up; int e, k0, row0, ldt; size_t dbase;
    if (up) { e = r / CONV_NUP1; const int q = r % CONV_NUP1, blk = q >> 4, kb = q & 15; k0 = 64 * kb; row0 = 32 * blk; ldt = D; dbase = WS_WUP + (size_t)e * 5632 * D * (f8 ? 1 : 2); }
    else { r -= n_up; e = r / CONV_NDN1; const int q = r % CONV_NDN1, blk = q / 44, kb = q % 44; k0 = 64 * kb; row0 = 32 * blk; ldt = FF; dbase = WS_WDN + (size_t)e * D * FF * (f8 ? 1 : 2); }
    const bool scaled = FUSE_DENSE_NORM && !moe && up;
    const float* ks = A.in[I_GFFN] + layer * D + k0 + (lane >> 3);
#pragma unroll
    for (int i = 0; i < 8; ++i) { LAS float* d = scr + (8 * i + (lane >> 3)) * 33 + 4 * (lane & 7); const float s = scaled ? sc * ks[8 * i] : sc; d[0] = ld[i][0] * s; d[1] = ld[i][1] * s; d[2] = ld[i][2] * s; d[3] = ld[i][3] * s; }
    LDS_WAIT(); asm volatile("" ::: "memory");
    const int c = lane & 7;
    if (f8) {
#pragma unroll
        for (int j = 0; j < 4; ++j) { const int n = (lane >> 3) + 8 * j; const LAS float* s = scr + (8 * c) * 33 + n;
            v2u o; o.x = pk4_fp8(s[0 * 33], s[1 * 33], s[2 * 33], s[3 * 33]); o.y = pk4_fp8(s[4 * 33], s[5 * 33], s[6 * 33], s[7 * 33]);
            *(GAS v2u*)(ws + dbase + (size_t)(row0 + n) * ldt + k0 + 8 * c) = o; }
    } else {
#pragma unroll
        for (int j = 0; j < 4; ++j) { const int n = (lane >> 3) + 8 * j; const LAS float* s = scr + (8 * c) * 33 + n;
            v4u o; o.x = pk2(s[0 * 33], s[1 * 33]); o.y = pk2(s[2 * 33], s[3 * 33]); o.z = pk2(s[4 * 33], s[5 * 33]); o.w = pk2(s[6 * 33], s[7 * 33]);
            *(GAS v4u*)((bf16*)(ws + dbase) + (size_t)(row0 + n) * ldt + k0 + 8 * c) = o; }
    }
    LDS_WAIT(); asm volatile("" ::: "memory");
}
__device__ __forceinline__ void convert_ffn_chunk(Frame& F, int layer, int chunk) {
    LAS float* scr = (LAS float*)(F.lds + F.wave * 16384); const int nf = conv_ffn_items(layer), base = chunk * CONV_CHUNK + F.wave;
    const Args& A = *F.a; unsigned char* ws = F.ws; const int lane = F.lane;
    f32x4 la[8], lb[8];
    ffn_item_load(A, layer, min(base, nf - 1), lane, la);
#pragma unroll 1
    for (int jj = 0; jj < CONV_CHUNK / NWAVES; jj += 2) {
        const int i0 = base + NWAVES * jj, i1 = i0 + NWAVES, i2 = i1 + NWAVES;
        ffn_item_load(A, layer, min(i1, nf - 1), lane, lb);
        if (i0 < nf) ffn_item_finish(A, ws, layer, i0, lane, la, scr);
        if (jj + 2 < CONV_CHUNK / NWAVES) ffn_item_load(A, layer, min(i2, nf - 1), lane, la);
        if (i1 < nf) ffn_item_finish(A, ws, layer, i1, lane, lb, scr);
    }
}
struct S5P { float lr, li, dt, kr, ki; };
__device__ __forceinline__ S5P s5_params(const Args& A, int layer, int g, int p) {
    S5P q; q.lr = A.in[I_LRE][(layer * 16 + g) * 64 + p]; q.li = A.in[I_LIM][(layer * 16 + g) * 64 + p]; q.dt = expf(A.in[I_LDT][layer * 16 + g]);
    const float mag = expf(q.lr * q.dt), abr = mag * cosf(q.li * q.dt), abi = mag * sinf(q.li * q.dt);
    const float nr = abr - 1.0f, ni = abi, den = q.lr * q.lr + q.li * q.li;
    q.kr = (nr * q.lr + ni * q.li) / den; q.ki = (ni * q.lr - nr * q.li) / den; return q;
}
__device__ __forceinline__ void s5_pow(const S5P& q, float n, float& pr, float& pi) { const float m = expf(n * q.lr * q.dt), a = n * q.li * q.dt; pr = m * cosf(a); pi = m * sinf(a); }
__device__ __forceinline__ void phase_kfun(Frame& F, int layer) {
    const Args& A = *F.a; float* kf = (float*)(F.ws + WS_KFUN);
    for (int it = F.gw; it < 16 * 64; it += F.NGW) {
        const int g = it >> 6, tau = it & 63, lane = F.lane;
        const S5P q = s5_params(A, layer, g, lane); float pr, pi; s5_pow(q, (float)tau, pr, pi);
        const float wr_ = pr * q.kr - pi * q.ki, wi_ = pr * q.ki + pi * q.kr;
        const int h = lane >> 2, hp0 = 4 * (lane & 3);
        const float* cre = A.in[I_CRE] + ((size_t)(layer * 16 + g) * 16 + h) * 64; const float* cim = A.in[I_CIM] + ((size_t)(layer * 16 + g) * 16 + h) * 64;
        const float* bre = A.in[I_BRE] + (size_t)(layer * 16 + g) * 64 * 16 + hp0; const float* bim = A.in[I_BIM] + (size_t)(layer * 16 + g) * 64 * 16 + hp0;
        f32x4 acc = {0.f, 0.f, 0.f, 0.f};
        for (int p = 0; p < 64; ++p) {
            const float wpr = __shfl(wr_, p), wpi = __shfl(wi_, p);
            const float cr = cre[p], ci = cim[p], cwr = cr * wpr - ci * wpi, cwi = cr * wpi + ci * wpr;
            const f32x4 br = *(const f32x4*)(bre + p * 16), bi = *(const f32x4*)(bim + p * 16);
            acc += cwr * br - cwi * bi;
        }
        *(f32x4*)(kf + ((size_t)(g * 64 + tau) * 16 + h) * 16 + hp0) = acc;
    }
}
__device__ __forceinline__ void moe_starts(Frame& F, int j2, int (&st)[NE + 1]) {
    const unsigned* cnt = (const unsigned*)(F.ws + WS_CTL) + CW_MOE + 64 * j2; int s = 0;
#pragma unroll
    for (int e = 0; e < NE; ++e) { st[e] = s; const int c = (int)__hip_atomic_load(cnt + e, __ATOMIC_RELAXED, __HIP_MEMORY_SCOPE_AGENT); s += (c + 255) & ~255; }
    st[NE] = s;
}
__device__ __forceinline__ void moe_combine_row(Frame& F, int row, f32x4 (&v)[4], const int (&st)[NE + 1]) {
    const unsigned* rt = (const unsigned*)(F.ws + WS_ROUTE) + (size_t)row * 8;
    const v4u rr = *(const v4u*)rt; unsigned s0 = rr.z, s1 = rr.w;
#pragma unroll
    for (int e = 0; e < NE; ++e) { if ((int)rr.x == e) s0 += (unsigned)st[e]; if ((int)rr.y == e) s1 += (unsigned)st[e]; }
    const float w0 = __builtin_bit_cast(float, rt[4]), w1 = __builtin_bit_cast(float, rt[5]);
    const bf16* yp = (const bf16*)(F.ws + WS_XNP);
#pragma unroll
    for (int j = 0; j < 4; ++j) { const v2u a = *(const v2u*)(yp + (size_t)s0 * D + 4 * F.lane + 256 * j), b = *(const v2u*)(yp + (size_t)s1 * D + 4 * F.lane + 256 * j);
        v[j][0] += w0 * bflo(a.x) + w1 * bflo(b.x); v[j][1] += w0 * bfhi(a.x) + w1 * bfhi(b.x); v[j][2] += w0 * bflo(a.y) + w1 * bflo(b.y); v[j][3] += w0 * bfhi(a.y) + w1 * bfhi(b.y); }
}
__device__ __forceinline__ void phase_rows_mixer(Frame& F, int layer) {
    const Args& A = *F.a; const int lane = F.lane;
    const float* xin = A.in[I_X]; bf16* xb = (bf16*)(F.ws + WS_XB); const bool first = (layer == 0), comb = (layer > 0) && (((layer - 1) & 1) != 0);
    f32x4 gv[4]; f32x4 wf[4][4];
#pragma unroll
    for (int j = 0; j < 4; ++j) { gv[j] = *(const f32x4*)(A.in[I_GMIX] + layer * D + 4 * lane + 256 * j);
#pragma unroll
        for (int e = 0; e < 4; ++e) wf[j][e] = *(const f32x4*)(A.in[I_WIN] + (size_t)layer * D * DP + (size_t)(4 * lane + 256 * j + e) * DP + 1024); }
    const f32x4 bf = *(const f32x4*)(A.in[I_BFORGET] + layer * 4);
    bf16* xn = (bf16*)(F.ws + WS_XN); float* lf = (float*)(F.ws + WS_LF); unsigned char* xn8 = F.ws + WS_XN8;
    int st[NE + 1];
#pragma unroll
    for (int e = 0; e <= NE; ++e) st[e] = 0;
    if (comb) moe_starts(F, (layer - 1) >> 1, st);
    for (int row = F.gw; row < T; row += F.NGW) {
        f32x4 v[4]; float ss = 0.f;
        if (first) {
#pragma unroll
            for (int j = 0; j < 4; ++j) v[j] = *(const f32x4*)(xin + (size_t)row * D + 4 * lane + 256 * j);
        } else {
#pragma unroll
            for (int j = 0; j < 4; ++j) { const v2u r = *(const v2u*)(xb + (size_t)row * D + 4 * lane + 256 * j); v[j] = (f32x4){bflo(r.x), bfhi(r.x), bflo(r.y), bfhi(r.y)}; }
        }
        if (comb) { moe_combine_row(F, row, v, st);
#pragma unroll
            for (int j = 0; j < 4; ++j) { v2u o; o.x = pk2(v[j][0], v[j][1]); o.y = pk2(v[j][2], v[j][3]); *(v2u*)(xb + (size_t)row * D + 4 * lane + 256 * j) = o;
                v[j] = (f32x4){bflo(o.x), bfhi(o.x), bflo(o.y), bfhi(o.y)}; } }
#pragma unroll
        for (int j = 0; j < 4; ++j) ss += (v[j][0] * v[j][0] + v[j][1] * v[j][1]) + (v[j][2] * v[j][2] + v[j][3] * v[j][3]);
        const float rs = 1.0f / sqrtf(wave_sum(ss) * (1.0f / D) + EPS);
        f32x4 fl = {0.f, 0.f, 0.f, 0.f};
#pragma unroll
        for (int j = 0; j < 4; ++j) { const f32x4 h = v[j] * rs * gv[j];
            v2u o; o.x = pk2(h[0], h[1]); o.y = pk2(h[2], h[3]); *(v2u*)(xn + (size_t)row * D + 4 * lane + 256 * j) = o;
            if (F8_GATES) *(unsigned*)(xn8 + (size_t)row * D + 4 * lane + 256 * j) = pk4_fp8(h[0], h[1], h[2], h[3]);
#pragma unroll
            for (int e = 0; e < 4; ++e) fl += h[e] * wf[j][e]; }
#pragma unroll
        for (int e = 0; e < 4; ++e) fl[e] = wave_sum(fl[e]);
        if (lane == 0) { f32x4 o;
#pragma unroll
            for (int e = 0; e < 4; ++e) { const float xx = fl[e] + bf[e]; o[e] = (fminf(xx, 0.f) - log1pf(expf(-fabsf(xx)))) * LOG2E; }
            *(f32x4*)(lf + (size_t)row * 4) = o; }
    }
}
__device__ __forceinline__ void phase_s5_tables(Frame& F, int layer) {
    const Args& A = *F.a; const int lane = F.lane;
    bf16* wz = (bf16*)(F.ws + WS_WZ); bf16* wy = (bf16*)(F.ws + WS_WY); const float* kf = (const float*)(F.ws + WS_KFUN);
    for (int it = F.gw; it < 16 * 256; it += F.NGW) {
        const int g = it >> 8, rowz = it & 255; bf16* dst = wz + ((size_t)(g * 256 + rowz)) * 1024 + lane * 16;
        v4u o0 = {0u, 0u, 0u, 0u}, o1 = {0u, 0u, 0u, 0u};
        if (rowz < 128) { const int p = rowz >> 1, ri = rowz & 1; const S5P q = s5_params(A, layer, g, p); float pr, pi; s5_pow(q, (float)(63 - lane), pr, pi);
            const float wr_ = pr * q.kr - pi * q.ki, wi_ = pr * q.ki + pi * q.kr;
            const float* bre = A.in[I_BRE] + ((size_t)(layer * 16 + g) * 64 + p) * 16; const float* bim = A.in[I_BIM] + ((size_t)(layer * 16 + g) * 64 + p) * 16;
            float val[16];
#pragma unroll
            for (int h = 0; h < 16; ++h) { const float br = bre[h], bi = bim[h]; val[h] = ri == 0 ? (wr_ * br - wi_ * bi) : (wr_ * bi + wi_ * br); }
            o0 = (v4u){pk2(val[0], val[1]), pk2(val[2], val[3]), pk2(val[4], val[5]), pk2(val[6], val[7])};
            o1 = (v4u){pk2(val[8], val[9]), pk2(val[10], val[11]), pk2(val[12], val[13]), pk2(val[14], val[15])}; }
        *(v4u*)dst = o0; *(v4u*)(dst + 8) = o1;
    }
    for (int it = F.gw; it < 16 * 1024; it += F.NGW) {
        const int g = it >> 10, n = it & 1023, t = n >> 4, h = n & 15; bf16* dst = wy + ((size_t)(g * 1024 + n)) * S5_LDA;
        v4u o0 = {0u, 0u, 0u, 0u}, o1 = {0u, 0u, 0u, 0u};
        if (lane <= t) { const float* src = kf + ((size_t)(g * 64 + (t - lane)) * 16 + h) * 16;
            const f32x4 a = *(const f32x4*)src, b = *(const f32x4*)(src + 4), c = *(const f32x4*)(src + 8), d = *(const f32x4*)(src + 12);
            o0 = (v4u){pk2(a[0], a[1]), pk2(a[2], a[3]), pk2(b[0], b[1]), pk2(b[2], b[3])}; o1 = (v4u){pk2(c[0], c[1]), pk2(c[2], c[3]), pk2(d[0], d[1]), pk2(d[2], d[3])}; }
        *(v4u*)(dst + lane * 16) = o0; *(v4u*)(dst + lane * 16 + 8) = o1;
        const S5P q = s5_params(A, layer, g, lane); float pr, pi; s5_pow(q, (float)(t + 1), pr, pi);
        const float cr = A.in[I_CRE][((size_t)(layer * 16 + g) * 16 + h) * 64 + lane], ci = A.in[I_CIM][((size_t)(layer * 16 + g) * 16 + h) * 64 + lane];
        *(unsigned*)(dst + 1024 + 2 * lane) = pk2(cr * pr - ci * pi, -(cr * pi + ci * pr));
    }
}
__device__ __forceinline__ void phase_cumsum(Frame& F) {
    const int first = (gridDim.x >= 160) ? 128 : 0;
    if ((int)blockIdx.x < first || (int)blockIdx.x >= first + 32) return;
    const int bh = (int)blockIdx.x - first, b = bh >> 2, h = bh & 3, tid = F.tid;
    const float* lf = (const float*)(F.ws + WS_LF); float* cum = (float*)(F.ws + WS_CUM);
    LAS float* wtot = (LAS float*)(F.lds);
    float v[8]; float run = 0.f;
#pragma unroll
    for (int i = 0; i < 8; ++i) { run += lf[((size_t)b * SEQ + tid * 8 + i) * 4 + h]; v[i] = run; }
    float incl = run;
#pragma unroll
    for (int o = 1; o < 64; o <<= 1) { const float n = __shfl_up(incl, o); if (F.lane >= o) incl += n; }
    if (F.lane == 63) wtot[F.wave] = incl;
    __syncthreads();
    float base = incl - run;
    for (int w = 0; w < F.wave; ++w) base += wtot[w];
#pragma unroll
    for (int i = 0; i < 8; ++i) cum[(size_t)bh * SEQ + tid * 8 + i] = base + v[i];
    __syncthreads();
}
__device__ __forceinline__ void phase_conv(Frame& F, int layer) {
    const Args& A = *F.a; const int lane = F.lane;
    LAS f32x4* wl = (LAS f32x4*)F.lds;
    { int ly = layer; asm volatile("" : "+v"(ly));
      const float* cw = A.in[I_CONVW] + (size_t)ly * 31 * 256;
      for (int i = F.tid; i < 31 * 64; i += NWAVES * 64) wl[i] = *(const f32x4*)(cw + (size_t)i * 4); }
    __syncthreads();
    const f32x4 cb = *(const f32x4*)(A.in[I_CONVB] + layer * 256 + 4 * lane), lg = *(const f32x4*)(A.in[I_LNG] + layer * 256 + 4 * lane), lb = *(const f32x4*)(A.in[I_LNB] + layer * 256 + 4 * lane);
    const bf16* uc = (const bf16*)(F.ws + WS_UC); bf16* ycat = (bf16*)(F.ws + WS_YCAT);
    for (int run = F.gw; run < T / 8; run += F.NGW) {
        const int t0 = run * 8, tl0 = t0 & (SEQ - 1);
        f32x4 acc[8];
#pragma unroll
        for (int i = 0; i < 8; ++i) acc[i] = cb;
#pragma unroll
        for (int r = 0; r < 38; ++r) {
            v2u raw = {0u, 0u};
            if (tl0 - 30 + r >= 0) raw = *(const v2u*)(uc + (size_t)(t0 - 30 + r) * 256 + 4 * lane);
            const f32x4 x = {bflo(raw.x), bfhi(raw.x), bflo(raw.y), bfhi(raw.y)};
#pragma unroll
            for (int i = 0; i < 8; ++i) { const int j = r - i; if (j >= 0 && j < 31) acc[i] += wl[j * 64 + lane] * x; }
        }
#pragma unroll
        for (int i = 0; i < 8; ++i) {
            const f32x4 a = acc[i];
            const float mean = wave_sum((a[0] + a[1]) + (a[2] + a[3])) * (1.0f / 256.0f);
            const f32x4 dlt = a - mean;
            const float var = wave_sum((dlt[0] * dlt[0] + dlt[1] * dlt[1]) + (dlt[2] * dlt[2] + dlt[3] * dlt[3])) * (1.0f / 256.0f);
            const float rs = 1.0f / sqrtf(var + EPS);
            f32x4 y = dlt * rs * lg + lb;
#pragma unroll
            for (int e = 0; e < 4; ++e) y[e] = y[e] * sigmoidf_(y[e]);
            v2u o; o.x = pk2(y[0], y[1]); o.y = pk2(y[2], y[3]);
            *(v2u*)(ycat + (size_t)(t0 + i) * 1024 + 512 + 4 * lane) = o;
        }
    }
    __syncthreads();
}

typedef float f32x16 __attribute__((ext_vector_type(16)));
typedef short s16x4 __attribute__((ext_vector_type(4)));
constexpr int AW_BLKS = 11, AW_KEYS = 32 * AW_BLKS, AW_K = 0, AW_V = AW_KEYS * 128, AW_C = 2 * AW_KEYS * 128, AW_FLAG = AW_C + AW_KEYS * 4;
constexpr float SB_DEAD = -64.0f;
__device__ __forceinline__ s16x4 tr_read(const LAS unsigned char* p) { return __builtin_bit_cast(s16x4, __builtin_amdgcn_ds_read_tr16_b64_v4i16((LAS s16x4*)p)); }

template <int MODE>
__device__ __forceinline__ void attn_unit(Frame& F, int bh, int qb, const bf16* Q, const bf16* K, const bf16* V, const float* CUM, bf16* Y, float z2max) {
    const int tid = F.tid, lane = F.lane, w = F.wave, l31 = lane & 31, hh = lane >> 5;
    const int b = bh >> 2, h = bh & 3, qblk = qb * 8 + w, qw0 = 32 * qblk, qrow = qw0 + l31;
    const size_t rowbase = (size_t)b * SEQ;
    LAS unsigned char* lds = F.lds;
    LAS unsigned* flags = (LAS unsigned*)(lds + AW_FLAG);
    if (tid < 3) flags[tid] = 0u;
    bf16x8 qf[4];
#pragma unroll
    for (int s = 0; s < 4; ++s) qf[s] = *(const bf16x8*)(Q + (rowbase + qrow) * 256 + h * 64 + 16 * s + 8 * hh);
    f32x16 ot[2];
#pragma unroll
    for (int r = 0; r < 16; ++r) { ot[0][r] = 0.f; ot[1][r] = 0.f; }
    float m_run = -INFINITY, l_run = 0.f, carry = 0.f;
    const int ti = lane & 15, tq = ti >> 2, tp = ti & 3, tg = (lane >> 4) & 1;
    int kofs[4], vofs[2];
#pragma unroll
    for (int s = 0; s < 4; ++s) kofs[s] = AW_K + l31 * 128 + (((2 * s + hh) ^ (l31 & 7)) << 4);
#pragma unroll
    for (int db = 0; db < 2; ++db) vofs[db] = AW_V + (4 * hh + tq) * 128 + (((4 * db + 2 * tg + (tp >> 1)) ^ (4 * hh + tq)) << 4) + 8 * (tp & 1);
    const int srow = lane >> 3, sch = ((lane & 7) ^ srow) * 8;
    int kbw = qblk; bool done = false; int it = 0;
    for (int whi = qb * 8 + 7; whi >= 0; whi -= AW_BLKS, ++it) {
        const int wlo = whi - (AW_BLKS - 1), key0 = 32 * wlo;
        for (int g = w; g < 2 * AW_KEYS / 8; g += NWAVES) {
            const int gg = g < AW_KEYS / 8 ? g : g - AW_KEYS / 8; const int key = max(key0 + 8 * gg + srow, 0);
            const bf16* src = (g < AW_KEYS / 8 ? K : V) + (rowbase + key) * 256 + h * 64 + sch;
            __builtin_amdgcn_global_load_lds((const unsigned*)src, (LAS unsigned*)(lds + (g < AW_KEYS / 8 ? AW_K : AW_V) + gg * 1024), 16, 0, 0);
        }
        if (MODE == 0 && tid < AW_KEYS) *(LAS float*)(lds + AW_C + tid * 4) = -CUM[(size_t)bh * SEQ + max(key0 + tid, 0)];
        asm volatile("s_waitcnt vmcnt(0)" ::: "memory");
        __syncthreads();
        if (!done) {
            const int lo = max(wlo, 0);
            for (; kbw >= lo; --kbw) {
                const int kv0 = 32 * kbw, rb = (kbw - wlo) * 32;
                if (MODE == 0) { const float clast = *(const LAS float*)(lds + AW_C + (rb + 31) * 4); if (__all((z2max + clast - m_run) < SB_DEAD)) { done = true; break; } }
                else if (__all(carry < SB_DEAD)) { done = true; break; }
                f32x16 p;
                if (MODE == 0) {
#pragma unroll
                    for (int c = 0; c < 4; ++c) { const f32x4 ck = *(const LAS f32x4*)(lds + AW_C + (rb + 8 * c + 4 * hh) * 4); p[4 * c] = ck[0]; p[4 * c + 1] = ck[1]; p[4 * c + 2] = ck[2]; p[4 * c + 3] = ck[3]; }
                } else {
#pragma unroll
                    for (int r = 0; r < 16; ++r) p[r] = 0.f;
                }
#pragma unroll
                for (int s = 0; s < 4; ++s) { const bf16x8 kf = *(const LAS bf16x8*)(lds + rb * 128 + kofs[s]); p = __builtin_amdgcn_mfma_f32_32x32x16_bf16(kf, qf[s], p, 0, 0, 0); }
                const bool diag = (kbw == qblk);
                if (MODE == 0) {
                    if (diag) {
#pragma unroll
                        for (int r = 0; r < 16; ++r) { const int kvg = kv0 + (r & 3) + 8 * (r >> 2) + 4 * hh; if (kvg > qrow) p[r] = -INFINITY; }
                    }
                    float mt = p[0];
#pragma unroll
                    for (int r = 1; r < 16; ++r) mt = fmaxf(mt, p[r]);
                    mt = fmaxf(mt, __shfl_xor(mt, 32));
                    const float mn = fmaxf(m_run, mt), alpha = fast_exp2(m_run - mn); m_run = mn;
                    float rs = 0.f;
#pragma unroll
                    for (int r = 0; r < 16; ++r) { p[r] = fast_exp2(p[r] - mn); rs += p[r]; }
                    l_run = l_run * alpha + rs;
                    if (__any(alpha != 1.0f)) {
#pragma unroll
                        for (int r = 0; r < 16; ++r) { ot[0][r] *= alpha; ot[1][r] *= alpha; } }
                } else {
                    f32x16 lk;
#pragma unroll
                    for (int r = 0; r < 16; ++r) { const float z = p[r], e = fast_exp2(-fabsf(z)), lg = __builtin_amdgcn_logf(1.0f + e);
                        float lb = fminf(z, 0.f) - lg, k_ = -(fmaxf(z, 0.f) + lg);
                        if (diag) { const int kvg = kv0 + (r & 3) + 8 * (r >> 2) + 4 * hh; if (kvg >= qrow) { k_ = 0.f; lb = -INFINITY; } }
                        p[r] = lb; lk[r] = k_; }
                    float T4[4], To[4], PS[4];
#pragma unroll
                    for (int c = 0; c < 4; ++c) { T4[c] = (lk[4 * c] + lk[4 * c + 1]) + (lk[4 * c + 2] + lk[4 * c + 3]); To[c] = __shfl_xor(T4[c], 32); }
                    float run = 0.f;
#pragma unroll
                    for (int c = 3; c >= 0; --c) { PS[c] = run; run += T4[c] + To[c]; }
#pragma unroll
                    for (int c = 0; c < 4; ++c) { const float base = carry + PS[c] + (hh == 0 ? To[c] : 0.f);
                        const float s3 = lk[4 * c + 3], s2 = s3 + lk[4 * c + 2], s1 = s2 + lk[4 * c + 1];
                        p[4 * c + 3] = fast_exp2(p[4 * c + 3] + base); p[4 * c + 2] = fast_exp2(p[4 * c + 2] + base + s3);
                        p[4 * c + 1] = fast_exp2(p[4 * c + 1] + base + s2); p[4 * c] = fast_exp2(p[4 * c] + base + s1); }
                    carry += run;
                }
                bf16x8 pb[2];
#pragma unroll
                for (int c2 = 0; c2 < 2; ++c2) { v4u wv; wv.x = pg8::cvt_pk_bf16(p[8 * c2], p[8 * c2 + 1]); wv.y = pg8::cvt_pk_bf16(p[8 * c2 + 2], p[8 * c2 + 3]);
                    wv.z = pg8::cvt_pk_bf16(p[8 * c2 + 4], p[8 * c2 + 5]); wv.w = pg8::cvt_pk_bf16(p[8 * c2 + 6], p[8 * c2 + 7]); pb[c2] = __builtin_bit_cast(bf16x8, wv); }
#pragma unroll
                for (int db = 0; db < 2; ++db)
#pragma unroll
                    for (int c2 = 0; c2 < 2; ++c2) { const LAS unsigned char* vp = lds + (rb + 16 * c2) * 128 + vofs[db];
                        const s16x4 lo4 = tr_read(vp), hi4 = tr_read(vp + 8 * 128);
                        const bf16x8 va = {lo4[0], lo4[1], lo4[2], lo4[3], hi4[0], hi4[1], hi4[2], hi4[3]};
                        ot[db] = __builtin_amdgcn_mfma_f32_32x32x16_bf16(va, pb[c2], ot[db], 0, 0, 0); }
            }
            if (kbw < 0) done = true;
        }
        { const int sl = it % 3, sn = (it + 1) % 3;
            if (!done && lane == 0) flags[sl] = 1u;
            if (tid == 0) flags[sn] = 0u;
            __syncthreads();
            if (flags[sl] == 0u) break; }
    }
    float inv = 1.0f;
    if (MODE == 0) { const float lt = l_run + __shfl_xor(l_run, 32); inv = 1.0f / lt; }
    bf16* yrow = Y + (rowbase + qrow) * 1024 + h * 64;
#pragma unroll
    for (int db = 0; db < 2; ++db)
#pragma unroll
        for (int c = 0; c < 4; ++c) { v2u o; o.x = pg8::cvt_pk_bf16(ot[db][4 * c] * inv, ot[db][4 * c + 1] * inv); o.y = pg8::cvt_pk_bf16(ot[db][4 * c + 2] * inv, ot[db][4 * c + 3] * inv);
            *(v2u*)(yrow + 32 * db + 8 * c + 4 * hh) = o; }
}
__device__ __forceinline__ int q_pop(Frame& F, unsigned* ctr) {
    LAS int* slot = (LAS int*)(F.lds + QSLOT_OFF);
    __syncthreads();
    if (F.tid == 0) *slot = (int)__hip_atomic_fetch_add(ctr, 1u, __ATOMIC_RELAXED, __HIP_MEMORY_SCOPE_AGENT);
    __syncthreads();
    return *slot;
}
__device__ __forceinline__ void phase_attn_sb(Frame& F, int layer, int rep) {
    const bf16* qkv = (const bf16*)(F.ws + WS_QKV); const size_t sz = (size_t)T * 256; bf16* ycat = (bf16*)(F.ws + WS_YCAT);
    unsigned* ctr = (unsigned*)(F.ws + WS_CTL) + CW_Q + 128 * layer + 16 * rep;
    for (;;) { const int un = q_pop(F, ctr); if (un >= 512) break;
        attn_unit<1>(F, un & 31, 15 - (un >> 5), qkv + 3 * sz, qkv + 4 * sz, qkv + 5 * sz, nullptr, ycat + 768, 0.f); }
}
__device__ __forceinline__ void phase_attn_fox(Frame& F, int layer, int rep) {
    const bf16* qkv = (const bf16*)(F.ws + WS_QKV); const size_t sz = (size_t)T * 256; const float* cum = (const float*)(F.ws + WS_CUM); bf16* ycat = (bf16*)(F.ws + WS_YCAT);
    unsigned* ctr = (unsigned*)(F.ws + WS_CTL) + CW_Q + 128 * layer + 64 + 16 * rep;
    const float gq = fabsf(F.a->in[I_FQG][layer * 64 + F.lane]), gk = fabsf(F.a->in[I_FKG][layer * 64 + F.lane]);
    float mq = gq, mk = gk;
#pragma unroll
    for (int o = 1; o < 64; o <<= 1) { mq = fmaxf(mq, __shfl_xor(mq, o)); mk = fmaxf(mk, __shfl_xor(mk, o)); }
    const float z2max = 8.0f * mq * mk * LOG2E * 1.02f + 0.25f;
    const int nchunk = (conv_ffn_items(layer) + CONV_CHUNK - 1) / CONV_CHUNK;
    const int total = 512 + nchunk;
    for (;;) { const int t = q_pop(F, ctr); if (t >= total) break;
        const int na0 = (int)(((long)t * 512) / total), na1 = (int)(((long)(t + 1) * 512) / total);
        if (na1 > na0) attn_unit<0>(F, na0 & 31, 15 - (na0 >> 5), qkv, qkv + sz, qkv + 2 * sz, cum, ycat + 256, z2max);
        else convert_ffn_chunk(F, layer, t - na0); }
}
__device__ __forceinline__ void phase_s5_scan_unit(Frame& F, int layer, int g, int pm) {
    __builtin_amdgcn_fence(__ATOMIC_ACQUIRE, "agent");
    if (F.tid < 256) {
        const int b = 4 * pm + (F.tid >> 6), p = F.tid & 63;
        const S5P q = s5_params(*F.a, layer, g, p); float ar, ai; s5_pow(q, 64.0f, ar, ai);
        const float* z = (const float*)(F.ws + WS_Z); bf16* ua = (bf16*)(F.ws + WS_UA);
        float sr = 0.f, si = 0.f;
        for (int n0 = 0; n0 < 64; n0 += 16) {
            f32x2 zz[16];
#pragma unroll
            for (int j = 0; j < 16; ++j) zz[j] = *(const f32x2*)(z + ((size_t)g * 512 + b * 64 + n0 + j) * 128 + 2 * p);
#pragma unroll
            for (int j = 0; j < 16; ++j) { const size_t ch = (size_t)g * 512 + b * 64 + n0 + j;
                *(unsigned*)(ua + ch * S5_LDA + 1024 + 2 * p) = pk2(sr, si);
                const float nr = ar * sr - ai * si + zz[j][0], ni = ar * si + ai * sr + zz[j][1]; sr = nr; si = ni; }
        }
    }
    __syncthreads();
}
__device__ __forceinline__ void phase_rows_ffn(Frame& F, int layer) {
    const Args& A = *F.a; const int lane = F.lane; const int j2 = layer >> 1;
    f32x4 gv[4];
#pragma unroll
    for (int j = 0; j < 4; ++j) gv[j] = *(const f32x4*)(A.in[I_GFFN] + layer * D + 4 * lane + 256 * j);
    const bf16* xb = (const bf16*)(F.ws + WS_XB); unsigned char* seg = F.ws + WS_XNP; unsigned* route = (unsigned*)(F.ws + WS_ROUTE); unsigned* cnt = (unsigned*)(F.ws + WS_CTL) + CW_MOE + 64 * j2;
    unsigned my_e0 = 0, my_e1 = 0, my_r0 = 0, my_r1 = 0; float my_w0 = 0.f, my_w1 = 0.f, my_rs = 0.f; unsigned long long lc = 0ull; int nrow = 0;
    for (int row = F.gw; row < T; row += F.NGW, ++nrow) {
        f32x4 v[4]; float ss = 0.f;
#pragma unroll
        for (int j = 0; j < 4; ++j) { const v2u r = *(const v2u*)(xb + (size_t)row * D + 4 * lane + 256 * j); v[j] = (f32x4){bflo(r.x), bfhi(r.x), bflo(r.y), bfhi(r.y)};
            ss += (v[j][0] * v[j][0] + v[j][1] * v[j][1]) + (v[j][2] * v[j][2] + v[j][3] * v[j][3]); }
        const float rs = 1.0f / sqrtf(wave_sum(ss) * (1.0f / D) + EPS);
        float lg[8];
#pragma unroll
        for (int e = 0; e < 8; ++e) lg[e] = 0.f;
#pragma unroll
        for (int j = 0; j < 4; ++j) { const f32x4 h = v[j] * rs * gv[j];
#pragma unroll
            for (int e4 = 0; e4 < 4; ++e4) { const float* wr = A.in[I_RW] + ((size_t)j2 * D + 4 * lane + 256 * j + e4) * NE; const f32x4 a = *(const f32x4*)wr, b = *(const f32x4*)(wr + 4);
                lg[0] += h[e4] * a[0]; lg[1] += h[e4] * a[1]; lg[2] += h[e4] * a[2]; lg[3] += h[e4] * a[3]; lg[4] += h[e4] * b[0]; lg[5] += h[e4] * b[1]; lg[6] += h[e4] * b[2]; lg[7] += h[e4] * b[3]; } }
#pragma unroll
        for (int e = 0; e < 8; ++e) lg[e] = wave_sum(lg[e]) + A.in[I_RB][j2 * NE + e];
        int e0 = 0; float v0 = lg[0];
#pragma unroll
        for (int e = 1; e < 8; ++e) if (lg[e] > v0) { v0 = lg[e]; e0 = e; }
        int e1 = -1; float v1 = -INFINITY;
#pragma unroll
        for (int e = 0; e < 8; ++e) if (e != e0 && lg[e] > v1) { v1 = lg[e]; e1 = e; }
        const float w1 = 1.0f / (1.0f + expf(v0 - v1)), w0 = 1.0f - w1;
        const unsigned r0 = (unsigned)(lc >> (8 * e0)) & 0xffu; lc += 1ull << (8 * e0);
        const unsigned r1 = (unsigned)(lc >> (8 * e1)) & 0xffu; lc += 1ull << (8 * e1);
        if (lane == nrow) { my_e0 = e0; my_e1 = e1; my_r0 = r0; my_r1 = r1; my_w0 = w0; my_w1 = w1; my_rs = rs; }
    }
    unsigned basev = 0;
    if (lane < 8) { const unsigned c = (unsigned)(lc >> (8 * lane)) & 0xffu; basev = c ? __hip_atomic_fetch_add(cnt + lane, c, __ATOMIC_RELAXED, __HIP_MEMORY_SCOPE_AGENT) : 0u; }
    const unsigned my_p0 = __shfl(basev, (int)my_e0) + my_r0, my_p1 = __shfl(basev, (int)my_e1) + my_r1;
    if (lane < nrow) { const int row = F.gw + lane * F.NGW; unsigned* rt = route + (size_t)row * 8;
        *(v4u*)rt = (v4u){my_e0, my_e1, my_p0, my_p1}; *(v4u*)(rt + 4) = (v4u){__builtin_bit_cast(unsigned, my_w0), __builtin_bit_cast(unsigned, my_w1), 0u, 0u}; }
    for (int i = 0; i < nrow; ++i) {
        const int row = F.gw + i * F.NGW; const float rs = __shfl(my_rs, i);
        const size_t d0 = ((size_t)__shfl((int)my_e0, i) * T + (size_t)__shfl((int)my_p0, i)) * D, d1 = ((size_t)__shfl((int)my_e1, i) * T + (size_t)__shfl((int)my_p1, i)) * D;
#pragma unroll
        for (int j = 0; j < 4; ++j) { const v2u r = *(const v2u*)(xb + (size_t)row * D + 4 * lane + 256 * j);
            const f32x4 h = (f32x4){bflo(r.x), bfhi(r.x), bflo(r.y), bfhi(r.y)} * rs * gv[j]; const unsigned w = pk4_fp8(h[0], h[1], h[2], h[3]);
            *(unsigned*)(seg + d0 + 4 * lane + 256 * j) = w; *(unsigned*)(seg + d1 + 4 * lane + 256 * j) = w; }
    }
}
__device__ __forceinline__ void phase_final_combine(Frame& F) {
    const Args& A = *F.a; int st[NE + 1]; moe_starts(F, (DEPTH - 1) >> 1, st);
    for (int row = F.gw; row < T; row += F.NGW) {
        f32x4 v[4];
#pragma unroll
        for (int j = 0; j < 4; ++j) { const v2u r = *(const v2u*)((const bf16*)(F.ws + WS_XB) + (size_t)row * D + 4 * F.lane + 256 * j); v[j] = (f32x4){bflo(r.x), bfhi(r.x), bflo(r.y), bfhi(r.y)}; }
        moe_combine_row(F, row, v, st);
#pragma unroll
        for (int j = 0; j < 4; ++j) *(f32x4*)(A.out + (size_t)row * D + 4 * F.lane + 256 * j) = v[j];
    }
}

__global__ void __launch_bounds__(NWAVES * 64, 2) mk_fwd(Args args) {
    extern __shared__ __attribute__((aligned(16))) unsigned char lds_raw[];
    Frame F; F.lds = (LAS unsigned char*)lds_raw; F.tid = threadIdx.x; F.lane = F.tid & 63; F.wave = __builtin_amdgcn_readfirstlane(F.tid >> 6);
    F.G = gridDim.x; { const int bx = blockIdx.x; F.bx = bx; F.vcu = (F.G % 8 == 0) ? (bx % 8) * (F.G / 8) + bx / 8 : bx; }
    F.gw = F.vcu * NWAVES + F.wave; F.NGW = F.G * NWAVES; F.a = &args; F.ws = args.ws;
    volatile LAS unsigned* MISC = (volatile LAS unsigned*)(F.lds + MISC_OFF);
    for (int u = F.tid; u < (LDS_BYTES - RING_BYTES) / 4; u += NWAVES * 64) ((LAS unsigned*)(F.lds + RING_BYTES))[u] = 0u;
    __syncthreads();
    unsigned* ctl = (unsigned*)(args.ws + WS_CTL);
    const bool multi = (args.gp_hi - args.gp_lo) > 1;
    XcdBarrier bar; bar.bar = ctl + CW_BAR; bar.x = 0; bar.st = nullptr;
    if (multi) bar = xcd_barrier_post(ctl + CW_BAR, MISC + 8);
    unsigned char* ws = args.ws;
    LAS unsigned char* ring = F.lds;

    if (threadIdx.x == 0) { MISC[17] = (unsigned)args.gp_lo; MISC[18] = (unsigned)args.gp_hi; }
    __syncthreads();
#define gp_lo ((int)__builtin_amdgcn_readfirstlane((int)MISC[17]))
#define gp_hi ((int)__builtin_amdgcn_readfirstlane((int)MISC[18]))
#define IN(p) (gp_lo <= layer * NPH + (p) && layer * NPH + (p) < gp_hi)
#define SEAM(p) do { if (IN(p) && layer * NPH + (p) + 1 < gp_hi) xcd_barrier(bar); } while (0)
#ifndef PH_MASK
#define PH_MASK 0xffff
#endif
#define ON(p) (((PH_MASK) >> (p)) & 1)
#ifndef PROBE_PH
#define PROBE_PH -1
#endif
#ifndef PROBE_N
#define PROBE_N 1
#endif
#ifndef PROBE_LAYERS
#define PROBE_LAYERS 15
#endif
#define REPS(p) ((((p) == PROBE_PH) && ((PROBE_LAYERS >> layer) & 1)) ? 1 + PROBE_N : 1)
#define SUBREPS(p) for (int r2_ = 0; r2_ < REPS(p); ++r2_)
#define ENTER() do { LAYER_REFRESH(); { int b_ = blockIdx.x; asm volatile("" : "+s"(b_)); F.bx = b_; F.vcu = (F.G % 8 == 0) ? (b_ % 8) * (F.G / 8) + b_ / 8 : b_; } ws = args.ws; asm volatile("" : "+s"(ws)); F.ws = ws; int t_ = threadIdx.x; asm volatile("" : "+v"(t_)); F.tid = t_; F.lane = t_ & 63; F.wave = __builtin_amdgcn_readfirstlane(t_ >> 6); F.gw = F.vcu * NWAVES + F.wave; } while (0)
#define LAYER_REFRESH() do { int l_ = __builtin_amdgcn_readfirstlane(layer_iv); asm volatile("" : "+s"(l_)); layer = l_; } while (0)
    for (int layer_iv = gp_lo / NPH; layer_iv < DEPTH && layer_iv * NPH < gp_hi; ++layer_iv) {
        int layer; LAYER_REFRESH();
        const bool moe = (layer & 1) != 0;
#if ON(0)
        if (IN(0)) for (int rep_ = 0; rep_ < REPS(0); ++rep_) { ENTER(); for (int r2_ = 0; r2_ < ((PROBE_PH == 100) ? 1 + PROBE_N : 1); ++r2_) { phase_convert(F, layer); phase_kfun(F, layer); } phase_rows_mixer(F, layer); }
        SEAM(0);
#endif
#if ON(1)
        if (IN(1)) for (int rep_ = 0; rep_ < REPS(1); ++rep_) { ENTER();
            phase_s5_tables(F, layer); phase_cumsum(F);
#if F8_GATES
            { pg8::Gemm g8{(const bf16*)(ws + WS_XN8), (const bf16*)(ws + WS_WIN8), D / 2, D / 2, D / 2}; pg8::StaticOrder S8; S8.init(T, 4096, F.G, F.bx, D / 2, D / 2);
              if (F.G == 256) S8.full = 7;
              pg8::EpiGateSig E8; E8.gate = (bf16*)(ws + WS_GATE);
              pg8::gemm_phase<pg8::EpiGateSig, pg8::StaticOrder, true, true>(ring, g8, S8, E8); }
#endif
            pg8::Gemm g{(const bf16*)(ws + WS_XN), (const bf16*)(ws + WS_WIN), D, D, D}; pg8::StaticOrder S; S.init(T, F8_GATES ? 2304 : NPROJ, F.G, F.bx, D, D);
            pg8::EpiInProj E; E.ua = (bf16*)(ws + WS_UA); E.qkv = (bf16*)(ws + WS_QKV); E.uc = (bf16*)(ws + WS_UC); E.gate = (bf16*)(ws + WS_GATE);
            { LAS float* gl = (LAS float*)(F.lds + GAIN_OFF);
              if (F.tid < 256) { const int w = F.tid >> 6, d = F.tid & 63; const float* src = (w == 0) ? args.in[I_FQG] : (w == 1) ? args.in[I_FKG] : (w == 2) ? args.in[I_SQG] : args.in[I_SKG];
                  gl[F.tid] = src[layer * 64 + d] * ((w == 0 || w == 2) ? QSCALE : 1.0f); }
              __syncthreads(); E.gl = gl; }
            pg8::gemm_phase<pg8::EpiInProj, pg8::StaticOrder, true>(ring, g, S, E);
        }
        SEAM(1);
#endif
#if ON(2)
        if (IN(2)) for (int rep_ = 0; rep_ < REPS(2); ++rep_) { ENTER();
            { pg8::Gemm g{(const bf16*)(ws + WS_UA), (const bf16*)(ws + WS_WZ), 1024, S5_LDA, 1024};
              pg8::BatchOrder S; S.nM = 2; S.nN = 1; S.nZ = 16; S.G = F.G; S.c = F.bx; S.tA = (size_t)256 * S5_LDA * 2; S.tB = 0; S.zA = (size_t)512 * S5_LDA * 2; S.zB = (size_t)256 * 1024 * 2;
              pg8::EpiZ E; E.z = (float*)(ws + WS_Z);
              SUBREPS(106) { pg8::gemm_phase<pg8::EpiZ, pg8::BatchOrder, false>(ring, g, S, E);
              if (F.bx < 32) phase_s5_scan_unit(F, layer, F.bx >> 1, F.bx & 1); } }
            SUBREPS(103) phase_conv(F, layer);
            SUBREPS(102) phase_attn_sb(F, layer, rep_ + r2_);
        }
        SEAM(2);
#endif
#if ON(4)
        if (IN(4)) for (int rep_ = 0; rep_ < REPS(4); ++rep_) { ENTER();
            { pg8::Gemm g{(const bf16*)(ws + WS_UA), (const bf16*)(ws + WS_WY), S5_LDA, S5_LDA, S5_LDA};
              pg8::BatchOrder S; S.nM = 2; S.nN = 4; S.nZ = 16; S.G = F.G; S.c = F.bx; S.tA = (size_t)256 * S5_LDA * 2; S.tB = (size_t)256 * S5_LDA * 2; S.zA = (size_t)512 * S5_LDA * 2; S.zB = (size_t)1024 * S5_LDA * 2;
              pg8::EpiY E; E.ua = (const bf16*)(ws + WS_UA); E.dskip = args.in[I_S5D] + layer * 256; E.yp = (bf16*)(ws + WS_YP);
              SUBREPS(105) pg8::gemm_phase<pg8::EpiY, pg8::BatchOrder, false>(ring, g, S, E); }
            SUBREPS(104) phase_attn_fox(F, layer, rep_ + r2_);
        }
        SEAM(4);
#endif
#if ON(5)
        if (IN(5) && F.G != 256) for (int rep_ = 0; rep_ < REPS(5); ++rep_) { ENTER();
            pg8::Gemm g{(const bf16*)(ws + WS_YP), (const bf16*)(ws + WS_WGLU), 256, 256, 256};
            pg8::BatchOrder S; S.nM = T / 256; S.nN = 1; S.nZ = 1; S.G = F.G; S.c = F.bx; S.tA = (size_t)256 * 256 * 2; S.tB = 0; S.zA = 0; S.zB = 0;
            pg8::EpiGlu E; E.yp = (const bf16*)(ws + WS_YP); E.ycat = (bf16*)(ws + WS_YCAT);
            pg8::gemm_phase<pg8::EpiGlu, pg8::BatchOrder, false>(ring, g, S, E);
        }
        if (F.G != 256) SEAM(5);
#endif
#if ON(6)
        if (IN(6)) for (int rep_ = 0; rep_ < REPS(6); ++rep_) { ENTER();
            const int paired = (F.G == 256) ? 1 : 0;
            if (paired) {
                pg8::Gemm g{(const bf16*)(ws + WS_YP), (const bf16*)(ws + WS_WGLU), 256, 256, 256};
                pg8::OneUnit S; S.pm = F.vcu >> 1; S.tA = (size_t)256 * 256 * 2;
                pg8::EpiGlu E; E.yp = (const bf16*)(ws + WS_YP); E.ycat = (bf16*)(ws + WS_YCAT);
                pg8::gemm_phase<pg8::EpiGlu, pg8::OneUnit, false>(ring, g, S, E);
            }
            pg8::Gemm g{(const bf16*)(ws + WS_YCAT), (const bf16*)(ws + WS_WBR), 256, 1024, 256};
            pg8::BranchOrder1 S; S.nM = T / 256; S.nN = 8; S.G = F.G; S.c = F.bx; S.tA = (size_t)256 * 1024 * 2; S.tB = (size_t)128 * 256 * 2; S.zA = 256 * 2; S.zB = (size_t)1024 * 256 * 2; S.paired = paired; S.vc = F.vcu;
            pg8::EpiGate1 E; E.gate = (const bf16*)(ws + WS_GATE); E.mb = (bf16*)(ws + WS_XN);
            pg8::gemm_phase_n1<pg8::EpiGate1, pg8::BranchOrder1>(ring, g, S, E);
        }
        SEAM(6);
#endif
#if ON(7)
        if (IN(7)) for (int rep_ = 0; rep_ < REPS(7); ++rep_) { ENTER();
            pg8::Gemm g{(const bf16*)(ws + WS_XN), (const bf16*)(ws + WS_WOUT), D, D, D}; pg8::StaticOrder S; S.init(T, D, F.G, F.bx, D, D);
            pg8::EpiResid<false> E; E.base32 = args.in[I_X]; E.base16 = (const bf16*)(ws + WS_XB); E.out = (bf16*)(ws + WS_XB); E.ss = (float*)(ws + WS_SSP); E.out8 = ws + WS_XN8;
            E.flags = ((layer == 0) ? 1 : 0) | ((FUSE_DENSE_NORM && !moe) ? 2 : 0) | ((FUSE_DENSE_NORM && !moe && DENSE8(layer)) ? 4 : 0);
            pg8::gemm_phase<pg8::EpiResid<false>, pg8::StaticOrder, true>(ring, g, S, E);
        }
        SEAM(7);
#endif
#if ON(8)
        if (IN(8)) for (int rep_ = 0; rep_ < REPS(8); ++rep_) { ENTER(); if (moe || !FUSE_DENSE_NORM) phase_rows_ffn(F, layer); }
        if (moe || !FUSE_DENSE_NORM) SEAM(8);
#endif
#if ON(10)
        if (IN(10)) for (int rep_ = 0; rep_ < REPS(10); ++rep_) { ENTER();
            if (!moe) {
                if (DENSE8(layer)) {
                    constexpr int DQ = D / 2;
                    pg8::Gemm g{(const bf16*)(ws + (FUSE_DENSE_NORM ? WS_XN8 : WS_XN)), (const bf16*)(ws + WS_WUP), DQ, DQ, DQ}; pg8::StaticOrder S; S.init(T, 2 * FF, F.G, F.bx, DQ, DQ);
                    pg8::EpiSwiGlu<true> E; E.h = (bf16*)(ws + WS_HH); E.sc = 1.0f / 64.0f; E.ss = (const float*)(ws + WS_SSP); E.use_ss = FUSE_DENSE_NORM;
                    pg8::gemm_phase<pg8::EpiSwiGlu<true>, pg8::StaticOrder, true, true>(ring, g, S, E);
                } else {
                    pg8::Gemm g{(const bf16*)(ws + (FUSE_DENSE_NORM ? WS_XB : WS_XN)), (const bf16*)(ws + WS_WUP), D, D, D}; pg8::StaticOrder S; S.init(T, 2 * FF, F.G, F.bx, D, D);
                    pg8::EpiSwiGlu<false> E; E.h = (bf16*)(ws + WS_HH); E.sc = 1.0f; E.ss = (const float*)(ws + WS_SSP); E.use_ss = FUSE_DENSE_NORM;
                    pg8::gemm_phase<pg8::EpiSwiGlu<false>, pg8::StaticOrder, true, false>(ring, g, S, E);
                }
            } else {
                constexpr bool U8 = F8_MOE_UP != 0, H8 = F8_MOE_DN != 0; constexpr int DQ = U8 ? D / 2 : D;
                pg8::Gemm g{(const bf16*)(ws + WS_XNP), (const bf16*)(ws + WS_WUP), DQ, DQ, DQ};
                pg8::GroupOrder S; S.nN = 22; S.G = F.G; S.c = F.bx; S.tA = (size_t)256 * DQ * 2; S.tB = (size_t)256 * DQ * 2; S.zB = (size_t)5632 * DQ * 2; S.zA = (size_t)T * DQ * 2;
                int st[NE + 1]; moe_starts(F, layer >> 1, st);
#pragma unroll
                for (int e = 0; e <= NE; ++e) S.ts[e] = __builtin_amdgcn_readfirstlane(st[e] >> 8);
                pg8::EpiSwiGlu<H8> E; E.h = (bf16*)(ws + WS_HP); E.sc = U8 ? (1.0f / 64.0f) : 1.0f; E.ss = (const float*)(ws + WS_SSP); E.use_ss = 0;
                pg8::gemm_phase<pg8::EpiSwiGlu<H8>, pg8::GroupOrder, true, U8>(ring, g, S, E);
            }
        }
        SEAM(10);
#endif
#if ON(11)
        if (IN(11)) for (int rep_ = 0; rep_ < REPS(11); ++rep_) { ENTER();
            if (!moe) {
                if (DENSE8(layer)) {
                    constexpr int FQ = FF / 2;
                    pg8::Gemm g{(const bf16*)(ws + WS_HH), (const bf16*)(ws + WS_WDN), FQ, FQ, FQ}; pg8::StaticOrder S; S.init(T, D, F.G, F.bx, FQ, FQ);
                    pg8::EpiResid<true> E; E.base32 = args.in[I_X]; E.base16 = (const bf16*)(ws + WS_XB); E.out = (bf16*)(ws + WS_XB); E.ss = (float*)(ws + WS_SSP); E.out8 = ws + WS_XN8; E.flags = 0;
                    pg8::gemm_phase<pg8::EpiResid<true>, pg8::StaticOrder, true, true>(ring, g, S, E);
                } else {
                    pg8::Gemm g{(const bf16*)(ws + WS_HH), (const bf16*)(ws + WS_WDN), FF, FF, FF}; pg8::StaticOrder S; S.init(T, D, F.G, F.bx, FF, FF);
                    pg8::EpiResid<false> E; E.base32 = args.in[I_X]; E.base16 = (const bf16*)(ws + WS_XB); E.out = (bf16*)(ws + WS_XB); E.ss = (float*)(ws + WS_SSP); E.out8 = ws + WS_XN8; E.flags = 0;
                    pg8::gemm_phase<pg8::EpiResid<false>, pg8::StaticOrder, true, false>(ring, g, S, E);
                }
            } else {
                constexpr bool F8 = F8_MOE_DN != 0; constexpr int FQ = F8 ? FF / 2 : FF;
                pg8::Gemm g{(const bf16*)(ws + WS_HP), (const bf16*)(ws + WS_WDN), FQ, FQ, FQ};
                pg8::GroupOrder S; S.nN = 4; S.G = F.G; S.c = F.bx; S.tA = (size_t)256 * FQ * 2; S.tB = (size_t)256 * FQ * 2; S.zB = (size_t)D * FQ * 2; S.zA = 0;
                int st[NE + 1]; moe_starts(F, layer >> 1, st);
#pragma unroll
                for (int e = 0; e <= NE; ++e) S.ts[e] = __builtin_amdgcn_readfirstlane(st[e] >> 8);
                pg8::EpiStore E; E.o = (bf16*)(ws + WS_XNP); E.sc = F8 ? (1.0f / 64.0f) : 1.0f;
                pg8::gemm_phase<pg8::EpiStore, pg8::GroupOrder, true, F8>(ring, g, S, E);
            }
        }
        SEAM(11);
#endif
    }
#if ON(12)
    if (gp_lo <= GP_FINAL && GP_FINAL < gp_hi) phase_final_combine(F);
#undef gp_lo
#undef gp_hi
#endif
}

extern "C" void kernel_launch(void* const* d_in, const int* in_sizes, int n_in, void* d_out, int out_size, void* d_ws, size_t ws_size, hipStream_t stream) {
    static int grid = 0;
    if (grid == 0) {
        if (n_in != 32 || in_sizes[0] != T * D || out_size != T * D || ws_size < WS_END) { fprintf(stderr, "kernel_launch: unexpected shapes / workspace (n_in %d, ws %zu < %zu)\n", n_in, ws_size, (size_t)WS_END); grid = -1; return; }
        int dev = 0, cus = 0, per_cu = 0;
        if (hipGetDevice(&dev) != hipSuccess || hipDeviceGetAttribute(&cus, hipDeviceAttributeMultiprocessorCount, dev) != hipSuccess) { grid = -1; return; }
        if (hipFuncSetAttribute((const void*)mk_fwd, hipFuncAttributeMaxDynamicSharedMemorySize, LDS_BYTES) != hipSuccess) { grid = -1; return; }
        if (hipOccupancyMaxActiveBlocksPerMultiprocessor(&per_cu, (const void*)mk_fwd, NWAVES * 64, LDS_BYTES) != hipSuccess || per_cu < 1) fprintf(stderr, "kernel_launch: occupancy query says %d\n", per_cu);
        (void)hipGetLastError();
        grid = cus;
    }
    if (grid < 0) return;
    if (hipMemsetAsync((char*)d_ws + WS_CTL, 0, CTL_ZERO_BYTES, stream) != hipSuccess) return;
    Args a{};
    for (int i = 0; i < 32; ++i) a.in[i] = (const float*)d_in[i];
    a.out = (float*)d_out; a.ws = (unsigned char*)d_ws;
    a.gp_lo = 0; a.gp_hi = GP_TOTAL;
    hipLaunchKernelGGL(mk_fwd, dim3(grid), dim3(NWAVES * 64), LDS_BYTES, stream, a);
}
```
